# Optimizing an MI355X kernel written in HIP

```python
import math
import jax
import jax.numpy as jnp
from jax import lax
import numpy as np

D_MODEL = 2048
BATCH = 1
SEQ = 16384
DEPTH = 2

GRID_W = 64
CTX_LEN = 256
N_MOD = 6
NORM_EPS = 1e-6

CONV_DIM = D_MODEL // 2
MLA_HEADS = 8
MLA_NOPE = 128
MLA_ROPE = 64
MLA_V = 128
MLA_QK = MLA_NOPE + MLA_ROPE
MLA_Q_RANK = D_MODEL // 4
MLA_KV_RANK = D_MODEL // 8
ATTN_SCALE = MLA_QK ** -0.5
ROPE_AXIS = MLA_ROPE // 2
ROPE_THETA = 10000.0
Q_BLOCK = 128
GM_DIM = D_MODEL // 2
GM_GROUPS = 8
GM_CHUNK = 128
HY_DIM = D_MODEL // 2
HY_BANDS = 16
HY_EMB = 1 + 2 * HY_BANDS
HY_FFN = 64
HY_TARGET = 1e-2
HY_FAST = 0.3
HY_SLOW = 1.5
PEER_KEYS = 128
PEER_EXPERTS = PEER_KEYS * PEER_KEYS
PEER_HEADS = 8
PEER_TOPK = 16
PEER_QDIM = 256
PEER_HALF = PEER_QDIM // 2
PEER_BLOCK = 128

IN0_COLS = 3 * CONV_DIM + MLA_Q_RANK + MLA_KV_RANK + MLA_ROPE
IN1_COLS = 2 * GM_DIM + 3 * HY_DIM
MIX0_WIDTH = CONV_DIM + MLA_HEADS * MLA_V
MIX1_WIDTH = GM_DIM + HY_DIM

kernel_name = 'hybrid_diffusion_conv_mla_gmlp_hyena_peer'


def rmsnorm(x, g):
    xf = x.astype(jnp.float32)
    y = xf * lax.rsqrt(jnp.mean(xf * xf, axis=-1, keepdims=True) + NORM_EPS)
    return (y * g.astype(jnp.float32)).astype(x.dtype)


def modulate(h, shift, scale):
    return h * (1 + scale) + shift


def dwconv3(u, w, b=None):
    up = jnp.pad(u, ((0, 0), (1, 1), (0, 0)))
    y = up[:, :-2] * w[0] + up[:, 1:-1] * w[1] + up[:, 2:] * w[2]
    return y if b is None else y + b


def axial_rope_tables(n_rows):
    rr, cc = jnp.meshgrid(jnp.arange(n_rows), jnp.arange(GRID_W), indexing='ij')
    inv = ROPE_THETA ** (-jnp.arange(ROPE_AXIS // 2, dtype=jnp.float32) / (ROPE_AXIS // 2))
    ar = rr.reshape(-1, 1).astype(jnp.float32) * inv
    ac = cc.reshape(-1, 1).astype(jnp.float32) * inv
    ang = jnp.concatenate([ar, ar, ac, ac], axis=-1)
    return jnp.cos(ang), jnp.sin(ang)


def rope_2d(u, cos, sin):
    us = u.reshape(u.shape[:-1] + (2, 2, ROPE_AXIS // 2))
    rot = jnp.stack([-us[..., 1, :], us[..., 0, :]], axis=-2).reshape(u.shape)
    out = u * cos[None, :, None, :] + rot * sin[None, :, None, :]
    return out.astype(u.dtype)


def mla_keys_values(kv_c, k_r, kv_norm_g, w_ukv, rope=None):
    B, L, _ = kv_c.shape
    kv = (rmsnorm(kv_c, kv_norm_g) @ w_ukv).reshape(B, L, MLA_HEADS, MLA_NOPE + MLA_V)
    k_r = k_r[:, :, None, :]
    if rope is not None:
        k_r = rope_2d(k_r, *rope)
    k = jnp.concatenate([kv[..., :MLA_NOPE], jnp.broadcast_to(k_r, (B, L, MLA_HEADS, MLA_ROPE))], axis=-1)
    return k, kv[..., MLA_NOPE:]


def block_attention(q, k, v):
    B, L, H, _ = q.shape
    qb = q.reshape(B, L // Q_BLOCK, Q_BLOCK, H, MLA_QK).transpose(1, 0, 2, 3, 4)

    def one_block(qi):
        s = jnp.einsum('bqhd,bkhd->bhqk', qi, k, preferred_element_type=jnp.float32) * ATTN_SCALE
        p = jax.nn.softmax(s, axis=-1).astype(v.dtype)
        return jnp.einsum('bhqk,bkhd->bqhd', p, v)

    o = lax.map(one_block, qb)
    return o.transpose(1, 0, 2, 3, 4).reshape(B, L, H * MLA_V)


def mixer_conv_mla(h, hc, cos, sin, w_in, conv_w, q_norm_g, w_uq, kv_norm_g, w_ukv, w_out):
    B, L, _ = h.shape
    p = h @ w_in
    c0 = 3 * CONV_DIM
    gate_b, gate_c, hv = jnp.split(p[..., :c0], 3, axis=-1)
    y_conv = gate_b * dwconv3(gate_c * hv, conv_w)
    q_c = p[..., c0:c0 + MLA_Q_RANK]
    kv_c = p[..., c0 + MLA_Q_RANK:c0 + MLA_Q_RANK + MLA_KV_RANK]
    k_r = p[..., c0 + MLA_Q_RANK + MLA_KV_RANK:]
    q = (rmsnorm(q_c, q_norm_g) @ w_uq).reshape(B, L, MLA_HEADS, MLA_QK)
    q = jnp.concatenate([q[..., :MLA_NOPE], rope_2d(q[..., MLA_NOPE:], cos, sin)], axis=-1)
    k_lat, v_lat = mla_keys_values(kv_c, k_r, kv_norm_g, w_ukv, (cos, sin))
    pc = hc @ w_in[:, c0 + MLA_Q_RANK:]
    k_ctx, v_ctx = mla_keys_values(pc[..., :MLA_KV_RANK], pc[..., MLA_KV_RANK:], kv_norm_g, w_ukv)
    k = jnp.concatenate([k_ctx, k_lat], axis=1)
    v = jnp.concatenate([v_ctx, v_lat], axis=1)
    y_att = block_attention(q, k, v)
    return jnp.concatenate([y_conv, y_att], axis=-1) @ w_out


def hyena_filters(L, w1, b1, f1, w2, b2, f2, w3):
    f32 = jnp.float32
    t = jnp.linspace(0.0, 1.0, L, dtype=f32)[:, None]
    bands = jnp.linspace(1e-4, HY_BANDS - 1, HY_BANDS, dtype=f32)
    w = (2.0 * math.pi / L) * jnp.arange(L, dtype=f32)[:, None]
    z = jnp.concatenate([t, jnp.cos(bands * w), -jnp.sin(bands * w)], axis=-1)
    a = jnp.sin(f1.astype(f32) * (z @ w1.astype(f32) + b1.astype(f32)))
    a = jnp.sin(f2.astype(f32) * (a @ w2.astype(f32) + b2.astype(f32)))
    hf = a @ w3.astype(f32)
    deltas = jnp.abs(jnp.linspace(math.log(HY_TARGET) / HY_SLOW, math.log(HY_TARGET) / HY_FAST, HY_DIM, dtype=f32))
    decay = jnp.exp(-t * deltas)
    h_fwd = hf[:, :HY_DIM] * decay
    h_bwd = hf[:, HY_DIM:] * decay
    k = jnp.concatenate([h_fwd, jnp.zeros((1, HY_DIM), f32), h_bwd[:0:-1]], axis=0)
    return k / (jnp.sum(jnp.abs(k), axis=0, keepdims=True) + 1e-6)


def fft_long_conv(u, k):
    L = u.shape[1]
    uf = jnp.fft.rfft(u.astype(jnp.float32), n=2 * L, axis=1)
    kf = jnp.fft.rfft(k, n=2 * L, axis=0)
    y = jnp.fft.irfft(uf * kf[None], n=2 * L, axis=1)[:, :L]
    return y.astype(u.dtype)


def mixer_gmlp_hyena(h, w_in, gm_norm_g, gm_ws, gm_b, hy_conv_w, hy_conv_b, hy_w1, hy_b1, hy_f1,
                     hy_w2, hy_b2, hy_f2, hy_w3, hy_bias, w_out):
    B, L, _ = h.shape
    p = h @ w_in
    z = jax.nn.gelu(p[..., :2 * GM_DIM])
    u, v = jnp.split(z, 2, axis=-1)
    v = rmsnorm(v, gm_norm_g).reshape(B, L // GM_CHUNK, GM_CHUNK, GM_GROUPS, GM_DIM // GM_GROUPS)
    s = jnp.einsum('gpq,bnqgc->bnpgc', gm_ws, v) + gm_b.T[:, :, None]
    y_gm = u * s.reshape(B, L, GM_DIM)
    xs = dwconv3(p[..., 2 * GM_DIM:], hy_conv_w, hy_conv_b)
    x0, x1, hv = jnp.split(xs, 3, axis=-1)
    filt = hyena_filters(L, hy_w1, hy_b1, hy_f1, hy_w2, hy_b2, hy_f2, hy_w3)
    g1 = x1 * hv
    y_hy = x0 * (fft_long_conv(g1, filt) + hy_bias * g1)
    return jnp.concatenate([y_gm, y_hy], axis=-1) @ w_out


def peer(h, w_q, sub_keys, u_tab, v_tab):
    B, L, D = h.shape
    T = B * L
    hf = h.reshape(T, D)
    q = (hf @ w_q).reshape(T, PEER_HEADS, 2, PEER_HALF)
    s = jnp.einsum('thpd,pnd->thpn', q, sub_keys, preferred_element_type=jnp.float32)
    s_top, i_top = lax.top_k(s, PEER_TOPK)
    n_cand = PEER_TOPK * PEER_TOPK
    cand_s = (s_top[:, :, 0, :, None] + s_top[:, :, 1, None, :]).reshape(T, PEER_HEADS, n_cand)
    cand_i = (i_top[:, :, 0, :, None] * PEER_KEYS + i_top[:, :, 1, None, :]).reshape(T, PEER_HEADS, n_cand)
    best_s, best_pos = lax.top_k(cand_s, PEER_TOPK)
    idx = jnp.take_along_axis(cand_i, best_pos, axis=-1)
    gate = jax.nn.softmax(best_s, axis=-1)
    nb = T // PEER_BLOCK

    def one_block(args):
        xb, ib, gb = args
        a = jax.nn.gelu(jnp.einsum('phkd,pd->phk', u_tab[ib], xb, preferred_element_type=jnp.float32))
        return jnp.einsum('phk,phkd->pd', (gb * a).astype(xb.dtype), v_tab[ib])

    out = lax.map(one_block, (hf.reshape(nb, PEER_BLOCK, D),
                              idx.reshape(nb, PEER_BLOCK, PEER_HEADS, PEER_TOPK),
                              gate.reshape(nb, PEER_BLOCK, PEER_HEADS, PEER_TOPK)))
    return out.reshape(B, L, D)


def setup_inputs(seed: int = 0) -> dict:
    key = jax.random.key(seed)
    ks = iter(jax.random.split(key, 64))

    def nrm(shape, std):
        return jax.random.normal(next(ks), shape, jnp.float32) * std

    def gain(n):
        return 1.0 + nrm((n,), 0.02)

    D = D_MODEL
    out = {}
    out['x'] = nrm((BATCH, SEQ, D), 1.0)
    out['c'] = nrm((BATCH, D), 1.0)
    out['ctx'] = nrm((BATCH, CTX_LEN, D), 1.0)
    out['c_ctx'] = nrm((D,), 1.0)
    out['ln1_g0'] = gain(D)
    out['w_mod0'] = nrm((D, N_MOD * D), 0.5 * D ** -0.5)
    out['b_mod0'] = nrm((N_MOD * D,), 0.01)
    out['w_in0'] = nrm((D, IN0_COLS), D ** -0.5)
    out['conv_w0'] = nrm((3, CONV_DIM), 3 ** -0.5)
    out['q_norm_g0'] = gain(MLA_Q_RANK)
    out['w_uq0'] = nrm((MLA_Q_RANK, MLA_HEADS * MLA_QK), MLA_Q_RANK ** -0.5)
    out['kv_norm_g0'] = gain(MLA_KV_RANK)
    out['w_ukv0'] = nrm((MLA_KV_RANK, MLA_HEADS * (MLA_NOPE + MLA_V)), MLA_KV_RANK ** -0.5)
    out['w_out0'] = nrm((MIX0_WIDTH, D), MIX0_WIDTH ** -0.5)
    out['ln2_g0'] = gain(D)
    out['peer_wq0'] = nrm((D, PEER_HEADS * PEER_QDIM), D ** -0.5)
    out['peer_keys0'] = nrm((2, PEER_KEYS, PEER_HALF), PEER_HALF ** -0.5)
    out['peer_u0'] = nrm((PEER_EXPERTS, D), D ** -0.5)
    out['peer_v0'] = nrm((PEER_EXPERTS, D), 1.0)
    out['ln1_g1'] = gain(D)
    out['w_mod1'] = nrm((D, N_MOD * D), 0.5 * D ** -0.5)
    out['b_mod1'] = nrm((N_MOD * D,), 0.01)
    out['w_in1'] = nrm((D, IN1_COLS), D ** -0.5)
    out['gm_norm_g1'] = gain(GM_DIM)
    out['gm_ws1'] = nrm((GM_GROUPS, GM_CHUNK, GM_CHUNK), GM_CHUNK ** -0.5)
    out['gm_b1'] = 1.0 + nrm((GM_GROUPS, GM_CHUNK), 0.1)
    out['hy_conv_w1'] = nrm((3, 3 * HY_DIM), 3 ** -0.5)
    out['hy_conv_b1'] = nrm((3 * HY_DIM,), 0.01)
    out['hy_w1'] = nrm((HY_EMB, HY_FFN), HY_EMB ** -0.5)
    out['hy_b1'] = nrm((HY_FFN,), 0.01)
    out['hy_f1'] = 1.0 + nrm((HY_FFN,), 0.1)
    out['hy_w2'] = nrm((HY_FFN, HY_FFN), HY_FFN ** -0.5)
    out['hy_b2'] = nrm((HY_FFN,), 0.01)
    out['hy_f2'] = 1.0 + nrm((HY_FFN,), 0.1)
    out['hy_w3'] = nrm((HY_FFN, 2 * HY_DIM), HY_FFN ** -0.5)
    out['hy_bias1'] = nrm((HY_DIM,), 0.1)
    out['w_out1'] = nrm((MIX1_WIDTH, D), MIX1_WIDTH ** -0.5)
    out['ln2_g1'] = gain(D)
    out['peer_wq1'] = nrm((D, PEER_HEADS * PEER_QDIM), D ** -0.5)
    out['peer_keys1'] = nrm((2, PEER_KEYS, PEER_HALF), PEER_HALF ** -0.5)
    out['peer_u1'] = nrm((PEER_EXPERTS, D), D ** -0.5)
    out['peer_v1'] = nrm((PEER_EXPERTS, D), 1.0)
    out['final_g'] = gain(D)
    return out


def reference(x, c, ctx, c_ctx,
              ln1_g0, w_mod0, b_mod0, w_in0, conv_w0, q_norm_g0, w_uq0, kv_norm_g0, w_ukv0, w_out0,
              ln2_g0, peer_wq0, peer_keys0, peer_u0, peer_v0,
              ln1_g1, w_mod1, b_mod1, w_in1, gm_norm_g1, gm_ws1, gm_b1, hy_conv_w1, hy_conv_b1,
              hy_w1, hy_b1, hy_f1, hy_w2, hy_b2, hy_f2, hy_w3, hy_bias1, w_out1,
              ln2_g1, peer_wq1, peer_keys1, peer_u1, peer_v1, final_g):
    D = D_MODEL
    n_rows = x.shape[1] // GRID_W
    cos, sin = axial_rope_tables(n_rows)
    ln1 = (ln1_g0, ln1_g1)
    ln2 = (ln2_g0, ln2_g1)
    w_mod = (w_mod0, w_mod1)
    b_mod = (b_mod0, b_mod1)
    mixers = ((w_in0, conv_w0, q_norm_g0, w_uq0, kv_norm_g0, w_ukv0, w_out0),
              (w_in1, gm_norm_g1, gm_ws1, gm_b1, hy_conv_w1, hy_conv_b1, hy_w1, hy_b1, hy_f1,
               hy_w2, hy_b2, hy_f2, hy_w3, hy_bias1, w_out1))
    peers = ((peer_wq0, peer_keys0, peer_u0, peer_v0),
             (peer_wq1, peer_keys1, peer_u1, peer_v1))
    for i in range(DEPTH):
        mod = (jax.nn.silu(c) @ w_mod[i] + b_mod[i]).reshape(c.shape[0], N_MOD, 1, D)
        sh_m, sc_m, g_m, sh_f, sc_f, g_f = [mod[:, j] for j in range(N_MOD)]
        h = modulate(rmsnorm(x, ln1[i]), sh_m, sc_m)
        if i % 2 == 0:
            mc = jax.nn.silu(c_ctx) @ w_mod[i][:, :2 * D] + b_mod[i][:2 * D]
            hc = modulate(rmsnorm(ctx, ln1[i]), mc[:D], mc[D:])
            y = mixer_conv_mla(h, hc, cos, sin, *mixers[i])
        else:
            y = mixer_gmlp_hyena(h, *mixers[i])
        x = x + g_m * y
        x = x + g_f * peer(modulate(rmsnorm(x, ln2[i]), sh_f, sc_f), *peers[i])
    return rmsnorm(x, final_g)
```

```cpp
#include <hip/hip_runtime.h>
namespace pg8 {
#define PG8_LAS __attribute__((address_space(3)))
typedef unsigned short bf16_t;
typedef short bf16x8 __attribute__((ext_vector_type(8)));
typedef float f32x4 __attribute__((ext_vector_type(4)));
typedef unsigned u32x4 __attribute__((ext_vector_type(4)));
constexpr int BM = 256, BK = 64, HALF = 128, HTB = HALF * BK * 2  , STAGE_BYTES = 8 * HTB, NXCD = 8, WGM = 8;

__host__ __device__ __forceinline__ int lds_byte(int r, int c) { const int st = (r >> 4) * 2 + (c >> 5), rr = r & 15, cc = c & 31, ob = rr * 64 + cc * 2; return st * 1024 + (ob ^ (((ob >> 9) & 1) << 5)); }
__host__ __device__ __forceinline__ void stage_rc(int b, int& R, int& C) { const int st = b / 1024, sb = b % 1024, swz = sb ^ (((sb >> 9) & 1) << 5); R = (st >> 1) * 16 + swz / 64; C = (st & 1) * 32 + (swz % 64) / 2; }
__host__ __device__ __forceinline__ int perm32(int rho) { const int n = rho >> 4, i = rho & 15; return 8 * (i >> 2) + 4 * n + (i & 3); }

struct Unit { int pm, pn; };
struct Gemm { const bf16_t* A; const bf16_t* Bt; int M, N, K; };

struct StaticOrder {
    int nM, nN, nwg, G, c;
    __host__ __device__ void init(int M, int N, int G_, int c_) { nM = M / BM; nN = N / BM; nwg = nM * nN; G = G_; c = c_; }
    __host__ __device__ bool next(int i, Unit& u) const {
        const long L = (long)i * G + c; if (L >= nwg) return false;
        int wgid = (int)L; { const int q = nwg / NXCD, r = nwg % NXCD, xcd = wgid % NXCD, off = wgid / NXCD; wgid = (xcd < r ? xcd * (q + 1) : r * (q + 1) + (xcd - r) * q) + off; }
        const int nig = WGM * nN, gid = wgid / nig, fm = gid * WGM, gsz = (nM - fm) < WGM ? (nM - fm) : WGM;
        u.pm = fm + ((wgid % nig) % gsz); u.pn = (wgid % nig) / gsz; return true;
    }
    __device__ __forceinline__ void a_ready(const Unit&) const {}
    __device__ __forceinline__ void done(const Unit&) const {}
};
struct CountedOrder : StaticOrder {
    const unsigned* ready; unsigned need; unsigned* tmo;
    __device__ __forceinline__ void a_ready(const Unit& u) const {
        if (threadIdx.x < 64) {
            const unsigned long long t0 = __builtin_amdgcn_s_memrealtime(); unsigned polls = 0;
            while ((unsigned)__builtin_amdgcn_readfirstlane(__hip_atomic_load(ready + 64 * u.pm, __ATOMIC_RELAXED, __HIP_MEMORY_SCOPE_AGENT)) < need) {
                if ((++polls & 255u) == 0u && __builtin_amdgcn_readfirstlane(__hip_atomic_load(tmo, __ATOMIC_RELAXED, __HIP_MEMORY_SCOPE_AGENT)) != 0u) break;
                if (__builtin_amdgcn_s_memrealtime() - t0 > 2000000ull) {
                    if (threadIdx.x == 0) { unsigned expect = 0u; __hip_atomic_compare_exchange_strong(tmo + 1, &expect, 0x600u | (unsigned)(u.pm & 0xff), __ATOMIC_RELAXED, __ATOMIC_RELAXED, __HIP_MEMORY_SCOPE_AGENT); __hip_atomic_store(tmo, 1u, __ATOMIC_RELAXED, __HIP_MEMORY_SCOPE_AGENT); }
                    break; }
                __builtin_amdgcn_s_sleep(2); }
            __builtin_amdgcn_fence(__ATOMIC_ACQUIRE, "agent");
            asm volatile("s_waitcnt vmcnt(0)" ::: "memory");
        }
#if !defined(BROKEN_HOOK_NO_BARRIER)
        asm volatile("" ::: "memory"); __builtin_amdgcn_s_barrier(); asm volatile("" ::: "memory");
#endif
    }
};

__device__ __forceinline__ unsigned cvt_pk_bf16(float lo, float hi) { unsigned r; asm volatile("v_cvt_pk_bf16_f32 %0, %1, %2" : "=v"(r) : "v"(lo), "v"(hi)); return r; }
typedef float f32x2 __attribute__((ext_vector_type(2)));
__device__ __forceinline__ f32x2 gelu_pk(f32x2 v) {
    const f32x2 av = __builtin_elementwise_abs(v), d = av * 0.2316418882f + 1.0f;
    f32x2 t; t.x = __builtin_amdgcn_rcpf(d.x); t.y = __builtin_amdgcn_rcpf(d.y);
    f32x2 q = t * 0.5307027145f + (-0.7265760135f); q = q * t + 0.7107068705f; q = q * t + (-0.142248368f); q = q * t + 0.127414796f; q = q * t;
    const f32x2 s = (v * v) * (-0.72134752044f);
    f32x2 e; e.x = __builtin_amdgcn_exp2f(s.x); e.y = __builtin_amdgcn_exp2f(s.y);
    const f32x2 m = v * (q * e), r = v - m;
    f32x2 o; o.x = v.x < 0.f ? m.x : r.x; o.y = v.y < 0.f ? m.y : r.y; return o;
}

struct EpiF32 {
    static constexpr bool PERM = false, AFTER_DRAIN = false;
    float* C; int ldc; const float* bias;
    __device__ __forceinline__ void operator()(const f32x4 (&acc)[2][2][4][2], const Unit& u, int wr, int wc, int fr, int fq) const {
        const int row0 = u.pm * BM + wr * 64 + fr, col0 = u.pn * BM + wc * 32 + 4 * fq;
        f32x4 bv[2][2];
#pragma unroll
        for (int bj = 0; bj < 2; ++bj)
#pragma unroll
            for (int n = 0; n < 2; ++n) bv[bj][n] = bias ? *(const f32x4*)(bias + col0 + bj * HALF + n * 16) : (f32x4){0.f, 0.f, 0.f, 0.f};
#pragma unroll
        for (int ai = 0; ai < 2; ++ai)
#pragma unroll
            for (int m = 0; m < 4; ++m) { float* rowp = C + (size_t)(row0 + ai * HALF + m * 16) * ldc + col0;
#pragma unroll
                for (int bj = 0; bj < 2; ++bj)
#pragma unroll
                    for (int n = 0; n < 2; ++n) *(f32x4*)(rowp + bj * HALF + n * 16) = acc[ai][bj][m][n] + bv[bj][n]; }
    }
};
template <int ACT  > struct EpiBf16 {
    static constexpr bool PERM = true, AFTER_DRAIN = false;
    bf16_t* O; int ldc; const float* bias; int split_cols; size_t split_stride;
    __device__ __forceinline__ void operator()(const f32x4 (&acc)[2][2][4][2], const Unit& u, int wr, int wc, int fr, int fq) const {
        const int row0 = u.pm * BM + wr * 64 + fr; int colt = u.pn * BM; bf16_t* base = O;
        if (split_cols) { const int t = colt / split_cols; base += (size_t)t * split_stride; colt -= t * split_cols; }
        const int col0 = colt + wc * 32 + 8 * fq, bcol0 = u.pn * BM + wc * 32 + 8 * fq;
        f32x4 bv[2][2];
#pragma unroll
        for (int bj = 0; bj < 2; ++bj)
#pragma unroll
            for (int n = 0; n < 2; ++n) bv[bj][n] = bias ? *(const f32x4*)(bias + bcol0 + bj * HALF + 4 * n) : (f32x4){0.f, 0.f, 0.f, 0.f};
#pragma unroll
        for (int ai = 0; ai < 2; ++ai)
#pragma unroll
            for (int m = 0; m < 4; ++m) { bf16_t* rowp = base + (size_t)(row0 + ai * HALF + m * 16) * ldc + col0;
#pragma unroll
                for (int bj = 0; bj < 2; ++bj) { f32x4 v0 = acc[ai][bj][m][0] + bv[bj][0], v1 = acc[ai][bj][m][1] + bv[bj][1];
                    if (ACT == 1) { f32x2 a = gelu_pk((f32x2){v0[0], v0[1]}), b = gelu_pk((f32x2){v0[2], v0[3]}), c = gelu_pk((f32x2){v1[0], v1[1]}), d = gelu_pk((f32x2){v1[2], v1[3]});
                        v0 = (f32x4){a.x, a.y, b.x, b.y}; v1 = (f32x4){c.x, c.y, d.x, d.y}; }
                    if (ACT == 2) {
#pragma unroll
                        for (int j = 0; j < 4; ++j) { v0[j] = 0.5f * v0[j] * (1.0f + erff(v0[j] * 0.70710678f)); v1[j] = 0.5f * v1[j] * (1.0f + erff(v1[j] * 0.70710678f)); } }
                    u32x4 w; w.x = cvt_pk_bf16(v0[0], v0[1]); w.y = cvt_pk_bf16(v0[2], v0[3]); w.z = cvt_pk_bf16(v1[0], v1[1]); w.w = cvt_pk_bf16(v1[2], v1[3]);
                    *(u32x4*)(rowp + bj * HALF) = w; } }
    }
};

struct PanelStats {
    unsigned* xbuf;
    unsigned* cnt;
    unsigned* tmo;
    int ntn; float eps;
    unsigned code;
    __device__ __forceinline__ bool run(const f32x4 (&v)[2][2][4][2], const Unit& u, int wr, int wc, int fr, int fq, PG8_LAS unsigned char* lds, int wid, int lane) const {
        typedef float f32x2v __attribute__((ext_vector_type(2)));
        PG8_LAS f32x2v* P = (PG8_LAS f32x2v*)lds;
        PG8_LAS f32x2v* S = (PG8_LAS f32x2v*)(lds + 8192);
        PG8_LAS unsigned* flag = (PG8_LAS unsigned*)(lds + 8192 + 2048);
#pragma unroll
        for (int ai = 0; ai < 2; ++ai)
#pragma unroll
            for (int m = 0; m < 4; ++m) {
                float s = 0.f;
#pragma unroll
                for (int bj = 0; bj < 2; ++bj)
#pragma unroll
                    for (int n = 0; n < 2; ++n) { const f32x4 x = v[ai][bj][m][n]; s += (x[0] + x[1]) + (x[2] + x[3]); }
                s += __shfl_xor(s, 16); s += __shfl_xor(s, 32);
                const float mw = s * (1.0f / 64.0f); float q = 0.f;
#pragma unroll
                for (int bj = 0; bj < 2; ++bj)
#pragma unroll
                    for (int n = 0; n < 2; ++n) { const f32x4 d = v[ai][bj][m][n] - mw; q += (d[0] * d[0] + d[1] * d[1]) + (d[2] * d[2] + d[3] * d[3]); }
                q += __shfl_xor(q, 16); q += __shfl_xor(q, 32);
                if (fq == 0) P[(ai * HALF + wr * 64 + m * 16 + fr) * 4 + wc] = (f32x2v){mw, q};
            }
        asm volatile("s_waitcnt lgkmcnt(0)" ::: "memory"); __builtin_amdgcn_s_barrier(); asm volatile("" ::: "memory");
#if defined(BROKEN_NO_WAIT)
        if (blockIdx.x >= 64) { const long long t0 = clock64(); while (clock64() - t0 < 60000) __builtin_amdgcn_s_sleep(8); }
#endif
        const int row = wid * 32 + (lane & 31);
        if (lane < 32) {
            const f32x2v a = P[row * 4 + 0], b = P[row * 4 + 1], c = P[row * 4 + 2], d = P[row * 4 + 3];
            const float mt = (a.x + b.x + c.x + d.x) * 0.25f;
            const float da = a.x - mt, db = b.x - mt, dc = c.x - mt, dd = d.x - mt;
            const float m2 = (a.y + b.y) + (c.y + d.y) + 64.0f * ((da * da + db * db) + (dc * dc + dd * dd));
            unsigned long long* slot = (unsigned long long*)xbuf + ((size_t)(u.pm * BM + row) * 4 + u.pn);
            __hip_atomic_store(slot, ((unsigned long long)__float_as_uint(m2) << 32) | __float_as_uint(mt), __ATOMIC_RELAXED, __HIP_MEMORY_SCOPE_AGENT);
        }
        asm volatile("s_waitcnt vmcnt(0)" ::: "memory");
        if (lane == 0) __hip_atomic_fetch_add(cnt + 64 * u.pm, 1u, __ATOMIC_RELAXED, __HIP_MEMORY_SCOPE_AGENT);
        if (wid == 0) {
            bool dead = false; const unsigned long long t0 = __builtin_amdgcn_s_memrealtime(); const unsigned want = 8u * (unsigned)ntn;
            for (;;) {
#if defined(BROKEN_NO_WAIT)
                break;
#endif
                if ((unsigned)__builtin_amdgcn_readfirstlane(__hip_atomic_load(cnt + 64 * u.pm, __ATOMIC_RELAXED, __HIP_MEMORY_SCOPE_AGENT)) >= want) break;
                if (__builtin_amdgcn_s_memrealtime() - t0 > 2000000ull) {
                    if (lane == 0) { unsigned expect = 0u; __hip_atomic_compare_exchange_strong(tmo + 1, &expect, code | (unsigned)(u.pm & 0xff), __ATOMIC_RELAXED, __ATOMIC_RELAXED, __HIP_MEMORY_SCOPE_AGENT);
                                     __hip_atomic_store(tmo, 1u, __ATOMIC_RELAXED, __HIP_MEMORY_SCOPE_AGENT); }
                    dead = true; break; }
                __builtin_amdgcn_s_sleep(2);
            }
            __builtin_amdgcn_fence(__ATOMIC_ACQUIRE, "agent");
            if (lane == 0) flag[0] = dead ? 1u : 0u;
        }
        asm volatile("s_waitcnt vmcnt(0) lgkmcnt(0)" ::: "memory"); __builtin_amdgcn_s_barrier(); asm volatile("" ::: "memory");
        const bool bad = flag[0] != 0u;
        if (lane < 32) {
            const unsigned long long* slot = (const unsigned long long*)xbuf + (size_t)(u.pm * BM + row) * 4; float mt[4], m2[4]; float ms = 0.f;
#pragma unroll
            for (int t = 0; t < 4; ++t) { if (t < ntn) { const unsigned long long w = __hip_atomic_load(slot + t, __ATOMIC_RELAXED, __HIP_MEMORY_SCOPE_AGENT); mt[t] = __uint_as_float((unsigned)w); m2[t] = __uint_as_float((unsigned)(w >> 32)); } else { mt[t] = 0.f; m2[t] = 0.f; } ms += mt[t]; }
            const float mean = ms / (float)ntn; float q = 0.f;
#pragma unroll
            for (int t = 0; t < 4; ++t) if (t < ntn) { const float dm = mt[t] - mean; q += m2[t] + 256.0f * dm * dm; }
            S[row] = (f32x2v){mean, 1.0f / sqrtf(q / (256.0f * (float)ntn) + eps)};
        }
        asm volatile("s_waitcnt lgkmcnt(0)" ::: "memory"); __builtin_amdgcn_s_barrier(); asm volatile("" ::: "memory");
        return bad;
    }
};
struct EpiLnRes {
    static constexpr bool PERM = false, AFTER_DRAIN = true;
    const float* base; float* out; int ldc; const float* bias; PanelStats st; unsigned poison;
    __device__ __forceinline__ void refuse(size_t i0, size_t stride, int M, int N) const { const float q = __builtin_nanf(""); for (size_t i = i0; i < (size_t)M * N; i += stride) out[(i / N) * ldc + i % N] = q;
        if (i0 == 0) { unsigned expect = 0u; __hip_atomic_compare_exchange_strong(st.tmo + 1, &expect, 0x7f0u, __ATOMIC_RELAXED, __ATOMIC_RELAXED, __HIP_MEMORY_SCOPE_AGENT); __hip_atomic_store(st.tmo, 1u, __ATOMIC_RELAXED, __HIP_MEMORY_SCOPE_AGENT); } }
    __device__ __forceinline__ void fused(f32x4 (&acc)[2][2][4][2], const Unit& u, int wr, int wc, int fr, int fq, PG8_LAS unsigned char* lds, int wid, int lane) const {
        typedef float f32x2v __attribute__((ext_vector_type(2)));
        const PG8_LAS f32x2v* S = (const PG8_LAS f32x2v*)(lds + 8192);
        const int col0 = u.pn * BM + wc * 32 + 4 * fq;
#pragma unroll
        for (int bj = 0; bj < 2; ++bj)
#pragma unroll
            for (int n = 0; n < 2; ++n) { const f32x4 bv = bias ? *(const f32x4*)(bias + col0 + bj * HALF + n * 16) : (f32x4){0.f, 0.f, 0.f, 0.f};
#pragma unroll
                for (int ai = 0; ai < 2; ++ai)
#pragma unroll
                    for (int m = 0; m < 4; ++m) acc[ai][bj][m][n] += bv; }
        const bool bad = st.run(acc, u, wr, wc, fr, fq, lds, wid, lane) || poison != 0u;
        const float qnan = __builtin_nanf("");
#pragma unroll
        for (int ai = 0; ai < 2; ++ai)
#pragma unroll
            for (int m = 0; m < 4; ++m) { const int r = ai * HALF + wr * 64 + m * 16 + fr; const f32x2v sr = S[r]; const size_t off = (size_t)(u.pm * BM + r) * ldc + col0;
#pragma unroll
                for (int bj = 0; bj < 2; ++bj)
#pragma unroll
                    for (int n = 0; n < 2; ++n) { const f32x4 bs = *(const f32x4*)(base + off + bj * HALF + n * 16); f32x4 o = bs + (acc[ai][bj][m][n] - sr.x) * sr.y;
                        if (bad) o = (f32x4){qnan, qnan, qnan, qnan}; *(f32x4*)(out + off + bj * HALF + n * 16) = o; }
                asm volatile("" ::: "memory"); }
    }
};
struct EpiLnResLn {
    static constexpr bool PERM = false, AFTER_DRAIN = true;
    const float* base; float* out; bf16_t* xn; int ldc; const float* bias; PanelStats st1, st2; unsigned poison;
    __device__ __forceinline__ void refuse(size_t i0, size_t stride, int M, int N) const { const float q = __builtin_nanf(""); for (size_t i = i0; i < (size_t)M * N; i += stride) { const size_t o = (i / N) * ldc + i % N; out[o] = q; xn[o] = (bf16_t)0x7fc0u; }
        if (i0 == 0) { unsigned expect = 0u; __hip_atomic_compare_exchange_strong(st1.tmo + 1, &expect, 0x7f0u, __ATOMIC_RELAXED, __ATOMIC_RELAXED, __HIP_MEMORY_SCOPE_AGENT); __hip_atomic_store(st1.tmo, 1u, __ATOMIC_RELAXED, __HIP_MEMORY_SCOPE_AGENT); } }
    __device__ __forceinline__ void fused(f32x4 (&acc)[2][2][4][2], const Unit& u, int wr, int wc, int fr, int fq, PG8_LAS unsigned char* lds, int wid, int lane) const {
        typedef float f32x2v __attribute__((ext_vector_type(2))); typedef unsigned u32x2v __attribute__((ext_vector_type(2)));
        const PG8_LAS f32x2v* S = (const PG8_LAS f32x2v*)(lds + 8192);
        const int col0 = u.pn * BM + wc * 32 + 4 * fq;
#pragma unroll
        for (int bj = 0; bj < 2; ++bj)
#pragma unroll
            for (int n = 0; n < 2; ++n) { const f32x4 bv = bias ? *(const f32x4*)(bias + col0 + bj * HALF + n * 16) : (f32x4){0.f, 0.f, 0.f, 0.f};
#pragma unroll
                for (int ai = 0; ai < 2; ++ai)
#pragma unroll
                    for (int m = 0; m < 4; ++m) acc[ai][bj][m][n] += bv; }
        bool bad = st1.run(acc, u, wr, wc, fr, fq, lds, wid, lane) || poison != 0u;
        const float qnan = __builtin_nanf("");
#pragma unroll
        for (int ai = 0; ai < 2; ++ai)
#pragma unroll
            for (int m = 0; m < 4; ++m) { const int r = ai * HALF + wr * 64 + m * 16 + fr; const f32x2v sr = S[r]; const size_t off = (size_t)(u.pm * BM + r) * ldc + col0;
#pragma unroll
                for (int bj = 0; bj < 2; ++bj)
#pragma unroll
                    for (int n = 0; n < 2; ++n) { const f32x4 bs = *(const f32x4*)(base + off + bj * HALF + n * 16); acc[ai][bj][m][n] = bs + (acc[ai][bj][m][n] - sr.x) * sr.y; }
                asm volatile("" : "+v"(acc[ai][0][m][0]), "+v"(acc[ai][0][m][1]), "+v"(acc[ai][1][m][0]), "+v"(acc[ai][1][m][1]));
                if (m & 1) asm volatile("" ::: "memory"); }
        const bool bad1 = bad;
        bad = st2.run(acc, u, wr, wc, fr, fq, lds, wid, lane) || bad;
#pragma unroll
        for (int ai = 0; ai < 2; ++ai)
#pragma unroll
            for (int m = 0; m < 4; ++m) { const int r = ai * HALF + wr * 64 + m * 16 + fr; const f32x2v sr = S[r]; const size_t off = (size_t)(u.pm * BM + r) * ldc + col0;
#pragma unroll
                for (int bj = 0; bj < 2; ++bj)
#pragma unroll
                    for (int n = 0; n < 2; ++n) { const f32x4 x1 = acc[ai][bj][m][n]; *(f32x4*)(out + off + bj * HALF + n * 16) = bad1 ? (f32x4){qnan, qnan, qnan, qnan} : x1;
                        const f32x4 o = (x1 - sr.x) * sr.y; u32x2v w; w.x = cvt_pk_bf16(o[0], o[1]); w.y = cvt_pk_bf16(o[2], o[3]);
                        if (bad) { w.x = 0x7fc07fc0u; w.y = 0x7fc07fc0u; } *(u32x2v*)(xn + off + bj * HALF + n * 16) = w; }
                asm volatile("" ::: "memory"); }
    }
};

template <class Epi, class Sched, bool STAMP = false>
__device__ __forceinline__ void gemm_phase(PG8_LAS unsigned char* lds, const Gemm g, const Sched& S, const Epi& E, unsigned long long* stamps) {
    const int tid = threadIdx.x, wid = __builtin_amdgcn_readfirstlane(tid >> 6), lane = tid & 63, wr = wid >> 2, wc = wid & 3, fr = lane & 15, fq = lane >> 4;
    const int K = g.K, nt = K / BK;
    int ts_lo = 0, ts_hi = 0, nts = 0; const unsigned long long rt_entry = STAMP ? (unsigned long long)wall_clock64() : 0ull;
#define PG8_STAMP() do { if (STAMP && wid == 0 && nts < 64) { const unsigned long long _c = (unsigned long long)clock64(); \
        ts_lo = (lane == nts) ? (int)(unsigned)_c : ts_lo; ts_hi = (lane == nts) ? (int)(unsigned)(_c >> 32) : ts_hi; ++nts; } } while (0)
    PG8_STAMP();
    unsigned voffA[2], voffB[2];
#pragma unroll
    for (int i = 0; i < 2; ++i) { int R, C; stage_rc(tid * 16 + i * 8192, R, C); const int Rb = Epi::PERM ? ((R & ~31) + perm32(R & 31)) : R;
        voffA[i] = (unsigned)(R * K + C) * 2u; voffB[i] = (unsigned)(Rb * K + C) * 2u; }
    const size_t kstep = (size_t)(BK * 2);
    const size_t hstep = (size_t)HALF * K * 2;
    const size_t tstep = 2 * hstep;
    const unsigned ldsw = (unsigned)wid * 1024u;
    const int aoff = lds_byte(wr * 64 + fr, fq * 8), boff = lds_byte(wc * 32 + fr, fq * 8);
#define PG8_SA(b, h) (((b) * 2 + (h)) * HTB)
#define PG8_SB(b, h) ((4 + (b) * 2 + (h)) * HTB)
#define PG8_STAGE(bufoff, gbase, voff) do { _Pragma("unroll") for (int _i = 0; _i < 2; ++_i) \
        __builtin_amdgcn_global_load_lds((const unsigned*)((const char*)(gbase) + (voff)[_i]), (PG8_LAS unsigned*)(lds + (bufoff) + ldsw + _i * 8192), 16, 0, 0); } while (0)
#define PG8_LDA(dst, b, h) do { _Pragma("unroll") for (int m = 0; m < 4; ++m) _Pragma("unroll") for (int k = 0; k < 2; ++k) dst[m][k] = *(const PG8_LAS bf16x8*)(lds + PG8_SA(b, h) + aoff + m * 2048 + k * 1024); } while (0)
#define PG8_LDB(dst, b, h) do { _Pragma("unroll") for (int n = 0; n < 2; ++n) _Pragma("unroll") for (int k = 0; k < 2; ++k) dst[n][k] = *(const PG8_LAS bf16x8*)(lds + PG8_SB(b, h) + boff + n * 2048 + k * 1024); } while (0)
#define PG8_MMA(ai, bj, At, Bt) do { __builtin_amdgcn_s_setprio(1); _Pragma("unroll") for (int m = 0; m < 4; ++m) _Pragma("unroll") for (int n = 0; n < 2; ++n) _Pragma("unroll") for (int k = 0; k < 2; ++k) \
        acc[ai][bj][m][n] = __builtin_amdgcn_mfma_f32_16x16x32_bf16(Bt[n][k], At[m][k], acc[ai][bj][m][n], 0, 0, 0); __builtin_amdgcn_s_setprio(0); } while (0)
#define PG8_WAIT_V(n) asm volatile("s_waitcnt vmcnt(" #n ")" ::: "memory")
#define PG8_WAIT_L(n) asm volatile("s_waitcnt lgkmcnt(" #n ")" ::: "memory")
#define PG8_BAR __builtin_amdgcn_s_barrier()
#define PG8_SCHED __builtin_amdgcn_sched_barrier(0)
    Unit cur, nxt; int ui = 0;
    if (!S.next(0, cur)) return;
    f32x4 acc[2][2][4][2];
#pragma unroll
    for (int a = 0; a < 2; ++a)
#pragma unroll
        for (int b = 0; b < 2; ++b)
#pragma unroll
            for (int m = 0; m < 4; ++m)
#pragma unroll
                for (int n = 0; n < 2; ++n) acc[a][b][m][n] = (f32x4){0.f, 0.f, 0.f, 0.f};
    bf16x8 At[4][2], B0[2][2], B1[2][2];
    const char* cA = (const char*)g.A + (size_t)cur.pm * tstep; const char* cB = (const char*)g.Bt + (size_t)cur.pn * tstep;
    S.a_ready(cur);
    PG8_STAGE(PG8_SB(0, 0), cB, voffB); PG8_STAGE(PG8_SA(0, 0), cA, voffA); PG8_STAGE(PG8_SB(0, 1), cB + hstep, voffB); PG8_STAGE(PG8_SA(0, 1), cA + hstep, voffA);
    if (wr == 1) PG8_BAR;
    PG8_WAIT_V(4); PG8_BAR;
    PG8_STAGE(PG8_SB(1, 0), cB + kstep, voffB); PG8_STAGE(PG8_SA(1, 0), cA + kstep, voffA); PG8_STAGE(PG8_SB(1, 1), cB + hstep + kstep, voffB);
    PG8_WAIT_V(6); PG8_BAR;
    PG8_STAMP();
    for (;;) {
        const bool has_next = S.next(ui + 1, nxt);
        const char* nA = has_next ? (const char*)g.A + (size_t)nxt.pm * tstep : cA; const char* nB = has_next ? (const char*)g.Bt + (size_t)nxt.pn * tstep : cB;
        for (int t = 0; t < nt; t += 2) {
            const bool last = (t == nt - 2);
            const char* a1 = cA + (size_t)(t + 1) * kstep;
            const char* a2 = last ? nA : cA + (size_t)(t + 2) * kstep; const char* b2 = last ? nB : cB + (size_t)(t + 2) * kstep;
            const char* a3 = a2 + kstep; const char* b3 = b2 + kstep;
            if (last && has_next) S.a_ready(nxt);
            PG8_LDB(B0, 0, 0); PG8_SCHED; PG8_LDA(At, 0, 0); PG8_STAGE(PG8_SA(1, 1), a1 + hstep, voffA);
            PG8_WAIT_L(8); PG8_BAR; PG8_WAIT_L(0); PG8_MMA(0, 0, At, B0); PG8_BAR; PG8_SCHED;
            PG8_LDB(B1, 0, 1); PG8_STAGE(PG8_SB(0, 0), b2, voffB);
            PG8_BAR; PG8_WAIT_L(0); PG8_MMA(0, 1, At, B1); PG8_BAR;
            PG8_LDA(At, 0, 1); PG8_STAGE(PG8_SA(0, 0), a2, voffA);
            PG8_BAR; PG8_WAIT_L(0); PG8_MMA(1, 0, At, B0); PG8_BAR; PG8_SCHED;
            PG8_STAGE(PG8_SB(0, 1), b2 + hstep, voffB);
            PG8_WAIT_V(6); PG8_BAR; PG8_MMA(1, 1, At, B1); PG8_BAR;
            PG8_LDB(B0, 1, 0); PG8_SCHED; PG8_LDA(At, 1, 0); PG8_STAGE(PG8_SA(0, 1), a2 + hstep, voffA);
            PG8_WAIT_L(8); PG8_BAR; PG8_WAIT_L(0); PG8_MMA(0, 0, At, B0); PG8_BAR; PG8_SCHED;
            PG8_LDB(B1, 1, 1); PG8_STAGE(PG8_SB(1, 0), b3, voffB);
            PG8_BAR; PG8_WAIT_L(0); PG8_MMA(0, 1, At, B1); PG8_BAR;
            PG8_LDA(At, 1, 1); PG8_STAGE(PG8_SA(1, 0), a3, voffA);
            PG8_BAR; PG8_WAIT_L(0); PG8_MMA(1, 0, At, B0); PG8_BAR; PG8_SCHED;
            PG8_STAGE(PG8_SB(1, 1), b3 + hstep, voffB);
            PG8_WAIT_V(6); PG8_BAR; PG8_MMA(1, 1, At, B1); PG8_BAR;
        }
        PG8_STAMP();
        if constexpr (!Epi::AFTER_DRAIN) { E(acc, cur, wr, wc, fr, fq); S.done(cur); }
        PG8_STAMP();
        if (!has_next) break;
#pragma unroll
        for (int a = 0; a < 2; ++a)
#pragma unroll
            for (int b = 0; b < 2; ++b)
#pragma unroll
                for (int m = 0; m < 4; ++m)
#pragma unroll
                    for (int n = 0; n < 2; ++n) acc[a][b][m][n] = (f32x4){0.f, 0.f, 0.f, 0.f};
        cur = nxt; cA = nA; cB = nB; ++ui;
    }
    PG8_WAIT_V(0);
    if (wr == 0) PG8_BAR;
    PG8_BAR;
    if constexpr (Epi::AFTER_DRAIN) { E.fused(acc, cur, wr, wc, fr, fq, lds, wid, lane); S.done(cur); }
    PG8_STAMP();
    if (STAMP && wid == 0) { stamps[lane] = lane < nts ? (((unsigned long long)(unsigned)ts_hi << 32) | (unsigned)ts_lo) : 0ull;
        if (lane == 62) stamps[62] = rt_entry; if (lane == 63) stamps[63] = (unsigned long long)wall_clock64(); }
#undef PG8_STAMP
#undef PG8_SA
#undef PG8_SB
#undef PG8_STAGE
#undef PG8_LDA
#undef PG8_LDB
#undef PG8_MMA
#undef PG8_WAIT_V
#undef PG8_WAIT_L
#undef PG8_BAR
#undef PG8_SCHED
}
}

#define LAS __attribute__((address_space(3)))
typedef unsigned short bf16_t;
typedef short bf16x8 __attribute__((ext_vector_type(8)));
typedef short s16x4 __attribute__((ext_vector_type(4)));
typedef float f32x4 __attribute__((ext_vector_type(4)));
typedef float f32x2 __attribute__((ext_vector_type(2)));
typedef float f32x16 __attribute__((ext_vector_type(16)));
typedef unsigned u32x4 __attribute__((ext_vector_type(4)));
typedef unsigned u32x2 __attribute__((ext_vector_type(2)));
typedef __bf16 bf2_t __attribute__((ext_vector_type(2)));

constexpr int SEQ = 16384, DM = 2048, CTXL = 256, NKEY = SEQ + CTXL;
constexpr int NTHR = 512;
constexpr int LDS_BYTES = 163840;
constexpr int LDS_CTL = LDS_BYTES - 256;

__device__ __forceinline__ float wave_sum(float v) {
#pragma unroll
    for (int o = 32; o >= 1; o >>= 1) v += __shfl_xor(v, o);
    return v;
}
__device__ __forceinline__ unsigned pk_bf16(float lo, float hi) { unsigned r; asm volatile("v_cvt_pk_bf16_f32 %0, %1, %2" : "=v"(r) : "v"(lo), "v"(hi)); return r; }
__device__ __forceinline__ float bf_lo(unsigned w) { return __uint_as_float(w << 16); }
__device__ __forceinline__ float bf_hi(unsigned w) { return __uint_as_float(w & 0xffff0000u); }
__device__ __forceinline__ float bf1(bf16_t h) { return __uint_as_float(((unsigned)h) << 16); }
__device__ __forceinline__ bf16_t f2bf(float f) { return (bf16_t)(pk_bf16(f, 0.f) & 0xffffu); }
__device__ __forceinline__ float gelu_tanh(float x) {
    const float u = 1.5957691216057308f * (x + 0.044715f * x * x * x);
    return x / (1.f + __expf(-u));
}
__device__ __forceinline__ float silu_f(float v) { return v / (1.f + __expf(-v)); }
__device__ __forceinline__ float dot2bf(unsigned a, unsigned b, float c) { return __builtin_amdgcn_fdot2_f32_bf16(*(bf2_t*)&a, *(bf2_t*)&b, c, false); }

#define XB_TMO      128
#define XB_XCNT(j)  (256  + 64 * (j))
#define XB_XSUB(j)  (1280 + 64 * (j))
#define XB_XGEN(j)  (2304 + 64 * (j))
#define XB_TOP      3328
#define XB_TOPGEN   3392
#define XCD_BAR_WORDS 3456
#define XB_SPIN_CAP (1u << 22)
__device__ __forceinline__ unsigned xb_ld(unsigned* p)              { return __hip_atomic_load(p, __ATOMIC_RELAXED, __HIP_MEMORY_SCOPE_AGENT); }
__device__ __forceinline__ unsigned xb_add(unsigned* p, unsigned v) { return __hip_atomic_fetch_add(p, v, __ATOMIC_RELAXED, __HIP_MEMORY_SCOPE_AGENT); }
__device__ __forceinline__ unsigned xb_xcc_id() { return (unsigned)__builtin_amdgcn_s_getreg((3 << 11) | 20) & 0xFu; }
#define XB_SPIN(cond, bar) do { unsigned _sp = 0; while (cond) { __builtin_amdgcn_s_sleep(1); \
    if ((++_sp & 255u) == 0u) { if (xb_ld(&(bar)[XB_TMO])) break; if (_sp > XB_SPIN_CAP) { atomicAdd(&(bar)[XB_TMO], 1u); break; } } } } while (0)
struct XcdBarrier { unsigned* bar; unsigned x; volatile LAS unsigned* st; };
__device__ __forceinline__ XcdBarrier xcd_barrier_post(unsigned* bar, volatile LAS unsigned* st) {
    XcdBarrier b; b.bar = bar; b.x = xb_xcc_id(); b.st = st;
    if (threadIdx.x == 0) (void)xb_add(&bar[XB_XCNT(b.x)], 1u);
    return b;
}
__device__ __forceinline__ void xcd_barrier_complete(unsigned* bar, unsigned x, unsigned& nloc, unsigned& nx) {
    const unsigned G = gridDim.x * gridDim.y * gridDim.z;
    unsigned sum, cnt, mine, sp = 0u;
    for (;;) {
        sum = 0u; cnt = 0u; mine = 0u;
#pragma unroll
        for (unsigned j = 0; j < 16; ++j) { const unsigned c = xb_ld(&bar[XB_XCNT(j)]); sum += c; cnt += (c > 0u) ? 1u : 0u; mine = (j == x) ? c : mine; }
        if (sum == G) break;
        __builtin_amdgcn_s_sleep(1);
        if ((++sp & 255u) == 0u) { if (xb_ld(&bar[XB_TMO])) break; if (sp > XB_SPIN_CAP) { atomicAdd(&bar[XB_TMO], 1u); break; } }
    }
    nloc = mine > 0u ? mine : 1u; nx = cnt > 0u ? cnt : 1u;
}
__device__ __forceinline__ void xcd_barrier(const XcdBarrier& b) {
    asm volatile("s_waitcnt vmcnt(0)" ::: "memory");
    __syncthreads();
    if (threadIdx.x == 0) {
        unsigned* bar = b.bar;
        __builtin_amdgcn_s_waitcnt(0);
        unsigned nloc = b.st[0], nx = b.st[1];
        if (nloc == 0u) { xcd_barrier_complete(bar, b.x, nloc, nx); b.st[0] = nloc; b.st[1] = nx; }
        const unsigned old = xb_add(&bar[XB_XSUB(b.x)], 1u);
        const unsigned gen = old / nloc;
        if (old + 1u == (gen + 1u) * nloc) {
            __builtin_amdgcn_fence(__ATOMIC_RELEASE, "agent");
            asm volatile("s_waitcnt vmcnt(0)" ::: "memory");
            const unsigned og = xb_add(&bar[XB_TOP], 1u);
            const unsigned tg = og / nx;
            if (og + 1u == (tg + 1u) * nx) xb_add(&bar[XB_TOPGEN], 1u);
            else XB_SPIN(xb_ld(&bar[XB_TOPGEN]) == tg, bar);
            __builtin_amdgcn_fence(__ATOMIC_ACQUIRE, "agent");
            xb_add(&bar[XB_XGEN(b.x)], 1u);
            asm volatile("s_waitcnt vmcnt(0)" ::: "memory");
        } else {
            XB_SPIN(xb_ld(&bar[XB_XGEN(b.x)]) == gen, bar);
            __builtin_amdgcn_fence(__ATOMIC_ACQUIRE, "agent");
            asm volatile("s_waitcnt vmcnt(0)" ::: "memory");
        }
    }
    __syncthreads();
}

constexpr size_t WS_CTL   = 0;
constexpr size_t WS_MOD0  = 65536;
constexpr size_t WS_MOD1  = WS_MOD0 + 49152;
constexpr size_t WS_MC0   = WS_MOD1 + 49152;
constexpr size_t WS_ROPEC = WS_MC0 + 16384;
constexpr size_t WS_ROPES = WS_ROPEC + 2097152;
constexpr size_t WS_FPART = WS_ROPES + 2097152;
constexpr size_t WS_FNORM = WS_FPART + 4194304;
constexpr size_t WS_KEYS0 = WS_FNORM + 4096;
constexpr size_t WS_KEYS1 = WS_KEYS0 + 65536;
constexpr size_t WS_GMWS  = WS_KEYS1 + 65536;
constexpr size_t WS_WIN0  = WS_GMWS + 262144;
constexpr size_t WS_WUQ   = WS_WIN0 + (size_t)4096 * 2048 * 2;
constexpr size_t WS_WUKV  = WS_WUQ + (size_t)1536 * 512 * 2;
constexpr size_t WS_WOUT0 = WS_WUKV + (size_t)2048 * 256 * 2;
constexpr size_t WS_WPQ0  = WS_WOUT0 + (size_t)2048 * 2048 * 2;
constexpr size_t WS_WIN1  = WS_WPQ0 + (size_t)2048 * 2048 * 2;
constexpr size_t WS_WOUT1 = WS_WIN1 + (size_t)5120 * 2048 * 2;
constexpr size_t WS_WPQ1  = WS_WOUT1 + (size_t)2048 * 2048 * 2;
constexpr size_t WS_TABU  = WS_WPQ1 + (size_t)2048 * 2048 * 2;
constexpr size_t WS_TABV  = WS_TABU + (size_t)16384 * 2048 * 2;
constexpr size_t WS_XR    = WS_TABV + (size_t)16384 * 2048 * 2;
constexpr size_t WS_H     = WS_XR + (size_t)16384 * 2048 * 4;
constexpr size_t WS_PBUF  = WS_H + (size_t)NKEY * 2048 * 2;
constexpr size_t WS_L0X   = WS_PBUF + (size_t)16384 * 5120 * 2;
constexpr size_t WS_QN    = WS_L0X;
constexpr size_t WS_KVN   = WS_QN + (size_t)16384 * 512 * 2;
constexpr size_t WS_KROPE = WS_KVN + (size_t)NKEY * 256 * 2;
constexpr size_t WS_Q     = WS_KROPE + (size_t)NKEY * 64 * 2;
constexpr size_t WS_KV    = WS_Q + (size_t)16384 * 1536 * 2;
constexpr size_t WS_L0END = WS_KV + (size_t)NKEY * 2048 * 2;
constexpr size_t WS_Z     = WS_L0X;
static_assert(WS_L0END - WS_L0X >= (size_t)32768 * 1024 * 4, "Z alias");
static_assert((size_t)NKEY * 4096 * 2 <= (size_t)16384 * 5120 * 2, "PBUF");
constexpr size_t WS_YCAT  = WS_L0END;
constexpr size_t WS_KZ    = WS_YCAT + (size_t)16384 * 2048 * 2;
constexpr size_t WS_END   = WS_KZ + (size_t)32768 * 1024 * 4;
constexpr size_t WS_G1B   = WS_H;
constexpr size_t WS_X0B   = WS_H + (size_t)16384 * 1024 * 2;
static_assert(WS_END < (size_t)1000000000, "workspace budget");

struct Params { const float* in[43]; float* out; unsigned char* ws; int ph_lo, ph_hi; };
struct Fr { const float* const* in; float* out; unsigned char* ws; LAS unsigned char* lds; int tid, lane, wave, G, bid; };

enum { I_X = 0, I_C, I_CTX, I_CCTX, I_LN1G0, I_WMOD0, I_BMOD0, I_WIN0, I_CONVW0, I_QNG0, I_WUQ0, I_KVNG0, I_WUKV0, I_WOUT0, I_LN2G0, I_PWQ0, I_PKEYS0, I_PU0, I_PV0,
       I_LN1G1, I_WMOD1, I_BMOD1, I_WIN1, I_GMNG1, I_GMWS1, I_GMB1, I_HYCW1, I_HYCB1, I_HYW1, I_HYB1, I_HYF1, I_HYW2, I_HYB2, I_HYF2, I_HYW3, I_HYBIAS1, I_WOUT1, I_LN2G1, I_PWQ1, I_PKEYS1, I_PU1, I_PV1, I_FINALG };

__device__ __forceinline__ void tconv_task(const Fr& F, const float* W, int K, int N, int Npad, bf16_t* Bt) {
    LAS float* tile = (LAS float*)F.lds;
    const int tn = Npad / 64, tk = K / 64;
    for (int t = F.bid; t < tn * tk; t += F.G) {
        const int n0 = (t % tn) * 64, k0 = (t / tn) * 64;
        const int i = F.tid >> 3, jq = F.tid & 7;
        f32x4 a = {0.f, 0.f, 0.f, 0.f}, b = {0.f, 0.f, 0.f, 0.f};
        if (n0 < N) { const float* p = W + (size_t)(k0 + i) * N + n0 + jq * 8; a = *(const f32x4*)p; b = *(const f32x4*)(p + 4); }
        __syncthreads();
#pragma unroll
        for (int e = 0; e < 4; ++e) { tile[i * 65 + jq * 8 + e] = a[e]; tile[i * 65 + jq * 8 + 4 + e] = b[e]; }
        __syncthreads();
        const int j = F.tid >> 3, ic = F.tid & 7;
        float v[8];
#pragma unroll
        for (int e = 0; e < 8; ++e) v[e] = tile[(ic * 8 + e) * 65 + j];
        u32x4 w; w.x = pk_bf16(v[0], v[1]); w.y = pk_bf16(v[2], v[3]); w.z = pk_bf16(v[4], v[5]); w.w = pk_bf16(v[6], v[7]);
        *(u32x4*)(Bt + (size_t)(n0 + j) * K + k0 + ic * 8) = w;
    }
    __syncthreads();
}
__device__ __forceinline__ void cvt_task(const Fr& F, const float* src, bf16_t* dst, size_t n8) {
    for (size_t i = (size_t)F.bid * NTHR + F.tid; i < n8; i += (size_t)F.G * NTHR) {
        const f32x4 a = *(const f32x4*)(src + i * 8), b = *(const f32x4*)(src + i * 8 + 4);
        u32x4 w; w.x = pk_bf16(a[0], a[1]); w.y = pk_bf16(a[2], a[3]); w.z = pk_bf16(b[0], b[1]); w.w = pk_bf16(b[2], b[3]);
        *(u32x4*)(dst + i * 8) = w;
    }
}
__device__ __forceinline__ void modgemv(const Fr& F, const float* c, const float* c2, const float* W, const float* b, float* out, float* out2, int ncol2) {
    LAS float* s1 = (LAS float*)F.lds;
    LAS float* s2 = s1 + 2048;
    LAS float* red = s2 + 2048;
    LAS float* red2 = red + 42 * 48;
    __syncthreads();
    for (int k = F.tid; k < 2048; k += NTHR) { s1[k] = silu_f(c[k]); s2[k] = c2 ? silu_f(c2[k]) : 0.f; }
    __syncthreads();
    for (int chunk = F.bid; chunk < 256; chunk += F.G) {
        const int col0 = chunk * 48, cq = F.tid % 12, kl = F.tid / 12;
        const bool do2 = (c2 != nullptr) && (col0 < ncol2);
        if (kl < 42) {
            f32x4 a1 = {0.f, 0.f, 0.f, 0.f}, a2 = {0.f, 0.f, 0.f, 0.f};
            const float* wp = W + col0 + cq * 4;
#pragma unroll 4
            for (int k = kl; k < 2048; k += 42) { const f32x4 w = *(const f32x4*)(wp + (size_t)k * 12288); a1 += s1[k] * w; a2 += s2[k] * w; }
#pragma unroll
            for (int e = 0; e < 4; ++e) { red[kl * 48 + cq * 4 + e] = a1[e]; red2[kl * 48 + cq * 4 + e] = a2[e]; }
        }
        __syncthreads();
        if (F.tid < 48) {
            float r1 = 0.f, r2 = 0.f;
            for (int q = 0; q < 42; ++q) { r1 += red[q * 48 + F.tid]; r2 += red2[q * 48 + F.tid]; }
            const float bb = b[col0 + F.tid];
            out[col0 + F.tid] = r1 + bb;
            if (do2 && col0 + F.tid < ncol2) out2[col0 + F.tid] = r2 + bb;
        }
        __syncthreads();
    }
}
__device__ __forceinline__ void rope_tables(const Fr& F, float* rc, float* rs) {
    for (int it = F.bid * NTHR + F.tid; it < SEQ * 32; it += F.G * NTHR) {
        const int t = it >> 5, jj = it & 31, seg = jj >> 4, j = jj & 15;
        const int pos = seg ? (t & 63) : (t >> 6);
        const float inv = powf(10000.0f, -(float)j / 16.0f);
        const float ang = (float)pos * inv;
        float s, c; sincosf(ang, &s, &c);
        rc[it] = c; rs[it] = s;
    }
}
__device__ __forceinline__ void hyena_filter_gen(const Fr& F, float* KZ, float* FPART) {
    const float* w1 = F.in[I_HYW1]; const float* b1 = F.in[I_HYB1]; const float* f1 = F.in[I_HYF1];
    const float* w2 = F.in[I_HYW2]; const float* b2 = F.in[I_HYB2]; const float* f2 = F.in[I_HYF2];
    const float* w3 = F.in[I_HYW3];
    LAS float* zf = (LAS float*)F.lds;
    LAS float* a1 = zf + 16 * 33;
    LAS float* a2 = a1 + 16 * 64;
    const int col4 = F.tid * 4;
    float psum[4] = {0.f, 0.f, 0.f, 0.f};
    const float da = -3.0701134573253944f, db = -15.350567286626972f;
    float delta[4];
#pragma unroll
    for (int e = 0; e < 4; ++e) { const int c = (col4 + e) & 1023; delta[e] = fabsf(da + (float)c * ((db - da) / 1023.0f)); }
    __syncthreads();
    for (int g = F.bid; g < SEQ / 16; g += F.G) {
        for (int it = F.tid; it < 16 * 33; it += NTHR) {
            const int pos = it / 33, f = it % 33; const int l = g * 16 + pos;
            const float t = (float)l / (float)(SEQ - 1);
            const float w = (6.283185307179586f / (float)SEQ) * (float)l;
            float v;
            if (f == 0) v = t;
            else { const int j = (f - 1) & 15; const float band = 1e-4f + (float)j * ((15.0f - 1e-4f) / 15.0f); v = (f <= 16) ? cosf(band * w) : -sinf(band * w); }
            zf[pos * 33 + f] = v;
        }
        __syncthreads();
        for (int it = F.tid; it < 16 * 64; it += NTHR) {
            const int pos = it >> 6, u = it & 63; float s = b1[u];
            for (int f = 0; f < 33; ++f) s += zf[pos * 33 + f] * w1[f * 64 + u];
            a1[pos * 64 + u] = sinf(f1[u] * s);
        }
        __syncthreads();
        for (int it = F.tid; it < 16 * 64; it += NTHR) {
            const int pos = it >> 6, u = it & 63; float s = b2[u];
            for (int v = 0; v < 64; ++v) s += a1[pos * 64 + v] * w2[v * 64 + u];
            a2[u * 16 + pos] = sinf(f2[u] * s);
        }
        __syncthreads();
        f32x4 acc[16];
#pragma unroll
        for (int p = 0; p < 16; ++p) acc[p] = (f32x4){0.f, 0.f, 0.f, 0.f};
        for (int u = 0; u < 64; ++u) {
            const f32x4 w = *(const f32x4*)(w3 + u * 2048 + col4);
            const f32x4 q0 = *(const LAS f32x4*)(a2 + u * 16), q1 = *(const LAS f32x4*)(a2 + u * 16 + 4), q2 = *(const LAS f32x4*)(a2 + u * 16 + 8), q3 = *(const LAS f32x4*)(a2 + u * 16 + 12);
#pragma unroll
            for (int e = 0; e < 4; ++e) { acc[e] += q0[e] * w; acc[4 + e] += q1[e] * w; acc[8 + e] += q2[e] * w; acc[12 + e] += q3[e] * w; }
        }
        const bool bwd = col4 >= 1024; const int c0 = col4 & 1023;
#pragma unroll
        for (int p = 0; p < 16; ++p) {
            const int l = g * 16 + p; const float t = (float)l / (float)(SEQ - 1);
            f32x4 v;
#pragma unroll
            for (int e = 0; e < 4; ++e) v[e] = acc[p][e] * __expf(-t * delta[e]);
            if (!bwd) { *(f32x4*)(KZ + (size_t)l * 1024 + c0) = v; for (int e = 0; e < 4; ++e) psum[e] += fabsf(v[e]); }
            else if (l >= 1) { *(f32x4*)(KZ + (size_t)(2 * SEQ - l) * 1024 + c0) = v; for (int e = 0; e < 4; ++e) psum[e] += fabsf(v[e]); }
        }
        __syncthreads();
    }
    *(f32x4*)(FPART + (size_t)F.bid * 2048 + col4) = (f32x4){psum[0], psum[1], psum[2], psum[3]};
    if (F.bid == 0) for (int c = F.tid; c < 1024; c += NTHR) KZ[(size_t)SEQ * 1024 + c] = 0.f;
}
__device__ __forceinline__ void hyena_filter_norm(const Fr& F, const float* FPART, float* FNORM) {
    const int c = F.bid * NTHR + F.tid;
    if (c < 1024) { float s = 0.f; for (int b = 0; b < F.G; ++b) s += FPART[(size_t)b * 2048 + c] + FPART[(size_t)b * 2048 + 1024 + c]; FNORM[c] = 1.0f / (s + 1e-6f); }
}

__device__ __forceinline__ void norm_rows(const Fr& F, const float* X, int nrows, const float* g, const float* sc, const float* sh, bf16_t* out) {
    for (int row = F.bid * 8 + F.wave; row < nrows; row += F.G * 8) {
        const float* xr = X + (size_t)row * DM;
        f32x4 v[8]; float ss = 0.f;
#pragma unroll
        for (int i = 0; i < 8; ++i) { v[i] = *(const f32x4*)(xr + i * 256 + F.lane * 4); ss += v[i][0] * v[i][0] + v[i][1] * v[i][1] + v[i][2] * v[i][2] + v[i][3] * v[i][3]; }
        ss = wave_sum(ss);
        const float rstd = rsqrtf(ss * (1.0f / DM) + 1e-6f);
#pragma unroll
        for (int i = 0; i < 8; ++i) {
            const int col = i * 256 + F.lane * 4;
            const f32x4 gg = *(const f32x4*)(g + col), a = *(const f32x4*)(sc + col), b = *(const f32x4*)(sh + col);
            const f32x4 y = v[i] * rstd * gg * (1.0f + a) + b;
            u32x2 w; w.x = pk_bf16(y[0], y[1]); w.y = pk_bf16(y[2], y[3]);
            *(u32x2*)(out + (size_t)row * DM + col) = w;
        }
    }
}

__device__ __forceinline__ void l0_post_proj(const Fr& F, const bf16_t* PB, bf16_t* QN, bf16_t* KVN, bf16_t* KROPE, bf16_t* YCAT,
                                             const float* rc, const float* rs) {
    const float* qg = F.in[I_QNG0]; const float* kvg = F.in[I_KVNG0]; const float* cw = F.in[I_CONVW0];
    for (int t = F.bid * 8 + F.wave; t < NKEY; t += F.G * 8) {
        const bf16_t* pr = PB + (size_t)t * 4096;
        if (t < SEQ) {
            const u32x4 w = *(const u32x4*)(pr + 3072 + F.lane * 8);
            float v[8] = {bf_lo(w.x), bf_hi(w.x), bf_lo(w.y), bf_hi(w.y), bf_lo(w.z), bf_hi(w.z), bf_lo(w.w), bf_hi(w.w)};
            float ss = 0.f;
#pragma unroll
            for (int e = 0; e < 8; ++e) ss += v[e] * v[e];
            ss = wave_sum(ss);
            const float rstd = rsqrtf(ss * (1.0f / 512.0f) + 1e-6f);
            const f32x4 g0 = *(const f32x4*)(qg + F.lane * 8), g1 = *(const f32x4*)(qg + F.lane * 8 + 4);
            u32x4 o; o.x = pk_bf16(v[0] * rstd * g0[0], v[1] * rstd * g0[1]); o.y = pk_bf16(v[2] * rstd * g0[2], v[3] * rstd * g0[3]);
            o.z = pk_bf16(v[4] * rstd * g1[0], v[5] * rstd * g1[1]); o.w = pk_bf16(v[6] * rstd * g1[2], v[7] * rstd * g1[3]);
            *(u32x4*)(QN + (size_t)t * 512 + F.lane * 8) = o;
        }
        {
            const u32x2 w = *(const u32x2*)(pr + 3584 + F.lane * 4);
            float v[4] = {bf_lo(w.x), bf_hi(w.x), bf_lo(w.y), bf_hi(w.y)};
            float ss = v[0] * v[0] + v[1] * v[1] + v[2] * v[2] + v[3] * v[3];
            ss = wave_sum(ss);
            const float rstd = rsqrtf(ss * (1.0f / 256.0f) + 1e-6f);
            const f32x4 g0 = *(const f32x4*)(kvg + F.lane * 4);
            u32x2 o; o.x = pk_bf16(v[0] * rstd * g0[0], v[1] * rstd * g0[1]); o.y = pk_bf16(v[2] * rstd * g0[2], v[3] * rstd * g0[3]);
            *(u32x2*)(KVN + (size_t)t * 256 + F.lane * 4) = o;
        }
        {
            const float u = bf1(pr[3840 + F.lane]);
            const float up = __shfl_xor(u, 16);
            float o = u;
            if (t < SEQ) {
                const int seg = F.lane >> 5, half = (F.lane >> 4) & 1, j = F.lane & 15;
                const float c = rc[(size_t)t * 32 + seg * 16 + j], s = rs[(size_t)t * 32 + seg * 16 + j];
                o = u * c + (half ? up : -up) * s;
            }
            KROPE[(size_t)t * 64 + F.lane] = f2bf(o);
        }
    }
    for (int tile = F.bid; tile < SEQ / 64; tile += F.G) {
        const int cg = F.tid & 127, sub = F.tid >> 7, c0 = cg * 8, t0 = tile * 64 + sub * 16;
        float w0[8], w1[8], w2[8];
#pragma unroll
        for (int e = 0; e < 8; ++e) { w0[e] = cw[c0 + e]; w1[e] = cw[1024 + c0 + e]; w2[e] = cw[2048 + c0 + e]; }
        float prev[8], cur[8], nxt[8];
        auto ldprod = [&](int t, float (&o)[8]) {
            if (t < 0 || t >= SEQ) {
#pragma unroll
                for (int e = 0; e < 8; ++e) o[e] = 0.f;
            } else {
                const u32x4 a = *(const u32x4*)(PB + (size_t)t * 4096 + 1024 + c0), b = *(const u32x4*)(PB + (size_t)t * 4096 + 2048 + c0);
                o[0] = bf_lo(a.x) * bf_lo(b.x); o[1] = bf_hi(a.x) * bf_hi(b.x); o[2] = bf_lo(a.y) * bf_lo(b.y); o[3] = bf_hi(a.y) * bf_hi(b.y);
                o[4] = bf_lo(a.z) * bf_lo(b.z); o[5] = bf_hi(a.z) * bf_hi(b.z); o[6] = bf_lo(a.w) * bf_lo(b.w); o[7] = bf_hi(a.w) * bf_hi(b.w);
            }
        };
        ldprod(t0 - 1, prev); ldprod(t0, cur);
        for (int i = 0; i < 16; ++i) {
            const int t = t0 + i;
            ldprod(t + 1, nxt);
            const u32x4 gb = *(const u32x4*)(PB + (size_t)t * 4096 + c0);
            const float g[8] = {bf_lo(gb.x), bf_hi(gb.x), bf_lo(gb.y), bf_hi(gb.y), bf_lo(gb.z), bf_hi(gb.z), bf_lo(gb.w), bf_hi(gb.w)};
            float y[8];
#pragma unroll
            for (int e = 0; e < 8; ++e) y[e] = g[e] * (w0[e] * prev[e] + w1[e] * cur[e] + w2[e] * nxt[e]);
            u32x4 o; o.x = pk_bf16(y[0], y[1]); o.y = pk_bf16(y[2], y[3]); o.z = pk_bf16(y[4], y[5]); o.w = pk_bf16(y[6], y[7]);
            *(u32x4*)(YCAT + (size_t)t * 2048 + c0) = o;
#pragma unroll
            for (int e = 0; e < 8; ++e) { prev[e] = cur[e]; cur[e] = nxt[e]; }
        }
    }
}

struct EpiBf16G {
    static constexpr bool PERM = true, AFTER_DRAIN = false;
    bf16_t* O; int ldc; int act_cols;
    __device__ __forceinline__ void operator()(const f32x4 (&acc)[2][2][4][2], const pg8::Unit& u, int wr, int wc, int fr, int fq) const {
        const int row0 = u.pm * 256 + wr * 64 + fr, col0 = u.pn * 256 + wc * 32 + 8 * fq;
        const bool act = (u.pn * 256) < act_cols;
#pragma unroll
        for (int ai = 0; ai < 2; ++ai)
#pragma unroll
            for (int m = 0; m < 4; ++m) { bf16_t* rowp = O + (size_t)(row0 + ai * 128 + m * 16) * ldc + col0;
#pragma unroll
                for (int bj = 0; bj < 2; ++bj) { f32x4 v0 = acc[ai][bj][m][0], v1 = acc[ai][bj][m][1];
                    if (act) {
#pragma unroll
                        for (int e = 0; e < 4; ++e) { v0[e] = gelu_tanh(v0[e]); v1[e] = gelu_tanh(v1[e]); } }
                    u32x4 w; w.x = pk_bf16(v0[0], v0[1]); w.y = pk_bf16(v0[2], v0[3]); w.z = pk_bf16(v1[0], v1[1]); w.w = pk_bf16(v1[2], v1[3]);
                    *(u32x4*)(rowp + bj * 128) = w; } }
    }
};
struct EpiQRope {
    static constexpr bool PERM = false, AFTER_DRAIN = false;
    bf16_t* Q; const float* rc; const float* rs;
    __device__ __forceinline__ void operator()(const f32x4 (&acc)[2][2][4][2], const pg8::Unit& u, int wr, int wc, int fr, int fq) const {
#pragma unroll
        for (int ai = 0; ai < 2; ++ai)
#pragma unroll
            for (int m = 0; m < 4; ++m) {
                const int row = u.pm * 256 + ai * 128 + wr * 64 + m * 16 + fr;
#pragma unroll
                for (int bj = 0; bj < 2; ++bj) {
                    const int cbase = u.pn * 256 + bj * 128 + wc * 32;
                    const bool rope = ((cbase >> 6) % 3) == 2; const int seg = (cbase >> 5) & 1;
                    f32x4 v0 = acc[ai][bj][m][0], v1 = acc[ai][bj][m][1];
                    if (rope) {
                        const f32x4 cs = *(const f32x4*)(rc + (size_t)row * 32 + seg * 16 + 4 * fq), sn = *(const f32x4*)(rs + (size_t)row * 32 + seg * 16 + 4 * fq);
                        const f32x4 o0 = v0 * cs - v1 * sn, o1 = v1 * cs + v0 * sn; v0 = o0; v1 = o1;
                    }
                    u32x2 w0, w1; w0.x = pk_bf16(v0[0], v0[1]); w0.y = pk_bf16(v0[2], v0[3]); w1.x = pk_bf16(v1[0], v1[1]); w1.y = pk_bf16(v1[2], v1[3]);
                    bf16_t* p = Q + (size_t)row * 1536 + cbase + 4 * fq;
                    *(u32x2*)p = w0; *(u32x2*)(p + 16) = w1;
                }
            }
    }
};
struct EpiResid {
    static constexpr bool PERM = false, AFTER_DRAIN = false;
    const float* base; float* out; const float* gate;
    __device__ __forceinline__ void operator()(const f32x4 (&acc)[2][2][4][2], const pg8::Unit& u, int wr, int wc, int fr, int fq) const {
        const int row0 = u.pm * 256 + wr * 64 + fr, col0 = u.pn * 256 + wc * 32 + 4 * fq;
        f32x4 gv[2][2];
#pragma unroll
        for (int bj = 0; bj < 2; ++bj)
#pragma unroll
            for (int n = 0; n < 2; ++n) gv[bj][n] = *(const f32x4*)(gate + col0 + bj * 128 + n * 16);
#pragma unroll
        for (int ai = 0; ai < 2; ++ai)
#pragma unroll
            for (int m = 0; m < 4; ++m) { const size_t off = (size_t)(row0 + ai * 128 + m * 16) * DM + col0;
#pragma unroll
                for (int bj = 0; bj < 2; ++bj)
#pragma unroll
                    for (int n = 0; n < 2; ++n) { const f32x4 b = *(const f32x4*)(base + off + bj * 128 + n * 16);
                        *(f32x4*)(out + off + bj * 128 + n * 16) = b + gv[bj][n] * acc[ai][bj][m][n]; } }
    }
};
struct OrderIn0 : pg8::StaticOrder {
    int rounds;
    __device__ void init2(int G_, int c_) { init(SEQ, 4096, G_, c_); rounds = (nwg + G - 1) / G; }
    __device__ bool next(int i, pg8::Unit& u) const {
        if (pg8::StaticOrder::next(i, u)) return true;
        if (i == rounds && c < 2) { u.pm = 64; u.pn = 14 + c; return true; }
        return false;
    }
};

namespace att {
constexpr int KVBLK = 64;
constexpr float SCALE = 0.07216878364870322f;
constexpr float THR = 8.f;
constexpr int LDQ = 1536, LDK = 2048, LDKR = 64, LDO = 2048;
constexpr int SHM_V = 16384, SHM_KN = 16384, SHM_KR = 8192;
constexpr int OFF_V = 0, OFF_KN = 2 * SHM_V, OFF_KR = OFF_KN + 2 * SHM_KN, OFF_WS = OFF_KR + 2 * SHM_KR, LDS_ATT = OFF_WS + 8 * 64 * 4;
#define KSWZ(row, colB) ((row) * 256 + ((colB) ^ (((row) & 7) << 4)))
#define KRSWZ(row, colB) ((row) * 128 + ((colB) ^ ((((row) >> 1) & 7) << 4)))
#define SBAR() __builtin_amdgcn_sched_barrier(0)
__device__ __forceinline__ int crow(int r, int hi) { return (r & 3) + 8 * (r >> 2) + 4 * hi; }

__device__ __forceinline__ void partialSM(f32x16& p0, f32x16& p1, float& m_reg, float& mn, float& alpha) {
    constexpr float C = SCALE * 1.4426950408889634f;
    float pmax = p0[0];
#pragma unroll
    for (int r = 1; r < 16; ++r) pmax = fmaxf(pmax, p0[r]);
#pragma unroll
    for (int r = 0; r < 16; ++r) pmax = fmaxf(pmax, p1[r]);
    { auto rr = __builtin_amdgcn_permlane32_swap(__float_as_uint(pmax), __float_as_uint(pmax), false, false);
      pmax = fmaxf(__uint_as_float(rr[0]), __uint_as_float(rr[1])); }
    if (__builtin_expect(__all(pmax - m_reg <= THR / SCALE), 1)) { mn = m_reg; alpha = 1.f; }
    else { mn = fmaxf(m_reg, pmax); alpha = __builtin_amdgcn_exp2f((m_reg - mn) * C); m_reg = mn; }
    const float mnC = -mn * C;
#pragma unroll
    for (int r = 0; r < 16; ++r) p0[r] = fmaf(p0[r], C, mnC);
#pragma unroll
    for (int r = 0; r < 16; ++r) p1[r] = fmaf(p1[r], C, mnC);
#pragma unroll
    for (int r = 0; r < 16; ++r) p0[r] = __builtin_amdgcn_exp2f(p0[r]);
}
__device__ __forceinline__ void finishSM(f32x16& p0, f32x16& p1, float alpha, float& l_reg, bf16x8& pa0, bf16x8& pa1, bf16x8& pa2, bf16x8& pa3) {
#pragma unroll
    for (int r = 0; r < 16; ++r) p1[r] = __builtin_amdgcn_exp2f(p1[r]);
    float ps = 0;
#pragma unroll
    for (int r = 0; r < 16; ++r) ps += p0[r];
#pragma unroll
    for (int r = 0; r < 16; ++r) ps += p1[r];
    { auto rr = __builtin_amdgcn_permlane32_swap(__float_as_uint(ps), __float_as_uint(ps), false, false);
      ps = __uint_as_float(rr[0]) + __uint_as_float(rr[1]); }
    l_reg = l_reg * alpha + ps;
#define PK4(P, BASE, OUT) do { unsigned a0 = pk_bf16(P[BASE + 0], P[BASE + 1]), a1 = pk_bf16(P[BASE + 2], P[BASE + 3]);   \
    unsigned b0 = pk_bf16(P[BASE + 4], P[BASE + 5]), b1 = pk_bf16(P[BASE + 6], P[BASE + 7]);                              \
    auto r0 = __builtin_amdgcn_permlane32_swap(a0, b0, false, false); auto r1 = __builtin_amdgcn_permlane32_swap(a1, b1, false, false); \
    u32x4 w = {r0[0], r1[0], r0[1], r1[1]}; OUT = *reinterpret_cast<bf16x8*>(&w); } while (0)
    PK4(p0, 0, pa0); PK4(p0, 8, pa1); PK4(p1, 0, pa2); PK4(p1, 8, pa3);
#undef PK4
}
__device__ __forceinline__ void qkt(f32x16& p0, f32x16& p1, const LAS unsigned char* Kn, const LAS unsigned char* Kr, const bf16x8 (&qr)[12], int r32, int hi) {
    p0 = f32x16{}; p1 = f32x16{};
#pragma unroll
    for (int d0 = 0; d0 < 8; ++d0) { const int cb = (d0 * 16 + hi * 8) * 2;
        const bf16x8 b0 = *(const LAS bf16x8*)(Kn + KSWZ(r32, cb));
        const bf16x8 b1 = *(const LAS bf16x8*)(Kn + KSWZ(32 + r32, cb));
        p0 = __builtin_amdgcn_mfma_f32_32x32x16_bf16(b0, qr[d0], p0, 0, 0, 0);
        p1 = __builtin_amdgcn_mfma_f32_32x32x16_bf16(b1, qr[d0], p1, 0, 0, 0); }
    SBAR();
#pragma unroll
    for (int d0 = 0; d0 < 4; ++d0) { const int cb = (d0 * 16 + hi * 8) * 2;
        const bf16x8 b0 = *(const LAS bf16x8*)(Kr + KRSWZ(r32, cb));
        const bf16x8 b1 = *(const LAS bf16x8*)(Kr + KRSWZ(32 + r32, cb));
        p0 = __builtin_amdgcn_mfma_f32_32x32x16_bf16(b0, qr[8 + d0], p0, 0, 0, 0);
        p1 = __builtin_amdgcn_mfma_f32_32x32x16_bf16(b1, qr[8 + d0], p1, 0, 0, 0); }
}
__device__ __forceinline__ int v_st(int k, int c) { const int kk = (k & ~0xC) | ((k & 4) << 1) | ((k & 8) >> 1); return ((kk >> 3) * 4 + (c >> 5)) * 512 + ((kk & 7) * 32 + (c & 31)) * 2; }
__device__ __forceinline__ int v_rd_base(int lane) { return ((lane & 3) << 3) | (((lane >> 2) & 3) << 6) | (((lane >> 4) & 1) << 5) | (((lane >> 5) & 1) << 8); }
constexpr int v_rd_off(int d0, int ks, int half) { return d0 * 512 + ks * 4096 + half * 2048; }
template <int OFF> __device__ __forceinline__ s16x4 tr_read(int vb) {
    s16x4 r; asm volatile("ds_read_b64_tr_b16 %0, %1 offset:%2" : "=&v"(r) : "v"(vb), "i"(OFF) : "memory"); return r;
}
template <int D0> __device__ __forceinline__ void pv_one(f32x16& od, int vb, bf16x8 pa0, bf16x8 pa1, bf16x8 pa2, bf16x8 pa3) {
    const s16x4 l0 = tr_read<v_rd_off(D0, 0, 0)>(vb), h0 = tr_read<v_rd_off(D0, 0, 1)>(vb), l1 = tr_read<v_rd_off(D0, 1, 0)>(vb), h1 = tr_read<v_rd_off(D0, 1, 1)>(vb);
    const s16x4 l2 = tr_read<v_rd_off(D0, 2, 0)>(vb), h2 = tr_read<v_rd_off(D0, 2, 1)>(vb), l3 = tr_read<v_rd_off(D0, 3, 0)>(vb), h3 = tr_read<v_rd_off(D0, 3, 1)>(vb);
    asm volatile("s_waitcnt lgkmcnt(0)" ::: "memory"); SBAR();
#define PKV(L, H) (bf16x8){L[0], L[1], L[2], L[3], H[0], H[1], H[2], H[3]}
    od = __builtin_amdgcn_mfma_f32_32x32x16_bf16(pa0, PKV(l0, h0), od, 0, 0, 0);
    od = __builtin_amdgcn_mfma_f32_32x32x16_bf16(pa1, PKV(l1, h1), od, 0, 0, 0);
    od = __builtin_amdgcn_mfma_f32_32x32x16_bf16(pa2, PKV(l2, h2), od, 0, 0, 0);
    od = __builtin_amdgcn_mfma_f32_32x32x16_bf16(pa3, PKV(l3, h3), od, 0, 0, 0);
#undef PKV
}
__device__ __forceinline__ void pv_d0(f32x16* o, int vb, bf16x8 pa0, bf16x8 pa1, bf16x8 pa2, bf16x8 pa3) {
    pv_one<0>(o[0], vb, pa0, pa1, pa2, pa3); pv_one<1>(o[1], vb, pa0, pa1, pa2, pa3); pv_one<2>(o[2], vb, pa0, pa1, pa2, pa3); pv_one<3>(o[3], vb, pa0, pa1, pa2, pa3);
}
constexpr int SLOTB = 40960, S_V = 0, S_KN = 16384, S_KR = 32768, OFF_QR = 3 * SLOTB, OFF_WS2 = OFF_QR + 32768, LDS_ATT2 = OFF_WS2 + 2048;
static_assert(LDS_ATT2 <= LDS_CTL, "attention LDS");
__device__ __forceinline__ void qkt2(f32x16& p0, f32x16& p1, const LAS unsigned char* slot, const LAS unsigned char* qrp, const bf16x8 (&qr)[8], int r32, int hi) {
    p0 = f32x16{}; p1 = f32x16{};
    const LAS unsigned char* Kn = slot + S_KN; const LAS unsigned char* Kr = slot + S_KR;
#pragma unroll
    for (int d0 = 0; d0 < 8; ++d0) { const int cb = (d0 * 16 + hi * 8) * 2;
        const bf16x8 b0 = *(const LAS bf16x8*)(Kn + KSWZ(r32, cb));
        const bf16x8 b1 = *(const LAS bf16x8*)(Kn + KSWZ(32 + r32, cb));
        p0 = __builtin_amdgcn_mfma_f32_32x32x16_bf16(b0, qr[d0], p0, 0, 0, 0);
        p1 = __builtin_amdgcn_mfma_f32_32x32x16_bf16(b1, qr[d0], p1, 0, 0, 0); }
#pragma unroll
    for (int d0 = 0; d0 < 4; ++d0) { const int cb = (d0 * 16 + hi * 8) * 2;
        const bf16x8 b0 = *(const LAS bf16x8*)(Kr + KRSWZ(r32, cb));
        const bf16x8 b1 = *(const LAS bf16x8*)(Kr + KRSWZ(32 + r32, cb));
        const bf16x8 qq = *(const LAS bf16x8*)(qrp + (cb ^ (((r32 >> 1) & 7) << 4)));
        p0 = __builtin_amdgcn_mfma_f32_32x32x16_bf16(b0, qq, p0, 0, 0, 0);
        p1 = __builtin_amdgcn_mfma_f32_32x32x16_bf16(b1, qq, p1, 0, 0, 0); }
}
__device__ __forceinline__ void attn_body(const bf16_t* __restrict__ Qb, const bf16_t* __restrict__ Kh, const bf16_t* __restrict__ Krp, const bf16_t* __restrict__ Vh,
                                          bf16_t* __restrict__ Ob, int seq, LAS unsigned char* lds) {
    const int tid = threadIdx.x, wid = __builtin_amdgcn_readfirstlane(tid >> 6), lane = tid & 63, r32 = lane & 31, hi = lane >> 5;
    LAS float* ws = (LAS float*)(lds + OFF_WS2) + wid * 64; LAS float* li_l = ws; LAS float* al_l = ws + 32;
    LAS unsigned char* qrp = lds + OFF_QR + (wid * 32 + r32) * 128;
    float m_reg = -1e30f, l_reg = 0; f32x16 o[4] = {}; bf16x8 qr[8];
    const bf16_t* Qw = Qb + (long)(wid * 32 + r32) * LDQ + hi * 8;
#pragma unroll
    for (int d0 = 0; d0 < 8; ++d0) qr[d0] = *(const bf16x8*)(Qw + d0 * 16);
#pragma unroll
    for (int d0 = 0; d0 < 4; ++d0) { const bf16x8 q = *(const bf16x8*)(Qw + 128 + d0 * 16); const int cb = (d0 * 16 + hi * 8) * 2;
        *(LAS bf16x8*)(qrp + (cb ^ (((r32 >> 1) & 7) << 4))) = q; }
    unsigned offV[1], offK[1], offR;
    {
        const int i = 0; const int u = wid * 64 + lane;
        { const int sub = u >> 5, within = u & 31, kk = ((sub >> 2) << 3) | (within >> 2), c = ((sub & 3) << 5) | ((within & 3) << 3);
          const int k = (kk & ~0xC) | ((kk & 4) << 1) | ((kk & 8) >> 1); offV[i] = (unsigned)(k * LDK + c); }
        { const int row = u >> 4, sl = u & 15; offK[i] = (unsigned)(row * LDK + ((sl ^ (row & 7)) << 3)); }
    }
    { const int u = wid * 64 + lane, row = u >> 3, sl = u & 7; offR = (unsigned)(row * LDKR + ((sl ^ ((row >> 1) & 7)) << 3)); }
    const int vbase = (int)(unsigned)(uintptr_t)lds + v_rd_base(lane);
#define DMA(t, slot) do { const bf16_t* vh_ = Vh + (size_t)(t) * KVBLK * LDK; const bf16_t* kh_ = Kh + (size_t)(t) * KVBLK * LDK; const bf16_t* kr_ = Krp + (size_t)(t) * KVBLK * LDKR; \
    LAS unsigned char* sb_ = lds + (slot) * SLOTB; \
    __builtin_amdgcn_global_load_lds((const unsigned*)(vh_ + offV[0]), (LAS unsigned*)(sb_ + S_V + wid * 1024), 16, 0, 0); \
    __builtin_amdgcn_global_load_lds((const unsigned*)(vh_ + offV[0] + 32 * LDK), (LAS unsigned*)(sb_ + S_V + (wid + 8) * 1024), 16, 0, 0); \
    __builtin_amdgcn_global_load_lds((const unsigned*)(kh_ + offK[0]), (LAS unsigned*)(sb_ + S_KN + wid * 1024), 16, 0, 0); \
    __builtin_amdgcn_global_load_lds((const unsigned*)(kh_ + offK[0] + 32 * LDK), (LAS unsigned*)(sb_ + S_KN + (wid + 8) * 1024), 16, 0, 0); \
    __builtin_amdgcn_global_load_lds((const unsigned*)(kr_ + offR), (LAS unsigned*)(sb_ + S_KR + wid * 1024), 16, 0, 0); } while (0)
#define RESC(a) do { if (__any((a) < 1.f)) { if (hi == 0) al_l[r32] = (a); asm volatile("s_waitcnt lgkmcnt(0)" ::: "memory"); \
    _Pragma("unroll") for (int d = 0; d < 4; ++d) _Pragma("unroll") for (int r = 0; r < 16; ++r) o[d][r] *= al_l[crow(r, hi)]; } } while (0)
#define TILE_SYNC() do { asm volatile("s_waitcnt vmcnt(0)" ::: "memory"); __syncthreads(); } while (0)
    f32x16 pA0, pA1, pB0, pB1; float mnA, mnB, alA, alB; bf16x8 pa0, pa1, pa2, pa3; const int NT = seq / KVBLK;
    DMA(0, 0); DMA(1, 1);
    TILE_SYNC();
    qkt2(pA0, pA1, lds, qrp, qr, r32, hi); partialSM(pA0, pA1, m_reg, mnA, alA);
    int s_prev = 0, s_cur = 1, s_next = 2;
    for (int j = 1; j + 1 < NT; j += 2) {
        DMA(j + 1, s_next);
        SBAR(); qkt2(pB0, pB1, lds + s_cur * SLOTB, qrp, qr, r32, hi);
        finishSM(pA0, pA1, alA, l_reg, pa0, pa1, pa2, pa3); SBAR();
        pv_d0(o, vbase + s_prev * SLOTB, pa0, pa1, pa2, pa3); partialSM(pB0, pB1, m_reg, mnB, alB);
        TILE_SYNC(); RESC(alB);
        { const int t_ = s_prev; s_prev = s_cur; s_cur = s_next; s_next = t_; }
        if (j + 2 < NT) DMA(j + 2, s_next);
        SBAR(); qkt2(pA0, pA1, lds + s_cur * SLOTB, qrp, qr, r32, hi);
        finishSM(pB0, pB1, alB, l_reg, pa0, pa1, pa2, pa3); SBAR();
        pv_d0(o, vbase + s_prev * SLOTB, pa0, pa1, pa2, pa3); partialSM(pA0, pA1, m_reg, mnA, alA);
        TILE_SYNC(); RESC(alA);
        { const int t_ = s_prev; s_prev = s_cur; s_cur = s_next; s_next = t_; }
    }
    SBAR(); qkt2(pB0, pB1, lds + s_cur * SLOTB, qrp, qr, r32, hi);
    finishSM(pA0, pA1, alA, l_reg, pa0, pa1, pa2, pa3); SBAR();
    pv_d0(o, vbase + s_prev * SLOTB, pa0, pa1, pa2, pa3); partialSM(pB0, pB1, m_reg, mnB, alB);
    RESC(alB);
    finishSM(pB0, pB1, alB, l_reg, pa0, pa1, pa2, pa3); SBAR();
    pv_d0(o, vbase + s_cur * SLOTB, pa0, pa1, pa2, pa3);
    if (hi == 0) li_l[r32] = l_reg; asm volatile("s_waitcnt lgkmcnt(0)" ::: "memory");
    float rli[16];
#pragma unroll
    for (int r = 0; r < 16; ++r) rli[r] = __builtin_amdgcn_rcpf(li_l[crow(r, hi)]);
    bf16_t* Ow = Ob + (long)(wid * 32) * LDO;
#pragma unroll
    for (int r = 0; r < 16; ++r) { const int orow = crow(r, hi);
#pragma unroll
        for (int d0 = 0; d0 < 4; ++d0) Ow[(long)orow * LDO + d0 * 32 + r32] = f2bf(o[d0][r] * rli[r]); }
    __syncthreads();
#undef DMA
#undef RESC
#undef TILE_SYNC
}
}

__device__ __forceinline__ int crow32(int r, int hi) { return (r & 3) + 8 * (r >> 2) + 4 * hi; }

template <bool FINAL>
__device__ __forceinline__ void peer_phase(const Fr& F, const bf16_t* PQ, const bf16_t* KEYS, bf16_t* H, const bf16_t* TU, const bf16_t* TV, float* XR,
                                           const float* gate_f, const float* ng, const float* nsc, const float* nsh, float* OUT) {
    LAS float* SC = (LAS float*)F.lds;
    LAS int* IDX = (LAS int*)(F.lds + 132096);
    LAS float* GT = (LAS float*)(F.lds + 132096 + 8192);
    const float NEG = -3.0e38f;
    for (int tile = F.bid; tile < SEQ / 16; tile += F.G) {
        const int t0 = tile * 16;
        {
            const int p = F.wave >> 2, rb = F.wave & 3, r = rb * 32 + (F.lane & 31), kg = F.lane >> 5, hi = kg;
            const int tl = r >> 3, h = r & 7;
            const bf16_t* qp = PQ + (size_t)(t0 + tl) * 2048 + h * 256 + p * 128 + kg * 8;
            bf16x8 qa[8];
#pragma unroll
            for (int k = 0; k < 8; ++k) qa[k] = *(const bf16x8*)(qp + k * 16);
#pragma unroll
            for (int nb = 0; nb < 4; ++nb) {
                const bf16_t* kp = KEYS + (size_t)(p * 128 + nb * 32 + (F.lane & 31)) * 128 + kg * 8;
                f32x16 acc = {};
#pragma unroll
                for (int k = 0; k < 8; ++k) { const bf16x8 kb = *(const bf16x8*)(kp + k * 16); acc = __builtin_amdgcn_mfma_f32_32x32x16_bf16(qa[k], kb, acc, 0, 0, 0); }
#pragma unroll
                for (int rr = 0; rr < 16; ++rr) SC[(p * 128 + rb * 32 + crow32(rr, hi)) * 129 + nb * 32 + (F.lane & 31)] = acc[rr];
            }
        }
        __syncthreads();
        if (F.tid < 256) {
            LAS float* row = SC + F.tid * 129;
            float gm[8];
#pragma unroll
            for (int g = 0; g < 8; ++g) { float m = row[g * 16];
#pragma unroll
                for (int e = 1; e < 16; ++e) m = fmaxf(m, row[g * 16 + e]);
                gm[g] = m; }
            float tv[16]; int ti[16];
#pragma unroll
            for (int k = 0; k < 16; ++k) {
                float best = gm[0]; int gb = 0;
#pragma unroll
                for (int g = 1; g < 8; ++g) if (gm[g] > best) { best = gm[g]; gb = g; }
                float m1 = NEG, m2 = NEG; int i1 = 0;
#pragma unroll
                for (int e = 0; e < 16; ++e) { const float v = row[gb * 16 + e]; if (v > m1) { m2 = m1; m1 = v; i1 = e; } else if (v > m2) m2 = v; }
                tv[k] = m1; ti[k] = gb * 16 + i1; row[gb * 16 + i1] = NEG;
#pragma unroll
                for (int g = 0; g < 8; ++g) gm[g] = (g == gb) ? m2 : gm[g];
            }
#pragma unroll
            for (int k = 0; k < 16; ++k) { row[k] = tv[k]; row[16 + k] = __int_as_float(ti[k]); }
        }
        __syncthreads();
        if (F.tid < 128) {
            const int j = F.tid, tl = j >> 3, h = j & 7;
            LAS float* r1 = SC + j * 129; LAS float* r2 = SC + (128 + j) * 129;
            float v1[16], v2[16];
#pragma unroll
            for (int k = 0; k < 16; ++k) { v1[k] = r1[k]; v2[k] = r2[k]; }
            float cand[50];
            {
                int n = 0;
#pragma unroll
                for (int a = 0; a < 16; ++a)
#pragma unroll
                    for (int b = 0; b < 16; ++b) if ((a + 1) * (b + 1) <= 16) { cand[n] = v1[a] + v2[b]; ++n; }
            }
            float bs[16]; int bc[16];
#pragma unroll
            for (int k = 0; k < 16; ++k) {
                float m = NEG; int mi = 0, mc = 0;
                {
                    int n = 0;
#pragma unroll
                    for (int a = 0; a < 16; ++a)
#pragma unroll
                        for (int b = 0; b < 16; ++b) if ((a + 1) * (b + 1) <= 16) { if (cand[n] > m) { m = cand[n]; mi = n; mc = a * 16 + b; } ++n; }
                }
                bs[k] = m; bc[k] = mc;
#pragma unroll
                for (int n = 0; n < 50; ++n) cand[n] = (n == mi) ? NEG : cand[n];
            }
            float den = 0.f, ex[16];
#pragma unroll
            for (int k = 0; k < 16; ++k) { ex[k] = __expf(bs[k] - bs[0]); den += ex[k]; }
            const float rden = 1.0f / den;
#pragma unroll
            for (int k = 0; k < 16; ++k) {
                const int a = bc[k] >> 4, b = bc[k] & 15;
                const int i1 = __float_as_int(r1[16 + a]), i2 = __float_as_int(r2[16 + b]);
                IDX[tl * 128 + h * 16 + k] = i1 * 128 + i2;
                GT[tl * 128 + h * 16 + k] = ex[k] * rden;
            }
        }
        __syncthreads();
        for (int s = 0; s < 2; ++s) {
            const int tl = F.wave * 2 + s, t = t0 + tl;
            u32x4 xh[4];
#pragma unroll
            for (int i = 0; i < 4; ++i) xh[i] = *(const u32x4*)(H + (size_t)t * 2048 + i * 512 + F.lane * 8);
            for (int e0 = 0; e0 < 128; e0 += 4) {
                int id[4]; u32x4 ur[4][4];
#pragma unroll
                for (int j = 0; j < 4; ++j) id[j] = __builtin_amdgcn_readfirstlane(IDX[tl * 128 + e0 + j]);
#pragma unroll
                for (int j = 0; j < 4; ++j)
#pragma unroll
                    for (int i = 0; i < 4; ++i) ur[j][i] = *(const u32x4*)(TU + (size_t)id[j] * 2048 + i * 512 + F.lane * 8);
                float d[4];
#pragma unroll
                for (int j = 0; j < 4; ++j) { float a = 0.f;
#pragma unroll
                    for (int i = 0; i < 4; ++i) { a = dot2bf(ur[j][i].x, xh[i].x, a); a = dot2bf(ur[j][i].y, xh[i].y, a); a = dot2bf(ur[j][i].z, xh[i].z, a); a = dot2bf(ur[j][i].w, xh[i].w, a); }
                    d[j] = wave_sum(a); }
                if (F.lane == 0) {
#pragma unroll
                    for (int j = 0; j < 4; ++j) GT[tl * 128 + e0 + j] *= gelu_tanh(d[j]);
                }
            }
            float acc[32];
#pragma unroll
            for (int q = 0; q < 32; ++q) acc[q] = 0.f;
            for (int e0 = 0; e0 < 128; e0 += 4) {
                int id[4]; float w[4]; u32x4 vr[4][4];
#pragma unroll
                for (int j = 0; j < 4; ++j) { id[j] = __builtin_amdgcn_readfirstlane(IDX[tl * 128 + e0 + j]); w[j] = GT[tl * 128 + e0 + j]; }
#pragma unroll
                for (int j = 0; j < 4; ++j)
#pragma unroll
                    for (int i = 0; i < 4; ++i) vr[j][i] = *(const u32x4*)(TV + (size_t)id[j] * 2048 + i * 512 + F.lane * 8);
#pragma unroll
                for (int j = 0; j < 4; ++j)
#pragma unroll
                    for (int i = 0; i < 4; ++i) {
                        acc[i * 8 + 0] += w[j] * bf_lo(vr[j][i].x); acc[i * 8 + 1] += w[j] * bf_hi(vr[j][i].x);
                        acc[i * 8 + 2] += w[j] * bf_lo(vr[j][i].y); acc[i * 8 + 3] += w[j] * bf_hi(vr[j][i].y);
                        acc[i * 8 + 4] += w[j] * bf_lo(vr[j][i].z); acc[i * 8 + 5] += w[j] * bf_hi(vr[j][i].z);
                        acc[i * 8 + 6] += w[j] * bf_lo(vr[j][i].w); acc[i * 8 + 7] += w[j] * bf_hi(vr[j][i].w);
                    }
            }
            float ss = 0.f;
#pragma unroll
            for (int i = 0; i < 4; ++i)
#pragma unroll
                for (int hf = 0; hf < 2; ++hf) {
                    const int col = i * 512 + F.lane * 8 + hf * 4;
                    const f32x4 xr = *(const f32x4*)(XR + (size_t)t * DM + col), gf = *(const f32x4*)(gate_f + col);
                    f32x4 x2;
#pragma unroll
                    for (int e = 0; e < 4; ++e) { x2[e] = xr[e] + gf[e] * acc[i * 8 + hf * 4 + e]; acc[i * 8 + hf * 4 + e] = x2[e]; ss += x2[e] * x2[e]; }
                    if (!FINAL) *(f32x4*)(XR + (size_t)t * DM + col) = x2;
                }
            ss = wave_sum(ss);
            const float rstd = rsqrtf(ss * (1.0f / DM) + 1e-6f);
#pragma unroll
            for (int i = 0; i < 4; ++i) {
                const int col = i * 512 + F.lane * 8;
                float y[8];
#pragma unroll
                for (int hf = 0; hf < 2; ++hf) {
                    const f32x4 g = *(const f32x4*)(ng + col + hf * 4);
                    if (!FINAL) {
                        const f32x4 a = *(const f32x4*)(nsc + col + hf * 4), b = *(const f32x4*)(nsh + col + hf * 4);
#pragma unroll
                        for (int e = 0; e < 4; ++e) y[hf * 4 + e] = acc[i * 8 + hf * 4 + e] * rstd * g[e] * (1.0f + a[e]) + b[e];
                    } else {
                        f32x4 o;
#pragma unroll
                        for (int e = 0; e < 4; ++e) o[e] = acc[i * 8 + hf * 4 + e] * rstd * g[e];
                        *(f32x4*)(OUT + (size_t)t * DM + col + hf * 4) = o;
                    }
                }
                if (!FINAL) { u32x4 w; w.x = pk_bf16(y[0], y[1]); w.y = pk_bf16(y[2], y[3]); w.z = pk_bf16(y[4], y[5]); w.w = pk_bf16(y[6], y[7]);
                    *(u32x4*)(H + (size_t)t * 2048 + col) = w; }
            }
        }
        __syncthreads();
    }
}

__device__ __forceinline__ void gmlp_phase(const Fr& F, const bf16_t* PB, const bf16_t* GMWS, bf16_t* YCAT) {
    const float* gng = F.in[I_GMNG1]; const float* gmb = F.in[I_GMB1];
    LAS float* rstd_s = (LAS float*)F.lds;
    LAS bf16_t* VT = (LAS bf16_t*)(F.lds + 1024);
    LAS bf16_t* AT = (LAS bf16_t*)(F.lds + 1024 + 128 * 136 * 2);
    for (int unit = F.bid; unit < 256; unit += F.G) {
        const int n = unit >> 1, gh = unit & 1, pos0 = n * 128;
        __syncthreads();
        for (int r = F.wave * 16; r < F.wave * 16 + 16; ++r) {
            const bf16_t* pr = PB + (size_t)(pos0 + r) * 5120 + 1024 + F.lane * 16;
            const u32x4 a = *(const u32x4*)pr, b = *(const u32x4*)(pr + 8);
            float ss = 0.f;
            ss += bf_lo(a.x) * bf_lo(a.x) + bf_hi(a.x) * bf_hi(a.x) + bf_lo(a.y) * bf_lo(a.y) + bf_hi(a.y) * bf_hi(a.y) + bf_lo(a.z) * bf_lo(a.z) + bf_hi(a.z) * bf_hi(a.z) + bf_lo(a.w) * bf_lo(a.w) + bf_hi(a.w) * bf_hi(a.w);
            ss += bf_lo(b.x) * bf_lo(b.x) + bf_hi(b.x) * bf_hi(b.x) + bf_lo(b.y) * bf_lo(b.y) + bf_hi(b.y) * bf_hi(b.y) + bf_lo(b.z) * bf_lo(b.z) + bf_hi(b.z) * bf_hi(b.z) + bf_lo(b.w) * bf_lo(b.w) + bf_hi(b.w) * bf_hi(b.w);
            ss = wave_sum(ss);
            if (F.lane == 0) rstd_s[r] = rsqrtf(ss * (1.0f / 1024.0f) + 1e-6f);
        }
        __syncthreads();
        for (int g = gh * 4; g < gh * 4 + 4; ++g) {
            for (int ch = F.tid; ch < 2048; ch += NTHR) { const int p = ch >> 4, q8 = (ch & 15) * 8;
                *(LAS u32x4*)(AT + p * 136 + q8) = *(const u32x4*)(GMWS + (size_t)g * 16384 + p * 128 + q8); }
            { const int q = F.tid >> 2, cp = (F.tid & 3) * 32; const float rs = rstd_s[q];
              const bf16_t* pr = PB + (size_t)(pos0 + q) * 5120 + 1024 + g * 128 + cp;
#pragma unroll
              for (int i = 0; i < 4; ++i) { const u32x4 w = *(const u32x4*)(pr + i * 8);
                  const float v[8] = {bf_lo(w.x), bf_hi(w.x), bf_lo(w.y), bf_hi(w.y), bf_lo(w.z), bf_hi(w.z), bf_lo(w.w), bf_hi(w.w)};
#pragma unroll
                  for (int e = 0; e < 8; ++e) { const int c = cp + i * 8 + e; VT[c * 136 + q] = f2bf(v[e] * rs * gng[g * 128 + c]); } } }
            __syncthreads();
            { const int pb = F.wave >> 1, cb0 = (F.wave & 1) * 2, r32 = F.lane & 31, hi = F.lane >> 5;
#pragma unroll
              for (int cbi = 0; cbi < 2; ++cbi) { const int cb = cb0 + cbi; f32x16 acc = {};
#pragma unroll
                  for (int k = 0; k < 8; ++k) { const bf16x8 a = *(const LAS bf16x8*)(AT + (pb * 32 + r32) * 136 + k * 16 + hi * 8), b = *(const LAS bf16x8*)(VT + (cb * 32 + r32) * 136 + k * 16 + hi * 8);
                      acc = __builtin_amdgcn_mfma_f32_32x32x16_bf16(a, b, acc, 0, 0, 0); }
                  const int c = g * 128 + cb * 32 + r32;
#pragma unroll
                  for (int rr = 0; rr < 16; ++rr) { const int p = pb * 32 + crow32(rr, hi); const size_t pos = (size_t)(pos0 + p);
                      const float sv = acc[rr] + gmb[g * 128 + p]; const float uu = bf1(PB[pos * 5120 + c]);
                      YCAT[pos * 2048 + c] = f2bf(uu * sv); } } }
            __syncthreads();
        }
    }
}
__device__ __forceinline__ void hyena_pre(const Fr& F, const bf16_t* PB, float* Z, bf16_t* G1B, bf16_t* X0B) {
    const float* cw = F.in[I_HYCW1]; const float* cb = F.in[I_HYCB1];
    for (int tile = F.bid; tile < SEQ / 64; tile += F.G) {
        const int cg = F.tid & 255, sub = F.tid >> 8, c0 = cg * 4, t0 = tile * 64 + sub * 32;
        float w0[3][4], w1[3][4], w2[3][4], bb[3][4];
#pragma unroll
        for (int pt = 0; pt < 3; ++pt)
#pragma unroll
            for (int e = 0; e < 4; ++e) { const int c = pt * 1024 + c0 + e; w0[pt][e] = cw[c]; w1[pt][e] = cw[3072 + c]; w2[pt][e] = cw[6144 + c]; bb[pt][e] = cb[c]; }
        float prev[3][4], cur[3][4], nxt[3][4];
        auto ld = [&](int t, float (&o)[3][4]) {
#pragma unroll
            for (int pt = 0; pt < 3; ++pt) {
                if (t < 0 || t >= SEQ) {
#pragma unroll
                    for (int e = 0; e < 4; ++e) o[pt][e] = 0.f;
                } else {
                    const u32x2 a = *(const u32x2*)(PB + (size_t)t * 5120 + 2048 + pt * 1024 + c0);
                    o[pt][0] = bf_lo(a.x); o[pt][1] = bf_hi(a.x); o[pt][2] = bf_lo(a.y); o[pt][3] = bf_hi(a.y);
                }
            }
        };
        ld(t0 - 1, prev); ld(t0, cur);
        for (int i = 0; i < 32; ++i) {
            const int t = t0 + i;
            ld(t + 1, nxt);
            float xs[3][4];
#pragma unroll
            for (int pt = 0; pt < 3; ++pt)
#pragma unroll
                for (int e = 0; e < 4; ++e) xs[pt][e] = w0[pt][e] * prev[pt][e] + w1[pt][e] * cur[pt][e] + w2[pt][e] * nxt[pt][e] + bb[pt][e];
            float g1[4];
#pragma unroll
            for (int e = 0; e < 4; ++e) g1[e] = xs[1][e] * xs[2][e];
            *(f32x4*)(Z + (size_t)t * 1024 + c0) = (f32x4){g1[0], g1[1], g1[2], g1[3]};
            u32x2 o; o.x = pk_bf16(g1[0], g1[1]); o.y = pk_bf16(g1[2], g1[3]);
            *(u32x2*)(G1B + (size_t)t * 1024 + c0) = o;
            o.x = pk_bf16(xs[0][0], xs[0][1]); o.y = pk_bf16(xs[0][2], xs[0][3]);
            *(u32x2*)(X0B + (size_t)t * 1024 + c0) = o;
#pragma unroll
            for (int pt = 0; pt < 3; ++pt)
#pragma unroll
                for (int e = 0; e < 4; ++e) { prev[pt][e] = cur[pt][e]; cur[pt][e] = nxt[pt][e]; }
        }
    }
}

__device__ __forceinline__ f32x2 cmul(f32x2 a, f32x2 b) { return (f32x2){a.x * b.x - a.y * b.y, a.x * b.y + a.y * b.x}; }
template <bool INV>
__device__ __forceinline__ void fft32(f32x2 (&v)[32]) {
    constexpr float CS[16] = {1.0f, 0.98078528040323043f, 0.92387953251128674f, 0.83146961230254524f, 0.70710678118654752f, 0.55557023301960218f, 0.38268343236508977f, 0.19509032201612825f,
                              0.0f, -0.19509032201612825f, -0.38268343236508977f, -0.55557023301960218f, -0.70710678118654752f, -0.83146961230254524f, -0.92387953251128674f, -0.98078528040323043f};
    constexpr float SN[16] = {0.0f, 0.19509032201612825f, 0.38268343236508977f, 0.55557023301960218f, 0.70710678118654752f, 0.83146961230254524f, 0.92387953251128674f, 0.98078528040323043f,
                              1.0f, 0.98078528040323043f, 0.92387953251128674f, 0.83146961230254524f, 0.70710678118654752f, 0.55557023301960218f, 0.38268343236508977f, 0.19509032201612825f};
#pragma unroll
    for (int s = 0; s < 5; ++s) {
        const int half = 16 >> s;
#pragma unroll
        for (int i = 0; i < 32; ++i) {
            if ((i & half) == 0) {
                const int j = i | half, tw = (i & (half - 1)) << s;
                const f32x2 a = v[i], b = v[j];
                v[i] = a + b;
                const f32x2 d = a - b;
                const float c = CS[tw], sn = INV ? SN[tw] : -SN[tw];
                v[j] = (f32x2){d.x * c - d.y * sn, d.x * sn + d.y * c};
            }
        }
    }
}
__host__ __device__ constexpr int brev5(int k) { return ((k & 1) << 4) | ((k & 2) << 2) | (k & 4) | ((k & 8) >> 2) | ((k & 16) >> 4); }

template <int MP, bool INV, int MODE>
__device__ __forceinline__ void fft_pass(const Fr& F, f32x2* Zb, const bf16_t* G1B, const bf16_t* X0B, const float* hbias, bf16_t* YCAT) {
    constexpr int S = 32 * MP;
    for (int it = F.bid * NTHR + F.tid; it < 1024 * 512; it += F.G * NTHR) {
        const int cp = it & 511, j = it >> 9, n_lo = j % MP, sblk = j / MP;
        const size_t base = ((size_t)sblk * S + n_lo) * 512 + cp;
        f32x2 v[32];
#pragma unroll
        for (int m = 0; m < 32; ++m) {
            if (MODE == 1 && m >= 16) v[m] = (f32x2){0.f, 0.f};
            else v[m] = Zb[base + (size_t)m * MP * 512];
        }
        if (!INV) {
            fft32<false>(v);
#pragma unroll
            for (int k = 0; k < 32; ++k) {
                f32x2 o = v[brev5(k)];
                if (MP > 1 && k > 0) { const float fr = (float)(n_lo * k) * (1.0f / (float)S); const f32x2 w = {__builtin_amdgcn_cosf(fr), -__builtin_amdgcn_sinf(fr)}; o = cmul(o, w); }
                Zb[base + (size_t)k * MP * 512] = o;
            }
        } else {
            if (MP > 1) {
#pragma unroll
                for (int k = 1; k < 32; ++k) { const float fr = (float)(n_lo * k) * (1.0f / (float)S); const f32x2 w = {__builtin_amdgcn_cosf(fr), __builtin_amdgcn_sinf(fr)}; v[k] = cmul(v[k], w); }
            }
            fft32<true>(v);
#pragma unroll
            for (int m = 0; m < 32; ++m) {
                const f32x2 o = v[brev5(m)];
                if (MODE != 2) Zb[base + (size_t)m * MP * 512] = o;
                else if (m < 16) {
                    const int nrow = sblk * S + n_lo + m * MP;
                    const unsigned g1w = *(const unsigned*)(G1B + (size_t)nrow * 1024 + cp * 2), x0w = *(const unsigned*)(X0B + (size_t)nrow * 1024 + cp * 2);
                    const f32x2 hb = *(const f32x2*)(hbias + cp * 2);
                    const float ya = bf_lo(x0w) * (o.x + hb.x * bf_lo(g1w)), yb = bf_hi(x0w) * (o.y + hb.y * bf_hi(g1w));
                    *(unsigned*)(YCAT + (size_t)nrow * 2048 + 1024 + cp * 2) = pk_bf16(ya, yb);
                }
            }
        }
    }
}
__device__ __forceinline__ int fft_pos(int k) { return ((k & 31) << 10) | (((k >> 5) & 31) << 5) | (k >> 10); }
__device__ __forceinline__ void fft_pointwise(const Fr& F, f32x2* Zb, const f32x2* Kb, const float* FNORM) {
    constexpr int N = 32768;
    for (int it = F.bid * NTHR + F.tid; it < (N / 2 + 1) * 512; it += F.G * NTHR) {
        const int cp = it & 511, k = it >> 9, k2 = (N - k) & (N - 1);
        const size_t p1 = (size_t)fft_pos(k) * 512 + cp, p2 = (size_t)fft_pos(k2) * 512 + cp;
        const f32x2 z1 = Zb[p1], z2 = Zb[p2], q1 = Kb[p1], q2 = Kb[p2];
        const float na = FNORM[cp * 2] * (0.5f * 0.5f / (float)N), nb = FNORM[cp * 2 + 1] * (0.5f * 0.5f / (float)N);
        const f32x2 ga = {z1.x + z2.x, z1.y - z2.y}, gb = {z1.y + z2.y, -(z1.x - z2.x)};
        const f32x2 ka = {(q1.x + q2.x) * na, (q1.y - q2.y) * na}, kb = {(q1.y + q2.y) * nb, -(q1.x - q2.x) * nb};
        const f32x2 ya = cmul(ga, ka), yb = cmul(gb, kb);
        Zb[p1] = (f32x2){ya.x - yb.y, ya.y + yb.x};
        if (k2 != k) Zb[p2] = (f32x2){ya.x + yb.y, -ya.y + yb.x};
    }
}

#ifndef MK_PER_PHASE
#define MK_PER_PHASE 1
#endif
constexpr int NPH = 23;

__global__ void __launch_bounds__(NTHR, 2) mk_fwd(Params P) {
    extern __shared__ __attribute__((aligned(16))) unsigned char lds_raw[];
    Fr F;
    F.in = P.in; F.out = P.out; F.ws = P.ws; F.lds = (LAS unsigned char*)lds_raw;
    F.tid = threadIdx.x; F.lane = F.tid & 63; F.wave = __builtin_amdgcn_readfirstlane(F.tid >> 6); F.G = gridDim.x; F.bid = blockIdx.x;
    unsigned char* ws = P.ws;
    const int lo = P.ph_lo, hi = P.ph_hi;
    volatile LAS unsigned* xbw = (volatile LAS unsigned*)(F.lds + LDS_CTL);
    if (F.tid < 4) xbw[F.tid] = 0u;
    __syncthreads();
    XcdBarrier bar; bar.bar = (unsigned*)(ws + WS_CTL); bar.x = 0; bar.st = xbw;
    if (hi - lo > 1) bar = xcd_barrier_post((unsigned*)(ws + WS_CTL), xbw);
#ifdef ONLY_PHASE
#define IN(k) ((k) == ONLY_PHASE && lo <= (k) && (k) < hi)
#else
#define IN(k) (lo <= (k) && (k) < hi)
#endif
#define SEAM(k) do { if (IN(k) && IN((k) + 1)) xcd_barrier(bar); } while (0)

    float* MOD0 = (float*)(ws + WS_MOD0); float* MOD1 = (float*)(ws + WS_MOD1); float* MC0 = (float*)(ws + WS_MC0);
    float* ROPEC = (float*)(ws + WS_ROPEC); float* ROPES = (float*)(ws + WS_ROPES);
    float* FPART = (float*)(ws + WS_FPART); float* FNORM = (float*)(ws + WS_FNORM);
    bf16_t* KEYS0 = (bf16_t*)(ws + WS_KEYS0); bf16_t* KEYS1 = (bf16_t*)(ws + WS_KEYS1); bf16_t* GMWS = (bf16_t*)(ws + WS_GMWS);
    bf16_t* WIN0 = (bf16_t*)(ws + WS_WIN0); bf16_t* WUQ = (bf16_t*)(ws + WS_WUQ); bf16_t* WUKV = (bf16_t*)(ws + WS_WUKV);
    bf16_t* WOUT0 = (bf16_t*)(ws + WS_WOUT0); bf16_t* WPQ0 = (bf16_t*)(ws + WS_WPQ0);
    bf16_t* WIN1 = (bf16_t*)(ws + WS_WIN1); bf16_t* WOUT1 = (bf16_t*)(ws + WS_WOUT1); bf16_t* WPQ1 = (bf16_t*)(ws + WS_WPQ1);
    bf16_t* TABU = (bf16_t*)(ws + WS_TABU); bf16_t* TABV = (bf16_t*)(ws + WS_TABV);
    float* XR = (float*)(ws + WS_XR); bf16_t* H = (bf16_t*)(ws + WS_H); bf16_t* PBUF = (bf16_t*)(ws + WS_PBUF);
    bf16_t* QN = (bf16_t*)(ws + WS_QN); bf16_t* KVN = (bf16_t*)(ws + WS_KVN); bf16_t* KROPE = (bf16_t*)(ws + WS_KROPE);
    bf16_t* Q = (bf16_t*)(ws + WS_Q); bf16_t* KV = (bf16_t*)(ws + WS_KV); bf16_t* YCAT = (bf16_t*)(ws + WS_YCAT);
    float* Z = (float*)(ws + WS_Z); float* KZ = (float*)(ws + WS_KZ);
    bf16_t* G1B = (bf16_t*)(ws + WS_G1B); bf16_t* X0B = (bf16_t*)(ws + WS_X0B);
    bf16_t* PQ = PBUF;

    if (IN(0)) {
        modgemv(F, P.in[I_C], P.in[I_CCTX], P.in[I_WMOD0], P.in[I_BMOD0], MOD0, MC0, 4096);
        modgemv(F, P.in[I_C], nullptr, P.in[I_WMOD1], P.in[I_BMOD1], MOD1, nullptr, 0);
        tconv_task(F, P.in[I_WIN0], 2048, 3904, 4096, WIN0);
        tconv_task(F, P.in[I_WUQ0], 512, 1536, 1536, WUQ);
        tconv_task(F, P.in[I_WUKV0], 256, 2048, 2048, WUKV);
        tconv_task(F, P.in[I_WOUT0], 2048, 2048, 2048, WOUT0);
        tconv_task(F, P.in[I_PWQ0], 2048, 2048, 2048, WPQ0);
        tconv_task(F, P.in[I_WIN1], 2048, 5120, 5120, WIN1);
        tconv_task(F, P.in[I_WOUT1], 2048, 2048, 2048, WOUT1);
        tconv_task(F, P.in[I_PWQ1], 2048, 2048, 2048, WPQ1);
        cvt_task(F, P.in[I_PKEYS0], KEYS0, 32768 / 8);
        cvt_task(F, P.in[I_PKEYS1], KEYS1, 32768 / 8);
        cvt_task(F, P.in[I_GMWS1], GMWS, 131072 / 8);
        rope_tables(F, ROPEC, ROPES);
        hyena_filter_gen(F, KZ, FPART);
        cvt_task(F, P.in[I_PU0], TABU, (size_t)16384 * 2048 / 8);
        cvt_task(F, P.in[I_PV0], TABV, (size_t)16384 * 2048 / 8);
    }
    SEAM(0);
    if (IN(1)) {
        norm_rows(F, P.in[I_X], SEQ, P.in[I_LN1G0], MOD0 + 2048, MOD0, H);
        norm_rows(F, P.in[I_CTX], CTXL, P.in[I_LN1G0], MC0 + 2048, MC0, H + (size_t)SEQ * 2048);
        hyena_filter_norm(F, FPART, FNORM);
        fft_pass<1024, false, 0>(F, (f32x2*)KZ, nullptr, nullptr, nullptr, nullptr);
    }
    SEAM(1);
    if (IN(2)) {
        pg8::Gemm g{H, WIN0, SEQ, 4096, 2048}; OrderIn0 S; S.init2(F.G, F.bid);
        EpiBf16G E{PBUF, 4096, 0};
        pg8::gemm_phase<EpiBf16G, OrderIn0, false>(F.lds, g, S, E, nullptr);
    }
    SEAM(2);
    if (IN(3)) {
        l0_post_proj(F, PBUF, QN, KVN, KROPE, YCAT, ROPEC, ROPES);
        fft_pass<32, false, 0>(F, (f32x2*)KZ, nullptr, nullptr, nullptr, nullptr);
    }
    SEAM(3);
    if (IN(4)) {
        { pg8::Gemm g{QN, WUQ, SEQ, 1536, 512}; pg8::StaticOrder S; S.init(SEQ, 1536, F.G, F.bid);
          EpiQRope E{Q, ROPEC, ROPES};
          pg8::gemm_phase<EpiQRope, pg8::StaticOrder, false>(F.lds, g, S, E, nullptr); }
        { pg8::Gemm g{KVN, WUKV, NKEY, 2048, 256}; pg8::StaticOrder S; S.init(NKEY, 2048, F.G, F.bid);
          EpiBf16G E{KV, 2048, 0};
          pg8::gemm_phase<EpiBf16G, pg8::StaticOrder, false>(F.lds, g, S, E, nullptr); }
    }
    SEAM(4);
    if (IN(5)) {
        for (int u = F.bid; u < 512; u += F.G) {
            const int h = u & 7, qb = u >> 3;
            att::attn_body(Q + (size_t)qb * 256 * 1536 + h * 192, KV + h * 256, KROPE, KV + h * 256 + 128, YCAT + (size_t)qb * 256 * 2048 + 1024 + h * 128, NKEY, F.lds);
        }
    }
    SEAM(5);
    if (IN(6)) {
        pg8::Gemm g{YCAT, WOUT0, SEQ, 2048, 2048}; pg8::StaticOrder S; S.init(SEQ, 2048, F.G, F.bid);
        EpiResid E{P.in[I_X], XR, MOD0 + 4096};
        pg8::gemm_phase<EpiResid, pg8::StaticOrder, false>(F.lds, g, S, E, nullptr);
    }
    SEAM(6);
    if (IN(7)) {
        norm_rows(F, XR, SEQ, P.in[I_LN2G0], MOD0 + 8192, MOD0 + 6144, H);
        fft_pass<1, false, 0>(F, (f32x2*)KZ, nullptr, nullptr, nullptr, nullptr);
    }
    SEAM(7);
    if (IN(8)) {
        pg8::Gemm g{H, WPQ0, SEQ, 2048, 2048}; pg8::StaticOrder S; S.init(SEQ, 2048, F.G, F.bid);
        EpiBf16G E{PQ, 2048, 0};
        pg8::gemm_phase<EpiBf16G, pg8::StaticOrder, false>(F.lds, g, S, E, nullptr);
    }
    SEAM(8);
    if (IN(9)) peer_phase<false>(F, PQ, KEYS0, H, TABU, TABV, XR, MOD0 + 10240, P.in[I_LN1G1], MOD1 + 2048, MOD1, nullptr);
    SEAM(9);
    if (IN(10)) {
        pg8::Gemm g{H, WIN1, SEQ, 5120, 2048}; pg8::StaticOrder S; S.init(SEQ, 5120, F.G, F.bid);
        EpiBf16G E{PBUF, 5120, 2048};
        pg8::gemm_phase<EpiBf16G, pg8::StaticOrder, false>(F.lds, g, S, E, nullptr);
    }
    SEAM(10);
    if (IN(11)) {
        gmlp_phase(F, PBUF, GMWS, YCAT);
        hyena_pre(F, PBUF, Z, G1B, X0B);
        cvt_task(F, P.in[I_PU1], TABU, (size_t)16384 * 2048 / 8);
        cvt_task(F, P.in[I_PV1], TABV, (size_t)16384 * 2048 / 8);
    }
    SEAM(11);
    if (IN(12)) fft_pass<1024, false, 1>(F, (f32x2*)Z, nullptr, nullptr, nullptr, nullptr);
    SEAM(12);
    if (IN(13)) fft_pass<32, false, 0>(F, (f32x2*)Z, nullptr, nullptr, nullptr, nullptr);
    SEAM(13);
    if (IN(14)) fft_pass<1, false, 0>(F, (f32x2*)Z, nullptr, nullptr, nullptr, nullptr);
    SEAM(14);
    if (IN(15)) fft_pointwise(F, (f32x2*)Z, (const f32x2*)KZ, FNORM);
    SEAM(15);
    if (IN(16)) fft_pass<1, true, 0>(F, (f32x2*)Z, nullptr, nullptr, nullptr, nullptr);
    SEAM(16);
    if (IN(17)) fft_pass<32, true, 0>(F, (f32x2*)Z, nullptr, nullptr, nullptr, nullptr);
    SEAM(17);
    if (IN(18)) fft_pass<1024, true, 2>(F, (f32x2*)Z, G1B, X0B, P.in[I_HYBIAS1], YCAT);
    SEAM(18);
    if (IN(19)) {
        pg8::Gemm g{YCAT, WOUT1, SEQ, 2048, 2048}; pg8::StaticOrder S; S.init(SEQ, 2048, F.G, F.bid);
        EpiResid E{XR, XR, MOD1 + 4096};
        pg8::gemm_phase<EpiResid, pg8::StaticOrder, false>(F.lds, g, S, E, nullptr);
    }
    SEAM(19);
    if (IN(20)) norm_rows(F, XR, SEQ, P.in[I_LN2G1], MOD1 + 8192, MOD1 + 6144, H);
    SEAM(20);
    if (IN(21)) {
        pg8::Gemm g{H, WPQ1, SEQ, 2048, 2048}; pg8::StaticOrder S; S.init(SEQ, 2048, F.G, F.bid);
        EpiBf16G E{PQ, 2048, 0};
        pg8::gemm_phase<EpiBf16G, pg8::StaticOrder, false>(F.lds, g, S, E, nullptr);
    }
    SEAM(21);
    if (IN(22)) peer_phase<true>(F, PQ, KEYS1, H, TABU, TABV, XR, MOD1 + 10240, P.in[I_FINALG], nullptr, nullptr, P.out);
#undef IN
#undef SEAM
}

#include <cstdio>
extern "C" void kernel_launch(void* const* d_in, const int* in_sizes, int n_in, void* d_out, int out_size, void* d_ws, size_t ws_size, hipStream_t stream) {
    static int grid = 0;
    if (grid == 0) {
        if (n_in != 43 || in_sizes[0] != SEQ * DM || out_size != SEQ * DM || ws_size < WS_END) {
            fprintf(stderr, "kernel_launch: unexpected shapes: n_in %d in0 %d out %d ws %zu (need %zu)\n", n_in, n_in > 0 ? in_sizes[0] : -1, out_size, ws_size, (size_t)WS_END); grid = -1; return; }
        int dev = 0, cus = 0, per_cu = 0;
        if (hipGetDevice(&dev) != hipSuccess || hipDeviceGetAttribute(&cus, hipDeviceAttributeMultiprocessorCount, dev) != hipSuccess) { grid = -1; return; }
        if (hipFuncSetAttribute((const void*)mk_fwd, hipFuncAttributeMaxDynamicSharedMemorySize, LDS_BYTES) != hipSuccess) { fprintf(stderr, "kernel_launch: hipFuncSetAttribute failed\n"); grid = -1; return; }
        if (hipOccupancyMaxActiveBlocksPerMultiprocessor(&per_cu, (const void*)mk_fwd, NTHR, LDS_BYTES) != hipSuccess || per_cu < 1) { fprintf(stderr, "kernel_launch: occupancy query says %d blocks per CU\n", per_cu); (void)hipGetLastError(); grid = -1; return; }
        grid = cus;
    }
    if (grid < 0) return;
    (void)hipMemsetAsync((char*)d_ws + WS_CTL, 0, 65536, stream);
    Params p{};
    for (int i = 0; i < 43; ++i) p.in[i] = (const float*)d_in[i];
    p.out = (float*)d_out; p.ws = (unsigned char*)d_ws;
#if MK_PER_PHASE
    for (int ph = 0; ph < NPH; ++ph) { p.ph_lo = ph; p.ph_hi = ph + 1; hipLaunchKernelGGL(mk_fwd, dim3(grid), dim3(NTHR), LDS_BYTES, stream, p); }
#else
    p.ph_lo = 0; p.ph_hi = NPH;
    hipLaunchKernelGGL(mk_fwd, dim3(grid), dim3(NTHR), LDS_BYTES, stream, p);
#endif
    const hipError_t le = hipPeekAtLastError();
    if (le != hipSuccess) fprintf(stderr, "kernel_launch: launch failed: %s\n", hipGetErrorName(le));
}
```

```cpp
#include <hip/hip_runtime.h>
namespace pg8 {
#define PG8_LAS __attribute__((address_space(3)))
typedef unsigned short bf16_t;
typedef short bf16x8 __attribute__((ext_vector_type(8)));
typedef float f32x4 __attribute__((ext_vector_type(4)));
typedef unsigned u32x4 __attribute__((ext_vector_type(4)));
constexpr int BM = 256, BK = 64, HALF = 128, HTB = HALF * BK * 2  , STAGE_BYTES = 8 * HTB, NXCD = 8, WGM = 8;

__host__ __device__ __forceinline__ int lds_byte(int r, int c) { const int st = (r >> 4) * 2 + (c >> 5), rr = r & 15, cc = c & 31, ob = rr * 64 + cc * 2; return st * 1024 + (ob ^ (((ob >> 9) & 1) << 5)); }
__host__ __device__ __forceinline__ void stage_rc(int b, int& R, int& C) { const int st = b / 1024, sb = b % 1024, swz = sb ^ (((sb >> 9) & 1) << 5); R = (st >> 1) * 16 + swz / 64; C = (st & 1) * 32 + (swz % 64) / 2; }
__host__ __device__ __forceinline__ int perm32(int rho) { const int n = rho >> 4, i = rho & 15; return 8 * (i >> 2) + 4 * n + (i & 3); }

struct Unit { int pm, pn; };
struct Gemm { const bf16_t* A; const bf16_t* Bt; int M, N, K; };

struct StaticOrder {
    int nM, nN, nwg, G, c;
    __host__ __device__ void init(int M, int N, int G_, int c_) { nM = M / BM; nN = N / BM; nwg = nM * nN; G = G_; c = c_; }
    __host__ __device__ bool next(int i, Unit& u) const {
        const long L = (long)i * G + c; if (L >= nwg) return false;
        int wgid = (int)L; { const int q = nwg / NXCD, r = nwg % NXCD, xcd = wgid % NXCD, off = wgid / NXCD; wgid = (xcd < r ? xcd * (q + 1) : r * (q + 1) + (xcd - r) * q) + off; }
        const int nig = WGM * nN, gid = wgid / nig, fm = gid * WGM, gsz = (nM - fm) < WGM ? (nM - fm) : WGM;
        u.pm = fm + ((wgid % nig) % gsz); u.pn = (wgid % nig) / gsz; return true;
    }
    __device__ __forceinline__ void a_ready(const Unit&) const {}
    __device__ __forceinline__ void done(const Unit&) const {}
};
struct CountedOrder : StaticOrder {
    const unsigned* ready; unsigned need; unsigned* tmo;
    __device__ __forceinline__ void a_ready(const Unit& u) const {
        if (threadIdx.x < 64) {
            const unsigned long long t0 = __builtin_amdgcn_s_memrealtime(); unsigned polls = 0;
            while ((unsigned)__builtin_amdgcn_readfirstlane(__hip_atomic_load(ready + 64 * u.pm, __ATOMIC_RELAXED, __HIP_MEMORY_SCOPE_AGENT)) < need) {
                if ((++polls & 255u) == 0u && __builtin_amdgcn_readfirstlane(__hip_atomic_load(tmo, __ATOMIC_RELAXED, __HIP_MEMORY_SCOPE_AGENT)) != 0u) break;
                if (__builtin_amdgcn_s_memrealtime() - t0 > 2000000ull) {
                    if (threadIdx.x == 0) { unsigned expect = 0u; __hip_atomic_compare_exchange_strong(tmo + 1, &expect, 0x600u | (unsigned)(u.pm & 0xff), __ATOMIC_RELAXED, __ATOMIC_RELAXED, __HIP_MEMORY_SCOPE_AGENT); __hip_atomic_store(tmo, 1u, __ATOMIC_RELAXED, __HIP_MEMORY_SCOPE_AGENT); }
                    break; }
                __builtin_amdgcn_s_sleep(2); }
            __builtin_amdgcn_fence(__ATOMIC_ACQUIRE, "agent");
            asm volatile("s_waitcnt vmcnt(0)" ::: "memory");
        }
#if !defined(BROKEN_HOOK_NO_BARRIER)
        asm volatile("" ::: "memory"); __builtin_amdgcn_s_barrier(); asm volatile("" ::: "memory");
#endif
    }
};

__device__ __forceinline__ unsigned cvt_pk_bf16(float lo, float hi) { unsigned r; asm volatile("v_cvt_pk_bf16_f32 %0, %1, %2" : "=v"(r) : "v"(lo), "v"(hi)); return r; }
typedef float f32x2 __attribute__((ext_vector_type(2)));
__device__ __forceinline__ f32x2 gelu_pk(f32x2 v) {
    const f32x2 av = __builtin_elementwise_abs(v), d = av * 0.2316418882f + 1.0f;
    f32x2 t; t.x = __builtin_amdgcn_rcpf(d.x); t.y = __builtin_amdgcn_rcpf(d.y);
    f32x2 q = t * 0.5307027145f + (-0.7265760135f); q = q * t + 0.7107068705f; q = q * t + (-0.142248368f); q = q * t + 0.127414796f; q = q * t;
    const f32x2 s = (v * v) * (-0.72134752044f);
    f32x2 e; e.x = __builtin_amdgcn_exp2f(s.x); e.y = __builtin_amdgcn_exp2f(s.y);
    const f32x2 m = v * (q * e), r = v - m;
    f32x2 o; o.x = v.x < 0.f ? m.x : r.x; o.y = v.y < 0.f ? m.y : r.y; return o;
}

struct EpiF32 {
    static constexpr bool PERM = false, AFTER_DRAIN = false;
    float* C; int ldc; const float* bias;
    __device__ __forceinline__ void operator()(const f32x4 (&acc)[2][2][4][2], const Unit& u, int wr, int wc, int fr, int fq) const {
        const int row0 = u.pm * BM + wr * 64 + fr, col0 = u.pn * BM + wc * 32 + 4 * fq;
        f32x4 bv[2][2];
#pragma unroll
        for (int bj = 0; bj < 2; ++bj)
#pragma unroll
            for (int n = 0; n < 2; ++n) bv[bj][n] = bias ? *(const f32x4*)(bias + col0 + bj * HALF + n * 16) : (f32x4){0.f, 0.f, 0.f, 0.f};
#pragma unroll
        for (int ai = 0; ai < 2; ++ai)
#pragma unroll
            for (int m = 0; m < 4; ++m) { float* rowp = C + (size_t)(row0 + ai * HALF + m * 16) * ldc + col0;
#pragma unroll
                for (int bj = 0; bj < 2; ++bj)
#pragma unroll
                    for (int n = 0; n < 2; ++n) *(f32x4*)(rowp + bj * HALF + n * 16) = acc[ai][bj][m][n] + bv[bj][n]; }
    }
};
template <int ACT  > struct EpiBf16 {
    static constexpr bool PERM = true, AFTER_DRAIN = false, I8 = false;
    bf16_t* O; int ldc; const float* bias; int split_cols; size_t split_stride;
    __device__ __forceinline__ void operator()(const f32x4 (&acc)[2][2][4][2], const Unit& u, int wr, int wc, int fr, int fq) const {
        const int row0 = u.pm * BM + wr * 64 + fr; int colt = u.pn * BM; bf16_t* base = O;
        if (split_cols) { const int t = colt / split_cols; base += (size_t)t * split_stride; colt -= t * split_cols; }
        const int col0 = colt + wc * 32 + 8 * fq, bcol0 = u.pn * BM + wc * 32 + 8 * fq;
        f32x4 bv[2][2];
#pragma unroll
        for (int bj = 0; bj < 2; ++bj)
#pragma unroll
            for (int n = 0; n < 2; ++n) bv[bj][n] = bias ? *(const f32x4*)(bias + bcol0 + bj * HALF + 4 * n) : (f32x4){0.f, 0.f, 0.f, 0.f};
#pragma unroll
        for (int ai = 0; ai < 2; ++ai)
#pragma unroll
            for (int m = 0; m < 4; ++m) { bf16_t* rowp = base + (size_t)(row0 + ai * HALF + m * 16) * ldc + col0;
#pragma unroll
                for (int bj = 0; bj < 2; ++bj) { f32x4 v0 = acc[ai][bj][m][0] + bv[bj][0], v1 = acc[ai][bj][m][1] + bv[bj][1];
                    if (ACT == 1) { f32x2 a = gelu_pk((f32x2){v0[0], v0[1]}), b = gelu_pk((f32x2){v0[2], v0[3]}), c = gelu_pk((f32x2){v1[0], v1[1]}), d = gelu_pk((f32x2){v1[2], v1[3]});
                        v0 = (f32x4){a.x, a.y, b.x, b.y}; v1 = (f32x4){c.x, c.y, d.x, d.y}; }
                    if (ACT == 2) {
#pragma unroll
                        for (int j = 0; j < 4; ++j) { v0[j] = 0.5f * v0[j] * (1.0f + erff(v0[j] * 0.70710678f)); v1[j] = 0.5f * v1[j] * (1.0f + erff(v1[j] * 0.70710678f)); } }
                    u32x4 w; w.x = cvt_pk_bf16(v0[0], v0[1]); w.y = cvt_pk_bf16(v0[2], v0[3]); w.z = cvt_pk_bf16(v1[0], v1[1]); w.w = cvt_pk_bf16(v1[2], v1[3]);
                    *(u32x4*)(rowp + bj * HALF) = w; } }
    }
};

struct PanelStats {
    unsigned* xbuf;
    unsigned* cnt;
    unsigned* tmo;
    int ntn; float eps;
    unsigned code;
    __device__ __forceinline__ bool run(const f32x4 (&v)[2][2][4][2], const Unit& u, int wr, int wc, int fr, int fq, PG8_LAS unsigned char* lds, int wid, int lane) const {
        typedef float f32x2v __attribute__((ext_vector_type(2)));
        PG8_LAS f32x2v* P = (PG8_LAS f32x2v*)lds;
        PG8_LAS f32x2v* S = (PG8_LAS f32x2v*)(lds + 8192);
        PG8_LAS unsigned* flag = (PG8_LAS unsigned*)(lds + 8192 + 2048);
#pragma unroll
        for (int ai = 0; ai < 2; ++ai)
#pragma unroll
            for (int m = 0; m < 4; ++m) {
                float s = 0.f;
#pragma unroll
                for (int bj = 0; bj < 2; ++bj)
#pragma unroll
                    for (int n = 0; n < 2; ++n) { const f32x4 x = v[ai][bj][m][n]; s += (x[0] + x[1]) + (x[2] + x[3]); }
                s += __shfl_xor(s, 16); s += __shfl_xor(s, 32);
                const float mw = s * (1.0f / 64.0f); float q = 0.f;
#pragma unroll
                for (int bj = 0; bj < 2; ++bj)
#pragma unroll
                    for (int n = 0; n < 2; ++n) { const f32x4 d = v[ai][bj][m][n] - mw; q += (d[0] * d[0] + d[1] * d[1]) + (d[2] * d[2] + d[3] * d[3]); }
                q += __shfl_xor(q, 16); q += __shfl_xor(q, 32);
                if (fq == 0) P[(ai * HALF + wr * 64 + m * 16 + fr) * 4 + wc] = (f32x2v){mw, q};
            }
        asm volatile("s_waitcnt lgkmcnt(0)" ::: "memory"); __builtin_amdgcn_s_barrier(); asm volatile("" ::: "memory");
#if defined(BROKEN_NO_WAIT)
        if (blockIdx.x >= 64) { const long long t0 = clock64(); while (clock64() - t0 < 60000) __builtin_amdgcn_s_sleep(8); }
#endif
        const int row = wid * 32 + (lane & 31);
        if (lane < 32) {
            const f32x2v a = P[row * 4 + 0], b = P[row * 4 + 1], c = P[row * 4 + 2], d = P[row * 4 + 3];
            const float mt = (a.x + b.x + c.x + d.x) * 0.25f;
            const float da = a.x - mt, db = b.x - mt, dc = c.x - mt, dd = d.x - mt;
            const float m2 = (a.y + b.y) + (c.y + d.y) + 64.0f * ((da * da + db * db) + (dc * dc + dd * dd));
            unsigned long long* slot = (unsigned long long*)xbuf + ((size_t)(u.pm * BM + row) * 4 + u.pn);
            __hip_atomic_store(slot, ((unsigned long long)__float_as_uint(m2) << 32) | __float_as_uint(mt), __ATOMIC_RELAXED, __HIP_MEMORY_SCOPE_AGENT);
        }
        asm volatile("s_waitcnt vmcnt(0)" ::: "memory");
        if (lane == 0) __hip_atomic_fetch_add(cnt + 64 * u.pm, 1u, __ATOMIC_RELAXED, __HIP_MEMORY_SCOPE_AGENT);
        if (wid == 0) {
            bool dead = false; const unsigned long long t0 = __builtin_amdgcn_s_memrealtime(); const unsigned want = 8u * (unsigned)ntn;
            for (;;) {
#if defined(BROKEN_NO_WAIT)
                break;
#endif
                if ((unsigned)__builtin_amdgcn_readfirstlane(__hip_atomic_load(cnt + 64 * u.pm, __ATOMIC_RELAXED, __HIP_MEMORY_SCOPE_AGENT)) >= want) break;
                if (__builtin_amdgcn_s_memrealtime() - t0 > 2000000ull) {
                    if (lane == 0) { unsigned expect = 0u; __hip_atomic_compare_exchange_strong(tmo + 1, &expect, code | (unsigned)(u.pm & 0xff), __ATOMIC_RELAXED, __ATOMIC_RELAXED, __HIP_MEMORY_SCOPE_AGENT);
                                     __hip_atomic_store(tmo, 1u, __ATOMIC_RELAXED, __HIP_MEMORY_SCOPE_AGENT); }
                    dead = true; break; }
                __builtin_amdgcn_s_sleep(2);
            }
            __builtin_amdgcn_fence(__ATOMIC_ACQUIRE, "agent");
            if (lane == 0) flag[0] = dead ? 1u : 0u;
        }
        asm volatile("s_waitcnt vmcnt(0) lgkmcnt(0)" ::: "memory"); __builtin_amdgcn_s_barrier(); asm volatile("" ::: "memory");
        const bool bad = flag[0] != 0u;
        if (lane < 32) {
            const unsigned long long* slot = (const unsigned long long*)xbuf + (size_t)(u.pm * BM + row) * 4; float mt[4], m2[4]; float ms = 0.f;
#pragma unroll
            for (int t = 0; t < 4; ++t) { if (t < ntn) { const unsigned long long w = __hip_atomic_load(slot + t, __ATOMIC_RELAXED, __HIP_MEMORY_SCOPE_AGENT); mt[t] = __uint_as_float((unsigned)w); m2[t] = __uint_as_float((unsigned)(w >> 32)); } else { mt[t] = 0.f; m2[t] = 0.f; } ms += mt[t]; }
            const float mean = ms / (float)ntn; float q = 0.f;
#pragma unroll
            for (int t = 0; t < 4; ++t) if (t < ntn) { const float dm = mt[t] - mean; q += m2[t] + 256.0f * dm * dm; }
            S[row] = (f32x2v){mean, 1.0f / sqrtf(q / (256.0f * (float)ntn) + eps)};
        }
        asm volatile("s_waitcnt lgkmcnt(0)" ::: "memory"); __builtin_amdgcn_s_barrier(); asm volatile("" ::: "memory");
        return bad;
    }
};
struct EpiLnRes {
    static constexpr bool PERM = false, AFTER_DRAIN = true;
    const float* base; float* out; int ldc; const float* bias; PanelStats st; unsigned poison;
    __device__ __forceinline__ void refuse(size_t i0, size_t stride, int M, int N) const { const float q = __builtin_nanf(""); for (size_t i = i0; i < (size_t)M * N; i += stride) out[(i / N) * ldc + i % N] = q;
        if (i0 == 0) { unsigned expect = 0u; __hip_atomic_compare_exchange_strong(st.tmo + 1, &expect, 0x7f0u, __ATOMIC_RELAXED, __ATOMIC_RELAXED, __HIP_MEMORY_SCOPE_AGENT); __hip_atomic_store(st.tmo, 1u, __ATOMIC_RELAXED, __HIP_MEMORY_SCOPE_AGENT); } }
    __device__ __forceinline__ void fused(f32x4 (&acc)[2][2][4][2], const Unit& u, int wr, int wc, int fr, int fq, PG8_LAS unsigned char* lds, int wid, int lane) const {
        typedef float f32x2v __attribute__((ext_vector_type(2)));
        const PG8_LAS f32x2v* S = (const PG8_LAS f32x2v*)(lds + 8192);
        const int col0 = u.pn * BM + wc * 32 + 4 * fq;
#pragma unroll
        for (int bj = 0; bj < 2; ++bj)
#pragma unroll
            for (int n = 0; n < 2; ++n) { const f32x4 bv = bias ? *(const f32x4*)(bias + col0 + bj * HALF + n * 16) : (f32x4){0.f, 0.f, 0.f, 0.f};
#pragma unroll
                for (int ai = 0; ai < 2; ++ai)
#pragma unroll
                    for (int m = 0; m < 4; ++m) acc[ai][bj][m][n] += bv; }
        const bool bad = st.run(acc, u, wr, wc, fr, fq, lds, wid, lane) || poison != 0u;
        const float qnan = __builtin_nanf("");
#pragma unroll
        for (int ai = 0; ai < 2; ++ai)
#pragma unroll
            for (int m = 0; m < 4; ++m) { const int r = ai * HALF + wr * 64 + m * 16 + fr; const f32x2v sr = S[r]; const size_t off = (size_t)(u.pm * BM + r) * ldc + col0;
#pragma unroll
                for (int bj = 0; bj < 2; ++bj)
#pragma unroll
                    for (int n = 0; n < 2; ++n) { const f32x4 bs = *(const f32x4*)(base + off + bj * HALF + n * 16); f32x4 o = bs + (acc[ai][bj][m][n] - sr.x) * sr.y;
                        if (bad) o = (f32x4){qnan, qnan, qnan, qnan}; *(f32x4*)(out + off + bj * HALF + n * 16) = o; }
                asm volatile("" ::: "memory"); }
    }
};
struct EpiLnResLn {
    static constexpr bool PERM = false, AFTER_DRAIN = true;
    const float* base; float* out; bf16_t* xn; int ldc; const float* bias; PanelStats st1, st2; unsigned poison;
    __device__ __forceinline__ void refuse(size_t i0, size_t stride, int M, int N) const { const float q = __builtin_nanf(""); for (size_t i = i0; i < (size_t)M * N; i += stride) { const size_t o = (i / N) * ldc + i % N; out[o] = q; xn[o] = (bf16_t)0x7fc0u; }
        if (i0 == 0) { unsigned expect = 0u; __hip_atomic_compare_exchange_strong(st1.tmo + 1, &expect, 0x7f0u, __ATOMIC_RELAXED, __ATOMIC_RELAXED, __HIP_MEMORY_SCOPE_AGENT); __hip_atomic_store(st1.tmo, 1u, __ATOMIC_RELAXED, __HIP_MEMORY_SCOPE_AGENT); } }
    __device__ __forceinline__ void fused(f32x4 (&acc)[2][2][4][2], const Unit& u, int wr, int wc, int fr, int fq, PG8_LAS unsigned char* lds, int wid, int lane) const {
        typedef float f32x2v __attribute__((ext_vector_type(2))); typedef unsigned u32x2v __attribute__((ext_vector_type(2)));
        const PG8_LAS f32x2v* S = (const PG8_LAS f32x2v*)(lds + 8192);
        const int col0 = u.pn * BM + wc * 32 + 4 * fq;
#pragma unroll
        for (int bj = 0; bj < 2; ++bj)
#pragma unroll
            for (int n = 0; n < 2; ++n) { const f32x4 bv = bias ? *(const f32x4*)(bias + col0 + bj * HALF + n * 16) : (f32x4){0.f, 0.f, 0.f, 0.f};
#pragma unroll
                for (int ai = 0; ai < 2; ++ai)
#pragma unroll
                    for (int m = 0; m < 4; ++m) acc[ai][bj][m][n] += bv; }
        bool bad = st1.run(acc, u, wr, wc, fr, fq, lds, wid, lane) || poison != 0u;
        const float qnan = __builtin_nanf("");
#pragma unroll
        for (int ai = 0; ai < 2; ++ai)
#pragma unroll
            for (int m = 0; m < 4; ++m) { const int r = ai * HALF + wr * 64 + m * 16 + fr; const f32x2v sr = S[r]; const size_t off = (size_t)(u.pm * BM + r) * ldc + col0;
#pragma unroll
                for (int bj = 0; bj < 2; ++bj)
#pragma unroll
                    for (int n = 0; n < 2; ++n) { const f32x4 bs = *(const f32x4*)(base + off + bj * HALF + n * 16); acc[ai][bj][m][n] = bs + (acc[ai][bj][m][n] - sr.x) * sr.y; }
                asm volatile("" : "+v"(acc[ai][0][m][0]), "+v"(acc[ai][0][m][1]), "+v"(acc[ai][1][m][0]), "+v"(acc[ai][1][m][1]));
                if (m & 1) asm volatile("" ::: "memory"); }
        const bool bad1 = bad;
        bad = st2.run(acc, u, wr, wc, fr, fq, lds, wid, lane) || bad;
#pragma unroll
        for (int ai = 0; ai < 2; ++ai)
#pragma unroll
            for (int m = 0; m < 4; ++m) { const int r = ai * HALF + wr * 64 + m * 16 + fr; const f32x2v sr = S[r]; const size_t off = (size_t)(u.pm * BM + r) * ldc + col0;
#pragma unroll
                for (int bj = 0; bj < 2; ++bj)
#pragma unroll
                    for (int n = 0; n < 2; ++n) { const f32x4 x1 = acc[ai][bj][m][n]; *(f32x4*)(out + off + bj * HALF + n * 16) = bad1 ? (f32x4){qnan, qnan, qnan, qnan} : x1;
                        const f32x4 o = (x1 - sr.x) * sr.y; u32x2v w; w.x = cvt_pk_bf16(o[0], o[1]); w.y = cvt_pk_bf16(o[2], o[3]);
                        if (bad) { w.x = 0x7fc07fc0u; w.y = 0x7fc07fc0u; } *(u32x2v*)(xn + off + bj * HALF + n * 16) = w; }
                asm volatile("" ::: "memory"); }
    }
};

typedef int i32x4_t __attribute__((ext_vector_type(4)));
template <bool I8> __device__ __forceinline__ f32x4 mma_step(const bf16x8& b, const bf16x8& a, const f32x4& c) {
    if constexpr (I8) { const i32x4_t r = __builtin_amdgcn_mfma_i32_16x16x64_i8(__builtin_bit_cast(i32x4_t, b), __builtin_bit_cast(i32x4_t, a), __builtin_bit_cast(i32x4_t, c), 0, 0, 0); return __builtin_bit_cast(f32x4, r); }
    else return __builtin_amdgcn_mfma_f32_16x16x32_bf16(b, a, c, 0, 0, 0);
}
template <class Epi, class Sched, bool STAMP = false>
__device__ __forceinline__ void gemm_phase(PG8_LAS unsigned char* lds, const Gemm g, const Sched& S, const Epi& E, unsigned long long* stamps) {
    const int tid = threadIdx.x, wid = __builtin_amdgcn_readfirstlane(tid >> 6), lane = tid & 63, wr = wid >> 2, wc = wid & 3, fr = lane & 15, fq = lane >> 4;
    const int K = g.K, nt = K / BK;
    int ts_lo = 0, ts_hi = 0, nts = 0; const unsigned long long rt_entry = STAMP ? (unsigned long long)wall_clock64() : 0ull;
#define PG8_STAMP() do { if (STAMP && wid == 0 && nts < 64) { const unsigned long long _c = (unsigned long long)clock64(); \
        ts_lo = (lane == nts) ? (int)(unsigned)_c : ts_lo; ts_hi = (lane == nts) ? (int)(unsigned)(_c >> 32) : ts_hi; ++nts; } } while (0)
    PG8_STAMP();
    unsigned voffA[2], voffB[2];
#pragma unroll
    for (int i = 0; i < 2; ++i) { int R, C; stage_rc(tid * 16 + i * 8192, R, C); const int Rb = Epi::PERM ? ((R & ~31) + perm32(R & 31)) : R;
        voffA[i] = (unsigned)(R * K + C) * 2u; voffB[i] = (unsigned)(Rb * K + C) * 2u; }
    const size_t kstep = (size_t)(BK * 2);
    const size_t hstep = (size_t)HALF * K * 2;
    const size_t tstep = 2 * hstep;
    const unsigned ldsw = (unsigned)wid * 1024u;
    const int aoff = lds_byte(wr * 64 + fr, fq * 8), boff = lds_byte(wc * 32 + fr, fq * 8);
#define PG8_SA(b, h) (((b) * 2 + (h)) * HTB)
#define PG8_SB(b, h) ((4 + (b) * 2 + (h)) * HTB)
#define PG8_STAGE(bufoff, gbase, voff) do { _Pragma("unroll") for (int _i = 0; _i < 2; ++_i) \
        __builtin_amdgcn_global_load_lds((const unsigned*)((const char*)(gbase) + (voff)[_i]), (PG8_LAS unsigned*)(lds + (bufoff) + ldsw + _i * 8192), 16, 0, 0); } while (0)
#define PG8_LDA(dst, b, h) do { _Pragma("unroll") for (int m = 0; m < 4; ++m) _Pragma("unroll") for (int k = 0; k < 2; ++k) dst[m][k] = *(const PG8_LAS bf16x8*)(lds + PG8_SA(b, h) + aoff + m * 2048 + k * 1024); } while (0)
#define PG8_LDB(dst, b, h) do { _Pragma("unroll") for (int n = 0; n < 2; ++n) _Pragma("unroll") for (int k = 0; k < 2; ++k) dst[n][k] = *(const PG8_LAS bf16x8*)(lds + PG8_SB(b, h) + boff + n * 2048 + k * 1024); } while (0)
#define PG8_MMA(ai, bj, At, Bt) do { __builtin_amdgcn_s_setprio(1); _Pragma("unroll") for (int m = 0; m < 4; ++m) _Pragma("unroll") for (int n = 0; n < 2; ++n) _Pragma("unroll") for (int k = 0; k < 2; ++k) \
        acc[ai][bj][m][n] = mma_step<Epi::I8>(Bt[n][k], At[m][k], acc[ai][bj][m][n]); __builtin_amdgcn_s_setprio(0); } while (0)
#define PG8_WAIT_V(n) asm volatile("s_waitcnt vmcnt(" #n ")" ::: "memory")
#define PG8_WAIT_L(n) asm volatile("s_waitcnt lgkmcnt(" #n ")" ::: "memory")
#define PG8_BAR __builtin_amdgcn_s_barrier()
#define PG8_SCHED __builtin_amdgcn_sched_barrier(0)
    Unit cur, nxt; int ui = 0;
    if (!S.next(0, cur)) return;
    f32x4 acc[2][2][4][2];
#pragma unroll
    for (int a = 0; a < 2; ++a)
#pragma unroll
        for (int b = 0; b < 2; ++b)
#pragma unroll
            for (int m = 0; m < 4; ++m)
#pragma unroll
                for (int n = 0; n < 2; ++n) acc[a][b][m][n] = (f32x4){0.f, 0.f, 0.f, 0.f};
    bf16x8 At[4][2], B0[2][2], B1[2][2];
    const char* cA = (const char*)g.A + (size_t)cur.pm * tstep; const char* cB = (const char*)g.Bt + (size_t)cur.pn * tstep;
    S.a_ready(cur);
    PG8_STAGE(PG8_SB(0, 0), cB, voffB); PG8_STAGE(PG8_SA(0, 0), cA, voffA); PG8_STAGE(PG8_SB(0, 1), cB + hstep, voffB); PG8_STAGE(PG8_SA(0, 1), cA + hstep, voffA);
    if (wr == 1) PG8_BAR;
    PG8_WAIT_V(4); PG8_BAR;
    PG8_STAGE(PG8_SB(1, 0), cB + kstep, voffB); PG8_STAGE(PG8_SA(1, 0), cA + kstep, voffA); PG8_STAGE(PG8_SB(1, 1), cB + hstep + kstep, voffB);
    PG8_WAIT_V(6); PG8_BAR;
    PG8_STAMP();
    for (;;) {
        const bool has_next = S.next(ui + 1, nxt);
        const char* nA = has_next ? (const char*)g.A + (size_t)nxt.pm * tstep : cA; const char* nB = has_next ? (const char*)g.Bt + (size_t)nxt.pn * tstep : cB;
        for (int t = 0; t < nt; t += 2) {
            const bool last = (t == nt - 2);
            const char* a1 = cA + (size_t)(t + 1) * kstep;
            const char* a2 = last ? nA : cA + (size_t)(t + 2) * kstep; const char* b2 = last ? nB : cB + (size_t)(t + 2) * kstep;
            const char* a3 = a2 + kstep; const char* b3 = b2 + kstep;
            if (last && has_next) S.a_ready(nxt);
            PG8_LDB(B0, 0, 0); PG8_SCHED; PG8_LDA(At, 0, 0); PG8_STAGE(PG8_SA(1, 1), a1 + hstep, voffA);
            PG8_WAIT_L(8); PG8_BAR; PG8_WAIT_L(0); PG8_MMA(0, 0, At, B0); PG8_BAR; PG8_SCHED;
            PG8_LDB(B1, 0, 1); PG8_STAGE(PG8_SB(0, 0), b2, voffB);
            PG8_BAR; PG8_WAIT_L(0); PG8_MMA(0, 1, At, B1); PG8_BAR;
            PG8_LDA(At, 0, 1); PG8_STAGE(PG8_SA(0, 0), a2, voffA);
            PG8_BAR; PG8_WAIT_L(0); PG8_MMA(1, 0, At, B0); PG8_BAR; PG8_SCHED;
            PG8_STAGE(PG8_SB(0, 1), b2 + hstep, voffB);
            PG8_WAIT_V(6); PG8_BAR; PG8_MMA(1, 1, At, B1); PG8_BAR;
            PG8_LDB(B0, 1, 0); PG8_SCHED; PG8_LDA(At, 1, 0); PG8_STAGE(PG8_SA(0, 1), a2 + hstep, voffA);
            PG8_WAIT_L(8); PG8_BAR; PG8_WAIT_L(0); PG8_MMA(0, 0, At, B0); PG8_BAR; PG8_SCHED;
            PG8_LDB(B1, 1, 1); PG8_STAGE(PG8_SB(1, 0), b3, voffB);
            PG8_BAR; PG8_WAIT_L(0); PG8_MMA(0, 1, At, B1); PG8_BAR;
            PG8_LDA(At, 1, 1); PG8_STAGE(PG8_SA(1, 0), a3, voffA);
            PG8_BAR; PG8_WAIT_L(0); PG8_MMA(1, 0, At, B0); PG8_BAR; PG8_SCHED;
            PG8_STAGE(PG8_SB(1, 1), b3 + hstep, voffB);
            PG8_WAIT_V(6); PG8_BAR; PG8_MMA(1, 1, At, B1); PG8_BAR;
        }
        PG8_STAMP();
        if constexpr (!Epi::AFTER_DRAIN) { E(acc, cur, wr, wc, fr, fq); S.done(cur); }
        PG8_STAMP();
        if (!has_next) break;
#pragma unroll
        for (int a = 0; a < 2; ++a)
#pragma unroll
            for (int b = 0; b < 2; ++b)
#pragma unroll
                for (int m = 0; m < 4; ++m)
#pragma unroll
                    for (int n = 0; n < 2; ++n) acc[a][b][m][n] = (f32x4){0.f, 0.f, 0.f, 0.f};
        cur = nxt; cA = nA; cB = nB; ++ui;
    }
    PG8_WAIT_V(0);
    if (wr == 0) PG8_BAR;
    PG8_BAR;
    if constexpr (Epi::AFTER_DRAIN) { E.fused(acc, cur, wr, wc, fr, fq, lds, wid, lane); S.done(cur); }
    PG8_STAMP();
    if (STAMP && wid == 0) { stamps[lane] = lane < nts ? (((unsigned long long)(unsigned)ts_hi << 32) | (unsigned)ts_lo) : 0ull;
        if (lane == 62) stamps[62] = rt_entry; if (lane == 63) stamps[63] = (unsigned long long)wall_clock64(); }
#undef PG8_STAMP
#undef PG8_SA
#undef PG8_SB
#undef PG8_STAGE
#undef PG8_LDA
#undef PG8_LDB
#undef PG8_MMA
#undef PG8_WAIT_V
#undef PG8_WAIT_L
#undef PG8_BAR
#undef PG8_SCHED
}
}

#define LAS __attribute__((address_space(3)))
typedef unsigned short bf16_t;
typedef short bf16x8 __attribute__((ext_vector_type(8)));
typedef short s16x4 __attribute__((ext_vector_type(4)));
typedef float f32x4 __attribute__((ext_vector_type(4)));
typedef float f32x2 __attribute__((ext_vector_type(2)));
typedef float f32x16 __attribute__((ext_vector_type(16)));
typedef unsigned u32x4 __attribute__((ext_vector_type(4)));
typedef unsigned u32x2 __attribute__((ext_vector_type(2)));
typedef __bf16 bf2_t __attribute__((ext_vector_type(2)));

constexpr int SEQ = 16384, DM = 2048, CTXL = 256, NKEY = SEQ + CTXL;
constexpr int NTHR = 512;
constexpr int ZP = 512;
constexpr int LDS_BYTES = 163840;
constexpr int LDS_CTL = LDS_BYTES - 256;

__device__ __forceinline__ float wave_sum(float v) {
#pragma unroll
    for (int o = 32; o >= 1; o >>= 1) v += __shfl_xor(v, o);
    return v;
}
__device__ __forceinline__ unsigned pk_bf16(float lo, float hi) { unsigned r; asm volatile("v_cvt_pk_bf16_f32 %0, %1, %2" : "=v"(r) : "v"(lo), "v"(hi)); return r; }
__device__ __forceinline__ float bf_lo(unsigned w) { return __uint_as_float(w << 16); }
__device__ __forceinline__ float bf_hi(unsigned w) { return __uint_as_float(w & 0xffff0000u); }
__device__ __forceinline__ float bf1(bf16_t h) { return __uint_as_float(((unsigned)h) << 16); }
__device__ __forceinline__ bf16_t f2bf(float f) { return (bf16_t)(pk_bf16(f, 0.f) & 0xffffu); }
__device__ __forceinline__ float gelu_tanh(float x) {
    const float u = 1.5957691216057308f * (x + 0.044715f * x * x * x);
    return x / (1.f + __expf(-u));
}
__device__ __forceinline__ float silu_f(float v) { return v / (1.f + __expf(-v)); }
__device__ __forceinline__ float dpp_f32_quad_swap1(float v) { return __int_as_float(__builtin_amdgcn_update_dpp(0, __float_as_int(v), 0xB1, 0xf, 0xf, true)); }
typedef _Float16 h2_t __attribute__((ext_vector_type(2)));
__device__ __forceinline__ unsigned pk_h2(f32x2 v) { h2_t h; h.x = (_Float16)v.x; h.y = (_Float16)v.y; return *(unsigned*)&h; }
__device__ __forceinline__ f32x2 un_h2(unsigned u) { h2_t h = *(h2_t*)&u; return (f32x2){(float)h.x, (float)h.y}; }

#define XB_TMO      128
#define XB_XCNT(j)  (256  + 64 * (j))
#define XB_XSUB(j)  (1280 + 64 * (j))
#define XB_XGEN(j)  (2304 + 64 * (j))
#define XB_TOP      3328
#define XB_TOPGEN   3392
#define XCD_BAR_WORDS 3456
#define XB_SPIN_CAP (1u << 22)
__device__ __forceinline__ unsigned xb_ld(unsigned* p)              { return __hip_atomic_load(p, __ATOMIC_RELAXED, __HIP_MEMORY_SCOPE_AGENT); }
__device__ __forceinline__ unsigned xb_add(unsigned* p, unsigned v) { return __hip_atomic_fetch_add(p, v, __ATOMIC_RELAXED, __HIP_MEMORY_SCOPE_AGENT); }
__device__ __forceinline__ unsigned xb_xcc_id() { return (unsigned)__builtin_amdgcn_s_getreg((3 << 11) | 20) & 0xFu; }
#define XB_SPIN(cond, bar) do { unsigned _sp = 0; while (cond) { __builtin_amdgcn_s_sleep(1); \
    if ((++_sp & 255u) == 0u) { if (xb_ld(&(bar)[XB_TMO])) break; if (_sp > XB_SPIN_CAP) { atomicAdd(&(bar)[XB_TMO], 1u); break; } } } } while (0)
struct XcdBarrier { unsigned* bar; unsigned x; volatile LAS unsigned* st; };
__device__ __forceinline__ XcdBarrier xcd_barrier_post(unsigned* bar, volatile LAS unsigned* st) {
    XcdBarrier b; b.bar = bar; b.x = xb_xcc_id(); b.st = st;
    if (threadIdx.x == 0) (void)xb_add(&bar[XB_XCNT(b.x)], 1u);
    return b;
}
__device__ __forceinline__ void xcd_barrier_complete(unsigned* bar, unsigned x, unsigned& nloc, unsigned& nx) {
    const unsigned G = gridDim.x * gridDim.y * gridDim.z;
    unsigned sum, cnt, mine, sp = 0u;
    for (;;) {
        sum = 0u; cnt = 0u; mine = 0u;
#pragma unroll
        for (unsigned j = 0; j < 16; ++j) { const unsigned c = xb_ld(&bar[XB_XCNT(j)]); sum += c; cnt += (c > 0u) ? 1u : 0u; mine = (j == x) ? c : mine; }
        if (sum == G) break;
        __builtin_amdgcn_s_sleep(1);
        if ((++sp & 255u) == 0u) { if (xb_ld(&bar[XB_TMO])) break; if (sp > XB_SPIN_CAP) { atomicAdd(&bar[XB_TMO], 1u); break; } }
    }
    nloc = mine > 0u ? mine : 1u; nx = cnt > 0u ? cnt : 1u;
}
__device__ __forceinline__ void xcd_barrier(const XcdBarrier& b) {
    asm volatile("s_waitcnt vmcnt(0)" ::: "memory");
    __syncthreads();
    if (threadIdx.x == 0) {
        unsigned* bar = b.bar;
        __builtin_amdgcn_s_waitcnt(0);
        unsigned nloc = b.st[0], nx = b.st[1];
        if (nloc == 0u) { xcd_barrier_complete(bar, b.x, nloc, nx); b.st[0] = nloc; b.st[1] = nx; }
        const unsigned old = xb_add(&bar[XB_XSUB(b.x)], 1u);
        const unsigned gen = old / nloc;
        if (old + 1u == (gen + 1u) * nloc) {
            __builtin_amdgcn_fence(__ATOMIC_RELEASE, "agent");
            asm volatile("s_waitcnt vmcnt(0)" ::: "memory");
            const unsigned og = xb_add(&bar[XB_TOP], 1u);
            const unsigned tg = og / nx;
            if (og + 1u == (tg + 1u) * nx) xb_add(&bar[XB_TOPGEN], 1u);
            else XB_SPIN(xb_ld(&bar[XB_TOPGEN]) == tg, bar);
            __builtin_amdgcn_fence(__ATOMIC_ACQUIRE, "agent");
            xb_add(&bar[XB_XGEN(b.x)], 1u);
            asm volatile("s_waitcnt vmcnt(0)" ::: "memory");
        } else {
            XB_SPIN(xb_ld(&bar[XB_XGEN(b.x)]) == gen, bar);
            __builtin_amdgcn_fence(__ATOMIC_ACQUIRE, "agent");
            asm volatile("s_waitcnt vmcnt(0)" ::: "memory");
        }
    }
    __syncthreads();
}

constexpr size_t WS_CTL   = 0;
constexpr size_t WS_MOD0  = 65536;
constexpr size_t WS_MOD1  = WS_MOD0 + 49152;
constexpr size_t WS_MC0   = WS_MOD1 + 49152;
constexpr size_t WS_ROPEC = WS_MC0 + 16384;
constexpr size_t WS_ROPES = WS_ROPEC + 2097152;
constexpr size_t WS_FPART = WS_ROPES + 2097152;
constexpr size_t WS_FNORM = WS_FPART + 4194304;
constexpr size_t WS_TSC   = WS_FNORM + 4096;
constexpr size_t WS_SA    = WS_TSC + 262144;
constexpr size_t WS_SW    = WS_SA + 69632;
constexpr size_t WS_KEYS0 = WS_SW + 131072;
constexpr size_t WS_KEYS1 = WS_KEYS0 + 65536;
constexpr size_t WS_GMWS  = WS_KEYS1 + 65536;
constexpr size_t WS_WIN0  = WS_GMWS + 262144;
constexpr size_t WS_WUQ   = WS_WIN0 + (size_t)4096 * 2048 * 2;
constexpr size_t WS_WUKV  = WS_WUQ + (size_t)1536 * 512 * 2;
constexpr size_t WS_WOUT0 = WS_WUKV + (size_t)2048 * 256 * 2;
constexpr size_t WS_WPQ0  = WS_WOUT0 + (size_t)2048 * 2048 * 2;
constexpr size_t WS_WIN1  = WS_WPQ0 + (size_t)2048 * 2048 * 2;
constexpr size_t WS_WOUT1 = WS_WIN1 + (size_t)5120 * 2048 * 2;
constexpr size_t WS_WPQ1  = WS_WOUT1 + (size_t)2048 * 2048 * 2;
constexpr size_t WS_TABU  = WS_WPQ1 + (size_t)2048 * 2048 * 2;
constexpr size_t WS_TABV  = WS_TABU + (size_t)16384 * 2048 * 2;
constexpr size_t WS_XR    = WS_TABV + (size_t)16384 * 2048 * 2;
constexpr size_t WS_H     = WS_XR + (size_t)16384 * 2048 * 4;
constexpr size_t WS_PBUF  = WS_H + (size_t)NKEY * 2048 * 2;
constexpr size_t WS_L0X   = WS_PBUF + (size_t)16384 * 5120 * 2;
constexpr size_t WS_QN    = WS_L0X;
constexpr size_t WS_KVN   = WS_QN + (size_t)16384 * 512 * 2;
constexpr size_t WS_KROPE = WS_KVN + (size_t)NKEY * 256 * 2;
constexpr size_t WS_Q     = WS_KROPE + (size_t)NKEY * 64 * 2;
constexpr size_t WS_KV    = WS_Q + (size_t)16384 * 1536 * 2;
constexpr size_t WS_L0END = WS_KV + (size_t)NKEY * 2048 * 2;
constexpr size_t WS_Z     = WS_L0X;
static_assert(WS_L0END - WS_L0X >= (size_t)32768 * ZP * 4, "Z alias");
static_assert(WS_L0END - WS_L0X >= (size_t)16 * 16384 * 128 * 4, "PD alias");
static_assert((size_t)NKEY * 4096 * 2 <= (size_t)16384 * 5120 * 2, "PBUF");
constexpr size_t WS_YCAT  = WS_L0END;
constexpr size_t WS_KZ    = WS_YCAT + (size_t)16384 * 2048 * 2;
constexpr size_t WS_KZ2   = WS_KZ + (size_t)32768 * ZP * 4;
constexpr size_t WS_END   = WS_KZ2 + (size_t)32768 * ZP * 4;
constexpr size_t WS_G1B   = WS_H;
constexpr size_t WS_X0B   = WS_H + (size_t)16384 * 1024 * 2;
static_assert(WS_END < (size_t)1000000000, "workspace budget");

struct Params { const float* in[43]; float* out; unsigned char* ws; int ph_lo, ph_hi, flags, pad; };
struct Fr { const float* const* in; float* out; unsigned char* ws; LAS unsigned char* lds; int tid, lane, wave, G, bid; int xcc, xcc_rank, xcc_n, xcc_ok; };

enum { I_X = 0, I_C, I_CTX, I_CCTX, I_LN1G0, I_WMOD0, I_BMOD0, I_WIN0, I_CONVW0, I_QNG0, I_WUQ0, I_KVNG0, I_WUKV0, I_WOUT0, I_LN2G0, I_PWQ0, I_PKEYS0, I_PU0, I_PV0,
       I_LN1G1, I_WMOD1, I_BMOD1, I_WIN1, I_GMNG1, I_GMWS1, I_GMB1, I_HYCW1, I_HYCB1, I_HYW1, I_HYB1, I_HYF1, I_HYW2, I_HYB2, I_HYF2, I_HYW3, I_HYBIAS1, I_WOUT1, I_LN2G1, I_PWQ1, I_PKEYS1, I_PU1, I_PV1, I_FINALG };

__device__ __forceinline__ void tconv_task(const Fr& F, const float* W, int K, int N, int Npad, bf16_t* Bt) {
    LAS float* tile = (LAS float*)F.lds;
    const int tn = Npad / 64, tk = K / 64, nt = tn * tk;
    for (int t0 = F.bid * 4; t0 < nt; t0 += F.G * 4) {
        const int i = F.tid >> 3, jq = F.tid & 7;
        f32x4 a[4], b[4];
#pragma unroll
        for (int q = 0; q < 4; ++q) { const int t = t0 + q; a[q] = (f32x4){0.f, 0.f, 0.f, 0.f}; b[q] = a[q];
            if (t < nt) { const int n0 = (t % tn) * 64, k0 = (t / tn) * 64;
                if (n0 < N) { const float* p = W + (size_t)(k0 + i) * N + n0 + jq * 8; a[q] = *(const f32x4*)p; b[q] = *(const f32x4*)(p + 4); } } }
        __syncthreads();
#pragma unroll
        for (int q = 0; q < 4; ++q)
#pragma unroll
            for (int e = 0; e < 4; ++e) { tile[q * 4160 + i * 65 + jq * 8 + e] = a[q][e]; tile[q * 4160 + i * 65 + jq * 8 + 4 + e] = b[q][e]; }
        __syncthreads();
        const int j = F.tid >> 3, ic = F.tid & 7;
#pragma unroll
        for (int q = 0; q < 4; ++q) { const int t = t0 + q;
            if (t < nt) { const int n0 = (t % tn) * 64, k0 = (t / tn) * 64;
                float v[8];
#pragma unroll
                for (int e = 0; e < 8; ++e) v[e] = tile[q * 4160 + (ic * 8 + e) * 65 + j];
                u32x4 w; w.x = pk_bf16(v[0], v[1]); w.y = pk_bf16(v[2], v[3]); w.z = pk_bf16(v[4], v[5]); w.w = pk_bf16(v[6], v[7]);
                *(u32x4*)(Bt + (size_t)(n0 + j) * K + k0 + ic * 8) = w; } }
    }
    __syncthreads();
}
__device__ __forceinline__ void colmax_task(const Fr& F, const float* W, int K, int N, int Npad, float* SW) {
    LAS float* red = (LAS float*)F.lds;
    const int i = F.tid >> 3, jq = F.tid & 7;
    for (int st = F.bid; st < Npad / 32; st += F.G) {
        const int n0 = st * 32;
        f32x4 cm = {0.f, 0.f, 0.f, 0.f};
        if (n0 < N) {
            const float* p = W + (size_t)i * N + n0 + jq * 4;
#pragma unroll 8
            for (int k = 0; k < K; k += 64) { const f32x4 w = *(const f32x4*)(p + (size_t)k * N);
                cm[0] = fmaxf(cm[0], fabsf(w[0])); cm[1] = fmaxf(cm[1], fabsf(w[1])); cm[2] = fmaxf(cm[2], fabsf(w[2])); cm[3] = fmaxf(cm[3], fabsf(w[3])); }
        }
        __syncthreads();
#pragma unroll
        for (int e = 0; e < 4; ++e) red[i * 33 + jq * 4 + e] = cm[e];
        __syncthreads();
        if (F.tid < 32) { float m = 0.f; for (int q = 0; q < 64; ++q) m = fmaxf(m, red[q * 33 + F.tid]); SW[n0 + F.tid] = m > 0.f ? m * (1.0f / 127.0f) : 1.0f; }
    }
    __syncthreads();
}
__device__ __forceinline__ void tconv_q_task(const Fr& F, const float* W, int K, int N, int Npad, const float* SW, unsigned char* Bt8) {
    LAS float* tile = (LAS float*)F.lds;
    const int tn = Npad / 64, tk = K / 64, nt = tn * tk;
    for (int t0 = F.bid * 4; t0 < nt; t0 += F.G * 4) {
        const int i = F.tid >> 3, jq = F.tid & 7;
        f32x4 a[4], b[4]; float sw4[4];
#pragma unroll
        for (int q = 0; q < 4; ++q) { const int t = t0 + q; a[q] = (f32x4){0.f, 0.f, 0.f, 0.f}; b[q] = a[q]; sw4[q] = 1.0f;
            if (t < nt) { const int n0 = (t % tn) * 64, k0 = (t / tn) * 64;
                sw4[q] = SW[n0 + (F.tid >> 3)];
                if (n0 < N) { const float* p = W + (size_t)(k0 + i) * N + n0 + jq * 8; a[q] = *(const f32x4*)p; b[q] = *(const f32x4*)(p + 4); } } }
        __syncthreads();
#pragma unroll
        for (int q = 0; q < 4; ++q)
#pragma unroll
            for (int e = 0; e < 4; ++e) { tile[q * 4160 + i * 65 + jq * 8 + e] = a[q][e]; tile[q * 4160 + i * 65 + jq * 8 + 4 + e] = b[q][e]; }
        __syncthreads();
        const int j = F.tid >> 3, ic = F.tid & 7;
#pragma unroll
        for (int q = 0; q < 4; ++q) { const int t = t0 + q;
            if (t < nt) { const int n0 = (t % tn) * 64, k0 = (t / tn) * 64;
                const float inv = 1.0f / sw4[q];
                int qv[8];
#pragma unroll
                for (int e = 0; e < 8; ++e) { const int r = (int)rintf(tile[q * 4160 + (ic * 8 + e) * 65 + j] * inv); qv[e] = r < -127 ? -127 : (r > 127 ? 127 : r); }
                u32x2 w; w.x = (unsigned)((qv[0] & 255) | ((qv[1] & 255) << 8) | ((qv[2] & 255) << 16) | ((qv[3] & 255) << 24));
                w.y = (unsigned)((qv[4] & 255) | ((qv[5] & 255) << 8) | ((qv[6] & 255) << 16) | ((qv[7] & 255) << 24));
                *(u32x2*)(Bt8 + (size_t)(n0 + j) * K + k0 + ic * 8) = w; } }
    }
    __syncthreads();
}
__device__ __forceinline__ void cvt_task(const Fr& F, const float* src, bf16_t* dst, size_t n8) {
    for (size_t i = (size_t)F.bid * NTHR + F.tid; i < n8; i += (size_t)F.G * NTHR) {
        const f32x4 a = *(const f32x4*)(src + i * 8), b = *(const f32x4*)(src + i * 8 + 4);
        u32x4 w; w.x = pk_bf16(a[0], a[1]); w.y = pk_bf16(a[2], a[3]); w.z = pk_bf16(b[0], b[1]); w.w = pk_bf16(b[2], b[3]);
        *(u32x4*)(dst + i * 8) = w;
    }
}
template <bool FP8>
__device__ __forceinline__ void cvt_table(const Fr& F, const float* src, unsigned char* dst, float* scale) {
    const int rstep = F.G * 16;
    f32x4 vn[2][8];
#define CT_LOAD(R0) do { _Pragma("unroll") for (int rr = 0; rr < 2; ++rr) _Pragma("unroll") for (int i = 0; i < 8; ++i) vn[rr][i] = *(const f32x4*)(src + (size_t)((R0) + rr) * 2048 + i * 256 + F.lane * 4); } while (0)
    { const int rf = (F.bid * 8 + F.wave) * 2; if (rf < 16384) CT_LOAD(rf); }
    for (int row0 = (F.bid * 8 + F.wave) * 2; row0 < 16384; row0 += rstep) {
        f32x4 v[2][8];
#pragma unroll
        for (int rr = 0; rr < 2; ++rr)
#pragma unroll
            for (int i = 0; i < 8; ++i) v[rr][i] = vn[rr][i];
        if (row0 + rstep < 16384) CT_LOAD(row0 + rstep);
#pragma unroll
        for (int rr = 0; rr < 2; ++rr) {
            const int row = row0 + rr; float am = 0.f;
#pragma unroll
            for (int i = 0; i < 8; ++i) am = fmaxf(am, fmaxf(fmaxf(fabsf(v[rr][i][0]), fabsf(v[rr][i][1])), fmaxf(fabsf(v[rr][i][2]), fabsf(v[rr][i][3]))));
#pragma unroll
            for (int o = 32; o >= 1; o >>= 1) am = fmaxf(am, __shfl_xor(am, o));
            const float top = FP8 ? 400.0f : 127.0f;
            const float sc = am > 0.f ? am * (1.0f / top) : 1.0f, inv = am > 0.f ? top / am : 1.0f;
#pragma unroll
            for (int i = 0; i < 8; ++i) {
                int p;
                if (FP8) { p = 0; p = __builtin_amdgcn_cvt_pk_fp8_f32(v[rr][i][0] * inv, v[rr][i][1] * inv, p, false); p = __builtin_amdgcn_cvt_pk_fp8_f32(v[rr][i][2] * inv, v[rr][i][3] * inv, p, true); }
                else { int q[4];
#pragma unroll
                    for (int e = 0; e < 4; ++e) { const int t = (int)rintf(v[rr][i][e] * inv); q[e] = t < -127 ? -127 : (t > 127 ? 127 : t); }
                    p = (q[0] & 255) | ((q[1] & 255) << 8) | ((q[2] & 255) << 16) | ((q[3] & 255) << 24); }
                const int e0 = i * 256 + F.lane * 4;
                *(int*)(dst + (size_t)(e0 >> 7) * 2097152 + (size_t)row * 128 + (e0 & 127)) = p; }
            if (F.lane == 0) scale[row] = sc;
        }
    }
#undef CT_LOAD
}
__device__ __forceinline__ void modgemv(const Fr& F, const float* c, const float* c2, const float* W, const float* b, float* out, float* out2, int ncol2) {
    LAS float* s1 = (LAS float*)F.lds;
    LAS float* s2 = s1 + 2048;
    LAS float* red = s2 + 2048;
    LAS float* red2 = red + 42 * 48;
    __syncthreads();
    for (int k = F.tid; k < 2048; k += NTHR) { s1[k] = silu_f(c[k]); s2[k] = c2 ? silu_f(c2[k]) : 0.f; }
    __syncthreads();
    for (int chunk = F.bid; chunk < 256; chunk += F.G) {
        const int col0 = chunk * 48, cq = F.tid % 12, kl = F.tid / 12;
        const bool do2 = (c2 != nullptr) && (col0 < ncol2);
        if (kl < 42) {
            f32x4 a1 = {0.f, 0.f, 0.f, 0.f}, a2 = {0.f, 0.f, 0.f, 0.f};
            const float* wp = W + col0 + cq * 4;
#pragma unroll 8
            for (int k = kl; k < 2048; k += 42) { const f32x4 w = *(const f32x4*)(wp + (size_t)k * 12288); a1 += s1[k] * w; a2 += s2[k] * w; }
#pragma unroll
            for (int e = 0; e < 4; ++e) { red[kl * 48 + cq * 4 + e] = a1[e]; red2[kl * 48 + cq * 4 + e] = a2[e]; }
        }
        __syncthreads();
        if (F.tid < 48) {
            float r1 = 0.f, r2 = 0.f;
            for (int q = 0; q < 42; ++q) { r1 += red[q * 48 + F.tid]; r2 += red2[q * 48 + F.tid]; }
            const float bb = b[col0 + F.tid];
            out[col0 + F.tid] = r1 + bb;
            if (do2 && col0 + F.tid < ncol2) out2[col0 + F.tid] = r2 + bb;
        }
        __syncthreads();
    }
}
__device__ __forceinline__ void rope_tables(const Fr& F, float* rc, float* rs) {
    for (int it = F.bid * NTHR + F.tid; it < SEQ * 32; it += F.G * NTHR) {
        const int t = it >> 5, jj = it & 31, seg = jj >> 4, j = jj & 15;
        const int pos = seg ? (t & 63) : (t >> 6);
        const float inv = powf(10000.0f, -(float)j / 16.0f);
        const float ang = (float)pos * inv;
        float s, c; sincosf(ang, &s, &c);
        rc[it] = c; rs[it] = s;
    }
}
__device__ __forceinline__ void quant_rows(const Fr& F, const bf16_t* X, unsigned char* out8, float* sa) {
    for (int row0 = (F.bid * 8 + F.wave) * 2; row0 < SEQ; row0 += F.G * 16) {
        u32x4 w[2][4];
#pragma unroll
        for (int rr = 0; rr < 2; ++rr)
#pragma unroll
            for (int i = 0; i < 4; ++i) w[rr][i] = *(const u32x4*)(X + (size_t)(row0 + rr) * DM + i * 512 + F.lane * 8);
        __builtin_amdgcn_sched_barrier(0);
#pragma unroll
        for (int rr = 0; rr < 2; ++rr) {
            f32x4 v[8]; float am = 0.f;
#pragma unroll
            for (int i = 0; i < 4; ++i) { v[2 * i] = (f32x4){bf_lo(w[rr][i].x), bf_hi(w[rr][i].x), bf_lo(w[rr][i].y), bf_hi(w[rr][i].y)}; v[2 * i + 1] = (f32x4){bf_lo(w[rr][i].z), bf_hi(w[rr][i].z), bf_lo(w[rr][i].w), bf_hi(w[rr][i].w)}; }
#pragma unroll
            for (int i = 0; i < 8; ++i) am = fmaxf(am, fmaxf(fmaxf(fabsf(v[i][0]), fabsf(v[i][1])), fmaxf(fabsf(v[i][2]), fabsf(v[i][3]))));
#pragma unroll
            for (int o = 32; o >= 1; o >>= 1) am = fmaxf(am, __shfl_xor(am, o));
            const float inv = am > 0.f ? 127.0f / am : 0.f;
#pragma unroll
            for (int i = 0; i < 4; ++i) { u32x2 o;
                { int q[4];
#pragma unroll
                  for (int e = 0; e < 4; ++e) q[e] = (int)rintf(v[2 * i][e] * inv);
                  o.x = (unsigned)((q[0] & 255) | ((q[1] & 255) << 8) | ((q[2] & 255) << 16) | ((q[3] & 255) << 24)); }
                { int q[4];
#pragma unroll
                  for (int e = 0; e < 4; ++e) q[e] = (int)rintf(v[2 * i + 1][e] * inv);
                  o.y = (unsigned)((q[0] & 255) | ((q[1] & 255) << 8) | ((q[2] & 255) << 16) | ((q[3] & 255) << 24)); }
                *(u32x2*)(out8 + (size_t)(row0 + rr) * DM + i * 512 + F.lane * 8) = o; }
            if (F.lane == 0) sa[row0 + rr] = am > 0.f ? am * (1.0f / 127.0f) : 1.0f;
        }
    }
}
template <bool Q8>
__device__ __forceinline__ void norm_rows_b(const Fr& F, const bf16_t* X, const float* g, const float* sc, const float* sh, bf16_t* out, unsigned char* out8 = nullptr, float* sa = nullptr) {
    f32x4 cs[8], cb[8];
#pragma unroll
    for (int i = 0; i < 4; ++i)
#pragma unroll
        for (int hf = 0; hf < 2; ++hf) { const int col = i * 512 + F.lane * 8 + hf * 4; const f32x4 gg = *(const f32x4*)(g + col), a = *(const f32x4*)(sc + col); cs[i * 2 + hf] = gg * (1.0f + a); cb[i * 2 + hf] = *(const f32x4*)(sh + col); }
    for (int row0 = (F.bid * 8 + F.wave) * 2; row0 < SEQ; row0 += F.G * 16) {
        u32x4 w[2][4];
#pragma unroll
        for (int rr = 0; rr < 2; ++rr)
#pragma unroll
            for (int i = 0; i < 4; ++i) w[rr][i] = *(const u32x4*)(X + (size_t)(row0 + rr) * DM + i * 512 + F.lane * 8);
        __builtin_amdgcn_sched_barrier(0);
#pragma unroll
        for (int rr = 0; rr < 2; ++rr) {
            f32x4 v[8]; float ss = 0.f;
#pragma unroll
            for (int i = 0; i < 4; ++i) { v[2 * i] = (f32x4){bf_lo(w[rr][i].x), bf_hi(w[rr][i].x), bf_lo(w[rr][i].y), bf_hi(w[rr][i].y)}; v[2 * i + 1] = (f32x4){bf_lo(w[rr][i].z), bf_hi(w[rr][i].z), bf_lo(w[rr][i].w), bf_hi(w[rr][i].w)}; }
#pragma unroll
            for (int i = 0; i < 8; ++i) ss += v[i][0] * v[i][0] + v[i][1] * v[i][1] + v[i][2] * v[i][2] + v[i][3] * v[i][3];
            ss = wave_sum(ss);
            const float rstd = rsqrtf(ss * (1.0f / DM) + 1e-6f);
            if constexpr (!Q8) {
#pragma unroll
            for (int i = 0; i < 4; ++i) {
                const f32x4 y0 = v[2 * i] * rstd * cs[2 * i] + cb[2 * i], y1 = v[2 * i + 1] * rstd * cs[2 * i + 1] + cb[2 * i + 1];
                u32x4 o; o.x = pk_bf16(y0[0], y0[1]); o.y = pk_bf16(y0[2], y0[3]); o.z = pk_bf16(y1[0], y1[1]); o.w = pk_bf16(y1[2], y1[3]);
                *(u32x4*)(out + (size_t)(row0 + rr) * DM + i * 512 + F.lane * 8) = o;
            }
            } else {
                float am = 0.f;
#pragma unroll
                for (int i = 0; i < 8; ++i) { v[i] = v[i] * rstd * cs[i] + cb[i]; am = fmaxf(am, fmaxf(fmaxf(fabsf(v[i][0]), fabsf(v[i][1])), fmaxf(fabsf(v[i][2]), fabsf(v[i][3])))); }
#pragma unroll
                for (int o = 32; o >= 1; o >>= 1) am = fmaxf(am, __shfl_xor(am, o));
                const float inv = am > 0.f ? 127.0f / am : 0.f;
#pragma unroll
                for (int i = 0; i < 4; ++i) { u32x2 o;
                    { int q[4];
#pragma unroll
                      for (int e = 0; e < 4; ++e) q[e] = (int)rintf(v[2 * i][e] * inv);
                      o.x = (unsigned)((q[0] & 255) | ((q[1] & 255) << 8) | ((q[2] & 255) << 16) | ((q[3] & 255) << 24)); }
                    { int q[4];
#pragma unroll
                      for (int e = 0; e < 4; ++e) q[e] = (int)rintf(v[2 * i + 1][e] * inv);
                      o.y = (unsigned)((q[0] & 255) | ((q[1] & 255) << 8) | ((q[2] & 255) << 16) | ((q[3] & 255) << 24)); }
                    *(u32x2*)(out8 + (size_t)(row0 + rr) * DM + i * 512 + F.lane * 8) = o; }
                if (F.lane == 0) sa[row0 + rr] = am > 0.f ? am * (1.0f / 127.0f) : 1.0f;
            }
        }
    }
}
__device__ __forceinline__ void hyena_filter_gen(const Fr& F, unsigned* KZ, float* FPART) {
    const float* w1 = F.in[I_HYW1]; const float* b1 = F.in[I_HYB1]; const float* f1 = F.in[I_HYF1];
    const float* w2 = F.in[I_HYW2]; const float* b2 = F.in[I_HYB2]; const float* f2 = F.in[I_HYF2];
    const float* w3 = F.in[I_HYW3];
    LAS float* zf = (LAS float*)F.lds;
    LAS float* a1 = zf + 64 * 33;
    LAS bf16_t* a2b = (LAS bf16_t*)(a1 + 64 * 64);
    const int r32 = F.lane & 31, hi = F.lane >> 5;
    const float da = -3.0701134573253944f, db = -15.350567286626972f;
    float psum[8];
#pragma unroll
    for (int cb = 0; cb < 8; ++cb) psum[cb] = 0.f;
    for (int pb = F.bid; pb < SEQ / 64; pb += F.G) {
        const int l0 = pb * 64;
        __syncthreads();
        for (int it = F.tid; it < 64 * 33; it += NTHR) {
            const int pos = it / 33, f = it % 33; const int l = l0 + pos;
            const float t = (float)l / (float)(SEQ - 1);
            const float w = (6.283185307179586f / (float)SEQ) * (float)l;
            float v;
            if (f == 0) v = t;
            else { const int j = (f - 1) & 15; const float band = 1e-4f + (float)j * ((15.0f - 1e-4f) / 15.0f); v = (f <= 16) ? cosf(band * w) : -sinf(band * w); }
            zf[pos * 33 + f] = v;
        }
        __syncthreads();
        for (int it = F.tid; it < 64 * 64; it += NTHR) {
            const int pos = it >> 6, u = it & 63; float s = b1[u];
            for (int f = 0; f < 33; ++f) s += zf[pos * 33 + f] * w1[f * 64 + u];
            a1[pos * 64 + u] = sinf(f1[u] * s);
        }
        __syncthreads();
        for (int it = F.tid; it < 64 * 64; it += NTHR) {
            const int pos = it >> 6, u = it & 63; float s = b2[u];
            for (int v = 0; v < 64; ++v) s += a1[pos * 64 + v] * w2[v * 64 + u];
            a2b[pos * 72 + u] = f2bf(sinf(f2[u] * s));
        }
        __syncthreads();
        bf16x8 af[2][4];
#pragma unroll
        for (int rb = 0; rb < 2; ++rb)
#pragma unroll
            for (int ks = 0; ks < 4; ++ks) af[rb][ks] = *(const LAS bf16x8*)(a2b + (rb * 32 + r32) * 72 + ks * 16 + hi * 8);
#pragma unroll 1
        for (int cb = 0; cb < 8; ++cb) {
            const int gcol = F.wave * 256 + cb * 32 + r32;
            f32x16 acc[2] = {};
#pragma unroll
            for (int ks = 0; ks < 4; ++ks) {
                float wv[8];
#pragma unroll
                for (int j = 0; j < 8; ++j) wv[j] = w3[(size_t)(ks * 16 + hi * 8 + j) * 2048 + gcol];
                u32x4 bw; bw.x = pk_bf16(wv[0], wv[1]); bw.y = pk_bf16(wv[2], wv[3]); bw.z = pk_bf16(wv[4], wv[5]); bw.w = pk_bf16(wv[6], wv[7]);
                const bf16x8 bf = *(bf16x8*)&bw;
                acc[0] = __builtin_amdgcn_mfma_f32_32x32x16_bf16(af[0][ks], bf, acc[0], 0, 0, 0);
                acc[1] = __builtin_amdgcn_mfma_f32_32x32x16_bf16(af[1][ks], bf, acc[1], 0, 0, 0);
            }
            const bool bwd = gcol >= 1024; const int c = gcol & 1023;
            const float dl2 = fabsf(da + (float)c * ((db - da) / 1023.0f)) * 1.4426950408889634f;
            float ps = 0.f;
#pragma unroll
            for (int rb = 0; rb < 2; ++rb)
#pragma unroll
                for (int rr = 0; rr < 16; ++rr) {
                    const int l = l0 + rb * 32 + (rr & 3) + 8 * (rr >> 2) + 4 * hi;
                    const float t = (float)l / (float)(SEQ - 1);
                    const float v = acc[rb][rr] * __builtin_amdgcn_exp2f(-t * dl2);
                    const float vn = dpp_f32_quad_swap1(v);
                    const bool keep = !(bwd && l == 0);
                    if (keep) ps += fabsf(v);
                    if (keep && (r32 & 1) == 0) KZ[(size_t)(bwd ? 2 * SEQ - l : l) * ZP + (c >> 1)] = pk_h2((f32x2){v, vn});
                }
            psum[cb] += ps;
        }
    }
#pragma unroll
    for (int cb = 0; cb < 8; ++cb) {
        auto sw = __builtin_amdgcn_permlane32_swap(__float_as_uint(psum[cb]), __float_as_uint(psum[cb]), false, false);
        const float tot = __uint_as_float(sw[0]) + __uint_as_float(sw[1]);
        if (hi == 0) FPART[(size_t)F.bid * 2048 + F.wave * 256 + cb * 32 + r32] = tot;
    }
    if (F.bid == 0) for (int c = F.tid; c < 512; c += NTHR) KZ[(size_t)SEQ * ZP + c] = 0u;
}
__device__ __forceinline__ void hyena_filter_norm(const Fr& F, const float* FPART, float* FNORM) {
    for (int c = F.bid * 8 + F.wave; c < 1024; c += F.G * 8) {
        float s = 0.f;
        for (int b = F.lane; b < F.G; b += 64) s += FPART[(size_t)b * 2048 + c] + FPART[(size_t)b * 2048 + 1024 + c];
        s = wave_sum(s);
        if (F.lane == 0) FNORM[c] = 1.0f / (s + 1e-6f);
    }
}

template <bool Q8>
__device__ __forceinline__ void norm_rows(const Fr& F, const float* X, int nrows, const float* g, const float* sc, const float* sh, bf16_t* out, unsigned char* out8 = nullptr, float* sa = nullptr) {
    f32x4 cs[8], cb[8];
#pragma unroll
    for (int i = 0; i < 8; ++i) { const int col = i * 256 + F.lane * 4; const f32x4 gg = *(const f32x4*)(g + col), a = *(const f32x4*)(sc + col); cs[i] = gg * (1.0f + a); cb[i] = *(const f32x4*)(sh + col); }
    for (int row0 = (F.bid * 8 + F.wave) * 2; row0 < nrows; row0 += F.G * 16) {
        f32x4 v[2][8];
#pragma unroll
        for (int i = 0; i < 8; ++i) { v[0][i] = *(const f32x4*)(X + (size_t)row0 * DM + i * 256 + F.lane * 4); v[1][i] = *(const f32x4*)(X + (size_t)(row0 + 1) * DM + i * 256 + F.lane * 4); }
        __builtin_amdgcn_sched_barrier(0);
#pragma unroll
        for (int rr = 0; rr < 2; ++rr) {
            float ss = 0.f;
#pragma unroll
            for (int i = 0; i < 8; ++i) ss += v[rr][i][0] * v[rr][i][0] + v[rr][i][1] * v[rr][i][1] + v[rr][i][2] * v[rr][i][2] + v[rr][i][3] * v[rr][i][3];
            ss = wave_sum(ss);
            const float rstd = rsqrtf(ss * (1.0f / DM) + 1e-6f);
            if constexpr (!Q8) {
#pragma unroll
            for (int i = 0; i < 8; ++i) {
                const f32x4 y = v[rr][i] * rstd * cs[i] + cb[i];
                u32x2 w; w.x = pk_bf16(y[0], y[1]); w.y = pk_bf16(y[2], y[3]);
                *(u32x2*)(out + (size_t)(row0 + rr) * DM + i * 256 + F.lane * 4) = w;
            }
            } else {
                float am = 0.f;
#pragma unroll
                for (int i = 0; i < 8; ++i) { v[rr][i] = v[rr][i] * rstd * cs[i] + cb[i]; am = fmaxf(am, fmaxf(fmaxf(fabsf(v[rr][i][0]), fabsf(v[rr][i][1])), fmaxf(fabsf(v[rr][i][2]), fabsf(v[rr][i][3])))); }
#pragma unroll
                for (int o = 32; o >= 1; o >>= 1) am = fmaxf(am, __shfl_xor(am, o));
                const float inv = am > 0.f ? 127.0f / am : 0.f;
#pragma unroll
                for (int i = 0; i < 8; ++i) { int q[4];
#pragma unroll
                    for (int e = 0; e < 4; ++e) q[e] = (int)rintf(v[rr][i][e] * inv);
                    *(unsigned*)(out8 + (size_t)(row0 + rr) * DM + i * 256 + F.lane * 4) = (unsigned)((q[0] & 255) | ((q[1] & 255) << 8) | ((q[2] & 255) << 16) | ((q[3] & 255) << 24)); }
                if (F.lane == 0) sa[row0 + rr] = am > 0.f ? am * (1.0f / 127.0f) : 1.0f;
            }
        }
    }
}

__device__ __forceinline__ void l0_post_proj(const Fr& F, const bf16_t* PB, bf16_t* QN, bf16_t* KVN, bf16_t* KROPE, bf16_t* YCAT,
                                             const float* rc, const float* rs, int nrows) {
    const float* qg = F.in[I_QNG0]; const float* kvg = F.in[I_KVNG0]; const float* cw = F.in[I_CONVW0];
    for (int tb = (F.bid * 8 + F.wave) * 4; tb < nrows; tb += F.G * 32) {
        u32x4 wq[4]; u32x2 wk[4]; bf16_t wr[4]; float rcv[4], rsv[4];
        const int seg = F.lane >> 5, half = (F.lane >> 4) & 1, j = F.lane & 15;
#pragma unroll
        for (int u = 0; u < 4; ++u) { const int t = (tb + u < nrows) ? tb + u : tb; const bf16_t* pr = PB + (size_t)t * 4096;
            wq[u] = (t < SEQ) ? *(const u32x4*)(pr + 3072 + F.lane * 8) : (u32x4){0u, 0u, 0u, 0u};
            wk[u] = *(const u32x2*)(pr + 3584 + F.lane * 4); wr[u] = pr[3840 + F.lane];
            rcv[u] = (t < SEQ) ? rc[(size_t)t * 32 + seg * 16 + j] : 1.f; rsv[u] = (t < SEQ) ? rs[(size_t)t * 32 + seg * 16 + j] : 0.f; }
#pragma unroll
        for (int u = 0; u < 4; ++u) {
            const int t = tb + u; if (t >= nrows) break;
            if (t < SEQ) {
                const u32x4 w = wq[u];
                float v[8] = {bf_lo(w.x), bf_hi(w.x), bf_lo(w.y), bf_hi(w.y), bf_lo(w.z), bf_hi(w.z), bf_lo(w.w), bf_hi(w.w)};
                float ss = 0.f;
#pragma unroll
                for (int e = 0; e < 8; ++e) ss += v[e] * v[e];
                ss = wave_sum(ss);
                const float rstd = rsqrtf(ss * (1.0f / 512.0f) + 1e-6f);
                const f32x4 g0 = *(const f32x4*)(qg + F.lane * 8), g1 = *(const f32x4*)(qg + F.lane * 8 + 4);
                u32x4 o; o.x = pk_bf16(v[0] * rstd * g0[0], v[1] * rstd * g0[1]); o.y = pk_bf16(v[2] * rstd * g0[2], v[3] * rstd * g0[3]);
                o.z = pk_bf16(v[4] * rstd * g1[0], v[5] * rstd * g1[1]); o.w = pk_bf16(v[6] * rstd * g1[2], v[7] * rstd * g1[3]);
                *(u32x4*)(QN + (size_t)t * 512 + F.lane * 8) = o;
            }
            {
                const u32x2 w = wk[u];
                float v[4] = {bf_lo(w.x), bf_hi(w.x), bf_lo(w.y), bf_hi(w.y)};
                float ss = v[0] * v[0] + v[1] * v[1] + v[2] * v[2] + v[3] * v[3];
                ss = wave_sum(ss);
                const float rstd = rsqrtf(ss * (1.0f / 256.0f) + 1e-6f);
                const f32x4 g0 = *(const f32x4*)(kvg + F.lane * 4);
                u32x2 o; o.x = pk_bf16(v[0] * rstd * g0[0], v[1] * rstd * g0[1]); o.y = pk_bf16(v[2] * rstd * g0[2], v[3] * rstd * g0[3]);
                *(u32x2*)(KVN + (size_t)t * 256 + F.lane * 4) = o;
            }
            {
                const float uu = bf1(wr[u]);
                const float up = __shfl_xor(uu, 16);
                const float o = uu * rcv[u] + (half ? up : -up) * rsv[u];
                KROPE[(size_t)t * 64 + F.lane] = f2bf(o);
            }
        }
    }
    {
        const int cg = F.tid & 127, c0 = cg * 8;
        float w0[8], w1[8], w2[8];
#pragma unroll
        for (int e = 0; e < 8; ++e) { w0[e] = cw[c0 + e]; w1[e] = cw[1024 + c0 + e]; w2[e] = cw[2048 + c0 + e]; }
        for (int t = F.bid * 4 + (F.tid >> 7); t < SEQ; t += F.G * 4) {
            u32x4 a[3], h[3];
#pragma unroll
            for (int dt = 0; dt < 3; ++dt) { const int tt = t + dt - 1; const bool ok = (tt >= 0) && (tt < SEQ);
                a[dt] = ok ? *(const u32x4*)(PB + (size_t)tt * 4096 + 1024 + c0) : (u32x4){0u, 0u, 0u, 0u};
                h[dt] = ok ? *(const u32x4*)(PB + (size_t)tt * 4096 + 2048 + c0) : (u32x4){0u, 0u, 0u, 0u}; }
            const u32x4 gb = *(const u32x4*)(PB + (size_t)t * 4096 + c0);
            float y[8];
#pragma unroll
            for (int q = 0; q < 4; ++q) {
                y[2 * q] = bf_lo(gb[q]) * (w0[2 * q] * bf_lo(a[0][q]) * bf_lo(h[0][q]) + w1[2 * q] * bf_lo(a[1][q]) * bf_lo(h[1][q]) + w2[2 * q] * bf_lo(a[2][q]) * bf_lo(h[2][q]));
                y[2 * q + 1] = bf_hi(gb[q]) * (w0[2 * q + 1] * bf_hi(a[0][q]) * bf_hi(h[0][q]) + w1[2 * q + 1] * bf_hi(a[1][q]) * bf_hi(h[1][q]) + w2[2 * q + 1] * bf_hi(a[2][q]) * bf_hi(h[2][q]));
            }
            *(u32x4*)(YCAT + (size_t)t * 2048 + c0) = (u32x4){pk_bf16(y[0], y[1]), pk_bf16(y[2], y[3]), pk_bf16(y[4], y[5]), pk_bf16(y[6], y[7])};
        }
    }
}

struct EpiBf16G {
    static constexpr bool PERM = true, AFTER_DRAIN = false, I8 = false;
    bf16_t* O; int ldc; int act_cols;
    __device__ __forceinline__ void operator()(const f32x4 (&acc)[2][2][4][2], const pg8::Unit& u, int wr, int wc, int fr, int fq) const {
        const int row0 = u.pm * 256 + wr * 64 + fr, col0 = u.pn * 256 + wc * 32 + 8 * fq;
        const bool act = (u.pn * 256) < act_cols;
#pragma unroll
        for (int ai = 0; ai < 2; ++ai)
#pragma unroll
            for (int m = 0; m < 4; ++m) { bf16_t* rowp = O + (size_t)(row0 + ai * 128 + m * 16) * ldc + col0;
#pragma unroll
                for (int bj = 0; bj < 2; ++bj) { f32x4 v0 = acc[ai][bj][m][0], v1 = acc[ai][bj][m][1];
                    if (act) {
#pragma unroll
                        for (int e = 0; e < 4; ++e) { v0[e] = gelu_tanh(v0[e]); v1[e] = gelu_tanh(v1[e]); } }
                    u32x4 w; w.x = pk_bf16(v0[0], v0[1]); w.y = pk_bf16(v0[2], v0[3]); w.z = pk_bf16(v1[0], v1[1]); w.w = pk_bf16(v1[2], v1[3]);
                    *(u32x4*)(rowp + bj * 128) = w; } }
    }
};
struct EpiI8G {
    static constexpr bool PERM = true, AFTER_DRAIN = false, I8 = true;
    bf16_t* O; int ldc; int act_cols; const float* sa; const float* sw;
    __device__ __forceinline__ void operator()(const f32x4 (&acc)[2][2][4][2], const pg8::Unit& u, int wr, int wc, int fr, int fq) const {
        const int row0 = u.pm * 256 + wr * 64 + fr, col0 = u.pn * 256 + wc * 32 + 8 * fq;
        const bool act = (u.pn * 256) < act_cols;
        f32x4 cw[2][2];
#pragma unroll
        for (int bj = 0; bj < 2; ++bj) { cw[bj][0] = *(const f32x4*)(sw + col0 + bj * 128); cw[bj][1] = *(const f32x4*)(sw + col0 + bj * 128 + 4); }
#pragma unroll
        for (int ai = 0; ai < 2; ++ai)
#pragma unroll
            for (int m = 0; m < 4; ++m) { const int row = row0 + ai * 128 + m * 16; bf16_t* rowp = O + (size_t)row * ldc + col0; const float rs = sa[row];
#pragma unroll
                for (int bj = 0; bj < 2; ++bj) { f32x4 v0, v1;
#pragma unroll
                    for (int e = 0; e < 4; ++e) { v0[e] = (float)__float_as_int(acc[ai][bj][m][0][e]) * rs * cw[bj][0][e]; v1[e] = (float)__float_as_int(acc[ai][bj][m][1][e]) * rs * cw[bj][1][e]; }
                    if (act) {
#pragma unroll
                        for (int e = 0; e < 4; ++e) { v0[e] = gelu_tanh(v0[e]); v1[e] = gelu_tanh(v1[e]); } }
                    u32x4 w; w.x = pk_bf16(v0[0], v0[1]); w.y = pk_bf16(v0[2], v0[3]); w.z = pk_bf16(v1[0], v1[1]); w.w = pk_bf16(v1[2], v1[3]);
                    *(u32x4*)(rowp + bj * 128) = w; } }
    }
};
struct EpiQRope {
    static constexpr bool PERM = false, AFTER_DRAIN = false, I8 = false;
    bf16_t* Q; const float* rc; const float* rs;
    __device__ __forceinline__ void operator()(const f32x4 (&acc)[2][2][4][2], const pg8::Unit& u, int wr, int wc, int fr, int fq) const {
#pragma unroll
        for (int ai = 0; ai < 2; ++ai)
#pragma unroll
            for (int m = 0; m < 4; ++m) {
                const int row = u.pm * 256 + ai * 128 + wr * 64 + m * 16 + fr;
#pragma unroll
                for (int bj = 0; bj < 2; ++bj) {
                    const int cbase = u.pn * 256 + bj * 128 + wc * 32;
                    const bool rope = ((cbase >> 6) % 3) == 2; const int seg = (cbase >> 5) & 1;
                    f32x4 v0 = acc[ai][bj][m][0], v1 = acc[ai][bj][m][1];
                    if (rope) {
                        const f32x4 cs = *(const f32x4*)(rc + (size_t)row * 32 + seg * 16 + 4 * fq), sn = *(const f32x4*)(rs + (size_t)row * 32 + seg * 16 + 4 * fq);
                        const f32x4 o0 = v0 * cs - v1 * sn, o1 = v1 * cs + v0 * sn; v0 = o0; v1 = o1;
                    }
                    u32x2 w0, w1; w0.x = pk_bf16(v0[0], v0[1]); w0.y = pk_bf16(v0[2], v0[3]); w1.x = pk_bf16(v1[0], v1[1]); w1.y = pk_bf16(v1[2], v1[3]);
                    bf16_t* p = Q + (size_t)row * 1536 + cbase + 4 * fq;
                    *(u32x2*)p = w0; *(u32x2*)(p + 16) = w1;
                }
            }
    }
};
template <bool BASEF, bool Q8 = false>
struct EpiResid {
    static constexpr bool PERM = true, AFTER_DRAIN = false, I8 = Q8;
    const void* base; bf16_t* out; const float* gate; const float* sa; const float* sw;
    __device__ __forceinline__ void operator()(const f32x4 (&acc)[2][2][4][2], const pg8::Unit& u, int wr, int wc, int fr, int fq) const {
        const int row0 = u.pm * 256 + wr * 64 + fr, col0 = u.pn * 256 + wc * 32 + 8 * fq;
        f32x4 gv[2][2];
#pragma unroll
        for (int bj = 0; bj < 2; ++bj)
#pragma unroll
            for (int n = 0; n < 2; ++n) { gv[bj][n] = *(const f32x4*)(gate + col0 + bj * 128 + n * 4); if (Q8) gv[bj][n] *= *(const f32x4*)(sw + col0 + bj * 128 + n * 4); }
#pragma unroll
        for (int ai = 0; ai < 2; ++ai)
#pragma unroll
            for (int m = 0; m < 4; ++m) { const size_t off = (size_t)(row0 + ai * 128 + m * 16) * DM + col0; const float rs = Q8 ? sa[row0 + ai * 128 + m * 16] : 1.0f;
                f32x4 bs[2][2];
#pragma unroll
                for (int bj = 0; bj < 2; ++bj) {
                    if (BASEF) { bs[bj][0] = *(const f32x4*)((const float*)base + off + bj * 128); bs[bj][1] = *(const f32x4*)((const float*)base + off + bj * 128 + 4); }
                    else { const u32x4 w = *(const u32x4*)((const bf16_t*)base + off + bj * 128); bs[bj][0] = (f32x4){bf_lo(w.x), bf_hi(w.x), bf_lo(w.y), bf_hi(w.y)}; bs[bj][1] = (f32x4){bf_lo(w.z), bf_hi(w.z), bf_lo(w.w), bf_hi(w.w)}; } }
#pragma unroll
                for (int bj = 0; bj < 2; ++bj) { f32x4 a0 = acc[ai][bj][m][0], a1 = acc[ai][bj][m][1];
                    if (Q8) {
#pragma unroll
                        for (int e = 0; e < 4; ++e) { a0[e] = (float)__float_as_int(a0[e]) * rs; a1[e] = (float)__float_as_int(a1[e]) * rs; } }
                    const f32x4 v0 = bs[bj][0] + gv[bj][0] * a0, v1 = bs[bj][1] + gv[bj][1] * a1;
                    u32x4 w; w.x = pk_bf16(v0[0], v0[1]); w.y = pk_bf16(v0[2], v0[3]); w.z = pk_bf16(v1[0], v1[1]); w.w = pk_bf16(v1[2], v1[3]);
                    *(u32x4*)(out + off + bj * 128) = w; } }
    }
};
struct OrderIn0 : pg8::StaticOrder {
    int rounds;
    __device__ void init2(int G_, int c_) { init(SEQ, 4096, G_, c_); rounds = (nwg + G - 1) / G; }
    __device__ bool next(int i, pg8::Unit& u) const {
        if (pg8::StaticOrder::next(i, u)) return true;
        if (i == rounds && c < 2) { u.pm = 64; u.pn = 14 + c; return true; }
        return false;
    }
};

struct OrderKV : pg8::StaticOrder {
    __device__ bool next(int i, pg8::Unit& u) const {
        if (G != 256 || nwg != 520) return pg8::StaticOrder::next(i, u);
        int L;
        if (c >= 128) { if (i > 2) return false; L = i * 128 + (c - 128); }
        else { if (i == 0) L = 384 + c; else if (i == 1 && c < 8) L = 512 + c; else return false; }
        pg8::StaticOrder t = *this; t.c = L % G;
        return t.pg8::StaticOrder::next(L / G, u);
    }
};
namespace att {
constexpr int KVBLK = 64;
constexpr float SCALE = 0.07216878364870322f;
constexpr float THR = 8.f;
constexpr int LDQ = 1536, LDK = 2048, LDKR = 64, LDO = 2048;
#define KSWZ(row, colB) ((row) * 256 + ((colB) ^ (((row) & 15) << 4)))
#define KRSWZ(row, colB) ((row) * 128 + ((colB) ^ ((((row) >> 1) & 7) << 4)))
#define SBAR() __builtin_amdgcn_sched_barrier(0)
__device__ __forceinline__ int crow(int r, int hi) { return (r & 3) + 8 * (r >> 2) + 4 * hi; }

__device__ __forceinline__ void partialSM(f32x16& p0, f32x16& p1, float& m_reg, float& mn, float& alpha) {
    constexpr float C = SCALE * 1.4426950408889634f;
    float pmax = p0[0];
#pragma unroll
    for (int r = 1; r < 16; ++r) pmax = fmaxf(pmax, p0[r]);
#pragma unroll
    for (int r = 0; r < 16; ++r) pmax = fmaxf(pmax, p1[r]);
    { auto rr = __builtin_amdgcn_permlane32_swap(__float_as_uint(pmax), __float_as_uint(pmax), false, false);
      pmax = fmaxf(__uint_as_float(rr[0]), __uint_as_float(rr[1])); }
    const bool keep = __all(pmax - m_reg <= THR / SCALE);
    mn = keep ? m_reg : fmaxf(m_reg, pmax); alpha = __builtin_amdgcn_exp2f((m_reg - mn) * C); m_reg = mn;
    const float mnC = -mn * C;
#pragma unroll
    for (int r = 0; r < 16; ++r) p0[r] = fmaf(p0[r], C, mnC);
#pragma unroll
    for (int r = 0; r < 16; ++r) p1[r] = fmaf(p1[r], C, mnC);
#pragma unroll
    for (int r = 0; r < 8; ++r) p0[r] = __builtin_amdgcn_exp2f(p0[r]);
}
#define PK4(P, BASE, OUT) do { unsigned a0 = pk_bf16(P[BASE + 0], P[BASE + 1]), a1 = pk_bf16(P[BASE + 2], P[BASE + 3]);   \
    unsigned b0 = pk_bf16(P[BASE + 4], P[BASE + 5]), b1 = pk_bf16(P[BASE + 6], P[BASE + 7]);                              \
    auto r0 = __builtin_amdgcn_permlane32_swap(a0, b0, false, false); auto r1 = __builtin_amdgcn_permlane32_swap(a1, b1, false, false); \
    u32x4 w = {r0[0], r1[0], r0[1], r1[1]}; OUT = *reinterpret_cast<bf16x8*>(&w); } while (0)
__device__ __forceinline__ void finishSM(f32x16& p0, f32x16& p1, float alpha, float& l_reg, bf16x8& pa0, bf16x8& pa1, bf16x8& pa2, bf16x8& pa3) {
#pragma unroll
    for (int r = 8; r < 16; ++r) p0[r] = __builtin_amdgcn_exp2f(p0[r]);
#pragma unroll
    for (int r = 0; r < 16; ++r) p1[r] = __builtin_amdgcn_exp2f(p1[r]);
    float ps = 0;
#pragma unroll
    for (int r = 0; r < 16; ++r) ps += p0[r];
#pragma unroll
    for (int r = 0; r < 16; ++r) ps += p1[r];
    { auto rr = __builtin_amdgcn_permlane32_swap(__float_as_uint(ps), __float_as_uint(ps), false, false);
      ps = __uint_as_float(rr[0]) + __uint_as_float(rr[1]); }
    l_reg = l_reg * alpha + ps;
    PK4(p0, 0, pa0); PK4(p0, 8, pa1); PK4(p1, 0, pa2); PK4(p1, 8, pa3);
}
template <int S> __device__ __forceinline__ void fin_piece(f32x16& p0, f32x16& p1, float& ps, bf16x8& pa0, bf16x8& pa1, bf16x8& pa2) {
    if constexpr (S < 8) p0[8 + S] = __builtin_amdgcn_exp2f(p0[8 + S]); else p1[S - 8] = __builtin_amdgcn_exp2f(p1[S - 8]);
    if constexpr (S == 0) ps = p0[0] + p0[1]; else if constexpr (S < 7) ps += p0[S + 1];
    if constexpr (S >= 1 && S <= 8) ps += p0[7 + S]; else if constexpr (S >= 9) ps += p1[S - 9];
    if constexpr (S == 8) PK4(p0, 0, pa0);
    if constexpr (S == 10) PK4(p0, 8, pa1);
    if constexpr (S == 18) PK4(p1, 0, pa2);
}
template <int S> __device__ __forceinline__ void part_piece(f32x16& o0, f32x16& o1, float& ps, float al_old, float& l_reg, bf16x8& pa3,
                                                           f32x16& q0, f32x16& q1, float (&t)[4], float& m_reg, float& mn, float& alpha, float& mnC) {
    constexpr float C = SCALE * 1.4426950408889634f;
    if constexpr (S == 0) { ps += o1[15]; auto rr = __builtin_amdgcn_permlane32_swap(__float_as_uint(ps), __float_as_uint(ps), false, false);
                            ps = __uint_as_float(rr[0]) + __uint_as_float(rr[1]); l_reg = l_reg * al_old + ps; }
    if constexpr (S == 1) PK4(o1, 8, pa3);
    if constexpr (S == 2) { float m = q0[0];
#pragma unroll
        for (int r = 1; r < 8; ++r) m = fmaxf(m, q0[r]); t[0] = m; }
    if constexpr (S == 3) { float m = q0[8];
#pragma unroll
        for (int r = 9; r < 16; ++r) m = fmaxf(m, q0[r]); t[1] = m; }
    if constexpr (S == 4) { float m = q1[0];
#pragma unroll
        for (int r = 1; r < 8; ++r) m = fmaxf(m, q1[r]); t[2] = m; }
    if constexpr (S == 5) { float m = q1[8];
#pragma unroll
        for (int r = 9; r < 16; ++r) m = fmaxf(m, q1[r]); t[3] = m; }
    if constexpr (S == 6) { float pmax = fmaxf(fmaxf(t[0], t[1]), fmaxf(t[2], t[3]));
        auto rr = __builtin_amdgcn_permlane32_swap(__float_as_uint(pmax), __float_as_uint(pmax), false, false);
        t[0] = fmaxf(__uint_as_float(rr[0]), __uint_as_float(rr[1])); }
    if constexpr (S == 7) { const bool keep = __all(t[0] - m_reg <= THR / SCALE);
        mn = keep ? m_reg : fmaxf(m_reg, t[0]); alpha = __builtin_amdgcn_exp2f((m_reg - mn) * C); m_reg = mn; mnC = -mn * C; }
    if constexpr (S >= 8 && S < 12) {
#pragma unroll
        for (int r = 0; r < 4; ++r) q0[(S - 8) * 4 + r] = fmaf(q0[(S - 8) * 4 + r], C, mnC); }
    if constexpr (S >= 12) {
#pragma unroll
        for (int r = 0; r < 4; ++r) q1[(S - 12) * 4 + r] = fmaf(q1[(S - 12) * 4 + r], C, mnC); }
    if constexpr (S >= 9) q0[S - 9] = __builtin_amdgcn_exp2f(q0[S - 9]);
    if constexpr (S == 15) q0[7] = __builtin_amdgcn_exp2f(q0[7]);
}
__device__ __forceinline__ int v_st(int k, int c) { const int kk = (k & ~0xC) | ((k & 4) << 1) | ((k & 8) >> 1); return ((kk >> 3) * 4 + (c >> 5)) * 512 + ((kk & 7) * 32 + (c & 31)) * 2; }
__device__ __forceinline__ int v_rd_base(int lane) { return ((lane & 3) << 3) | (((lane >> 2) & 3) << 6) | (((lane >> 4) & 1) << 5) | (((lane >> 5) & 1) << 8); }
constexpr int v_rd_off(int d0, int ks, int half) { return d0 * 512 + ks * 4096 + half * 2048; }
template <int OFF> __device__ __forceinline__ s16x4 tr_read(int vb) {
    s16x4 r; asm volatile("ds_read_b64_tr_b16 %0, %1 offset:%2" : "=&v"(r) : "v"(vb), "i"(OFF) : "memory"); return r;
}
struct VFrag { s16x4 l0, h0, l1, h1, l2, h2, l3, h3; };
template <int D0> __device__ __forceinline__ void pv_read(VFrag& f, int vb) {
    f.l0 = tr_read<v_rd_off(D0, 0, 0)>(vb); f.h0 = tr_read<v_rd_off(D0, 0, 1)>(vb); f.l1 = tr_read<v_rd_off(D0, 1, 0)>(vb); f.h1 = tr_read<v_rd_off(D0, 1, 1)>(vb);
    f.l2 = tr_read<v_rd_off(D0, 2, 0)>(vb); f.h2 = tr_read<v_rd_off(D0, 2, 1)>(vb); f.l3 = tr_read<v_rd_off(D0, 3, 0)>(vb); f.h3 = tr_read<v_rd_off(D0, 3, 1)>(vb);
}
__device__ __forceinline__ void pv_mma(f32x16& od, const VFrag& f, bf16x8 pa0, bf16x8 pa1, bf16x8 pa2, bf16x8 pa3) {
#define PKV(L, H) (bf16x8){L[0], L[1], L[2], L[3], H[0], H[1], H[2], H[3]}
    od = __builtin_amdgcn_mfma_f32_32x32x16_bf16(pa0, PKV(f.l0, f.h0), od, 0, 0, 0);
    od = __builtin_amdgcn_mfma_f32_32x32x16_bf16(pa1, PKV(f.l1, f.h1), od, 0, 0, 0);
    od = __builtin_amdgcn_mfma_f32_32x32x16_bf16(pa2, PKV(f.l2, f.h2), od, 0, 0, 0);
    od = __builtin_amdgcn_mfma_f32_32x32x16_bf16(pa3, PKV(f.l3, f.h3), od, 0, 0, 0);
#undef PKV
}
__device__ __forceinline__ void pv_d0(f32x16* o, int vb, bf16x8 pa0, bf16x8 pa1, bf16x8 pa2, bf16x8 pa3) {
    VFrag fa, fb;
    pv_read<0>(fa, vb); pv_read<1>(fb, vb);
    asm volatile("s_waitcnt lgkmcnt(8)" ::: "memory"); SBAR(); pv_mma(o[0], fa, pa0, pa1, pa2, pa3); SBAR();
    pv_read<2>(fa, vb);
    asm volatile("s_waitcnt lgkmcnt(8)" ::: "memory"); SBAR(); pv_mma(o[1], fb, pa0, pa1, pa2, pa3); SBAR();
    pv_read<3>(fb, vb);
    asm volatile("s_waitcnt lgkmcnt(8)" ::: "memory"); SBAR(); pv_mma(o[2], fa, pa0, pa1, pa2, pa3); SBAR();
    asm volatile("s_waitcnt lgkmcnt(0)" ::: "memory"); SBAR(); pv_mma(o[3], fb, pa0, pa1, pa2, pa3);
}
constexpr int SLOTB = 40960, S_V = 0, S_KN = 16384, S_KR = 32768, OFF_QR = 3 * SLOTB, OFF_WS2 = OFF_QR + 32768, LDS_ATT2 = OFF_WS2 + 2048;
static_assert(LDS_ATT2 <= LDS_CTL, "attention LDS");
__device__ __forceinline__ void qkt2(f32x16& p0, f32x16& p1, const LAS unsigned char* slot, const LAS unsigned char* qrp, const bf16x8 (&qr)[8], int r32, int hi) {
    p0 = f32x16{}; p1 = f32x16{};
    const LAS unsigned char* Kn = slot + S_KN; const LAS unsigned char* Kr = slot + S_KR;
    bf16x8 a0 = *(const LAS bf16x8*)(Kn + KSWZ(r32, (hi * 8) * 2)), a1 = *(const LAS bf16x8*)(Kn + KSWZ(32 + r32, (hi * 8) * 2));
#pragma unroll
    for (int d0 = 0; d0 < 8; ++d0) {
        bf16x8 n0, n1;
        if (d0 < 7) { const int cb = ((d0 + 1) * 16 + hi * 8) * 2; n0 = *(const LAS bf16x8*)(Kn + KSWZ(r32, cb)); n1 = *(const LAS bf16x8*)(Kn + KSWZ(32 + r32, cb)); }
        else { const int cb = (hi * 8) * 2; n0 = *(const LAS bf16x8*)(Kr + KRSWZ(r32, cb)); n1 = *(const LAS bf16x8*)(Kr + KRSWZ(32 + r32, cb)); }
        p0 = __builtin_amdgcn_mfma_f32_32x32x16_bf16(a0, qr[d0], p0, 0, 0, 0);
        p1 = __builtin_amdgcn_mfma_f32_32x32x16_bf16(a1, qr[d0], p1, 0, 0, 0);
        a0 = n0; a1 = n1;
    }
    bf16x8 qq = *(const LAS bf16x8*)(qrp + (((hi * 8) * 2) ^ (((r32 >> 1) & 7) << 4)));
#pragma unroll
    for (int d0 = 0; d0 < 4; ++d0) {
        bf16x8 n0, n1, nq;
        if (d0 < 3) { const int cb = ((d0 + 1) * 16 + hi * 8) * 2; n0 = *(const LAS bf16x8*)(Kr + KRSWZ(r32, cb)); n1 = *(const LAS bf16x8*)(Kr + KRSWZ(32 + r32, cb)); nq = *(const LAS bf16x8*)(qrp + (cb ^ (((r32 >> 1) & 7) << 4))); }
        p0 = __builtin_amdgcn_mfma_f32_32x32x16_bf16(a0, qq, p0, 0, 0, 0);
        p1 = __builtin_amdgcn_mfma_f32_32x32x16_bf16(a1, qq, p1, 0, 0, 0);
        if (d0 < 3) { a0 = n0; a1 = n1; qq = nq; }
    }
}
__device__ __forceinline__ void s1_step(f32x16& q0, f32x16& q1, const LAS unsigned char* slot, const LAS unsigned char* qrp, const bf16x8 (&qr)[8], int r32, int hi,
                                        f32x16& p0, f32x16& p1, float& ps, bf16x8& pa0, bf16x8& pa1, bf16x8& pa2) {
    q0 = f32x16{}; q1 = f32x16{};
    const LAS unsigned char* Kn = slot + S_KN; const LAS unsigned char* Kr = slot + S_KR;
    bf16x8 a0 = *(const LAS bf16x8*)(Kn + KSWZ(r32, (hi * 8) * 2)), a1 = *(const LAS bf16x8*)(Kn + KSWZ(32 + r32, (hi * 8) * 2)), qq = a0;
#define S1_STEP(D) do { bf16x8 n0 = a0, n1 = a1, nq = qq; \
        if ((D) < 7) { const int cb = (((D) + 1) * 16 + hi * 8) * 2; n0 = *(const LAS bf16x8*)(Kn + KSWZ(r32, cb)); n1 = *(const LAS bf16x8*)(Kn + KSWZ(32 + r32, cb)); } \
        else if ((D) < 11) { const int cb = (((D) - 7) * 16 + hi * 8) * 2; n0 = *(const LAS bf16x8*)(Kr + KRSWZ(r32, cb)); n1 = *(const LAS bf16x8*)(Kr + KRSWZ(32 + r32, cb)); \
                             nq = *(const LAS bf16x8*)(qrp + (cb ^ (((r32 >> 1) & 7) << 4))); } \
        q0 = __builtin_amdgcn_mfma_f32_32x32x16_bf16(a0, (D) < 8 ? qr[(D) & 7] : qq, q0, 0, 0, 0); fin_piece<2 * (D)>(p0, p1, ps, pa0, pa1, pa2); SBAR(); \
        q1 = __builtin_amdgcn_mfma_f32_32x32x16_bf16(a1, (D) < 8 ? qr[(D) & 7] : qq, q1, 0, 0, 0); fin_piece<2 * (D) + 1>(p0, p1, ps, pa0, pa1, pa2); SBAR(); \
        a0 = n0; a1 = n1; qq = nq; } while (0)
    S1_STEP(0); S1_STEP(1); S1_STEP(2); S1_STEP(3); S1_STEP(4); S1_STEP(5); S1_STEP(6); S1_STEP(7); S1_STEP(8); S1_STEP(9); S1_STEP(10); S1_STEP(11);
#undef S1_STEP
}
__device__ __forceinline__ void s2_step(f32x16* o, int vb, bf16x8 pa0, bf16x8 pa1, bf16x8 pa2, bf16x8& pa3, f32x16& po0, f32x16& po1, float& ps, float al_old, float& l_reg,
                                        f32x16& q0, f32x16& q1, float& m_reg, float& mn, float& alpha) {
    VFrag fa, fb; float t[4] = {0.f, 0.f, 0.f, 0.f}, mnC = 0.f;
#define PKV(L, H) (bf16x8){L[0], L[1], L[2], L[3], H[0], H[1], H[2], H[3]}
#define S2_MMA(OD, L, H, PA, S) do { OD = __builtin_amdgcn_mfma_f32_32x32x16_bf16(PA, PKV(L, H), OD, 0, 0, 0); part_piece<S>(po0, po1, ps, al_old, l_reg, pa3, q0, q1, t, m_reg, mn, alpha, mnC); SBAR(); } while (0)
    pv_read<0>(fa, vb); pv_read<1>(fb, vb);
    asm volatile("s_waitcnt lgkmcnt(8)" ::: "memory"); SBAR();
    S2_MMA(o[0], fa.l0, fa.h0, pa0, 0); S2_MMA(o[0], fa.l1, fa.h1, pa1, 1); S2_MMA(o[0], fa.l2, fa.h2, pa2, 2); S2_MMA(o[0], fa.l3, fa.h3, pa3, 3);
    pv_read<2>(fa, vb);
    asm volatile("s_waitcnt lgkmcnt(8)" ::: "memory"); SBAR();
    S2_MMA(o[1], fb.l0, fb.h0, pa0, 4); S2_MMA(o[1], fb.l1, fb.h1, pa1, 5); S2_MMA(o[1], fb.l2, fb.h2, pa2, 6); S2_MMA(o[1], fb.l3, fb.h3, pa3, 7);
    pv_read<3>(fb, vb);
    asm volatile("s_waitcnt lgkmcnt(8)" ::: "memory"); SBAR();
    S2_MMA(o[2], fa.l0, fa.h0, pa0, 8); S2_MMA(o[2], fa.l1, fa.h1, pa1, 9); S2_MMA(o[2], fa.l2, fa.h2, pa2, 10); S2_MMA(o[2], fa.l3, fa.h3, pa3, 11);
    asm volatile("s_waitcnt lgkmcnt(0)" ::: "memory"); SBAR();
    S2_MMA(o[3], fb.l0, fb.h0, pa0, 12); S2_MMA(o[3], fb.l1, fb.h1, pa1, 13); S2_MMA(o[3], fb.l2, fb.h2, pa2, 14); S2_MMA(o[3], fb.l3, fb.h3, pa3, 15);
    asm volatile("" : "+v"(q0), "+v"(q1));
#undef S2_MMA
#undef PKV
}
__device__ __forceinline__ void attn_body(const bf16_t* __restrict__ Qb, const bf16_t* __restrict__ Kh, const bf16_t* __restrict__ Krp, const bf16_t* __restrict__ Vh,
                                          bf16_t* __restrict__ Ob, int seq, LAS unsigned char* lds) {
    int tid = threadIdx.x; asm volatile("" : "+v"(tid));
    const int wid = __builtin_amdgcn_readfirstlane(tid >> 6), lane = tid & 63, r32 = lane & 31, hi = lane >> 5;
    LAS float* ws = (LAS float*)(lds + OFF_WS2) + wid * 64; LAS float* li_l = ws; LAS float* al_l = ws + 32;
    LAS unsigned char* qrp = lds + OFF_QR + (wid * 32 + r32) * 128;
    float m_reg = -1e30f, l_reg = 0; f32x16 o[4] = {}; bf16x8 qr[8];
    const bf16_t* Qw = Qb + (long)(wid * 32 + r32) * LDQ + hi * 8;
#pragma unroll
    for (int d0 = 0; d0 < 8; ++d0) qr[d0] = *(const bf16x8*)(Qw + d0 * 16);
#pragma unroll
    for (int d0 = 0; d0 < 4; ++d0) { const bf16x8 q = *(const bf16x8*)(Qw + 128 + d0 * 16); const int cb = (d0 * 16 + hi * 8) * 2;
        *(LAS bf16x8*)(qrp + (cb ^ (((r32 >> 1) & 7) << 4))) = q; }
#define OFF_V() ({ const int u_ = wid * 64 + lane, sub_ = u_ >> 5, within_ = u_ & 31, kk_ = ((sub_ >> 2) << 3) | (within_ >> 2), c_ = ((sub_ & 3) << 5) | ((within_ & 3) << 3); \
                  const int k_ = (kk_ & ~0xC) | ((kk_ & 4) << 1) | ((kk_ & 8) >> 1); (unsigned)(k_ * LDK + c_); })
#define OFF_K() ({ const int u_ = wid * 64 + lane, row_ = u_ >> 4, sl_ = u_ & 15; (unsigned)(row_ * LDK + ((sl_ ^ (row_ & 15)) << 3)); })
#define OFF_R() ({ const int u_ = wid * 64 + lane, row_ = u_ >> 3, sl_ = u_ & 7; (unsigned)(row_ * LDKR + ((sl_ ^ ((row_ >> 1) & 7)) << 3)); })
    const int vbase = (int)(unsigned)(uintptr_t)lds + v_rd_base(lane);
#define DMA(t, slot) do { const bf16_t* vh_ = Vh + (size_t)(t) * KVBLK * LDK; const bf16_t* kh_ = Kh + (size_t)(t) * KVBLK * LDK; const bf16_t* kr_ = Krp + (size_t)(t) * KVBLK * LDKR; \
    LAS unsigned char* sb_ = lds + (slot) * SLOTB; \
    __builtin_amdgcn_global_load_lds((const unsigned*)(vh_ + OFF_V()), (LAS unsigned*)(sb_ + S_V + wid * 1024), 16, 0, 0); \
    __builtin_amdgcn_global_load_lds((const unsigned*)(vh_ + OFF_V() + 32 * LDK), (LAS unsigned*)(sb_ + S_V + (wid + 8) * 1024), 16, 0, 0); \
    __builtin_amdgcn_global_load_lds((const unsigned*)(kh_ + OFF_K()), (LAS unsigned*)(sb_ + S_KN + wid * 1024), 16, 0, 0); \
    __builtin_amdgcn_global_load_lds((const unsigned*)(kh_ + OFF_K() + 32 * LDK), (LAS unsigned*)(sb_ + S_KN + (wid + 8) * 1024), 16, 0, 0); \
    __builtin_amdgcn_global_load_lds((const unsigned*)(kr_ + OFF_R()), (LAS unsigned*)(sb_ + S_KR + wid * 1024), 16, 0, 0); } while (0)
#define RESC(a) do { if (__any((a) < 1.f)) { if (hi == 0) al_l[r32] = (a); asm volatile("s_waitcnt lgkmcnt(0)" ::: "memory"); \
    _Pragma("unroll") for (int d = 0; d < 4; ++d) _Pragma("unroll") for (int r = 0; r < 16; ++r) o[d][r] *= al_l[crow(r, hi)]; } } while (0)
#define TILE_SYNC() do { asm volatile("s_waitcnt vmcnt(0)" ::: "memory"); __syncthreads(); } while (0)
    f32x16 pA0, pA1, pB0, pB1; float mnA, mnB, alA, alB, psum = 0.f; bf16x8 pa0, pa1, pa2, pa3; const int NT = seq / KVBLK;
    DMA(0, 0); DMA(1, 1);
    TILE_SYNC();
    qkt2(pA0, pA1, lds, qrp, qr, r32, hi); partialSM(pA0, pA1, m_reg, mnA, alA);
    int s_prev = 0, s_cur = 1, s_next = 2;
    for (int j = 1; j + 1 < NT; j += 2) {
        DMA(j + 1, s_next);
        SBAR(); s1_step(pB0, pB1, lds + s_cur * SLOTB, qrp, qr, r32, hi, pA0, pA1, psum, pa0, pa1, pa2);
        s2_step(o, vbase + s_prev * SLOTB, pa0, pa1, pa2, pa3, pA0, pA1, psum, alA, l_reg, pB0, pB1, m_reg, mnB, alB);
        TILE_SYNC(); RESC(alB);
        { const int t_ = s_prev; s_prev = s_cur; s_cur = s_next; s_next = t_; }
        if (j + 2 < NT) DMA(j + 2, s_next);
        SBAR(); s1_step(pA0, pA1, lds + s_cur * SLOTB, qrp, qr, r32, hi, pB0, pB1, psum, pa0, pa1, pa2);
        s2_step(o, vbase + s_prev * SLOTB, pa0, pa1, pa2, pa3, pB0, pB1, psum, alB, l_reg, pA0, pA1, m_reg, mnA, alA);
        TILE_SYNC(); RESC(alA);
        { const int t_ = s_prev; s_prev = s_cur; s_cur = s_next; s_next = t_; }
    }
    SBAR(); qkt2(pB0, pB1, lds + s_cur * SLOTB, qrp, qr, r32, hi);
    finishSM(pA0, pA1, alA, l_reg, pa0, pa1, pa2, pa3); SBAR();
    pv_d0(o, vbase + s_prev * SLOTB, pa0, pa1, pa2, pa3); partialSM(pB0, pB1, m_reg, mnB, alB);
    RESC(alB);
    finishSM(pB0, pB1, alB, l_reg, pa0, pa1, pa2, pa3); SBAR();
    pv_d0(o, vbase + s_cur * SLOTB, pa0, pa1, pa2, pa3);
    if (hi == 0) li_l[r32] = l_reg; asm volatile("s_waitcnt lgkmcnt(0)" ::: "memory");
    float rli[16];
#pragma unroll
    for (int r = 0; r < 16; ++r) rli[r] = __builtin_amdgcn_rcpf(li_l[crow(r, hi)]);
    bf16_t* Ow = Ob + (long)(wid * 32) * LDO;
#pragma unroll
    for (int r = 0; r < 16; ++r) { const int orow = crow(r, hi);
#pragma unroll
        for (int d0 = 0; d0 < 4; ++d0) Ow[(long)orow * LDO + d0 * 32 + r32] = f2bf(o[d0][r] * rli[r]); }
    __syncthreads();
#undef DMA
#undef OFF_V
#undef OFF_K
#undef OFF_R
#undef RESC
#undef TILE_SYNC
}

constexpr int SLOTB8 = 28672, S8_V = 0, S8_KN = 16384, S8_KR = 24576, OFF8_WS = 3 * SLOTB8, OFF8_SK = OFF8_WS + 2048, LDS_ATT8 = OFF8_SK + 2048;
static_assert(LDS_ATT8 <= LDS_CTL, "attention LDS (int8)");
typedef int i32x4v __attribute__((ext_vector_type(4)));
typedef int i32x16v __attribute__((ext_vector_type(16)));
#define K8N_SWZ(row, ch) ((row) * 128 + ((((ch)) ^ (((row) >> 1) & 7)) << 4))
#define K8R_SWZ(row, ch) ((row) * 64 + ((((ch)) ^ (((row) >> 2) & 3)) << 4))
__device__ __forceinline__ unsigned q8pack(float a, float b, float c, float d) {
    const int q0 = (int)rintf(a), q1 = (int)rintf(b), q2 = (int)rintf(c), q3 = (int)rintf(d);
    return (unsigned)((q0 & 255) | ((q1 & 255) << 8) | ((q2 & 255) << 16) | ((q3 & 255) << 24));
}
__device__ __forceinline__ void kq_phase(const Fr& F, const bf16_t* KV, const bf16_t* KR, unsigned char* K8N, unsigned char* K8R, float* SK, int nkey) {
    const int ntile = nkey / 64, kq = F.lane >> 3, ch = F.lane & 7;
    for (int it = F.bid * 8 + F.wave; it < ntile * 8; it += F.G * 8) {
        const int h = it & 7, t = it >> 3;
        u32x4 n[8][2]; u32x4 r[8];
#pragma unroll
        for (int g = 0; g < 8; ++g) { const size_t key = (size_t)t * 64 + g * 8 + kq;
            n[g][0] = *(const u32x4*)(KV + key * LDK + h * 256 + ch * 16); n[g][1] = *(const u32x4*)(KV + key * LDK + h * 256 + ch * 16 + 8);
            r[g] = *(const u32x4*)(KR + key * LDKR + ch * 8); }
        float am = 0.f;
#pragma unroll
        for (int g = 0; g < 8; ++g) {
#pragma unroll
            for (int q = 0; q < 4; ++q) { am = fmaxf(am, fmaxf(fabsf(bf_lo(n[g][0][q])), fabsf(bf_hi(n[g][0][q])))); am = fmaxf(am, fmaxf(fabsf(bf_lo(n[g][1][q])), fabsf(bf_hi(n[g][1][q]))));
                am = fmaxf(am, fmaxf(fabsf(bf_lo(r[g][q])), fabsf(bf_hi(r[g][q])))); } }
#pragma unroll
        for (int o = 32; o >= 1; o >>= 1) am = fmaxf(am, __shfl_xor(am, o));
        const float inv = am > 0.f ? 127.0f / am : 0.f;
#pragma unroll
        for (int g = 0; g < 8; ++g) { const size_t key = (size_t)t * 64 + g * 8 + kq;
            u32x4 w;
            w.x = q8pack(bf_lo(n[g][0].x) * inv, bf_hi(n[g][0].x) * inv, bf_lo(n[g][0].y) * inv, bf_hi(n[g][0].y) * inv);
            w.y = q8pack(bf_lo(n[g][0].z) * inv, bf_hi(n[g][0].z) * inv, bf_lo(n[g][0].w) * inv, bf_hi(n[g][0].w) * inv);
            w.z = q8pack(bf_lo(n[g][1].x) * inv, bf_hi(n[g][1].x) * inv, bf_lo(n[g][1].y) * inv, bf_hi(n[g][1].y) * inv);
            w.w = q8pack(bf_lo(n[g][1].z) * inv, bf_hi(n[g][1].z) * inv, bf_lo(n[g][1].w) * inv, bf_hi(n[g][1].w) * inv);
            *(u32x4*)(K8N + ((size_t)h * nkey + key) * 128 + ch * 16) = w;
            u32x2 v;
            v.x = q8pack(bf_lo(r[g].x) * inv, bf_hi(r[g].x) * inv, bf_lo(r[g].y) * inv, bf_hi(r[g].y) * inv);
            v.y = q8pack(bf_lo(r[g].z) * inv, bf_hi(r[g].z) * inv, bf_lo(r[g].w) * inv, bf_hi(r[g].w) * inv);
            *(u32x2*)(K8R + ((size_t)h * nkey + key) * 64 + ch * 8) = v; }
        if (F.lane == 0) SK[h * ntile + t] = am > 0.f ? am * (1.0f / 127.0f) : 1.0f;
    }
}
#define QK8_FRAG(S, ROW) ((S) < 4 ? *(const LAS i32x4v*)(Kn + K8N_SWZ((ROW), (S) * 2 + hi)) : *(const LAS i32x4v*)(Kr + K8R_SWZ((ROW), ((S) - 4) * 2 + hi)))
__device__ __forceinline__ void qkt8(f32x16& p0, f32x16& p1, const LAS unsigned char* slot, const i32x4v (&qi)[6], int r32, int hi) {
    const LAS unsigned char* Kn = slot + S8_KN; const LAS unsigned char* Kr = slot + S8_KR;
    i32x16v c0 = {}, c1 = {};
    i32x4v a0 = QK8_FRAG(0, r32), a1 = QK8_FRAG(0, 32 + r32);
#pragma unroll
    for (int s = 0; s < 6; ++s) {
        i32x4v n0 = a0, n1 = a1;
        if (s < 5) { n0 = QK8_FRAG(s + 1, r32); n1 = QK8_FRAG(s + 1, 32 + r32); }
        c0 = __builtin_amdgcn_mfma_i32_32x32x32_i8(a0, qi[s], c0, 0, 0, 0);
        c1 = __builtin_amdgcn_mfma_i32_32x32x32_i8(a1, qi[s], c1, 0, 0, 0);
        a0 = n0; a1 = n1;
    }
    p0 = __builtin_bit_cast(f32x16, c0); p1 = __builtin_bit_cast(f32x16, c1);
}
__device__ __forceinline__ void i2f_scores(f32x16& p0, f32x16& p1, float mraw) {
#pragma unroll
    for (int r = 0; r < 16; ++r) { p0[r] = (float)__float_as_int(p0[r]) * mraw; p1[r] = (float)__float_as_int(p1[r]) * mraw; }
}
__device__ __forceinline__ void s1_step8(f32x16& q0, f32x16& q1, const LAS unsigned char* slot, const i32x4v (&qi)[6], int r32, int hi,
                                         f32x16& p0, f32x16& p1, float& ps, bf16x8& pa0, bf16x8& pa1, bf16x8& pa2) {
    const LAS unsigned char* Kn = slot + S8_KN; const LAS unsigned char* Kr = slot + S8_KR;
    i32x16v c0 = {}, c1 = {};
    i32x4v a0 = QK8_FRAG(0, r32), a1 = QK8_FRAG(0, 32 + r32);
#define S1_STEP8(S) do { i32x4v n0 = a0, n1 = a1; \
        if ((S) < 5) { n0 = QK8_FRAG((S) + 1, r32); n1 = QK8_FRAG((S) + 1, 32 + r32); } \
        c0 = __builtin_amdgcn_mfma_i32_32x32x32_i8(a0, qi[S], c0, 0, 0, 0); fin_piece<4 * (S)>(p0, p1, ps, pa0, pa1, pa2); SBAR(); fin_piece<4 * (S) + 1>(p0, p1, ps, pa0, pa1, pa2); SBAR(); \
        c1 = __builtin_amdgcn_mfma_i32_32x32x32_i8(a1, qi[S], c1, 0, 0, 0); fin_piece<4 * (S) + 2>(p0, p1, ps, pa0, pa1, pa2); SBAR(); fin_piece<4 * (S) + 3>(p0, p1, ps, pa0, pa1, pa2); SBAR(); \
        a0 = n0; a1 = n1; } while (0)
    S1_STEP8(0); S1_STEP8(1); S1_STEP8(2); S1_STEP8(3); S1_STEP8(4); S1_STEP8(5);
#undef S1_STEP8
    q0 = __builtin_bit_cast(f32x16, c0); q1 = __builtin_bit_cast(f32x16, c1);
}
template <int S> __device__ __forceinline__ void part_piece8(f32x16& o0, f32x16& o1, float& ps, float al_old, float& l_reg, bf16x8& pa3,
                                                            f32x16& q0, f32x16& q1, int (&ti)[4], float& tf, float mraw, float& m_reg, float& mn, float& alpha, float& mnC) {
    constexpr float C = SCALE * 1.4426950408889634f;
    if constexpr (S == 0) { ps += o1[15]; auto rr = __builtin_amdgcn_permlane32_swap(__float_as_uint(ps), __float_as_uint(ps), false, false);
                            ps = __uint_as_float(rr[0]) + __uint_as_float(rr[1]); l_reg = l_reg * al_old + ps; }
    if constexpr (S == 1) PK4(o1, 8, pa3);
    if constexpr (S == 2) { int m = __float_as_int(q0[0]);
#pragma unroll
        for (int r = 1; r < 8; ++r) m = max(m, __float_as_int(q0[r])); ti[0] = m; }
    if constexpr (S == 3) { int m = __float_as_int(q0[8]);
#pragma unroll
        for (int r = 9; r < 16; ++r) m = max(m, __float_as_int(q0[r])); ti[1] = m; }
    if constexpr (S == 4) { int m = __float_as_int(q1[0]);
#pragma unroll
        for (int r = 1; r < 8; ++r) m = max(m, __float_as_int(q1[r])); ti[2] = m; }
    if constexpr (S == 5) { int m = __float_as_int(q1[8]);
#pragma unroll
        for (int r = 9; r < 16; ++r) m = max(m, __float_as_int(q1[r])); ti[3] = m; }
    if constexpr (S == 6) { const float pmax = (float)max(max(ti[0], ti[1]), max(ti[2], ti[3])) * mraw;
        auto rr = __builtin_amdgcn_permlane32_swap(__float_as_uint(pmax), __float_as_uint(pmax), false, false);
        tf = fmaxf(__uint_as_float(rr[0]), __uint_as_float(rr[1])); }
    if constexpr (S == 7) { const bool keep = __all(tf - m_reg <= THR / SCALE);
        mn = keep ? m_reg : fmaxf(m_reg, tf); alpha = __builtin_amdgcn_exp2f((m_reg - mn) * C); m_reg = mn; mnC = -mn * C; }
    if constexpr (S >= 8 && S < 12) {
#pragma unroll
        for (int r = 0; r < 4; ++r) q0[(S - 8) * 4 + r] = fmaf((float)__float_as_int(q0[(S - 8) * 4 + r]), mraw * C, mnC); }
    if constexpr (S >= 12) {
#pragma unroll
        for (int r = 0; r < 4; ++r) q1[(S - 12) * 4 + r] = fmaf((float)__float_as_int(q1[(S - 12) * 4 + r]), mraw * C, mnC); }
    if constexpr (S >= 9) q0[S - 9] = __builtin_amdgcn_exp2f(q0[S - 9]);
    if constexpr (S == 15) q0[7] = __builtin_amdgcn_exp2f(q0[7]);
}
__device__ __forceinline__ void s2_step8(f32x16* o, int vb, bf16x8 pa0, bf16x8 pa1, bf16x8 pa2, bf16x8& pa3, f32x16& po0, f32x16& po1, float& ps, float al_old, float& l_reg,
                                         f32x16& q0, f32x16& q1, float mraw, float& m_reg, float& mn, float& alpha) {
    VFrag fa, fb; int ti[4] = {0, 0, 0, 0}; float tf = 0.f, mnC = 0.f;
#define PKV(L, H) (bf16x8){L[0], L[1], L[2], L[3], H[0], H[1], H[2], H[3]}
#define S2_MMA(OD, L, H, PA, S) do { OD = __builtin_amdgcn_mfma_f32_32x32x16_bf16(PA, PKV(L, H), OD, 0, 0, 0); part_piece8<S>(po0, po1, ps, al_old, l_reg, pa3, q0, q1, ti, tf, mraw, m_reg, mn, alpha, mnC); SBAR(); } while (0)
    pv_read<0>(fa, vb); pv_read<1>(fb, vb);
    asm volatile("s_waitcnt lgkmcnt(8)" ::: "memory"); SBAR();
    S2_MMA(o[0], fa.l0, fa.h0, pa0, 0); S2_MMA(o[0], fa.l1, fa.h1, pa1, 1); S2_MMA(o[0], fa.l2, fa.h2, pa2, 2); S2_MMA(o[0], fa.l3, fa.h3, pa3, 3);
    pv_read<2>(fa, vb);
    asm volatile("s_waitcnt lgkmcnt(8)" ::: "memory"); SBAR();
    S2_MMA(o[1], fb.l0, fb.h0, pa0, 4); S2_MMA(o[1], fb.l1, fb.h1, pa1, 5); S2_MMA(o[1], fb.l2, fb.h2, pa2, 6); S2_MMA(o[1], fb.l3, fb.h3, pa3, 7);
    pv_read<3>(fb, vb);
    asm volatile("s_waitcnt lgkmcnt(8)" ::: "memory"); SBAR();
    S2_MMA(o[2], fa.l0, fa.h0, pa0, 8); S2_MMA(o[2], fa.l1, fa.h1, pa1, 9); S2_MMA(o[2], fa.l2, fa.h2, pa2, 10); S2_MMA(o[2], fa.l3, fa.h3, pa3, 11);
    asm volatile("s_waitcnt lgkmcnt(0)" ::: "memory"); SBAR();
    S2_MMA(o[3], fb.l0, fb.h0, pa0, 12); S2_MMA(o[3], fb.l1, fb.h1, pa1, 13); S2_MMA(o[3], fb.l2, fb.h2, pa2, 14); S2_MMA(o[3], fb.l3, fb.h3, pa3, 15);
    asm volatile("" : "+v"(q0), "+v"(q1));
#undef S2_MMA
#undef PKV
}
__device__ __forceinline__ void attn_body8(const bf16_t* __restrict__ Qb, const unsigned char* __restrict__ K8n, const unsigned char* __restrict__ K8r, const float* __restrict__ SKh,
                                           const bf16_t* __restrict__ Vh, bf16_t* __restrict__ Ob, int seq, LAS unsigned char* lds) {
    int tid = threadIdx.x; asm volatile("" : "+v"(tid));
    const int wid = __builtin_amdgcn_readfirstlane(tid >> 6), lane = tid & 63, r32 = lane & 31, hi = lane >> 5;
    LAS float* ws = (LAS float*)(lds + OFF8_WS) + wid * 64; LAS float* li_l = ws; LAS float* al_l = ws + 32;
    float m_reg = -1e30f, l_reg = 0; f32x16 o[4] = {}; i32x4v qi[6]; float sq;
    {
        const bf16_t* Qw = Qb + (long)(wid * 32 + r32) * LDQ + hi * 16;
        u32x4 w[6][2];
#pragma unroll
        for (int s = 0; s < 6; ++s) { w[s][0] = *(const u32x4*)(Qw + s * 32); w[s][1] = *(const u32x4*)(Qw + s * 32 + 8); }
        float am = 0.f;
#pragma unroll
        for (int s = 0; s < 6; ++s)
#pragma unroll
            for (int q = 0; q < 4; ++q) { am = fmaxf(am, fmaxf(fabsf(bf_lo(w[s][0][q])), fabsf(bf_hi(w[s][0][q])))); am = fmaxf(am, fmaxf(fabsf(bf_lo(w[s][1][q])), fabsf(bf_hi(w[s][1][q])))); }
        { auto rr = __builtin_amdgcn_permlane32_swap(__float_as_uint(am), __float_as_uint(am), false, false); am = fmaxf(__uint_as_float(rr[0]), __uint_as_float(rr[1])); }
        const float inv = am > 0.f ? 127.0f / am : 0.f; sq = am * (1.0f / 127.0f);
#pragma unroll
        for (int s = 0; s < 6; ++s) {
            qi[s].x = (int)q8pack(bf_lo(w[s][0].x) * inv, bf_hi(w[s][0].x) * inv, bf_lo(w[s][0].y) * inv, bf_hi(w[s][0].y) * inv);
            qi[s].y = (int)q8pack(bf_lo(w[s][0].z) * inv, bf_hi(w[s][0].z) * inv, bf_lo(w[s][0].w) * inv, bf_hi(w[s][0].w) * inv);
            qi[s].z = (int)q8pack(bf_lo(w[s][1].x) * inv, bf_hi(w[s][1].x) * inv, bf_lo(w[s][1].y) * inv, bf_hi(w[s][1].y) * inv);
            qi[s].w = (int)q8pack(bf_lo(w[s][1].z) * inv, bf_hi(w[s][1].z) * inv, bf_lo(w[s][1].w) * inv, bf_hi(w[s][1].w) * inv); }
    }
#define OFF_V() ({ const int u_ = wid * 64 + lane, sub_ = u_ >> 5, within_ = u_ & 31, kk_ = ((sub_ >> 2) << 3) | (within_ >> 2), c_ = ((sub_ & 3) << 5) | ((within_ & 3) << 3); \
                  const int k_ = (kk_ & ~0xC) | ((kk_ & 4) << 1) | ((kk_ & 8) >> 1); (unsigned)(k_ * LDK + c_); })
#define OFF_KN8() ({ const int u_ = wid * 64 + lane, row_ = u_ >> 3, c_ = u_ & 7; (unsigned)(row_ * 128 + ((c_ ^ ((row_ >> 1) & 7)) << 4)); })
#define OFF_KR8() ({ const int u_ = wid * 64 + lane, row_ = u_ >> 2, c_ = u_ & 3; (unsigned)(row_ * 64 + ((c_ ^ ((row_ >> 2) & 3)) << 4)); })
    const int vbase = (int)(unsigned)(uintptr_t)lds + v_rd_base(lane);
#define DMA(t, slot) do { const bf16_t* vh_ = Vh + (size_t)(t) * KVBLK * LDK; LAS unsigned char* sb_ = lds + (slot) * SLOTB8; \
    __builtin_amdgcn_global_load_lds((const unsigned*)(vh_ + OFF_V()), (LAS unsigned*)(sb_ + S8_V + wid * 1024), 16, 0, 0); \
    __builtin_amdgcn_global_load_lds((const unsigned*)(vh_ + OFF_V() + 32 * LDK), (LAS unsigned*)(sb_ + S8_V + (wid + 8) * 1024), 16, 0, 0); \
    __builtin_amdgcn_global_load_lds((const unsigned*)(K8n + (size_t)(t) * 8192 + OFF_KN8()), (LAS unsigned*)(sb_ + S8_KN + wid * 1024), 16, 0, 0); \
    if (wid < 4) __builtin_amdgcn_global_load_lds((const unsigned*)(K8r + (size_t)(t) * 4096 + OFF_KR8()), (LAS unsigned*)(sb_ + S8_KR + wid * 1024), 16, 0, 0); } while (0)
#define RESC(a) do { if (__any((a) < 1.f)) { if (hi == 0) al_l[r32] = (a); asm volatile("s_waitcnt lgkmcnt(0)" ::: "memory"); \
    _Pragma("unroll") for (int d = 0; d < 4; ++d) _Pragma("unroll") for (int r = 0; r < 16; ++r) o[d][r] *= al_l[crow(r, hi)]; } } while (0)
#define TILE_SYNC() do { asm volatile("s_waitcnt vmcnt(0)" ::: "memory"); __syncthreads(); } while (0)
    f32x16 pA0, pA1, pB0, pB1; float mnA, mnB, alA, alB, psum = 0.f; bf16x8 pa0, pa1, pa2, pa3; const int NT = seq / KVBLK;
    LAS float* skl = (LAS float*)(lds + OFF8_SK);
    for (int i = tid; i < NT; i += NTHR) skl[i] = SKh[i];
    DMA(0, 0); DMA(1, 1);
    TILE_SYNC();
    qkt8(pA0, pA1, lds, qi, r32, hi); i2f_scores(pA0, pA1, sq * skl[0]); partialSM(pA0, pA1, m_reg, mnA, alA);
    int s_prev = 0, s_cur = 1, s_next = 2;
    for (int j = 1; j + 1 < NT; j += 2) {
        DMA(j + 1, s_next);
        const float mB = sq * skl[j];
        SBAR(); s1_step8(pB0, pB1, lds + s_cur * SLOTB8, qi, r32, hi, pA0, pA1, psum, pa0, pa1, pa2);
        s2_step8(o, vbase + s_prev * SLOTB8, pa0, pa1, pa2, pa3, pA0, pA1, psum, alA, l_reg, pB0, pB1, mB, m_reg, mnB, alB);
        TILE_SYNC(); RESC(alB);
        { const int t_ = s_prev; s_prev = s_cur; s_cur = s_next; s_next = t_; }
        if (j + 2 < NT) DMA(j + 2, s_next);
        const float mA = sq * skl[j + 1];
        SBAR(); s1_step8(pA0, pA1, lds + s_cur * SLOTB8, qi, r32, hi, pB0, pB1, psum, pa0, pa1, pa2);
        s2_step8(o, vbase + s_prev * SLOTB8, pa0, pa1, pa2, pa3, pB0, pB1, psum, alB, l_reg, pA0, pA1, mA, m_reg, mnA, alA);
        TILE_SYNC(); RESC(alA);
        { const int t_ = s_prev; s_prev = s_cur; s_cur = s_next; s_next = t_; }
    }
    SBAR(); qkt8(pB0, pB1, lds + s_cur * SLOTB8, qi, r32, hi); i2f_scores(pB0, pB1, sq * skl[NT - 1]);
    finishSM(pA0, pA1, alA, l_reg, pa0, pa1, pa2, pa3); SBAR();
    pv_d0(o, vbase + s_prev * SLOTB8, pa0, pa1, pa2, pa3); partialSM(pB0, pB1, m_reg, mnB, alB);
    RESC(alB);
    finishSM(pB0, pB1, alB, l_reg, pa0, pa1, pa2, pa3); SBAR();
    pv_d0(o, vbase + s_cur * SLOTB8, pa0, pa1, pa2, pa3);
    if (hi == 0) li_l[r32] = l_reg; asm volatile("s_waitcnt lgkmcnt(0)" ::: "memory");
    float rli[16];
#pragma unroll
    for (int r = 0; r < 16; ++r) rli[r] = __builtin_amdgcn_rcpf(li_l[crow(r, hi)]);
    bf16_t* Ow = Ob + (long)(wid * 32) * LDO;
#pragma unroll
    for (int r = 0; r < 16; ++r) { const int orow = crow(r, hi);
#pragma unroll
        for (int d0 = 0; d0 < 4; ++d0) Ow[(long)orow * LDO + d0 * 32 + r32] = f2bf(o[d0][r] * rli[r]); }
    __syncthreads();
#undef DMA
#undef OFF_V
#undef OFF_KN8
#undef OFF_KR8
#undef RESC
#undef TILE_SYNC
}
}

__device__ __forceinline__ int crow32(int r, int hi) { return (r & 3) + 8 * (r >> 2) + 4 * hi; }

__device__ __forceinline__ void ce_desc(unsigned& x, unsigned& y) { const unsigned hi = x > y ? x : y, lo = x > y ? y : x; x = hi; y = lo; }
__device__ __forceinline__ unsigned f2key(float s) { const unsigned b = __float_as_uint(s); return b ^ (((unsigned)((int)b >> 31)) | 0x80000000u); }
__device__ __forceinline__ float key2f(unsigned k) { const unsigned b = (k & 0x80000000u) ? (k ^ 0x80000000u) : ~k; return __uint_as_float(b); }
__device__ __forceinline__ void sort16_desc(unsigned (&a)[16]) {
#pragma unroll
    for (int k = 2; k <= 16; k <<= 1)
#pragma unroll
        for (int j = k >> 1; j > 0; j >>= 1)
#pragma unroll
            for (int i = 0; i < 16; ++i) { const int l = i ^ j; if (l > i) { if ((i & k) == 0) ce_desc(a[i], a[l]); else ce_desc(a[l], a[i]); } }
}
__device__ __forceinline__ void merge_top16(unsigned (&a)[16], const unsigned (&b)[16]) {
#pragma unroll
    for (int i = 0; i < 16; ++i) a[i] = a[i] > b[15 - i] ? a[i] : b[15 - i];
#pragma unroll
    for (int j = 8; j > 0; j >>= 1)
#pragma unroll
        for (int i = 0; i < 16; ++i) { const int l = i ^ j; if (l > i) ce_desc(a[i], a[l]); }
}
__device__ __forceinline__ void peer_select(const Fr& F, const bf16_t* PQ, const bf16_t* KEYS, unsigned short* PIDX, float* PGATE) {
    LAS bf16_t* KL = (LAS bf16_t*)F.lds;
    LAS unsigned* LST = (LAS unsigned*)(F.lds + 69632);
    LAS int* IDX = (LAS int*)(F.lds + 69632 + 16384);
    LAS float* GT = (LAS float*)(F.lds + 69632 + 16384 + 8192);
    LAS int* CODE = (LAS int*)(F.lds + 69632 + 16384 + 16384);
    __syncthreads();
    if (F.tid < 64) { int cnt = 0, code = 0; for (int ab = 0; ab < 256; ++ab) { if (((ab >> 4) + 1) * ((ab & 15) + 1) <= 16) { if (cnt == F.tid) code = ab; ++cnt; } } CODE[F.tid] = code; }
    for (int ch = F.tid; ch < 2 * 128 * 16; ch += NTHR) { const int row = ch >> 4, c8 = (ch & 15) * 8; *(LAS u32x4*)(KL + row * 136 + c8) = *(const u32x4*)(KEYS + (size_t)row * 128 + c8); }
    __syncthreads();
    const int r32 = F.lane & 31, hi = F.lane >> 5;
    for (int tile = F.bid; tile < SEQ / 16; tile += F.G) {
        const int t0 = tile * 16;
        {
            const int p = F.wave >> 2, rb = F.wave & 3, r = rb * 32 + r32, tl = r >> 3, h = r & 7;
            const bf16_t* qp = PQ + (size_t)(t0 + tl) * 2048 + h * 256 + p * 128 + hi * 8;
            bf16x8 qa[8];
#pragma unroll
            for (int k = 0; k < 8; ++k) qa[k] = *(const bf16x8*)(qp + k * 16);
            unsigned g[4][16];
#pragma unroll
            for (int nb = 0; nb < 4; ++nb) {
                const LAS bf16_t* kp = KL + (p * 128 + nb * 32 + r32) * 136 + hi * 8;
                f32x16 acc = {};
#pragma unroll
                for (int k = 0; k < 8; ++k) { const bf16x8 kb = *(const LAS bf16x8*)(kp + k * 16); acc = __builtin_amdgcn_mfma_f32_32x32x16_bf16(kb, qa[k], acc, 0, 0, 0); }
#pragma unroll
                for (int rr = 0; rr < 16; ++rr) { const int nbase = nb * 32 + (rr & 3) + 8 * (rr >> 2);
                    g[nb][rr] = (f2key(acc[rr]) & ~127u) | (unsigned)((127 - nbase) - 4 * hi); }
            }
            sort16_desc(g[0]); sort16_desc(g[1]); sort16_desc(g[2]); sort16_desc(g[3]);
            merge_top16(g[0], g[1]); merge_top16(g[2], g[3]); merge_top16(g[0], g[2]);
            unsigned other[16];
#pragma unroll
            for (int k = 0; k < 16; ++k) { auto sw = __builtin_amdgcn_permlane32_swap(g[0][k], g[0][k], false, false); other[k] = hi ? sw[0] : sw[1]; }
            merge_top16(g[0], other);
            if (hi == 0) {
#pragma unroll
                for (int k = 0; k < 16; k += 4) *(LAS u32x4*)(LST + (p * 128 + r) * 16 + k) = (u32x4){g[0][k], g[0][k + 1], g[0][k + 2], g[0][k + 3]};
            }
        }
        __syncthreads();
        if (F.tid < 128) {
            const int j = F.tid, tl = j >> 3, h = j & 7;
            unsigned k1[16], k2[16];
#pragma unroll
            for (int k = 0; k < 16; k += 4) { const u32x4 a = *(const LAS u32x4*)(LST + j * 16 + k), b = *(const LAS u32x4*)(LST + (128 + j) * 16 + k);
                k1[k] = a.x; k1[k + 1] = a.y; k1[k + 2] = a.z; k1[k + 3] = a.w; k2[k] = b.x; k2[k + 1] = b.y; k2[k + 2] = b.z; k2[k + 3] = b.w; }
            float v1[16], v2[16];
#pragma unroll
            for (int k = 0; k < 16; ++k) { v1[k] = key2f(k1[k] & ~127u); v2[k] = key2f(k2[k] & ~127u); }
            unsigned cg[4][16];
            {
                int n = 0;
#pragma unroll
                for (int a = 0; a < 16; ++a)
#pragma unroll
                    for (int b = 0; b < 16; ++b) if ((a + 1) * (b + 1) <= 16) { cg[n >> 4][n & 15] = (f2key(v1[a] + v2[b]) & ~63u) | (unsigned)(63 - n); ++n; }
#pragma unroll
                for (int m = 50; m < 64; ++m) cg[m >> 4][m & 15] = 0u;
            }
            sort16_desc(cg[0]); sort16_desc(cg[1]); sort16_desc(cg[2]); sort16_desc(cg[3]);
            merge_top16(cg[0], cg[1]); merge_top16(cg[2], cg[3]); merge_top16(cg[0], cg[2]);
            float bs[16];
#pragma unroll
            for (int k = 0; k < 16; ++k) bs[k] = key2f(cg[0][k] & ~63u);
            float den = 0.f, ex[16];
#pragma unroll
            for (int k = 0; k < 16; ++k) { ex[k] = __expf(bs[k] - bs[0]); den += ex[k]; }
            const float rden = 1.0f / den;
            unsigned ib = (unsigned)(uintptr_t)(IDX + tl * 128 + h * 2), gb2 = (unsigned)(uintptr_t)(GT + tl * 128 + h * 2), lb = (unsigned)(uintptr_t)(LST + j * 16);
            asm volatile("" : "+v"(ib), "+v"(gb2), "+v"(lb));
            LAS int* ip = (LAS int*)(uintptr_t)ib; LAS float* gp = (LAS float*)(uintptr_t)gb2; LAS unsigned* l1 = (LAS unsigned*)(uintptr_t)lb;
#pragma unroll
            for (int k = 0; k < 16; ++k) {
                const int code = CODE[63 - (int)(cg[0][k] & 63u)]; const int a = code >> 4, b = code & 15;
                const int i1 = 127 - (int)(l1[a] & 127u), i2 = 127 - (int)(l1[128 * 16 + b] & 127u);
                ip[(k & 7) * 16 + (k >> 3)] = i1 * 128 + i2;
                gp[(k & 7) * 16 + (k >> 3)] = ex[k] * rden;
            }
        }
        __syncthreads();
        for (int i = F.tid; i < 16 * 128; i += NTHR) { PIDX[(size_t)t0 * 128 + i] = (unsigned short)IDX[i]; PGATE[(size_t)t0 * 128 + i] = GT[i]; }
        __syncthreads();
    }
}

struct PeerBuf { u32x4 g[8]; };
struct PeerMeta { u32x4 id[2]; u32x4 p[2]; unsigned xr; };
template <int CTRL> __device__ __forceinline__ float dpp_f(float v) { return __int_as_float(__builtin_amdgcn_update_dpp(0, __float_as_int(v), CTRL, 0xf, 0xf, true)); }
__device__ __forceinline__ float xor16_f(float v, bool hi16) { auto r = __builtin_amdgcn_permlane16_swap(__float_as_uint(v), __float_as_uint(v), false, false); return __uint_as_float(hi16 ? r[0] : r[1]); }
__device__ __forceinline__ float xor32_f(float v, bool hi32) { auto r = __builtin_amdgcn_permlane32_swap(__float_as_uint(v), __float_as_uint(v), false, false); return __uint_as_float(hi32 ? r[0] : r[1]); }
template <int HALF>
__device__ __forceinline__ void peer_issue(PeerBuf& b, const unsigned char* tab, unsigned lane_off, const PeerMeta& m) {
#pragma unroll
    for (int i = 0; i < 8; ++i) { const int k = HALF * 8 + i; const unsigned w = m.id[k >> 3][(k >> 1) & 3]; const unsigned idx = (k & 1) ? (w >> 16) : (w & 0xffffu); b.g[i] = *(const u32x4*)(tab + (idx * 128u + lane_off)); }
}
__device__ __forceinline__ void peer_u_quant(const PeerMeta& m, int (&xq)[4], float& sx) {
#pragma unroll
    for (int q = 0; q < 4; ++q) xq[q] = (int)m.p[0][q];
    sx = __uint_as_float(m.p[1].x);
}
template <int HALF>
__device__ __forceinline__ void peer_u_compute(const PeerBuf& b, const int (&xq)[4], float sx, _Float16* pdrow, int q8, int eg) {
    int d[8];
#pragma unroll
    for (int i = 0; i < 8; ++i) { int a = 0;
#pragma unroll
        for (int q = 0; q < 4; ++q) a = __builtin_amdgcn_sdot4((int)b.g[i][q], xq[q], a, false);
        d[i] = a; }
    const bool b2 = (q8 & 4) != 0, b1 = (q8 & 2) != 0, b0 = (q8 & 1) != 0;
    int k4[4], k2[2];
#pragma unroll
    for (int k = 0; k < 4; ++k) { const int keep = b2 ? d[4 + k] : d[k], send = b2 ? d[k] : d[4 + k]; k4[k] = keep + __builtin_amdgcn_update_dpp(0, send, 0x141, 0xf, 0xf, true); }
#pragma unroll
    for (int k = 0; k < 2; ++k) { const int keep = b1 ? k4[2 + k] : k4[k], send = b1 ? k4[k] : k4[2 + k]; k2[k] = keep + __builtin_amdgcn_update_dpp(0, send, 0x4E, 0xf, 0xf, true); }
    const int keep = b0 ? k2[1] : k2[0], send = b0 ? k2[0] : k2[1];
    pdrow[eg * 16 + 8 * HALF + q8] = (_Float16)((float)(keep + __builtin_amdgcn_update_dpp(0, send, 0xB1, 0xf, 0xf, true)) * (sx * 0.0625f));
}
template <int HALF>
__device__ __forceinline__ void peer_v_accum(h2_t (&acc)[8], const PeerBuf& b, const PeerMeta& m) {
#pragma unroll
    for (int i = 0; i < 8; ++i) { const int k = HALF * 8 + i; const unsigned ww = m.p[k >> 3][(k >> 1) & 3];
        const unsigned rep = (k & 1) ? ((ww >> 16) | (ww & 0xffff0000u)) : ((ww & 0xffffu) | (ww << 16));
        const h2_t w2 = *(const h2_t*)&rep;
#pragma unroll
        for (int q = 0; q < 4; ++q) { const unsigned w = b.g[i][q];
            const h2_t lo = __builtin_amdgcn_cvt_scalef32_pk_f16_fp8(w, 1.0f, false), hi2 = __builtin_amdgcn_cvt_scalef32_pk_f16_fp8(w, 1.0f, true);
            acc[2 * q] = __builtin_elementwise_fma(w2, lo, acc[2 * q]); acc[2 * q + 1] = __builtin_elementwise_fma(w2, hi2, acc[2 * q + 1]); } }
}
__device__ __forceinline__ void peer_v_finish(h2_t (&acch)[8], bf16_t* xrow, const unsigned xr, const f32x2 gf, int q8, int eg) {
    float acc[16];
#pragma unroll
    for (int q = 0; q < 8; ++q) { acc[2 * q] = (float)acch[q].x; acc[2 * q + 1] = (float)acch[q].y; acch[q] = (h2_t){(_Float16)0.f, (_Float16)0.f}; }
    const bool c0 = (eg & 1) != 0, c1 = (eg & 2) != 0, c2 = (eg & 4) != 0;
    float k8[8], k4[4], k2[2];
#pragma unroll
    for (int k = 0; k < 8; ++k) { const float keep = c0 ? acc[8 + k] : acc[k], send = c0 ? acc[k] : acc[8 + k]; k8[k] = keep + dpp_f<0x128>(send); }
#pragma unroll
    for (int k = 0; k < 4; ++k) { const float keep = c1 ? k8[4 + k] : k8[k], send = c1 ? k8[k] : k8[4 + k]; k4[k] = keep + xor16_f(send, c1); }
#pragma unroll
    for (int k = 0; k < 2; ++k) { const float keep = c2 ? k4[2 + k] : k4[k], send = c2 ? k4[k] : k4[2 + k]; k2[k] = keep + xor32_f(send, c2); }
    const int dim = q8 * 16 + (c0 ? 8 : 0) + (c1 ? 4 : 0) + (c2 ? 2 : 0);
    *(unsigned*)(xrow + dim) = pk_bf16(bf_lo(xr) + gf.x * (k2[0] * (1.0f / 1024.0f)), bf_hi(xr) + gf.y * (k2[1] * (1.0f / 1024.0f)));
}
template <int MODE>
__device__ __forceinline__ void peer_sliced(const Fr& F, const unsigned char* TAB, const unsigned short* PIDX, const unsigned char* H8, const float* SA, const _Float16* PW, _Float16* PD, bf16_t* XR, const float* gate_f) {
    const bool hw = F.xcc_ok != 0, al = (F.G & 7) == 0;
    const int nr = hw ? F.xcc_n : (al ? (F.G >> 3) : F.G), r = hw ? F.xcc_rank : (al ? (F.bid >> 3) : F.bid);
    const int xs_lo = hw ? F.xcc : (al ? (F.bid & 7) : 0), xs_hi = (hw || al) ? xs_lo + 1 : 8;
    const int q8 = F.lane & 7, eg = F.lane >> 3;
    const int stride = nr * 8, tfirst = r + nr * F.wave;
    const int ntok = tfirst < SEQ ? (SEQ - tfirst + stride - 1) / stride : 0;
    for (int xs = xs_lo; xs < xs_hi; ++xs)
        for (int ps = 0; ps < 2; ++ps) {
            const int s = xs * 2 + ps;
            const unsigned lane_off = (unsigned)(s * 2097152 + q8 * 16);
            PeerBuf b0, b1, b2; PeerMeta m0, m1, m2; h2_t acc[8];
            const int vdim = q8 * 16 + ((eg & 1) ? 8 : 0) + ((eg & 2) ? 4 : 0) + ((eg & 4) ? 2 : 0);
            const f32x2 gfv = (MODE == 1) ? *(const f32x2*)(gate_f + s * 128 + vdim) : (f32x2){0.f, 0.f};
#pragma unroll
            for (int q = 0; q < 8; ++q) acc[q] = (h2_t){(_Float16)0.f, (_Float16)0.f};
#define PEER_META(m, t) do { const u32x4* ip_ = (const u32x4*)(PIDX + (size_t)(t) * 128 + eg * 16); (m).id[0] = ip_[0]; (m).id[1] = ip_[1]; \
    if (MODE == 0) { (m).p[0] = *(const u32x4*)(H8 + (size_t)(t) * 2048 + s * 128 + q8 * 16); (m).p[1].x = __float_as_uint(SA[(t)]); } \
    else { const u32x4* wp_ = (const u32x4*)(PW + (size_t)(t) * 128 + eg * 16); (m).p[0] = wp_[0]; (m).p[1] = wp_[1]; \
           (m).xr = *(const unsigned*)(XR + (size_t)(t) * DM + s * 128 + vdim); } } while (0)
#define PEER_TRIP(mc, mn, ml, bx, by, bz, kk, C2, C1) do { const int t = tfirst + (kk) * stride; int xq_[4] = {0, 0, 0, 0}; float sx_ = 0.f; \
                if (C2) PEER_META(ml, t + 2 * stride); \
                if (C1) peer_issue<0>(bz, TAB, lane_off, mn); \
                if (MODE == 0) { peer_u_quant(mc, xq_, sx_); peer_u_compute<0>(bx, xq_, sx_, PD + ((size_t)s * SEQ + t) * 128, q8, eg); } else peer_v_accum<0>(acc, bx, mc); \
                if (C1) peer_issue<1>(bx, TAB, lane_off, mn); \
                if (MODE == 0) peer_u_compute<1>(by, xq_, sx_, PD + ((size_t)s * SEQ + t) * 128, q8, eg); \
                else { peer_v_accum<1>(acc, by, mc); peer_v_finish(acc, XR + (size_t)t * DM + s * 128, (mc).xr, gfv, q8, eg); } } while (0)
            int k = 0;
            if (ntok >= 5) {
                PEER_META(m0, tfirst); PEER_META(m1, tfirst + stride);
                peer_issue<0>(b0, TAB, lane_off, m0); peer_issue<1>(b1, TAB, lane_off, m0);
                for (; k + 4 < ntok; k += 3) {
                    PEER_TRIP(m0, m1, m2, b0, b1, b2, k, true, true);
                    PEER_TRIP(m1, m2, m0, b2, b0, b1, k + 1, true, true);
                    PEER_TRIP(m2, m0, m1, b1, b2, b0, k + 2, true, true);
                }
            } else if (ntok > 0) {
                PEER_META(m0, tfirst);
                if (ntok > 1) PEER_META(m1, tfirst + stride);
                peer_issue<0>(b0, TAB, lane_off, m0); peer_issue<1>(b1, TAB, lane_off, m0);
            }
            for (; k < ntok; k += 3) {
                PEER_TRIP(m0, m1, m2, b0, b1, b2, k, (k + 2 < ntok), (k + 1 < ntok));
                if (k + 1 < ntok) PEER_TRIP(m1, m2, m0, b2, b0, b1, k + 1, (k + 3 < ntok), (k + 2 < ntok));
                if (k + 2 < ntok) PEER_TRIP(m2, m0, m1, b1, b2, b0, k + 2, (k + 4 < ntok), (k + 3 < ntok));
            }
#undef PEER_TRIP
#undef PEER_META
        }
}
__device__ __forceinline__ void peer_weights(const Fr& F, const _Float16* PD, const unsigned short* PIDX, const float* PGATE, const float* SU, const float* SV, _Float16* PW) {
    typedef _Float16 h4_t __attribute__((ext_vector_type(4)));
    for (int it = F.bid * NTHR + F.tid; it < SEQ * 32; it += F.G * NTHR) {
        const size_t o = (size_t)it * 4;
        f32x4 a = {0.f, 0.f, 0.f, 0.f};
#pragma unroll
        for (int s = 0; s < 16; ++s) { const h4_t h = *(const h4_t*)(PD + (size_t)s * SEQ * 128 + o); a += (f32x4){(float)h[0], (float)h[1], (float)h[2], (float)h[3]}; }
        const u32x2 iw = *(const u32x2*)(PIDX + o); const f32x4 g = *(const f32x4*)(PGATE + o);
        const unsigned idx[4] = {iw.x & 0xffffu, iw.x >> 16, iw.y & 0xffffu, iw.y >> 16};
        h4_t w;
#pragma unroll
        for (int e = 0; e < 4; ++e) w[e] = (_Float16)(g[e] * gelu_tanh(a[e] * (16.0f * SU[idx[e]])) * SV[idx[e]] * 1024.0f);
        *(h4_t*)(PW + o) = w;
    }
}
__device__ __forceinline__ void final_norm_rows(const Fr& F, const bf16_t* X, const float* g, float* out) {
    f32x4 cs[8];
#pragma unroll
    for (int i = 0; i < 4; ++i) { cs[2 * i] = *(const f32x4*)(g + i * 512 + F.lane * 8); cs[2 * i + 1] = *(const f32x4*)(g + i * 512 + F.lane * 8 + 4); }
    for (int row0 = (F.bid * 8 + F.wave) * 2; row0 < SEQ; row0 += F.G * 16) {
        u32x4 w[2][4];
#pragma unroll
        for (int rr = 0; rr < 2; ++rr)
#pragma unroll
            for (int i = 0; i < 4; ++i) w[rr][i] = *(const u32x4*)(X + (size_t)(row0 + rr) * DM + i * 512 + F.lane * 8);
#pragma unroll
        for (int rr = 0; rr < 2; ++rr) {
            f32x4 v[8]; float ss = 0.f;
#pragma unroll
            for (int i = 0; i < 4; ++i) { v[2 * i] = (f32x4){bf_lo(w[rr][i].x), bf_hi(w[rr][i].x), bf_lo(w[rr][i].y), bf_hi(w[rr][i].y)}; v[2 * i + 1] = (f32x4){bf_lo(w[rr][i].z), bf_hi(w[rr][i].z), bf_lo(w[rr][i].w), bf_hi(w[rr][i].w)}; }
#pragma unroll
            for (int i = 0; i < 8; ++i) ss += v[i][0] * v[i][0] + v[i][1] * v[i][1] + v[i][2] * v[i][2] + v[i][3] * v[i][3];
            ss = wave_sum(ss);
            const float rstd = rsqrtf(ss * (1.0f / DM) + 1e-6f);
#pragma unroll
            for (int i = 0; i < 4; ++i) { float* op = out + (size_t)(row0 + rr) * DM + i * 512 + F.lane * 8; *(f32x4*)op = v[2 * i] * rstd * cs[2 * i]; *(f32x4*)(op + 4) = v[2 * i + 1] * rstd * cs[2 * i + 1]; }
        }
    }
}

__device__ __forceinline__ void gmlp_phase(const Fr& F, const bf16_t* PB, const bf16_t* GMWS, bf16_t* YCAT) {
    const float* gng = F.in[I_GMNG1]; const float* gmb = F.in[I_GMB1];
    LAS float* rstd_s = (LAS float*)F.lds;
    LAS bf16_t* VT = (LAS bf16_t*)(F.lds + 1024);
    LAS bf16_t* AT = (LAS bf16_t*)(F.lds + 1024 + 128 * 136 * 2);
    LAS float* ST = (LAS float*)(F.lds + 1024 + 2 * 128 * 136 * 2);
    for (int unit = F.bid; unit < 256; unit += F.G) {
        const int n = unit >> 1, gh = unit & 1, pos0 = n * 128;
        __syncthreads();
#pragma unroll 1
        for (int r0 = F.wave * 16; r0 < F.wave * 16 + 16; r0 += 8) {
            u32x4 a[8], b[8];
#pragma unroll
            for (int q = 0; q < 8; ++q) { const bf16_t* pr = PB + (size_t)(pos0 + r0 + q) * 5120 + 1024 + F.lane * 16; a[q] = *(const u32x4*)pr; b[q] = *(const u32x4*)(pr + 8); }
#pragma unroll
            for (int q = 0; q < 8; ++q) {
                float ss = 0.f;
#pragma unroll
                for (int e = 0; e < 4; ++e) { ss += bf_lo(a[q][e]) * bf_lo(a[q][e]) + bf_hi(a[q][e]) * bf_hi(a[q][e]) + bf_lo(b[q][e]) * bf_lo(b[q][e]) + bf_hi(b[q][e]) * bf_hi(b[q][e]); }
                ss = wave_sum(ss);
                if (F.lane == 0) rstd_s[r0 + q] = rsqrtf(ss * (1.0f / 1024.0f) + 1e-6f);
            }
        }
        __syncthreads();
        for (int g = gh * 4; g < gh * 4 + 4; ++g) {
            { u32x4 a4[4];
#pragma unroll
              for (int k = 0; k < 4; ++k) { const int ch = F.tid + k * NTHR, p = ch >> 4, q8 = (ch & 15) * 8; a4[k] = *(const u32x4*)(GMWS + (size_t)g * 16384 + p * 128 + q8); }
#pragma unroll
              for (int k = 0; k < 4; ++k) { const int ch = F.tid + k * NTHR, p = ch >> 4, q8 = (ch & 15) * 8; *(LAS u32x4*)(AT + p * 136 + q8) = a4[k]; } }
            { const int q = F.tid >> 2, cp = (F.tid & 3) * 32; const float rs = rstd_s[q];
              const bf16_t* pr = PB + (size_t)(pos0 + q) * 5120 + 1024 + g * 128 + cp;
              u32x4 w4[4]; f32x4 gg[8];
#pragma unroll
              for (int i = 0; i < 4; ++i) { w4[i] = *(const u32x4*)(pr + i * 8); gg[2 * i] = *(const f32x4*)(gng + g * 128 + cp + i * 8); gg[2 * i + 1] = *(const f32x4*)(gng + g * 128 + cp + i * 8 + 4); }
#pragma unroll
              for (int i = 0; i < 4; ++i) { const u32x4 w = w4[i];
                  const float v[8] = {bf_lo(w.x), bf_hi(w.x), bf_lo(w.y), bf_hi(w.y), bf_lo(w.z), bf_hi(w.z), bf_lo(w.w), bf_hi(w.w)};
#pragma unroll
                  for (int e = 0; e < 8; ++e) { const int c = cp + i * 8 + e; VT[c * 136 + q] = f2bf(v[e] * rs * gg[2 * i + (e >> 2)][e & 3]); } } }
            __syncthreads();
            { const int pb = F.wave >> 1, cb0 = (F.wave & 1) * 2, r32 = F.lane & 31, hi = F.lane >> 5;
#pragma unroll
              for (int cbi = 0; cbi < 2; ++cbi) { const int cb = cb0 + cbi; f32x16 acc = {};
#pragma unroll
                  for (int k = 0; k < 8; ++k) { const bf16x8 a = *(const LAS bf16x8*)(AT + (pb * 32 + r32) * 136 + k * 16 + hi * 8), b = *(const LAS bf16x8*)(VT + (cb * 32 + r32) * 136 + k * 16 + hi * 8);
                      acc = __builtin_amdgcn_mfma_f32_32x32x16_bf16(a, b, acc, 0, 0, 0); }
#pragma unroll
                  for (int rr = 0; rr < 16; ++rr) { const int p = pb * 32 + crow32(rr, hi); ST[p * 132 + cb * 32 + r32] = acc[rr] + gmb[g * 128 + p]; } } }
            __syncthreads();
            u32x4 u4[4];
#pragma unroll
            for (int k = 0; k < 4; ++k) { const int ch = F.tid + k * NTHR, p = ch >> 4, c8 = (ch & 15) * 8; u4[k] = *(const u32x4*)(PB + (size_t)(pos0 + p) * 5120 + g * 128 + c8); }
#pragma unroll
            for (int k = 0; k < 4; ++k) { const int ch = F.tid + k * NTHR; const int p = ch >> 4, c8 = (ch & 15) * 8; const size_t pos = (size_t)(pos0 + p);
                const f32x4 s0 = *(const LAS f32x4*)(ST + p * 132 + c8), s1 = *(const LAS f32x4*)(ST + p * 132 + c8 + 4);
                const u32x4 uu = u4[k];
                u32x4 y; y.x = pk_bf16(bf_lo(uu.x) * s0[0], bf_hi(uu.x) * s0[1]); y.y = pk_bf16(bf_lo(uu.y) * s0[2], bf_hi(uu.y) * s0[3]);
                y.z = pk_bf16(bf_lo(uu.z) * s1[0], bf_hi(uu.z) * s1[1]); y.w = pk_bf16(bf_lo(uu.w) * s1[2], bf_hi(uu.w) * s1[3]);
                *(u32x4*)(YCAT + pos * 2048 + g * 128 + c8) = y; }
        }
    }
}
__device__ __forceinline__ void hyena_pre(const Fr& F, const bf16_t* PB, unsigned* Z, bf16_t* G1B, bf16_t* X0B) {
    const float* cw = F.in[I_HYCW1]; const float* cb = F.in[I_HYCB1];
    const int cg = F.tid & 127, c0 = cg * 8;
    float w0[3][8], w1[3][8], w2[3][8], bb[3][8];
#pragma unroll
    for (int pt = 0; pt < 3; ++pt)
#pragma unroll
        for (int e = 0; e < 8; ++e) { const int c = pt * 1024 + c0 + e; w0[pt][e] = cw[c]; w1[pt][e] = cw[3072 + c]; w2[pt][e] = cw[6144 + c]; bb[pt][e] = cb[c]; }
    for (int t = F.bid * 4 + (F.tid >> 7); t < SEQ; t += F.G * 4) {
        u32x4 r[3][3];
#pragma unroll
        for (int dt = 0; dt < 3; ++dt) { const int tt = t + dt - 1; const bool ok = (tt >= 0) && (tt < SEQ);
#pragma unroll
            for (int pt = 0; pt < 3; ++pt) r[dt][pt] = ok ? *(const u32x4*)(PB + (size_t)tt * 5120 + 2048 + pt * 1024 + c0) : (u32x4){0u, 0u, 0u, 0u}; }
        float xs[3][8];
#pragma unroll
        for (int pt = 0; pt < 3; ++pt)
#pragma unroll
            for (int q = 0; q < 4; ++q) {
                xs[pt][2 * q] = w0[pt][2 * q] * bf_lo(r[0][pt][q]) + w1[pt][2 * q] * bf_lo(r[1][pt][q]) + w2[pt][2 * q] * bf_lo(r[2][pt][q]) + bb[pt][2 * q];
                xs[pt][2 * q + 1] = w0[pt][2 * q + 1] * bf_hi(r[0][pt][q]) + w1[pt][2 * q + 1] * bf_hi(r[1][pt][q]) + w2[pt][2 * q + 1] * bf_hi(r[2][pt][q]) + bb[pt][2 * q + 1];
            }
        float g1[8];
#pragma unroll
        for (int e = 0; e < 8; ++e) g1[e] = xs[1][e] * xs[2][e];
        *(u32x4*)(Z + (size_t)t * ZP + (c0 >> 1)) = (u32x4){pk_h2((f32x2){g1[0] * 0.125f, g1[1] * 0.125f}), pk_h2((f32x2){g1[2] * 0.125f, g1[3] * 0.125f}),
                                                              pk_h2((f32x2){g1[4] * 0.125f, g1[5] * 0.125f}), pk_h2((f32x2){g1[6] * 0.125f, g1[7] * 0.125f})};
        *(u32x4*)(G1B + (size_t)t * 1024 + c0) = (u32x4){pk_bf16(g1[0], g1[1]), pk_bf16(g1[2], g1[3]), pk_bf16(g1[4], g1[5]), pk_bf16(g1[6], g1[7])};
        *(u32x4*)(X0B + (size_t)t * 1024 + c0) = (u32x4){pk_bf16(xs[0][0], xs[0][1]), pk_bf16(xs[0][2], xs[0][3]), pk_bf16(xs[0][4], xs[0][5]), pk_bf16(xs[0][6], xs[0][7])};
    }
}

__device__ __forceinline__ f32x2 cmul(f32x2 a, f32x2 b) { return (f32x2){a.x * b.x - a.y * b.y, a.x * b.y + a.y * b.x}; }
template <bool INV>
__device__ __forceinline__ void fft32(f32x2 (&v)[32]) {
    constexpr float CS[16] = {1.0f, 0.98078528040323043f, 0.92387953251128674f, 0.83146961230254524f, 0.70710678118654752f, 0.55557023301960218f, 0.38268343236508977f, 0.19509032201612825f,
                              0.0f, -0.19509032201612825f, -0.38268343236508977f, -0.55557023301960218f, -0.70710678118654752f, -0.83146961230254524f, -0.92387953251128674f, -0.98078528040323043f};
    constexpr float SN[16] = {0.0f, 0.19509032201612825f, 0.38268343236508977f, 0.55557023301960218f, 0.70710678118654752f, 0.83146961230254524f, 0.92387953251128674f, 0.98078528040323043f,
                              1.0f, 0.98078528040323043f, 0.92387953251128674f, 0.83146961230254524f, 0.70710678118654752f, 0.55557023301960218f, 0.38268343236508977f, 0.19509032201612825f};
#pragma unroll
    for (int s = 0; s < 5; ++s) {
        const int half = 16 >> s;
#pragma unroll
        for (int i = 0; i < 32; ++i) {
            if ((i & half) == 0) {
                const int j = i | half, tw = (i & (half - 1)) << s;
                const f32x2 a = v[i], b = v[j];
                v[i] = a + b;
                const f32x2 d = a - b;
                const float c = CS[tw], sn = INV ? SN[tw] : -SN[tw];
                v[j] = (f32x2){d.x * c - d.y * sn, d.x * sn + d.y * c};
            }
        }
    }
}
__host__ __device__ constexpr int brev5(int k) { return ((k & 1) << 4) | ((k & 2) << 2) | (k & 4) | ((k & 8) >> 2) | ((k & 16) >> 4); }

template <int MP, bool INV, int MODE>
__device__ __forceinline__ void fft_pass(const Fr& F, const unsigned* Zs, unsigned* Zb, const bf16_t* G1B, const bf16_t* X0B, const float* hbias, bf16_t* YCAT) {
    constexpr int S = 32 * MP, NIT = 1024 * 512;
    const int step = F.G * NTHR;
    int it = F.bid * NTHR + F.tid;
    unsigned raw[32];
#define FFT_LOAD(itx) do { const int cp_ = (itx) & 511, j_ = (itx) >> 9, nl_ = j_ % MP, sb_ = j_ / MP; const size_t b_ = ((size_t)sb_ * S + nl_) * ZP + cp_; \
        _Pragma("unroll") for (int m = 0; m < 32; ++m) raw[m] = (MODE == 1 && m >= 16) ? 0u : Zs[b_ + (size_t)m * MP * ZP]; } while (0)
    if (it < NIT) FFT_LOAD(it);
    for (; it < NIT; it += step) {
        const int cp = it & 511, j = it >> 9, n_lo = j % MP, sblk = j / MP;
        const size_t base = ((size_t)sblk * S + n_lo) * ZP + cp;
        f32x2 v[32];
#pragma unroll
        for (int m = 0; m < 32; ++m) v[m] = un_h2(raw[m]);
        if (it + step < NIT) FFT_LOAD(it + step);
        if (!INV) {
            fft32<false>(v);
#pragma unroll
            for (int k = 0; k < 32; ++k) {
                f32x2 o = v[brev5(k)];
                if (MP > 1 && k > 0) { const float fr = (float)(n_lo * k) * (1.0f / (float)S); const f32x2 w = {__builtin_amdgcn_cosf(fr), -__builtin_amdgcn_sinf(fr)}; o = cmul(o, w); }
                Zb[base + (size_t)k * MP * ZP] = pk_h2(o);
            }
        } else {
            if (MP > 1) {
#pragma unroll
                for (int k = 1; k < 32; ++k) { const float fr = (float)(n_lo * k) * (1.0f / (float)S); const f32x2 w = {__builtin_amdgcn_cosf(fr), __builtin_amdgcn_sinf(fr)}; v[k] = cmul(v[k], w); }
            }
            fft32<true>(v);
#pragma unroll
            for (int m = 0; m < 32; ++m) {
                const f32x2 o = v[brev5(m)];
                if (MODE != 2) Zb[base + (size_t)m * MP * ZP] = pk_h2(o);
                else if (m < 16) {
                    const int nrow = sblk * S + n_lo + m * MP;
                    const unsigned g1w = *(const unsigned*)(G1B + (size_t)nrow * 1024 + cp * 2), x0w = *(const unsigned*)(X0B + (size_t)nrow * 1024 + cp * 2);
                    const f32x2 hb = *(const f32x2*)(hbias + cp * 2);
                    const float ya = bf_lo(x0w) * (o.x * (1.0f / 128.0f) + hb.x * bf_lo(g1w)), yb = bf_hi(x0w) * (o.y * (1.0f / 128.0f) + hb.y * bf_hi(g1w));
                    *(unsigned*)(YCAT + (size_t)nrow * 2048 + 1024 + cp * 2) = pk_bf16(ya, yb);
                }
            }
        }
    }
#undef FFT_LOAD
}
__device__ __forceinline__ int fft_pos(int k) { return ((k & 31) << 10) | (((k >> 5) & 31) << 5) | (k >> 10); }
__device__ __forceinline__ void fft_pointwise(const Fr& F, unsigned* Zb, const unsigned* Kb, const float* FNORM) {
    constexpr int N = 32768, NIT = (N / 2 + 1) * 512;
    const int step = F.G * NTHR;
    for (int it0 = F.bid * NTHR + F.tid; it0 < NIT; it0 += 4 * step) {
        unsigned z1[4], z2[4], q1[4], q2[4]; size_t p1[4], p2[4]; bool ok[4], two[4];
#pragma unroll
        for (int u = 0; u < 4; ++u) { const int it = it0 + u * step; ok[u] = it < NIT; const int itc = ok[u] ? it : it0;
            const int cp = itc & 511, k = itc >> 9, k2 = (N - k) & (N - 1);
            p1[u] = (size_t)fft_pos(k) * ZP + cp; p2[u] = (size_t)fft_pos(k2) * ZP + cp; two[u] = (k2 != k);
            z1[u] = Zb[p1[u]]; z2[u] = Zb[p2[u]]; q1[u] = Kb[p1[u]]; q2[u] = Kb[p2[u]]; }
        const int cp = it0 & 511;
        const float na = FNORM[cp * 2] * (0.25f * 8.0f / 256.0f), nb = FNORM[cp * 2 + 1] * (0.25f * 8.0f / 256.0f);
#pragma unroll
        for (int u = 0; u < 4; ++u) {
            if (!ok[u]) continue;
            const f32x2 a1 = un_h2(z1[u]), a2 = un_h2(z2[u]), b1 = un_h2(q1[u]), b2 = un_h2(q2[u]);
            const f32x2 ga = {a1.x + a2.x, a1.y - a2.y}, gb = {a1.y + a2.y, -(a1.x - a2.x)};
            const f32x2 ka = {(b1.x + b2.x) * na, (b1.y - b2.y) * na}, kb = {(b1.y + b2.y) * nb, -(b1.x - b2.x) * nb};
            const f32x2 ya = cmul(ga, ka), yb = cmul(gb, kb);
            Zb[p1[u]] = pk_h2((f32x2){ya.x - yb.y, ya.y + yb.x});
            if (two[u]) Zb[p2[u]] = pk_h2((f32x2){ya.x + yb.y, -ya.y + yb.x});
        }
    }
}

#ifndef MK_PER_PHASE
#define MK_PER_PHASE 0
#endif
enum { PH_PRO = 0, PH_NORM0, PH_IN0, PH_POST0, PH_UP0, PH_KQ, PH_ATT, PH_QY0, PH_OUT0, PH_PNORM0, PH_PQ0, PH_SEL0, PH_U0, PH_W0, PH_V0, PH_N1,
       PH_IN1, PH_POST1, PH_F1, PH_F2, PH_F3, PH_PWISE, PH_I1, PH_I2, PH_I3, PH_QY1, PH_OUT1, PH_PNORM1, PH_PQ1, PH_SEL1, PH_U1, PH_W1, PH_V1, PH_FIN, NPH };
#ifndef PROBE_SEQ
#define PROBE_SEQ 0
#endif

__global__ void __launch_bounds__(NTHR, 2) mk_fwd(Params P) {
    extern __shared__ __attribute__((aligned(16))) unsigned char lds_raw[];
    Fr F;
    F.in = P.in; F.out = P.out; F.ws = P.ws; F.lds = (LAS unsigned char*)lds_raw;
    F.tid = threadIdx.x; F.lane = F.tid & 63; F.wave = __builtin_amdgcn_readfirstlane(F.tid >> 6); F.G = gridDim.x; F.bid = blockIdx.x;
    unsigned char* ws = P.ws;
    const int lo = P.ph_lo, hi = P.ph_hi;
    volatile LAS unsigned* xbw = (volatile LAS unsigned*)(F.lds + LDS_CTL);
    if (F.tid < 4) xbw[F.tid] = 0u;
    __syncthreads();
    XcdBarrier bar; bar.bar = (unsigned*)(ws + WS_CTL); bar.x = 0; bar.st = xbw;
    if (hi - lo > 1) bar = xcd_barrier_post((unsigned*)(ws + WS_CTL), xbw);
    if (F.tid == 0) { const unsigned x = xb_xcc_id(); xbw[2] = x; xbw[3] = (hi - lo > 1) ? xb_add((unsigned*)(ws + WS_CTL) + 8192 + 64 * x, 1u) : 0u; }
    __syncthreads();
    F.xcc = (int)xbw[2]; F.xcc_rank = (int)xbw[3]; F.xcc_n = 0; F.xcc_ok = 0;
#define XCC_REFRESH() do { const unsigned nl_ = xbw[0], nx_ = xbw[1]; F.xcc_n = (int)nl_; F.xcc_ok = (hi - lo > 1) && nx_ == 8u && nl_ > 0u && F.xcc < 8 && F.xcc_rank < (int)nl_; } while (0)
#ifdef ONLY_PHASE
#define IN(k) ((k) == ONLY_PHASE && lo <= (k) && (k) < hi)
#else
#define IN(k) (lo <= (k) && (k) < hi)
#endif
#define SEAM(k) do { if (IN(k) && IN((k) + 1)) xcd_barrier(bar); } while (0)

    float* MOD0 = (float*)(ws + WS_MOD0); float* MOD1 = (float*)(ws + WS_MOD1); float* MC0 = (float*)(ws + WS_MC0);
    float* ROPEC = (float*)(ws + WS_ROPEC); float* ROPES = (float*)(ws + WS_ROPES);
    float* FPART = (float*)(ws + WS_FPART); float* FNORM = (float*)(ws + WS_FNORM);
    bf16_t* KEYS0 = (bf16_t*)(ws + WS_KEYS0); bf16_t* KEYS1 = (bf16_t*)(ws + WS_KEYS1); bf16_t* GMWS = (bf16_t*)(ws + WS_GMWS);
    bf16_t* WIN0 = (bf16_t*)(ws + WS_WIN0); bf16_t* WUQ = (bf16_t*)(ws + WS_WUQ); bf16_t* WUKV = (bf16_t*)(ws + WS_WUKV);
    bf16_t* WOUT0 = (bf16_t*)(ws + WS_WOUT0); bf16_t* WPQ0 = (bf16_t*)(ws + WS_WPQ0);
    bf16_t* WIN1 = (bf16_t*)(ws + WS_WIN1); bf16_t* WOUT1 = (bf16_t*)(ws + WS_WOUT1); bf16_t* WPQ1 = (bf16_t*)(ws + WS_WPQ1);
    unsigned char* TABU = ws + WS_TABU; unsigned char* TABV = ws + WS_TABV; float* TSC = (float*)(ws + WS_TSC);
    float* SA = (float*)(ws + WS_SA); float* SW = (float*)(ws + WS_SW); unsigned char* H8 = ws + WS_H;
    bf16_t* XR = (bf16_t*)(ws + WS_XR); bf16_t* H = (bf16_t*)(ws + WS_H); bf16_t* PBUF = (bf16_t*)(ws + WS_PBUF);
    bf16_t* QN = (bf16_t*)(ws + WS_QN); bf16_t* KVN = (bf16_t*)(ws + WS_KVN); bf16_t* KROPE = (bf16_t*)(ws + WS_KROPE);
    bf16_t* Q = (bf16_t*)(ws + WS_Q); bf16_t* KV = (bf16_t*)(ws + WS_KV); bf16_t* YCAT = (bf16_t*)(ws + WS_YCAT);
    unsigned* Z = (unsigned*)(ws + WS_Z); unsigned* KZ = (unsigned*)(ws + WS_KZ); unsigned* KZ2 = (unsigned*)(ws + WS_KZ2);
    bf16_t* G1B = (bf16_t*)(ws + WS_G1B); bf16_t* X0B = (bf16_t*)(ws + WS_X0B);
    bf16_t* PQ = PBUF;
    unsigned short* PIDX = (unsigned short*)(ws + WS_YCAT); float* PGATE = (float*)(ws + WS_YCAT + 8388608); _Float16* PW = (_Float16*)(ws + WS_YCAT + 16777216);
    _Float16* PD = (_Float16*)(ws + WS_L0X);

    if (IN(PH_PRO)) {
        const int fl = P.flags;
        if (!(fl & 2)) {
        modgemv(F, P.in[I_C], P.in[I_CCTX], P.in[I_WMOD0], P.in[I_BMOD0], MOD0, MC0, 4096);
        }
        if (!(fl & 4)) {
        colmax_task(F, P.in[I_WIN0], 2048, 3904, 4096, SW);
        tconv_task(F, P.in[I_WUQ0], 512, 1536, 1536, WUQ);
        tconv_task(F, P.in[I_WUKV0], 256, 2048, 2048, WUKV);
        }
        if (!(fl & 16)) {
        cvt_task(F, P.in[I_PKEYS0], KEYS0, 32768 / 8);
        cvt_task(F, P.in[I_PKEYS1], KEYS1, 32768 / 8);
        cvt_task(F, P.in[I_GMWS1], GMWS, 131072 / 8);
        rope_tables(F, ROPEC, ROPES);
        hyena_filter_gen(F, KZ, FPART);
        }
        if (!(fl & 8)) {
        }
    }
    SEAM(PH_PRO);
    if (IN(PH_NORM0)) {
        tconv_q_task(F, P.in[I_WIN0], 2048, 3904, 4096, SW, (unsigned char*)WIN0);
        norm_rows<true>(F, P.in[I_X], SEQ, P.in[I_LN1G0], MOD0 + 2048, MOD0, nullptr, H8, SA);
        norm_rows<true>(F, P.in[I_CTX], CTXL, P.in[I_LN1G0], MC0 + 2048, MC0, nullptr, H8 + (size_t)SEQ * 2048, SA + SEQ);
        hyena_filter_norm(F, FPART, FNORM);
        fft_pass<1024, false, 0>(F, KZ, KZ2, nullptr, nullptr, nullptr, nullptr);
    }
    SEAM(PH_NORM0);
    if (IN(PH_IN0)) {
        pg8::Gemm g{(const bf16_t*)H8, (const bf16_t*)WIN0, SEQ, 4096, 1024}; OrderIn0 S; S.init2(F.G, F.bid);
        EpiI8G E{PBUF, 4096, 0, SA, SW};
        pg8::gemm_phase<EpiI8G, OrderIn0, false>(F.lds, g, S, E, nullptr);
        const bool sh = F.G > 2;
        if (!sh || F.bid >= 2) {
            Fr F2 = F; if (sh) { F2.bid -= 2; F2.G -= 2; }
            __syncthreads();
            colmax_task(F2, P.in[I_WIN1], 2048, 5120, 5120, SW + 6144);
            colmax_task(F2, P.in[I_WOUT1], 2048, 2048, 2048, SW + 15360);
            colmax_task(F2, P.in[I_WOUT0], 2048, 2048, 2048, SW + 13312);
            colmax_task(F2, P.in[I_PWQ1], 2048, 2048, 2048, SW + 11264);
            colmax_task(F2, P.in[I_PWQ0], 2048, 2048, 2048, SW + 4096);
            cvt_table<false>(F2, P.in[I_PU1], TABU + (size_t)33554432, TSC + 32768);
        }
    }
    SEAM(PH_IN0);
    if (IN(PH_POST0)) {
        l0_post_proj(F, PBUF, QN, KVN, KROPE, YCAT, ROPEC, ROPES, NKEY);
        fft_pass<32, false, 0>(F, KZ2, KZ, nullptr, nullptr, nullptr, nullptr);
    }
    SEAM(PH_POST0);
    if (IN(PH_UP0)) {
        { pg8::Gemm g{QN, WUQ, SEQ, 1536, 512}; pg8::StaticOrder S; S.init(SEQ, 1536, F.G, F.bid);
          EpiQRope E{Q, ROPEC, ROPES};
          pg8::gemm_phase<EpiQRope, pg8::StaticOrder, false>(F.lds, g, S, E, nullptr); }
        { pg8::Gemm g{KVN, WUKV, NKEY, 2048, 256}; OrderKV S; S.init(NKEY, 2048, F.G, F.bid);
          EpiBf16G E{KV, 2048, 0};
          pg8::gemm_phase<EpiBf16G, OrderKV, false>(F.lds, g, S, E, nullptr); }
    }
    SEAM(PH_UP0);
    unsigned char* K8N = (unsigned char*)PBUF; unsigned char* K8R = K8N + (size_t)8 * NKEY * 128; float* SKT = (float*)(K8R + (size_t)8 * NKEY * 64);
    if (IN(PH_KQ)) att::kq_phase(F, KV, KROPE, K8N, K8R, SKT, NKEY);
    SEAM(PH_KQ);
    if (IN(PH_ATT)) {
        const int nu = F.bid < 512 ? (512 - F.bid + F.G - 1) / F.G : 0;
        const int grp = (F.bid >> 3) % 3, slot = grp < nu ? grp : nu;
        for (int i = 0; i <= nu; ++i) {
            if (i == slot) {
                Fr F3 = F;
                asm volatile("" : "+v"(F3.tid), "+v"(F3.lane));
                asm volatile("" : "+s"(F3.bid), "+s"(F3.wave), "+s"(F3.G));
                tconv_q_task(F3, P.in[I_WOUT0], 2048, 2048, 2048, SW + 13312, (unsigned char*)WOUT0);
                tconv_q_task(F3, P.in[I_WOUT1], 2048, 2048, 2048, SW + 15360, (unsigned char*)WOUT1);
                tconv_q_task(F3, P.in[I_PWQ0], 2048, 2048, 2048, SW + 4096, (unsigned char*)WPQ0);
                tconv_q_task(F3, P.in[I_PWQ1], 2048, 2048, 2048, SW + 11264, (unsigned char*)WPQ1);
                tconv_q_task(F3, P.in[I_WIN1], 2048, 5120, 5120, SW + 6144, (unsigned char*)WIN1);
                cvt_table<false>(F3, P.in[I_PU0], TABU, TSC);
                cvt_table<true>(F3, P.in[I_PV0], TABV, TSC + 16384);
                cvt_table<true>(F3, P.in[I_PV1], TABV + (size_t)33554432, TSC + 49152);
                modgemv(F3, P.in[I_C], nullptr, P.in[I_WMOD1], P.in[I_BMOD1], MOD1, nullptr, 0);
            }
            if (i < nu) {
                const int u = F.bid + i * F.G, h = u & 7, qb = u >> 3;
                att::attn_body8(Q + (size_t)qb * 256 * 1536 + h * 192, K8N + (size_t)h * NKEY * 128, K8R + (size_t)h * NKEY * 64, SKT + h * (NKEY / 64), KV + h * 256 + 128,
                                YCAT + (size_t)qb * 256 * 2048 + 1024 + h * 128, NKEY, F.lds);
            }
        }
    }
    SEAM(PH_ATT);
    if (IN(PH_QY0)) quant_rows(F, YCAT, H8, SA);
    SEAM(PH_QY0);
    if (IN(PH_OUT0)) {
        pg8::Gemm g{(const bf16_t*)H8, (const bf16_t*)WOUT0, SEQ, 2048, 1024}; pg8::StaticOrder S; S.init(SEQ, 2048, F.G, F.bid);
        EpiResid<true, true> E{P.in[I_X], XR, MOD0 + 4096, SA, SW + 13312};
        pg8::gemm_phase<EpiResid<true, true>, pg8::StaticOrder, false>(F.lds, g, S, E, nullptr);
    }
    SEAM(PH_OUT0);
    if (IN(PH_PNORM0)) {
        norm_rows_b<true>(F, XR, P.in[I_LN2G0], MOD0 + 8192, MOD0 + 6144, nullptr, H8, SA);
        fft_pass<1, false, 0>(F, KZ, KZ2, nullptr, nullptr, nullptr, nullptr);
    }
    SEAM(PH_PNORM0);
    if (IN(PH_PQ0)) {
        pg8::Gemm g{(const bf16_t*)H8, (const bf16_t*)WPQ0, SEQ, 2048, 1024}; pg8::StaticOrder S; S.init(SEQ, 2048, F.G, F.bid);
        EpiI8G E{PQ, 2048, 0, SA, SW + 4096};
        pg8::gemm_phase<EpiI8G, pg8::StaticOrder, false>(F.lds, g, S, E, nullptr);
    }
    SEAM(PH_PQ0);
    if (IN(PH_SEL0)) peer_select(F, PQ, KEYS0, PIDX, PGATE);
    SEAM(PH_SEL0);
    XCC_REFRESH();
    if (IN(PH_U0)) peer_sliced<0>(F, TABU, PIDX, H8, SA, nullptr, PD, nullptr, nullptr);
    SEAM(PH_U0);
    if (IN(PH_W0)) peer_weights(F, PD, PIDX, PGATE, TSC, TSC + 16384, PW);
    SEAM(PH_W0);
    XCC_REFRESH();
    if (IN(PH_V0)) peer_sliced<1>(F, TABV, PIDX, nullptr, nullptr, PW, nullptr, XR, (P.flags & 1) ? (const float*)(ws + WS_CTL + 40960) : MOD0 + 10240);
    SEAM(PH_V0);
    if (IN(PH_N1)) norm_rows_b<true>(F, XR, P.in[I_LN1G1], MOD1 + 2048, MOD1, nullptr, H8, SA);
    SEAM(PH_N1);
    if (IN(PH_IN1)) {
        pg8::Gemm g{(const bf16_t*)H8, (const bf16_t*)WIN1, SEQ, 5120, 1024}; pg8::StaticOrder S; S.init(SEQ, 5120, F.G, F.bid);
        EpiI8G E{PBUF, 5120, 2048, SA, SW + 6144};
        pg8::gemm_phase<EpiI8G, pg8::StaticOrder, false>(F.lds, g, S, E, nullptr);
    }
    SEAM(PH_IN1);
    if (IN(PH_POST1)) {
        gmlp_phase(F, PBUF, GMWS, YCAT);
        hyena_pre(F, PBUF, Z, G1B, X0B);
    }
    SEAM(PH_POST1);
    if (IN(PH_F1)) fft_pass<1024, false, 1>(F, Z, Z, nullptr, nullptr, nullptr, nullptr);
    SEAM(PH_F1);
    if (IN(PH_F2)) fft_pass<32, false, 0>(F, Z, Z, nullptr, nullptr, nullptr, nullptr);
    SEAM(PH_F2);
    if (IN(PH_F3)) fft_pass<1, false, 0>(F, Z, Z, nullptr, nullptr, nullptr, nullptr);
    SEAM(PH_F3);
    if (IN(PH_PWISE)) fft_pointwise(F, Z, KZ2, FNORM);
    SEAM(PH_PWISE);
    if (IN(PH_I1)) fft_pass<1, true, 0>(F, Z, Z, nullptr, nullptr, nullptr, nullptr);
    SEAM(PH_I1);
    if (IN(PH_I2)) fft_pass<32, true, 0>(F, Z, Z, nullptr, nullptr, nullptr, nullptr);
    SEAM(PH_I2);
    if (IN(PH_I3)) fft_pass<1024, true, 2>(F, Z, Z, G1B, X0B, P.in[I_HYBIAS1], YCAT);
    SEAM(PH_I3);
    if (IN(PH_QY1)) quant_rows(F, YCAT, H8, SA);
    SEAM(PH_QY1);
    if (IN(PH_OUT1)) {
        pg8::Gemm g{(const bf16_t*)H8, (const bf16_t*)WOUT1, SEQ, 2048, 1024}; pg8::StaticOrder S; S.init(SEQ, 2048, F.G, F.bid);
        EpiResid<false, true> E{XR, XR, MOD1 + 4096, SA, SW + 15360};
        pg8::gemm_phase<EpiResid<false, true>, pg8::StaticOrder, false>(F.lds, g, S, E, nullptr);
    }
    SEAM(PH_OUT1);
    if (IN(PH_PNORM1)) norm_rows_b<true>(F, XR, P.in[I_LN2G1], MOD1 + 8192, MOD1 + 6144, nullptr, H8, SA);
    SEAM(PH_PNORM1);
    if (IN(PH_PQ1)) {
        pg8::Gemm g{(const bf16_t*)H8, (const bf16_t*)WPQ1, SEQ, 2048, 1024}; pg8::StaticOrder S; S.init(SEQ, 2048, F.G, F.bid);
        EpiI8G E{PQ, 2048, 0, SA, SW + 11264};
        pg8::gemm_phase<EpiI8G, pg8::StaticOrder, false>(F.lds, g, S, E, nullptr);
    }
    SEAM(PH_PQ1);
    if (IN(PH_SEL1)) peer_select(F, PQ, KEYS1, PIDX, PGATE);
    SEAM(PH_SEL1);
    XCC_REFRESH();
    if (IN(PH_U1)) peer_sliced<0>(F, TABU + (size_t)33554432, PIDX, H8, SA, nullptr, PD, nullptr, nullptr);
    SEAM(PH_U1);
    if (IN(PH_W1)) peer_weights(F, PD, PIDX, PGATE, TSC + 32768, TSC + 49152, PW);
    SEAM(PH_W1);
    XCC_REFRESH();
    if (IN(PH_V1)) peer_sliced<1>(F, TABV + (size_t)33554432, PIDX, nullptr, nullptr, PW, nullptr, XR, MOD1 + 10240);
    SEAM(PH_V1);
    if (IN(PH_FIN)) final_norm_rows(F, XR, P.in[I_FINALG], P.out);
#undef IN
#undef SEAM
}

#include <cstdio>
extern "C" void kernel_launch(void* const* d_in, const int* in_sizes, int n_in, void* d_out, int out_size, void* d_ws, size_t ws_size, hipStream_t stream) {
    static int grid = 0;
    if (grid == 0) {
        if (n_in != 43 || in_sizes[0] != SEQ * DM || out_size != SEQ * DM || ws_size < WS_END) {
            fprintf(stderr, "kernel_launch: unexpected shapes: n_in %d in0 %d out %d ws %zu (need %zu)\n", n_in, n_in > 0 ? in_sizes[0] : -1, out_size, ws_size, (size_t)WS_END); grid = -1; return; }
        int dev = 0, cus = 0, per_cu = 0;
        if (hipGetDevice(&dev) != hipSuccess || hipDeviceGetAttribute(&cus, hipDeviceAttributeMultiprocessorCount, dev) != hipSuccess) { grid = -1; return; }
        if (hipFuncSetAttribute((const void*)mk_fwd, hipFuncAttributeMaxDynamicSharedMemorySize, LDS_BYTES) != hipSuccess) { fprintf(stderr, "kernel_launch: hipFuncSetAttribute failed\n"); grid = -1; return; }
        if (hipOccupancyMaxActiveBlocksPerMultiprocessor(&per_cu, (const void*)mk_fwd, NTHR, LDS_BYTES) != hipSuccess || per_cu < 1) { fprintf(stderr, "kernel_launch: occupancy query says %d blocks per CU\n", per_cu); (void)hipGetLastError(); grid = -1; return; }
        grid = cus;
    }
    if (grid < 0) return;
    (void)hipMemsetAsync((char*)d_ws + WS_CTL, 0, 65536, stream);
    Params p{};
    for (int i = 0; i < 43; ++i) p.in[i] = (const float*)d_in[i];
    p.out = (float*)d_out; p.ws = (unsigned char*)d_ws;
#if MK_PER_PHASE
    for (int ph = 0; ph < NPH; ++ph) { p.ph_lo = ph; p.ph_hi = ph + 1; hipLaunchKernelGGL(mk_fwd, dim3(grid), dim3(NTHR), LDS_BYTES, stream, p); }
#else
#if PROBE_SEQ == 0
    p.ph_lo = 0; p.ph_hi = NPH;
    hipLaunchKernelGGL(mk_fwd, dim3(grid), dim3(NTHR), LDS_BYTES, stream, p);
#elif PROBE_SEQ == 40
    p.ph_lo = 0; p.ph_hi = NPH;
    hipLaunchKernelGGL(mk_fwd, dim3(grid), dim3(NTHR), LDS_BYTES, stream, p);
    for (int r = 0; r < 6; ++r) for (int ph = PROBE_LO; ph < PROBE_HI; ++ph) { p.ph_lo = ph; p.ph_hi = ph + 1; p.flags = 32; hipLaunchKernelGGL(mk_fwd, dim3(grid), dim3(NTHR), LDS_BYTES, stream, p); }
#elif PROBE_SEQ >= 20
    p.ph_lo = 0; p.ph_hi = NPH;
    hipLaunchKernelGGL(mk_fwd, dim3(grid), dim3(NTHR), LDS_BYTES, stream, p);
    for (int r = 0; r < 8; ++r) { p.ph_lo = 0; p.ph_hi = 1; p.flags = PROBE_FLAGS; hipLaunchKernelGGL(mk_fwd, dim3(grid), dim3(NTHR), LDS_BYTES, stream, p); }
#else
    static const int seq[][2] = {
#if PROBE_SEQ == 1
        {0, PH_U0 + 1}, {PH_U0, PH_U0 + 1}, {PH_U0 + 1, NPH}
#elif PROBE_SEQ == 2
        {0, PH_SEL0 + 1}, {PH_SEL0, PH_SEL0 + 1}, {PH_SEL0 + 1, NPH}
#elif PROBE_SEQ == 10
        {0, PH_W0 + 1}, {PH_W0, PH_W0 + 1}, {PH_W0 + 1, NPH}
#elif PROBE_SEQ == 11
        {0, 1}, {0, 1}, {1, NPH}
#elif PROBE_SEQ == 12
        {0, PH_POST1 + 1}, {PH_POST1, PH_POST1 + 1}, {PH_POST1 + 1, NPH}
#elif PROBE_SEQ == 13
        {0, PH_OUT1}, {PH_POST1, PH_OUT1}, {PH_OUT1, NPH}
#elif PROBE_SEQ == 15
        {0, PH_PQ0 + 1}, {PH_PQ0, PH_PQ0 + 1}, {PH_PQ0 + 1, NPH}
#elif PROBE_SEQ == 16
        {0, PH_IN0 + 1}, {PH_IN0, PH_IN0 + 1}, {PH_IN0 + 1, NPH}
#elif PROBE_SEQ == 14
        {0, PH_N1 + 1}, {PH_N1, PH_N1 + 1}, {PH_N1 + 1, NPH}
#elif PROBE_SEQ == 99
        {0, 0}
#elif PROBE_SEQ == 3
        {0, PH_UP0 + 1}, {PH_UP0, PH_UP0 + 1}, {PH_UP0 + 1, NPH}
#elif PROBE_SEQ == 5
        {0, PH_IN1 + 1}, {PH_IN1, PH_IN1 + 1}, {PH_IN1 + 1, NPH}
#elif PROBE_SEQ == 6
        {0, PH_OUT0 + 1}, {PH_OUT0, PH_OUT0 + 1}, {PH_OUT0 + 1, NPH}
#elif PROBE_SEQ == 7
        {0, PH_NORM0 + 1}, {PH_NORM0, PH_NORM0 + 1}, {PH_NORM0 + 1, NPH}
#elif PROBE_SEQ == 8
        {0, PH_POST0 + 1}, {PH_POST0, PH_POST0 + 1}, {PH_POST0 + 1, NPH}
#elif PROBE_SEQ == 9
        {0, PH_PNORM0 + 1}, {PH_PNORM0, PH_PNORM0 + 1}, {PH_PNORM0 + 1, NPH}
#elif PROBE_SEQ == 4
        {0, PH_V0 + 1}, {-PH_V0, PH_V0 + 1}, {PH_V0 + 1, NPH}
#endif
    };
#if PROBE_SEQ == 99
    for (int ph = 0; ph < NPH; ++ph) { p.ph_lo = ph; p.ph_hi = ph + 1; hipLaunchKernelGGL(mk_fwd, dim3(grid), dim3(NTHR), LDS_BYTES, stream, p); }
#endif
    for (unsigned i = 0; i < sizeof(seq) / sizeof(seq[0]); ++i) {
        if (PROBE_SEQ == 99) break;
        (void)hipMemsetAsync((char*)d_ws + WS_CTL, 0, 65536, stream);
        p.ph_lo = seq[i][0] < 0 ? -seq[i][0] : seq[i][0]; p.ph_hi = seq[i][1]; p.flags = seq[i][0] < 0 ? 1 : 0;
        hipLaunchKernelGGL(mk_fwd, dim3(grid), dim3(NTHR), LDS_BYTES, stream, p);
    }
#endif
#endif
    const hipError_t le = hipPeekAtLastError();
    if (le != hipSuccess) fprintf(stderr, "kernel_launch: launch failed: %s\n", hipGetErrorName(le));
}
```

```cpp
#include <hip/hip_runtime.h>
namespace pg8 {
#define PG8_LAS __attribute__((address_space(3)))
typedef unsigned short bf16_t;
typedef short bf16x8 __attribute__((ext_vector_type(8)));
typedef float f32x4 __attribute__((ext_vector_type(4)));
typedef unsigned u32x4 __attribute__((ext_vector_type(4)));
constexpr int BM = 256, BK = 64, HALF = 128, HTB = HALF * BK * 2  , STAGE_BYTES = 8 * HTB, NXCD = 8, WGM = 8;

__host__ __device__ __forceinline__ int lds_byte(int r, int c) { const int st = (r >> 4) * 2 + (c >> 5), rr = r & 15, cc = c & 31, ob = rr * 64 + cc * 2; return st * 1024 + (ob ^ (((ob >> 9) & 1) << 5)); }
__host__ __device__ __forceinline__ void stage_rc(int b, int& R, int& C) { const int st = b / 1024, sb = b % 1024, swz = sb ^ (((sb >> 9) & 1) << 5); R = (st >> 1) * 16 + swz / 64; C = (st & 1) * 32 + (swz % 64) / 2; }
__host__ __device__ __forceinline__ int perm32(int rho) { const int n = rho >> 4, i = rho & 15; return 8 * (i >> 2) + 4 * n + (i & 3); }

struct Unit { int pm, pn; };
struct Gemm { const bf16_t* A; const bf16_t* Bt; int M, N, K; };

struct StaticOrder {
    int nM, nN, nwg, G, c;
    __host__ __device__ void init(int M, int N, int G_, int c_) { nM = M / BM; nN = N / BM; nwg = nM * nN; G = G_; c = c_; }
    __host__ __device__ bool next(int i, Unit& u) const {
        const long L = (long)i * G + c; if (L >= nwg) return false;
        int wgid = (int)L; { const int q = nwg / NXCD, r = nwg % NXCD, xcd = wgid % NXCD, off = wgid / NXCD; wgid = (xcd < r ? xcd * (q + 1) : r * (q + 1) + (xcd - r) * q) + off; }
        const int nig = WGM * nN, gid = wgid / nig, fm = gid * WGM, gsz = (nM - fm) < WGM ? (nM - fm) : WGM;
        u.pm = fm + ((wgid % nig) % gsz); u.pn = (wgid % nig) / gsz; return true;
    }
    __device__ __forceinline__ void a_ready(const Unit&) const {}
    __device__ __forceinline__ void done(const Unit&) const {}
};
struct CountedOrder : StaticOrder {
    const unsigned* ready; unsigned need; unsigned* tmo;
    __device__ __forceinline__ void a_ready(const Unit& u) const {
        if (threadIdx.x < 64) {
            const unsigned long long t0 = __builtin_amdgcn_s_memrealtime(); unsigned polls = 0;
            while ((unsigned)__builtin_amdgcn_readfirstlane(__hip_atomic_load(ready + 64 * u.pm, __ATOMIC_RELAXED, __HIP_MEMORY_SCOPE_AGENT)) < need) {
                if ((++polls & 255u) == 0u && __builtin_amdgcn_readfirstlane(__hip_atomic_load(tmo, __ATOMIC_RELAXED, __HIP_MEMORY_SCOPE_AGENT)) != 0u) break;
                if (__builtin_amdgcn_s_memrealtime() - t0 > 2000000ull) {
                    if (threadIdx.x == 0) { unsigned expect = 0u; __hip_atomic_compare_exchange_strong(tmo + 1, &expect, 0x600u | (unsigned)(u.pm & 0xff), __ATOMIC_RELAXED, __ATOMIC_RELAXED, __HIP_MEMORY_SCOPE_AGENT); __hip_atomic_store(tmo, 1u, __ATOMIC_RELAXED, __HIP_MEMORY_SCOPE_AGENT); }
                    break; }
                __builtin_amdgcn_s_sleep(2); }
            __builtin_amdgcn_fence(__ATOMIC_ACQUIRE, "agent");
            asm volatile("s_waitcnt vmcnt(0)" ::: "memory");
        }
#if !defined(BROKEN_HOOK_NO_BARRIER)
        asm volatile("" ::: "memory"); __builtin_amdgcn_s_barrier(); asm volatile("" ::: "memory");
#endif
    }
};

__device__ __forceinline__ unsigned cvt_pk_bf16(float lo, float hi) { unsigned r; asm volatile("v_cvt_pk_bf16_f32 %0, %1, %2" : "=v"(r) : "v"(lo), "v"(hi)); return r; }
typedef float f32x2 __attribute__((ext_vector_type(2)));
__device__ __forceinline__ f32x2 gelu_pk(f32x2 v) {
    const f32x2 av = __builtin_elementwise_abs(v), d = av * 0.2316418882f + 1.0f;
    f32x2 t; t.x = __builtin_amdgcn_rcpf(d.x); t.y = __builtin_amdgcn_rcpf(d.y);
    f32x2 q = t * 0.5307027145f + (-0.7265760135f); q = q * t + 0.7107068705f; q = q * t + (-0.142248368f); q = q * t + 0.127414796f; q = q * t;
    const f32x2 s = (v * v) * (-0.72134752044f);
    f32x2 e; e.x = __builtin_amdgcn_exp2f(s.x); e.y = __builtin_amdgcn_exp2f(s.y);
    const f32x2 m = v * (q * e), r = v - m;
    f32x2 o; o.x = v.x < 0.f ? m.x : r.x; o.y = v.y < 0.f ? m.y : r.y; return o;
}

struct EpiF32 {
    static constexpr bool PERM = false, AFTER_DRAIN = false;
    float* C; int ldc; const float* bias;
    __device__ __forceinline__ void operator()(const f32x4 (&acc)[2][2][4][2], const Unit& u, int wr, int wc, int fr, int fq) const {
        const int row0 = u.pm * BM + wr * 64 + fr, col0 = u.pn * BM + wc * 32 + 4 * fq;
        f32x4 bv[2][2];
#pragma unroll
        for (int bj = 0; bj < 2; ++bj)
#pragma unroll
            for (int n = 0; n < 2; ++n) bv[bj][n] = bias ? *(const f32x4*)(bias + col0 + bj * HALF + n * 16) : (f32x4){0.f, 0.f, 0.f, 0.f};
#pragma unroll
        for (int ai = 0; ai < 2; ++ai)
#pragma unroll
            for (int m = 0; m < 4; ++m) { float* rowp = C + (size_t)(row0 + ai * HALF + m * 16) * ldc + col0;
#pragma unroll
                for (int bj = 0; bj < 2; ++bj)
#pragma unroll
                    for (int n = 0; n < 2; ++n) *(f32x4*)(rowp + bj * HALF + n * 16) = acc[ai][bj][m][n] + bv[bj][n]; }
    }
};
template <int ACT  > struct EpiBf16 {
    static constexpr bool PERM = true, AFTER_DRAIN = false, I8 = false;
    bf16_t* O; int ldc; const float* bias; int split_cols; size_t split_stride;
    __device__ __forceinline__ void operator()(const f32x4 (&acc)[2][2][4][2], const Unit& u, int wr, int wc, int fr, int fq) const {
        const int row0 = u.pm * BM + wr * 64 + fr; int colt = u.pn * BM; bf16_t* base = O;
        if (split_cols) { const int t = colt / split_cols; base += (size_t)t * split_stride; colt -= t * split_cols; }
        const int col0 = colt + wc * 32 + 8 * fq, bcol0 = u.pn * BM + wc * 32 + 8 * fq;
        f32x4 bv[2][2];
#pragma unroll
        for (int bj = 0; bj < 2; ++bj)
#pragma unroll
            for (int n = 0; n < 2; ++n) bv[bj][n] = bias ? *(const f32x4*)(bias + bcol0 + bj * HALF + 4 * n) : (f32x4){0.f, 0.f, 0.f, 0.f};
#pragma unroll
        for (int ai = 0; ai < 2; ++ai)
#pragma unroll
            for (int m = 0; m < 4; ++m) { bf16_t* rowp = base + (size_t)(row0 + ai * HALF + m * 16) * ldc + col0;
#pragma unroll
                for (int bj = 0; bj < 2; ++bj) { f32x4 v0 = acc[ai][bj][m][0] + bv[bj][0], v1 = acc[ai][bj][m][1] + bv[bj][1];
                    if (ACT == 1) { f32x2 a = gelu_pk((f32x2){v0[0], v0[1]}), b = gelu_pk((f32x2){v0[2], v0[3]}), c = gelu_pk((f32x2){v1[0], v1[1]}), d = gelu_pk((f32x2){v1[2], v1[3]});
                        v0 = (f32x4){a.x, a.y, b.x, b.y}; v1 = (f32x4){c.x, c.y, d.x, d.y}; }
                    if (ACT == 2) {
#pragma unroll
                        for (int j = 0; j < 4; ++j) { v0[j] = 0.5f * v0[j] * (1.0f + erff(v0[j] * 0.70710678f)); v1[j] = 0.5f * v1[j] * (1.0f + erff(v1[j] * 0.70710678f)); } }
                    u32x4 w; w.x = cvt_pk_bf16(v0[0], v0[1]); w.y = cvt_pk_bf16(v0[2], v0[3]); w.z = cvt_pk_bf16(v1[0], v1[1]); w.w = cvt_pk_bf16(v1[2], v1[3]);
                    *(u32x4*)(rowp + bj * HALF) = w; } }
    }
};

struct PanelStats {
    unsigned* xbuf;
    unsigned* cnt;
    unsigned* tmo;
    int ntn; float eps;
    unsigned code;
    __device__ __forceinline__ bool run(const f32x4 (&v)[2][2][4][2], const Unit& u, int wr, int wc, int fr, int fq, PG8_LAS unsigned char* lds, int wid, int lane) const {
        typedef float f32x2v __attribute__((ext_vector_type(2)));
        PG8_LAS f32x2v* P = (PG8_LAS f32x2v*)lds;
        PG8_LAS f32x2v* S = (PG8_LAS f32x2v*)(lds + 8192);
        PG8_LAS unsigned* flag = (PG8_LAS unsigned*)(lds + 8192 + 2048);
#pragma unroll
        for (int ai = 0; ai < 2; ++ai)
#pragma unroll
            for (int m = 0; m < 4; ++m) {
                float s = 0.f;
#pragma unroll
                for (int bj = 0; bj < 2; ++bj)
#pragma unroll
                    for (int n = 0; n < 2; ++n) { const f32x4 x = v[ai][bj][m][n]; s += (x[0] + x[1]) + (x[2] + x[3]); }
                s += __shfl_xor(s, 16); s += __shfl_xor(s, 32);
                const float mw = s * (1.0f / 64.0f); float q = 0.f;
#pragma unroll
                for (int bj = 0; bj < 2; ++bj)
#pragma unroll
                    for (int n = 0; n < 2; ++n) { const f32x4 d = v[ai][bj][m][n] - mw; q += (d[0] * d[0] + d[1] * d[1]) + (d[2] * d[2] + d[3] * d[3]); }
                q += __shfl_xor(q, 16); q += __shfl_xor(q, 32);
                if (fq == 0) P[(ai * HALF + wr * 64 + m * 16 + fr) * 4 + wc] = (f32x2v){mw, q};
            }
        asm volatile("s_waitcnt lgkmcnt(0)" ::: "memory"); __builtin_amdgcn_s_barrier(); asm volatile("" ::: "memory");
#if defined(BROKEN_NO_WAIT)
        if (blockIdx.x >= 64) { const long long t0 = clock64(); while (clock64() - t0 < 60000) __builtin_amdgcn_s_sleep(8); }
#endif
        const int row = wid * 32 + (lane & 31);
        if (lane < 32) {
            const f32x2v a = P[row * 4 + 0], b = P[row * 4 + 1], c = P[row * 4 + 2], d = P[row * 4 + 3];
            const float mt = (a.x + b.x + c.x + d.x) * 0.25f;
            const float da = a.x - mt, db = b.x - mt, dc = c.x - mt, dd = d.x - mt;
            const float m2 = (a.y + b.y) + (c.y + d.y) + 64.0f * ((da * da + db * db) + (dc * dc + dd * dd));
            unsigned long long* slot = (unsigned long long*)xbuf + ((size_t)(u.pm * BM + row) * 4 + u.pn);
            __hip_atomic_store(slot, ((unsigned long long)__float_as_uint(m2) << 32) | __float_as_uint(mt), __ATOMIC_RELAXED, __HIP_MEMORY_SCOPE_AGENT);
        }
        asm volatile("s_waitcnt vmcnt(0)" ::: "memory");
        if (lane == 0) __hip_atomic_fetch_add(cnt + 64 * u.pm, 1u, __ATOMIC_RELAXED, __HIP_MEMORY_SCOPE_AGENT);
        if (wid == 0) {
            bool dead = false; const unsigned long long t0 = __builtin_amdgcn_s_memrealtime(); const unsigned want = 8u * (unsigned)ntn;
            for (;;) {
#if defined(BROKEN_NO_WAIT)
                break;
#endif
                if ((unsigned)__builtin_amdgcn_readfirstlane(__hip_atomic_load(cnt + 64 * u.pm, __ATOMIC_RELAXED, __HIP_MEMORY_SCOPE_AGENT)) >= want) break;
                if (__builtin_amdgcn_s_memrealtime() - t0 > 2000000ull) {
                    if (lane == 0) { unsigned expect = 0u; __hip_atomic_compare_exchange_strong(tmo + 1, &expect, code | (unsigned)(u.pm & 0xff), __ATOMIC_RELAXED, __ATOMIC_RELAXED, __HIP_MEMORY_SCOPE_AGENT);
                                     __hip_atomic_store(tmo, 1u, __ATOMIC_RELAXED, __HIP_MEMORY_SCOPE_AGENT); }
                    dead = true; break; }
                __builtin_amdgcn_s_sleep(2);
            }
            __builtin_amdgcn_fence(__ATOMIC_ACQUIRE, "agent");
            if (lane == 0) flag[0] = dead ? 1u : 0u;
        }
        asm volatile("s_waitcnt vmcnt(0) lgkmcnt(0)" ::: "memory"); __builtin_amdgcn_s_barrier(); asm volatile("" ::: "memory");
        const bool bad = flag[0] != 0u;
        if (lane < 32) {
            const unsigned long long* slot = (const unsigned long long*)xbuf + (size_t)(u.pm * BM + row) * 4; float mt[4], m2[4]; float ms = 0.f;
#pragma unroll
            for (int t = 0; t < 4; ++t) { if (t < ntn) { const unsigned long long w = __hip_atomic_load(slot + t, __ATOMIC_RELAXED, __HIP_MEMORY_SCOPE_AGENT); mt[t] = __uint_as_float((unsigned)w); m2[t] = __uint_as_float((unsigned)(w >> 32)); } else { mt[t] = 0.f; m2[t] = 0.f; } ms += mt[t]; }
            const float mean = ms / (float)ntn; float q = 0.f;
#pragma unroll
            for (int t = 0; t < 4; ++t) if (t < ntn) { const float dm = mt[t] - mean; q += m2[t] + 256.0f * dm * dm; }
            S[row] = (f32x2v){mean, 1.0f / sqrtf(q / (256.0f * (float)ntn) + eps)};
        }
        asm volatile("s_waitcnt lgkmcnt(0)" ::: "memory"); __builtin_amdgcn_s_barrier(); asm volatile("" ::: "memory");
        return bad;
    }
};
struct EpiLnRes {
    static constexpr bool PERM = false, AFTER_DRAIN = true;
    const float* base; float* out; int ldc; const float* bias; PanelStats st; unsigned poison;
    __device__ __forceinline__ void refuse(size_t i0, size_t stride, int M, int N) const { const float q = __builtin_nanf(""); for (size_t i = i0; i < (size_t)M * N; i += stride) out[(i / N) * ldc + i % N] = q;
        if (i0 == 0) { unsigned expect = 0u; __hip_atomic_compare_exchange_strong(st.tmo + 1, &expect, 0x7f0u, __ATOMIC_RELAXED, __ATOMIC_RELAXED, __HIP_MEMORY_SCOPE_AGENT); __hip_atomic_store(st.tmo, 1u, __ATOMIC_RELAXED, __HIP_MEMORY_SCOPE_AGENT); } }
    __device__ __forceinline__ void fused(f32x4 (&acc)[2][2][4][2], const Unit& u, int wr, int wc, int fr, int fq, PG8_LAS unsigned char* lds, int wid, int lane) const {
        typedef float f32x2v __attribute__((ext_vector_type(2)));
        const PG8_LAS f32x2v* S = (const PG8_LAS f32x2v*)(lds + 8192);
        const int col0 = u.pn * BM + wc * 32 + 4 * fq;
#pragma unroll
        for (int bj = 0; bj < 2; ++bj)
#pragma unroll
            for (int n = 0; n < 2; ++n) { const f32x4 bv = bias ? *(const f32x4*)(bias + col0 + bj * HALF + n * 16) : (f32x4){0.f, 0.f, 0.f, 0.f};
#pragma unroll
                for (int ai = 0; ai < 2; ++ai)
#pragma unroll
                    for (int m = 0; m < 4; ++m) acc[ai][bj][m][n] += bv; }
        const bool bad = st.run(acc, u, wr, wc, fr, fq, lds, wid, lane) || poison != 0u;
        const float qnan = __builtin_nanf("");
#pragma unroll
        for (int ai = 0; ai < 2; ++ai)
#pragma unroll
            for (int m = 0; m < 4; ++m) { const int r = ai * HALF + wr * 64 + m * 16 + fr; const f32x2v sr = S[r]; const size_t off = (size_t)(u.pm * BM + r) * ldc + col0;
#pragma unroll
                for (int bj = 0; bj < 2; ++bj)
#pragma unroll
                    for (int n = 0; n < 2; ++n) { const f32x4 bs = *(const f32x4*)(base + off + bj * HALF + n * 16); f32x4 o = bs + (acc[ai][bj][m][n] - sr.x) * sr.y;
                        if (bad) o = (f32x4){qnan, qnan, qnan, qnan}; *(f32x4*)(out + off + bj * HALF + n * 16) = o; }
                asm volatile("" ::: "memory"); }
    }
};
struct EpiLnResLn {
    static constexpr bool PERM = false, AFTER_DRAIN = true;
    const float* base; float* out; bf16_t* xn; int ldc; const float* bias; PanelStats st1, st2; unsigned poison;
    __device__ __forceinline__ void refuse(size_t i0, size_t stride, int M, int N) const { const float q = __builtin_nanf(""); for (size_t i = i0; i < (size_t)M * N; i += stride) { const size_t o = (i / N) * ldc + i % N; out[o] = q; xn[o] = (bf16_t)0x7fc0u; }
        if (i0 == 0) { unsigned expect = 0u; __hip_atomic_compare_exchange_strong(st1.tmo + 1, &expect, 0x7f0u, __ATOMIC_RELAXED, __ATOMIC_RELAXED, __HIP_MEMORY_SCOPE_AGENT); __hip_atomic_store(st1.tmo, 1u, __ATOMIC_RELAXED, __HIP_MEMORY_SCOPE_AGENT); } }
    __device__ __forceinline__ void fused(f32x4 (&acc)[2][2][4][2], const Unit& u, int wr, int wc, int fr, int fq, PG8_LAS unsigned char* lds, int wid, int lane) const {
        typedef float f32x2v __attribute__((ext_vector_type(2))); typedef unsigned u32x2v __attribute__((ext_vector_type(2)));
        const PG8_LAS f32x2v* S = (const PG8_LAS f32x2v*)(lds + 8192);
        const int col0 = u.pn * BM + wc * 32 + 4 * fq;
#pragma unroll
        for (int bj = 0; bj < 2; ++bj)
#pragma unroll
            for (int n = 0; n < 2; ++n) { const f32x4 bv = bias ? *(const f32x4*)(bias + col0 + bj * HALF + n * 16) : (f32x4){0.f, 0.f, 0.f, 0.f};
#pragma unroll
                for (int ai = 0; ai < 2; ++ai)
#pragma unroll
                    for (int m = 0; m < 4; ++m) acc[ai][bj][m][n] += bv; }
        bool bad = st1.run(acc, u, wr, wc, fr, fq, lds, wid, lane) || poison != 0u;
        const float qnan = __builtin_nanf("");
#pragma unroll
        for (int ai = 0; ai < 2; ++ai)
#pragma unroll
            for (int m = 0; m < 4; ++m) { const int r = ai * HALF + wr * 64 + m * 16 + fr; const f32x2v sr = S[r]; const size_t off = (size_t)(u.pm * BM + r) * ldc + col0;
#pragma unroll
                for (int bj = 0; bj < 2; ++bj)
#pragma unroll
                    for (int n = 0; n < 2; ++n) { const f32x4 bs = *(const f32x4*)(base + off + bj * HALF + n * 16); acc[ai][bj][m][n] = bs + (acc[ai][bj][m][n] - sr.x) * sr.y; }
                asm volatile("" : "+v"(acc[ai][0][m][0]), "+v"(acc[ai][0][m][1]), "+v"(acc[ai][1][m][0]), "+v"(acc[ai][1][m][1]));
                if (m & 1) asm volatile("" ::: "memory"); }
        const bool bad1 = bad;
        bad = st2.run(acc, u, wr, wc, fr, fq, lds, wid, lane) || bad;
#pragma unroll
        for (int ai = 0; ai < 2; ++ai)
#pragma unroll
            for (int m = 0; m < 4; ++m) { const int r = ai * HALF + wr * 64 + m * 16 + fr; const f32x2v sr = S[r]; const size_t off = (size_t)(u.pm * BM + r) * ldc + col0;
#pragma unroll
                for (int bj = 0; bj < 2; ++bj)
#pragma unroll
                    for (int n = 0; n < 2; ++n) { const f32x4 x1 = acc[ai][bj][m][n]; *(f32x4*)(out + off + bj * HALF + n * 16) = bad1 ? (f32x4){qnan, qnan, qnan, qnan} : x1;
                        const f32x4 o = (x1 - sr.x) * sr.y; u32x2v w; w.x = cvt_pk_bf16(o[0], o[1]); w.y = cvt_pk_bf16(o[2], o[3]);
                        if (bad) { w.x = 0x7fc07fc0u; w.y = 0x7fc07fc0u; } *(u32x2v*)(xn + off + bj * HALF + n * 16) = w; }
                asm volatile("" ::: "memory"); }
    }
};

typedef int i32x4_t __attribute__((ext_vector_type(4)));
template <bool I8> __device__ __forceinline__ f32x4 mma_step(const bf16x8& b, const bf16x8& a, const f32x4& c) {
    if constexpr (I8) { const i32x4_t r = __builtin_amdgcn_mfma_i32_16x16x64_i8(__builtin_bit_cast(i32x4_t, b), __builtin_bit_cast(i32x4_t, a), __builtin_bit_cast(i32x4_t, c), 0, 0, 0); return __builtin_bit_cast(f32x4, r); }
    else return __builtin_amdgcn_mfma_f32_16x16x32_bf16(b, a, c, 0, 0, 0);
}
template <class Epi, class Sched, bool STAMP = false>
__device__ __forceinline__ void gemm_phase(PG8_LAS unsigned char* lds, const Gemm g, const Sched& S, const Epi& E, unsigned long long* stamps) {
    const int tid = threadIdx.x, wid = __builtin_amdgcn_readfirstlane(tid >> 6), lane = tid & 63, wr = wid >> 2, wc = wid & 3, fr = lane & 15, fq = lane >> 4;
    const int K = g.K, nt = K / BK;
    int ts_lo = 0, ts_hi = 0, nts = 0; const unsigned long long rt_entry = STAMP ? (unsigned long long)wall_clock64() : 0ull;
#define PG8_STAMP() do { if (STAMP && wid == 0 && nts < 64) { const unsigned long long _c = (unsigned long long)clock64(); \
        ts_lo = (lane == nts) ? (int)(unsigned)_c : ts_lo; ts_hi = (lane == nts) ? (int)(unsigned)(_c >> 32) : ts_hi; ++nts; } } while (0)
    PG8_STAMP();
    unsigned voffA[2], voffB[2];
#pragma unroll
    for (int i = 0; i < 2; ++i) { int R, C; stage_rc(tid * 16 + i * 8192, R, C); const int Rb = Epi::PERM ? ((R & ~31) + perm32(R & 31)) : R;
        voffA[i] = (unsigned)(R * K + C) * 2u; voffB[i] = (unsigned)(Rb * K + C) * 2u; }
    const size_t kstep = (size_t)(BK * 2);
    const size_t hstep = (size_t)HALF * K * 2;
    const size_t tstep = 2 * hstep;
    const unsigned ldsw = (unsigned)wid * 1024u;
    const int aoff = lds_byte(wr * 64 + fr, fq * 8), boff = lds_byte(wc * 32 + fr, fq * 8);
#define PG8_SA(b, h) (((b) * 2 + (h)) * HTB)
#define PG8_SB(b, h) ((4 + (b) * 2 + (h)) * HTB)
#define PG8_STAGE(bufoff, gbase, voff) do { _Pragma("unroll") for (int _i = 0; _i < 2; ++_i) \
        __builtin_amdgcn_global_load_lds((const unsigned*)((const char*)(gbase) + (voff)[_i]), (PG8_LAS unsigned*)(lds + (bufoff) + ldsw + _i * 8192), 16, 0, 0); } while (0)
#define PG8_LDA(dst, b, h) do { _Pragma("unroll") for (int m = 0; m < 4; ++m) _Pragma("unroll") for (int k = 0; k < 2; ++k) dst[m][k] = *(const PG8_LAS bf16x8*)(lds + PG8_SA(b, h) + aoff + m * 2048 + k * 1024); } while (0)
#define PG8_LDB(dst, b, h) do { _Pragma("unroll") for (int n = 0; n < 2; ++n) _Pragma("unroll") for (int k = 0; k < 2; ++k) dst[n][k] = *(const PG8_LAS bf16x8*)(lds + PG8_SB(b, h) + boff + n * 2048 + k * 1024); } while (0)
#define PG8_MMA(ai, bj, At, Bt) do { __builtin_amdgcn_s_setprio(1); _Pragma("unroll") for (int m = 0; m < 4; ++m) _Pragma("unroll") for (int n = 0; n < 2; ++n) _Pragma("unroll") for (int k = 0; k < 2; ++k) \
        acc[ai][bj][m][n] = mma_step<Epi::I8>(Bt[n][k], At[m][k], acc[ai][bj][m][n]); __builtin_amdgcn_s_setprio(0); } while (0)
#define PG8_WAIT_V(n) asm volatile("s_waitcnt vmcnt(" #n ")" ::: "memory")
#define PG8_WAIT_L(n) asm volatile("s_waitcnt lgkmcnt(" #n ")" ::: "memory")
#define PG8_BAR __builtin_amdgcn_s_barrier()
#define PG8_SCHED __builtin_amdgcn_sched_barrier(0)
    Unit cur, nxt; int ui = 0;
    if (!S.next(0, cur)) return;
    f32x4 acc[2][2][4][2];
#pragma unroll
    for (int a = 0; a < 2; ++a)
#pragma unroll
        for (int b = 0; b < 2; ++b)
#pragma unroll
            for (int m = 0; m < 4; ++m)
#pragma unroll
                for (int n = 0; n < 2; ++n) acc[a][b][m][n] = (f32x4){0.f, 0.f, 0.f, 0.f};
    bf16x8 At[4][2], B0[2][2], B1[2][2];
    const char* cA = (const char*)g.A + (size_t)cur.pm * tstep; const char* cB = (const char*)g.Bt + (size_t)cur.pn * tstep;
    S.a_ready(cur);
    PG8_STAGE(PG8_SB(0, 0), cB, voffB); PG8_STAGE(PG8_SA(0, 0), cA, voffA); PG8_STAGE(PG8_SB(0, 1), cB + hstep, voffB); PG8_STAGE(PG8_SA(0, 1), cA + hstep, voffA);
    if (wr == 1) PG8_BAR;
    PG8_WAIT_V(4); PG8_BAR;
    PG8_STAGE(PG8_SB(1, 0), cB + kstep, voffB); PG8_STAGE(PG8_SA(1, 0), cA + kstep, voffA); PG8_STAGE(PG8_SB(1, 1), cB + hstep + kstep, voffB);
    PG8_WAIT_V(6); PG8_BAR;
    PG8_STAMP();
    for (;;) {
        const bool has_next = S.next(ui + 1, nxt);
        const char* nA = has_next ? (const char*)g.A + (size_t)nxt.pm * tstep : cA; const char* nB = has_next ? (const char*)g.Bt + (size_t)nxt.pn * tstep : cB;
        for (int t = 0; t < nt; t += 2) {
            const bool last = (t == nt - 2);
            const char* a1 = cA + (size_t)(t + 1) * kstep;
            const char* a2 = last ? nA : cA + (size_t)(t + 2) * kstep; const char* b2 = last ? nB : cB + (size_t)(t + 2) * kstep;
            const char* a3 = a2 + kstep; const char* b3 = b2 + kstep;
            if (last && has_next) S.a_ready(nxt);
            PG8_LDB(B0, 0, 0); PG8_SCHED; PG8_LDA(At, 0, 0); PG8_STAGE(PG8_SA(1, 1), a1 + hstep, voffA);
            PG8_WAIT_L(8); PG8_BAR; PG8_WAIT_L(0); PG8_MMA(0, 0, At, B0); PG8_BAR; PG8_SCHED;
            PG8_LDB(B1, 0, 1); PG8_STAGE(PG8_SB(0, 0), b2, voffB);
            PG8_BAR; PG8_WAIT_L(0); PG8_MMA(0, 1, At, B1); PG8_BAR;
            PG8_LDA(At, 0, 1); PG8_STAGE(PG8_SA(0, 0), a2, voffA);
            PG8_BAR; PG8_WAIT_L(0); PG8_MMA(1, 0, At, B0); PG8_BAR; PG8_SCHED;
            PG8_STAGE(PG8_SB(0, 1), b2 + hstep, voffB);
            PG8_WAIT_V(6); PG8_BAR; PG8_MMA(1, 1, At, B1); PG8_BAR;
            PG8_LDB(B0, 1, 0); PG8_SCHED; PG8_LDA(At, 1, 0); PG8_STAGE(PG8_SA(0, 1), a2 + hstep, voffA);
            PG8_WAIT_L(8); PG8_BAR; PG8_WAIT_L(0); PG8_MMA(0, 0, At, B0); PG8_BAR; PG8_SCHED;
            PG8_LDB(B1, 1, 1); PG8_STAGE(PG8_SB(1, 0), b3, voffB);
            PG8_BAR; PG8_WAIT_L(0); PG8_MMA(0, 1, At, B1); PG8_BAR;
            PG8_LDA(At, 1, 1); PG8_STAGE(PG8_SA(1, 0), a3, voffA);
            PG8_BAR; PG8_WAIT_L(0); PG8_MMA(1, 0, At, B0); PG8_BAR; PG8_SCHED;
            PG8_STAGE(PG8_SB(1, 1), b3 + hstep, voffB);
            PG8_WAIT_V(6); PG8_BAR; PG8_MMA(1, 1, At, B1); PG8_BAR;
        }
        PG8_STAMP();
        if constexpr (!Epi::AFTER_DRAIN) { E(acc, cur, wr, wc, fr, fq); S.done(cur); }
        PG8_STAMP();
        if (!has_next) break;
#pragma unroll
        for (int a = 0; a < 2; ++a)
#pragma unroll
            for (int b = 0; b < 2; ++b)
#pragma unroll
                for (int m = 0; m < 4; ++m)
#pragma unroll
                    for (int n = 0; n < 2; ++n) acc[a][b][m][n] = (f32x4){0.f, 0.f, 0.f, 0.f};
        cur = nxt; cA = nA; cB = nB; ++ui;
    }
    PG8_WAIT_V(0);
    if (wr == 0) PG8_BAR;
    PG8_BAR;
    if constexpr (Epi::AFTER_DRAIN) { E.fused(acc, cur, wr, wc, fr, fq, lds, wid, lane); S.done(cur); }
    PG8_STAMP();
    if (STAMP && wid == 0) { stamps[lane] = lane < nts ? (((unsigned long long)(unsigned)ts_hi << 32) | (unsigned)ts_lo) : 0ull;
        if (lane == 62) stamps[62] = rt_entry; if (lane == 63) stamps[63] = (unsigned long long)wall_clock64(); }
#undef PG8_STAMP
#undef PG8_SA
#undef PG8_SB
#undef PG8_STAGE
#undef PG8_LDA
#undef PG8_LDB
#undef PG8_MMA
#undef PG8_WAIT_V
#undef PG8_WAIT_L
#undef PG8_BAR
#undef PG8_SCHED
}
}

#define LAS __attribute__((address_space(3)))
typedef unsigned short bf16_t;
typedef short bf16x8 __attribute__((ext_vector_type(8)));
typedef short s16x4 __attribute__((ext_vector_type(4)));
typedef float f32x4 __attribute__((ext_vector_type(4)));
typedef float f32x2 __attribute__((ext_vector_type(2)));
typedef float f32x16 __attribute__((ext_vector_type(16)));
typedef unsigned u32x4 __attribute__((ext_vector_type(4)));
typedef unsigned u32x2 __attribute__((ext_vector_type(2)));
typedef __bf16 bf2_t __attribute__((ext_vector_type(2)));

constexpr int SEQ = 16384, DM = 2048, CTXL = 256, NKEY = SEQ + CTXL;
constexpr int NTHR = 512;
constexpr int ZP = 512;
constexpr int LDS_BYTES = 163840;
constexpr int LDS_CTL = LDS_BYTES - 256;

__device__ __forceinline__ float wave_sum(float v) {
#pragma unroll
    for (int o = 32; o >= 1; o >>= 1) v += __shfl_xor(v, o);
    return v;
}
__device__ __forceinline__ unsigned pk_bf16(float lo, float hi) { unsigned r; asm volatile("v_cvt_pk_bf16_f32 %0, %1, %2" : "=v"(r) : "v"(lo), "v"(hi)); return r; }
__device__ __forceinline__ float bf_lo(unsigned w) { return __uint_as_float(w << 16); }
__device__ __forceinline__ float bf_hi(unsigned w) { return __uint_as_float(w & 0xffff0000u); }
__device__ __forceinline__ float bf1(bf16_t h) { return __uint_as_float(((unsigned)h) << 16); }
__device__ __forceinline__ bf16_t f2bf(float f) { return (bf16_t)(pk_bf16(f, 0.f) & 0xffffu); }
__device__ __forceinline__ float gelu_tanh(float x) {
    const float u = 1.5957691216057308f * (x + 0.044715f * x * x * x);
    return x / (1.f + __expf(-u));
}
__device__ __forceinline__ float silu_f(float v) { return v / (1.f + __expf(-v)); }
__device__ __forceinline__ float dpp_f32_quad_swap1(float v) { return __int_as_float(__builtin_amdgcn_update_dpp(0, __float_as_int(v), 0xB1, 0xf, 0xf, true)); }
typedef _Float16 h2_t __attribute__((ext_vector_type(2)));
__device__ __forceinline__ unsigned pk_h2(f32x2 v) { h2_t h; h.x = (_Float16)v.x; h.y = (_Float16)v.y; return *(unsigned*)&h; }
__device__ __forceinline__ f32x2 un_h2(unsigned u) { h2_t h = *(h2_t*)&u; return (f32x2){(float)h.x, (float)h.y}; }

#define XB_TMO      128
#define XB_XCNT(j)  (256  + 64 * (j))
#define XB_XSUB(j)  (1280 + 64 * (j))
#define XB_XGEN(j)  (2304 + 64 * (j))
#define XB_TOP      3328
#define XB_TOPGEN   3392
#define XCD_BAR_WORDS 3456
#define XB_SPIN_CAP (1u << 22)
__device__ __forceinline__ unsigned xb_ld(unsigned* p)              { return __hip_atomic_load(p, __ATOMIC_RELAXED, __HIP_MEMORY_SCOPE_AGENT); }
__device__ __forceinline__ unsigned xb_add(unsigned* p, unsigned v) { return __hip_atomic_fetch_add(p, v, __ATOMIC_RELAXED, __HIP_MEMORY_SCOPE_AGENT); }
__device__ __forceinline__ unsigned xb_xcc_id() { return (unsigned)__builtin_amdgcn_s_getreg((3 << 11) | 20) & 0xFu; }
#define XB_SPIN(cond, bar) do { unsigned _sp = 0; while (cond) { __builtin_amdgcn_s_sleep(1); \
    if ((++_sp & 255u) == 0u) { if (xb_ld(&(bar)[XB_TMO])) break; if (_sp > XB_SPIN_CAP) { atomicAdd(&(bar)[XB_TMO], 1u); break; } } } } while (0)
struct XcdBarrier { unsigned* bar; unsigned x; volatile LAS unsigned* st; };
__device__ __forceinline__ XcdBarrier xcd_barrier_post(unsigned* bar, volatile LAS unsigned* st) {
    XcdBarrier b; b.bar = bar; b.x = xb_xcc_id(); b.st = st;
    if (threadIdx.x == 0) (void)xb_add(&bar[XB_XCNT(b.x)], 1u);
    return b;
}
__device__ __forceinline__ void xcd_barrier_complete(unsigned* bar, unsigned x, unsigned& nloc, unsigned& nx) {
    const unsigned G = gridDim.x * gridDim.y * gridDim.z;
    unsigned sum, cnt, mine, sp = 0u;
    for (;;) {
        sum = 0u; cnt = 0u; mine = 0u;
#pragma unroll
        for (unsigned j = 0; j < 16; ++j) { const unsigned c = xb_ld(&bar[XB_XCNT(j)]); sum += c; cnt += (c > 0u) ? 1u : 0u; mine = (j == x) ? c : mine; }
        if (sum == G) break;
        __builtin_amdgcn_s_sleep(1);
        if ((++sp & 255u) == 0u) { if (xb_ld(&bar[XB_TMO])) break; if (sp > XB_SPIN_CAP) { atomicAdd(&bar[XB_TMO], 1u); break; } }
    }
    nloc = mine > 0u ? mine : 1u; nx = cnt > 0u ? cnt : 1u;
}
__device__ __forceinline__ void xcd_barrier(const XcdBarrier& b) {
    asm volatile("s_waitcnt vmcnt(0)" ::: "memory");
    __syncthreads();
    if (threadIdx.x == 0) {
        unsigned* bar = b.bar;
        __builtin_amdgcn_s_waitcnt(0);
        unsigned nloc = b.st[0], nx = b.st[1];
        if (nloc == 0u) { xcd_barrier_complete(bar, b.x, nloc, nx); b.st[0] = nloc; b.st[1] = nx; }
        const unsigned old = xb_add(&bar[XB_XSUB(b.x)], 1u);
        const unsigned gen = old / nloc;
        if (old + 1u == (gen + 1u) * nloc) {
            __builtin_amdgcn_fence(__ATOMIC_RELEASE, "agent");
            asm volatile("s_waitcnt vmcnt(0)" ::: "memory");
            const unsigned og = xb_add(&bar[XB_TOP], 1u);
            const unsigned tg = og / nx;
            if (og + 1u == (tg + 1u) * nx) xb_add(&bar[XB_TOPGEN], 1u);
            else XB_SPIN(xb_ld(&bar[XB_TOPGEN]) == tg, bar);
            __builtin_amdgcn_fence(__ATOMIC_ACQUIRE, "agent");
            xb_add(&bar[XB_XGEN(b.x)], 1u);
            asm volatile("s_waitcnt vmcnt(0)" ::: "memory");
        } else {
            XB_SPIN(xb_ld(&bar[XB_XGEN(b.x)]) == gen, bar);
            __builtin_amdgcn_fence(__ATOMIC_ACQUIRE, "agent");
            asm volatile("s_waitcnt vmcnt(0)" ::: "memory");
        }
    }
    __syncthreads();
}

constexpr size_t WS_CTL   = 0;
constexpr size_t WS_MOD0  = 65536;
constexpr size_t WS_MOD1  = WS_MOD0 + 49152;
constexpr size_t WS_MC0   = WS_MOD1 + 49152;
constexpr size_t WS_ROPEC = WS_MC0 + 16384;
constexpr size_t WS_ROPES = WS_ROPEC + 2097152;
constexpr size_t WS_FPART = WS_ROPES + 2097152;
constexpr size_t WS_FNORM = WS_FPART + 4194304;
constexpr size_t WS_TSC   = WS_FNORM + 4096;
constexpr size_t WS_SA    = WS_TSC + 262144;
constexpr size_t WS_SW    = WS_SA + 69632;
constexpr size_t WS_KEYS0 = WS_SW + 131072;
constexpr size_t WS_KEYS1 = WS_KEYS0 + 65536;
constexpr size_t WS_GMWS  = WS_KEYS1 + 65536;
constexpr size_t WS_WIN0  = WS_GMWS + 262144;
constexpr size_t WS_WUQ   = WS_WIN0 + (size_t)4096 * 2048 * 2;
constexpr size_t WS_WUKV  = WS_WUQ + (size_t)1536 * 512 * 2;
constexpr size_t WS_WOUT0 = WS_WUKV + (size_t)2048 * 256 * 2;
constexpr size_t WS_WPQ0  = WS_WOUT0 + (size_t)2048 * 2048 * 2;
constexpr size_t WS_WIN1  = WS_WPQ0 + (size_t)2048 * 2048 * 2;
constexpr size_t WS_WOUT1 = WS_WIN1 + (size_t)5120 * 2048 * 2;
constexpr size_t WS_WPQ1  = WS_WOUT1 + (size_t)2048 * 2048 * 2;
constexpr size_t WS_TABU  = WS_WPQ1 + (size_t)2048 * 2048 * 2;
constexpr size_t WS_TABV  = WS_TABU + (size_t)16384 * 2048 * 2;
constexpr size_t WS_XR    = WS_TABV + (size_t)16384 * 2048 * 2;
constexpr size_t WS_H     = WS_XR + (size_t)16384 * 2048 * 4;
constexpr size_t WS_PBUF  = WS_H + (size_t)NKEY * 2048 * 2;
constexpr size_t WS_L0X   = WS_PBUF + (size_t)16384 * 5120 * 2;
constexpr size_t WS_QN    = WS_L0X;
constexpr size_t WS_KVN   = WS_QN + (size_t)16384 * 512 * 2;
constexpr size_t WS_KROPE = WS_KVN + (size_t)NKEY * 256 * 2;
constexpr size_t WS_Q     = WS_KROPE + (size_t)NKEY * 64 * 2;
constexpr size_t WS_KV    = WS_Q + (size_t)16384 * 1536 * 2;
constexpr size_t WS_L0END = WS_KV + (size_t)NKEY * 2048 * 2;
constexpr size_t WS_Z     = WS_L0X;
static_assert(WS_L0END - WS_L0X >= (size_t)32768 * ZP * 4, "Z alias");
static_assert(WS_L0END - WS_L0X >= (size_t)16 * 16384 * 128 * 4, "PD alias");
static_assert((size_t)NKEY * 4096 * 2 <= (size_t)16384 * 5120 * 2, "PBUF");
constexpr size_t WS_YCAT  = WS_L0END;
constexpr size_t WS_KZ    = WS_YCAT + (size_t)16384 * 2048 * 2;
constexpr size_t WS_KZ2   = WS_KZ + (size_t)32768 * ZP * 4;
constexpr size_t WS_END   = WS_KZ2 + (size_t)32768 * ZP * 4;
constexpr size_t WS_G1B   = WS_H;
constexpr size_t WS_X0B   = WS_H + (size_t)16384 * 1024 * 2;
static_assert(WS_END < (size_t)1000000000, "workspace budget");

struct Params { const float* in[43]; float* out; unsigned char* ws; int ph_lo, ph_hi, flags, pad; };
struct Fr { const float* const* in; float* out; unsigned char* ws; LAS unsigned char* lds; int tid, lane, wave, G, bid; int xcc, xcc_rank, xcc_n, xcc_ok; };

enum { I_X = 0, I_C, I_CTX, I_CCTX, I_LN1G0, I_WMOD0, I_BMOD0, I_WIN0, I_CONVW0, I_QNG0, I_WUQ0, I_KVNG0, I_WUKV0, I_WOUT0, I_LN2G0, I_PWQ0, I_PKEYS0, I_PU0, I_PV0,
       I_LN1G1, I_WMOD1, I_BMOD1, I_WIN1, I_GMNG1, I_GMWS1, I_GMB1, I_HYCW1, I_HYCB1, I_HYW1, I_HYB1, I_HYF1, I_HYW2, I_HYB2, I_HYF2, I_HYW3, I_HYBIAS1, I_WOUT1, I_LN2G1, I_PWQ1, I_PKEYS1, I_PU1, I_PV1, I_FINALG };

__device__ __forceinline__ void tconv_task(const Fr& F, const float* W, int K, int N, int Npad, bf16_t* Bt) {
    LAS float* tile = (LAS float*)F.lds;
    const int tn = Npad / 64, tk = K / 64, nt = tn * tk;
    for (int t0 = F.bid * 4; t0 < nt; t0 += F.G * 4) {
        const int i = F.tid >> 3, jq = F.tid & 7;
        f32x4 a[4], b[4];
#pragma unroll
        for (int q = 0; q < 4; ++q) { const int t = t0 + q; a[q] = (f32x4){0.f, 0.f, 0.f, 0.f}; b[q] = a[q];
            if (t < nt) { const int n0 = (t % tn) * 64, k0 = (t / tn) * 64;
                if (n0 < N) { const float* p = W + (size_t)(k0 + i) * N + n0 + jq * 8; a[q] = *(const f32x4*)p; b[q] = *(const f32x4*)(p + 4); } } }
        __syncthreads();
#pragma unroll
        for (int q = 0; q < 4; ++q)
#pragma unroll
            for (int e = 0; e < 4; ++e) { tile[q * 4160 + i * 65 + jq * 8 + e] = a[q][e]; tile[q * 4160 + i * 65 + jq * 8 + 4 + e] = b[q][e]; }
        __syncthreads();
        const int j = F.tid >> 3, ic = F.tid & 7;
#pragma unroll
        for (int q = 0; q < 4; ++q) { const int t = t0 + q;
            if (t < nt) { const int n0 = (t % tn) * 64, k0 = (t / tn) * 64;
                float v[8];
#pragma unroll
                for (int e = 0; e < 8; ++e) v[e] = tile[q * 4160 + (ic * 8 + e) * 65 + j];
                u32x4 w; w.x = pk_bf16(v[0], v[1]); w.y = pk_bf16(v[2], v[3]); w.z = pk_bf16(v[4], v[5]); w.w = pk_bf16(v[6], v[7]);
                *(u32x4*)(Bt + (size_t)(n0 + j) * K + k0 + ic * 8) = w; } }
    }
    __syncthreads();
}
__device__ __forceinline__ void colmax_task(const Fr& F, const float* W, int K, int N, int Npad, float* SW) {
    LAS float* red = (LAS float*)F.lds;
    const int i = F.tid >> 3, jq = F.tid & 7;
    for (int st = F.bid; st < Npad / 32; st += F.G) {
        const int n0 = st * 32;
        f32x4 cm = {0.f, 0.f, 0.f, 0.f};
        if (n0 < N) {
            const float* p = W + (size_t)i * N + n0 + jq * 4;
#pragma unroll 8
            for (int k = 0; k < K; k += 64) { const f32x4 w = *(const f32x4*)(p + (size_t)k * N);
                cm[0] = fmaxf(cm[0], fabsf(w[0])); cm[1] = fmaxf(cm[1], fabsf(w[1])); cm[2] = fmaxf(cm[2], fabsf(w[2])); cm[3] = fmaxf(cm[3], fabsf(w[3])); }
        }
        __syncthreads();
#pragma unroll
        for (int e = 0; e < 4; ++e) red[i * 33 + jq * 4 + e] = cm[e];
        __syncthreads();
        if (F.tid < 32) { float m = 0.f; for (int q = 0; q < 64; ++q) m = fmaxf(m, red[q * 33 + F.tid]); SW[n0 + F.tid] = m > 0.f ? m * (1.0f / 127.0f) : 1.0f; }
    }
    __syncthreads();
}
__device__ __forceinline__ void tconv_q_task(const Fr& F, const float* W, int K, int N, int Npad, const float* SW, unsigned char* Bt8) {
    LAS float* tile = (LAS float*)F.lds;
    const int tn = Npad / 64, tk = K / 64, nt = tn * tk;
    for (int t0 = F.bid * 4; t0 < nt; t0 += F.G * 4) {
        const int i = F.tid >> 3, jq = F.tid & 7;
        f32x4 a[4], b[4]; float sw4[4];
#pragma unroll
        for (int q = 0; q < 4; ++q) { const int t = t0 + q; a[q] = (f32x4){0.f, 0.f, 0.f, 0.f}; b[q] = a[q]; sw4[q] = 1.0f;
            if (t < nt) { const int n0 = (t % tn) * 64, k0 = (t / tn) * 64;
                sw4[q] = SW[n0 + (F.tid >> 3)];
                if (n0 < N) { const float* p = W + (size_t)(k0 + i) * N + n0 + jq * 8; a[q] = *(const f32x4*)p; b[q] = *(const f32x4*)(p + 4); } } }
        __syncthreads();
#pragma unroll
        for (int q = 0; q < 4; ++q)
#pragma unroll
            for (int e = 0; e < 4; ++e) { tile[q * 4160 + i * 65 + jq * 8 + e] = a[q][e]; tile[q * 4160 + i * 65 + jq * 8 + 4 + e] = b[q][e]; }
        __syncthreads();
        const int j = F.tid >> 3, ic = F.tid & 7;
#pragma unroll
        for (int q = 0; q < 4; ++q) { const int t = t0 + q;
            if (t < nt) { const int n0 = (t % tn) * 64, k0 = (t / tn) * 64;
                const float inv = 1.0f / sw4[q];
                int qv[8];
#pragma unroll
                for (int e = 0; e < 8; ++e) { const int r = (int)rintf(tile[q * 4160 + (ic * 8 + e) * 65 + j] * inv); qv[e] = r < -127 ? -127 : (r > 127 ? 127 : r); }
                u32x2 w; w.x = (unsigned)((qv[0] & 255) | ((qv[1] & 255) << 8) | ((qv[2] & 255) << 16) | ((qv[3] & 255) << 24));
                w.y = (unsigned)((qv[4] & 255) | ((qv[5] & 255) << 8) | ((qv[6] & 255) << 16) | ((qv[7] & 255) << 24));
                *(u32x2*)(Bt8 + (size_t)(n0 + j) * K + k0 + ic * 8) = w; } }
    }
    __syncthreads();
}
__device__ __forceinline__ void cvt_task(const Fr& F, const float* src, bf16_t* dst, size_t n8) {
    for (size_t i = (size_t)F.bid * NTHR + F.tid; i < n8; i += (size_t)F.G * NTHR) {
        const f32x4 a = *(const f32x4*)(src + i * 8), b = *(const f32x4*)(src + i * 8 + 4);
        u32x4 w; w.x = pk_bf16(a[0], a[1]); w.y = pk_bf16(a[2], a[3]); w.z = pk_bf16(b[0], b[1]); w.w = pk_bf16(b[2], b[3]);
        *(u32x4*)(dst + i * 8) = w;
    }
}
template <bool FP8>
__device__ __forceinline__ void cvt_table(const Fr& F, const float* src, unsigned char* dst, float* scale) {
    const int rstep = F.G * 16;
    f32x4 vn[2][8];
#define CT_LOAD(R0) do { _Pragma("unroll") for (int rr = 0; rr < 2; ++rr) _Pragma("unroll") for (int i = 0; i < 8; ++i) vn[rr][i] = *(const f32x4*)(src + (size_t)((R0) + rr) * 2048 + i * 256 + F.lane * 4); } while (0)
    { const int rf = (F.bid * 8 + F.wave) * 2; if (rf < 16384) CT_LOAD(rf); }
    for (int row0 = (F.bid * 8 + F.wave) * 2; row0 < 16384; row0 += rstep) {
        f32x4 v[2][8];
#pragma unroll
        for (int rr = 0; rr < 2; ++rr)
#pragma unroll
            for (int i = 0; i < 8; ++i) v[rr][i] = vn[rr][i];
        if (row0 + rstep < 16384) CT_LOAD(row0 + rstep);
#pragma unroll
        for (int rr = 0; rr < 2; ++rr) {
            const int row = row0 + rr; float am = 0.f;
#pragma unroll
            for (int i = 0; i < 8; ++i) am = fmaxf(am, fmaxf(fmaxf(fabsf(v[rr][i][0]), fabsf(v[rr][i][1])), fmaxf(fabsf(v[rr][i][2]), fabsf(v[rr][i][3]))));
#pragma unroll
            for (int o = 32; o >= 1; o >>= 1) am = fmaxf(am, __shfl_xor(am, o));
            const float top = FP8 ? 400.0f : 127.0f;
            const float sc = am > 0.f ? am * (1.0f / top) : 1.0f, inv = am > 0.f ? top / am : 1.0f;
#pragma unroll
            for (int i = 0; i < 8; ++i) {
                int p;
                if (FP8) { p = 0; p = __builtin_amdgcn_cvt_pk_fp8_f32(v[rr][i][0] * inv, v[rr][i][1] * inv, p, false); p = __builtin_amdgcn_cvt_pk_fp8_f32(v[rr][i][2] * inv, v[rr][i][3] * inv, p, true); }
                else { int q[4];
#pragma unroll
                    for (int e = 0; e < 4; ++e) { const int t = (int)rintf(v[rr][i][e] * inv); q[e] = t < -127 ? -127 : (t > 127 ? 127 : t); }
                    p = (q[0] & 255) | ((q[1] & 255) << 8) | ((q[2] & 255) << 16) | ((q[3] & 255) << 24); }
                const int e0 = i * 256 + F.lane * 4;
                *(int*)(dst + (size_t)(e0 >> 7) * 2097152 + (size_t)row * 128 + (e0 & 127)) = p; }
            if (F.lane == 0) scale[row] = sc;
        }
    }
#undef CT_LOAD
}
__device__ __forceinline__ void modgemv(const Fr& F, const float* c, const float* c2, const float* W, const float* b, float* out, float* out2, int ncol2) {
    LAS float* s1 = (LAS float*)F.lds;
    LAS float* s2 = s1 + 2048;
    LAS float* red = s2 + 2048;
    LAS float* red2 = red + 42 * 48;
    __syncthreads();
    for (int k = F.tid; k < 2048; k += NTHR) { s1[k] = silu_f(c[k]); s2[k] = c2 ? silu_f(c2[k]) : 0.f; }
    __syncthreads();
    for (int chunk = F.bid; chunk < 256; chunk += F.G) {
        const int col0 = chunk * 48, cq = F.tid % 12, kl = F.tid / 12;
        const bool do2 = (c2 != nullptr) && (col0 < ncol2);
        if (kl < 42) {
            f32x4 a1 = {0.f, 0.f, 0.f, 0.f}, a2 = {0.f, 0.f, 0.f, 0.f};
            const float* wp = W + col0 + cq * 4;
#pragma unroll 8
            for (int k = kl; k < 2048; k += 42) { const f32x4 w = *(const f32x4*)(wp + (size_t)k * 12288); a1 += s1[k] * w; a2 += s2[k] * w; }
#pragma unroll
            for (int e = 0; e < 4; ++e) { red[kl * 48 + cq * 4 + e] = a1[e]; red2[kl * 48 + cq * 4 + e] = a2[e]; }
        }
        __syncthreads();
        if (F.tid < 48) {
            float r1 = 0.f, r2 = 0.f;
            for (int q = 0; q < 42; ++q) { r1 += red[q * 48 + F.tid]; r2 += red2[q * 48 + F.tid]; }
            const float bb = b[col0 + F.tid];
            out[col0 + F.tid] = r1 + bb;
            if (do2 && col0 + F.tid < ncol2) out2[col0 + F.tid] = r2 + bb;
        }
        __syncthreads();
    }
}
__device__ __forceinline__ void rope_tables(const Fr& F, float* rc, float* rs) {
    for (int it = F.bid * NTHR + F.tid; it < SEQ * 32; it += F.G * NTHR) {
        const int t = it >> 5, jj = it & 31, seg = jj >> 4, j = jj & 15;
        const int pos = seg ? (t & 63) : (t >> 6);
        const float inv = powf(10000.0f, -(float)j / 16.0f);
        const float ang = (float)pos * inv;
        float s, c; sincosf(ang, &s, &c);
        rc[it] = c; rs[it] = s;
    }
}
__device__ __forceinline__ void quant_rows(const Fr& F, const bf16_t* X, unsigned char* out8, float* sa) {
    for (int row0 = (F.bid * 8 + F.wave) * 2; row0 < SEQ; row0 += F.G * 16) {
        u32x4 w[2][4];
#pragma unroll
        for (int rr = 0; rr < 2; ++rr)
#pragma unroll
            for (int i = 0; i < 4; ++i) w[rr][i] = *(const u32x4*)(X + (size_t)(row0 + rr) * DM + i * 512 + F.lane * 8);
        __builtin_amdgcn_sched_barrier(0);
#pragma unroll
        for (int rr = 0; rr < 2; ++rr) {
            f32x4 v[8]; float am = 0.f;
#pragma unroll
            for (int i = 0; i < 4; ++i) { v[2 * i] = (f32x4){bf_lo(w[rr][i].x), bf_hi(w[rr][i].x), bf_lo(w[rr][i].y), bf_hi(w[rr][i].y)}; v[2 * i + 1] = (f32x4){bf_lo(w[rr][i].z), bf_hi(w[rr][i].z), bf_lo(w[rr][i].w), bf_hi(w[rr][i].w)}; }
#pragma unroll
            for (int i = 0; i < 8; ++i) am = fmaxf(am, fmaxf(fmaxf(fabsf(v[i][0]), fabsf(v[i][1])), fmaxf(fabsf(v[i][2]), fabsf(v[i][3]))));
#pragma unroll
            for (int o = 32; o >= 1; o >>= 1) am = fmaxf(am, __shfl_xor(am, o));
            const float inv = am > 0.f ? 127.0f / am : 0.f;
#pragma unroll
            for (int i = 0; i < 4; ++i) { u32x2 o;
                { int q[4];
#pragma unroll
                  for (int e = 0; e < 4; ++e) q[e] = (int)rintf(v[2 * i][e] * inv);
                  o.x = (unsigned)((q[0] & 255) | ((q[1] & 255) << 8) | ((q[2] & 255) << 16) | ((q[3] & 255) << 24)); }
                { int q[4];
#pragma unroll
                  for (int e = 0; e < 4; ++e) q[e] = (int)rintf(v[2 * i + 1][e] * inv);
                  o.y = (unsigned)((q[0] & 255) | ((q[1] & 255) << 8) | ((q[2] & 255) << 16) | ((q[3] & 255) << 24)); }
                *(u32x2*)(out8 + (size_t)(row0 + rr) * DM + i * 512 + F.lane * 8) = o; }
            if (F.lane == 0) sa[row0 + rr] = am > 0.f ? am * (1.0f / 127.0f) : 1.0f;
        }
    }
}
template <bool Q8>
__device__ __forceinline__ void norm_rows_b(const Fr& F, const bf16_t* X, const float* g, const float* sc, const float* sh, bf16_t* out, unsigned char* out8 = nullptr, float* sa = nullptr) {
    f32x4 cs[8], cb[8];
#pragma unroll
    for (int i = 0; i < 4; ++i)
#pragma unroll
        for (int hf = 0; hf < 2; ++hf) { const int col = i * 512 + F.lane * 8 + hf * 4; const f32x4 gg = *(const f32x4*)(g + col), a = *(const f32x4*)(sc + col); cs[i * 2 + hf] = gg * (1.0f + a); cb[i * 2 + hf] = *(const f32x4*)(sh + col); }
    for (int row0 = (F.bid * 8 + F.wave) * 2; row0 < SEQ; row0 += F.G * 16) {
        u32x4 w[2][4];
#pragma unroll
        for (int rr = 0; rr < 2; ++rr)
#pragma unroll
            for (int i = 0; i < 4; ++i) w[rr][i] = *(const u32x4*)(X + (size_t)(row0 + rr) * DM + i * 512 + F.lane * 8);
        __builtin_amdgcn_sched_barrier(0);
#pragma unroll
        for (int rr = 0; rr < 2; ++rr) {
            f32x4 v[8]; float ss = 0.f;
#pragma unroll
            for (int i = 0; i < 4; ++i) { v[2 * i] = (f32x4){bf_lo(w[rr][i].x), bf_hi(w[rr][i].x), bf_lo(w[rr][i].y), bf_hi(w[rr][i].y)}; v[2 * i + 1] = (f32x4){bf_lo(w[rr][i].z), bf_hi(w[rr][i].z), bf_lo(w[rr][i].w), bf_hi(w[rr][i].w)}; }
#pragma unroll
            for (int i = 0; i < 8; ++i) ss += v[i][0] * v[i][0] + v[i][1] * v[i][1] + v[i][2] * v[i][2] + v[i][3] * v[i][3];
            ss = wave_sum(ss);
            const float rstd = rsqrtf(ss * (1.0f / DM) + 1e-6f);
            if constexpr (!Q8) {
#pragma unroll
            for (int i = 0; i < 4; ++i) {
                const f32x4 y0 = v[2 * i] * rstd * cs[2 * i] + cb[2 * i], y1 = v[2 * i + 1] * rstd * cs[2 * i + 1] + cb[2 * i + 1];
                u32x4 o; o.x = pk_bf16(y0[0], y0[1]); o.y = pk_bf16(y0[2], y0[3]); o.z = pk_bf16(y1[0], y1[1]); o.w = pk_bf16(y1[2], y1[3]);
                *(u32x4*)(out + (size_t)(row0 + rr) * DM + i * 512 + F.lane * 8) = o;
            }
            } else {
                float am = 0.f;
#pragma unroll
                for (int i = 0; i < 8; ++i) { v[i] = v[i] * rstd * cs[i] + cb[i]; am = fmaxf(am, fmaxf(fmaxf(fabsf(v[i][0]), fabsf(v[i][1])), fmaxf(fabsf(v[i][2]), fabsf(v[i][3])))); }
#pragma unroll
                for (int o = 32; o >= 1; o >>= 1) am = fmaxf(am, __shfl_xor(am, o));
                const float inv = am > 0.f ? 127.0f / am : 0.f;
#pragma unroll
                for (int i = 0; i < 4; ++i) { u32x2 o;
                    { int q[4];
#pragma unroll
                      for (int e = 0; e < 4; ++e) q[e] = (int)rintf(v[2 * i][e] * inv);
                      o.x = (unsigned)((q[0] & 255) | ((q[1] & 255) << 8) | ((q[2] & 255) << 16) | ((q[3] & 255) << 24)); }
                    { int q[4];
#pragma unroll
                      for (int e = 0; e < 4; ++e) q[e] = (int)rintf(v[2 * i + 1][e] * inv);
                      o.y = (unsigned)((q[0] & 255) | ((q[1] & 255) << 8) | ((q[2] & 255) << 16) | ((q[3] & 255) << 24)); }
                    *(u32x2*)(out8 + (size_t)(row0 + rr) * DM + i * 512 + F.lane * 8) = o; }
                if (F.lane == 0) sa[row0 + rr] = am > 0.f ? am * (1.0f / 127.0f) : 1.0f;
            }
        }
    }
}
__device__ __forceinline__ void hyena_filter_gen(const Fr& F, unsigned* KZ, float* FPART) {
    const float* w1 = F.in[I_HYW1]; const float* b1 = F.in[I_HYB1]; const float* f1 = F.in[I_HYF1];
    const float* w2 = F.in[I_HYW2]; const float* b2 = F.in[I_HYB2]; const float* f2 = F.in[I_HYF2];
    const float* w3 = F.in[I_HYW3];
    LAS float* zf = (LAS float*)F.lds;
    LAS float* a1 = zf + 64 * 33;
    LAS bf16_t* a2b = (LAS bf16_t*)(a1 + 64 * 64);
    const int r32 = F.lane & 31, hi = F.lane >> 5;
    const float da = -3.0701134573253944f, db = -15.350567286626972f;
    float psum[8];
#pragma unroll
    for (int cb = 0; cb < 8; ++cb) psum[cb] = 0.f;
    for (int pb = F.bid; pb < SEQ / 64; pb += F.G) {
        const int l0 = pb * 64;
        __syncthreads();
        for (int it = F.tid; it < 64 * 33; it += NTHR) {
            const int pos = it / 33, f = it % 33; const int l = l0 + pos;
            const float t = (float)l / (float)(SEQ - 1);
            const float w = (6.283185307179586f / (float)SEQ) * (float)l;
            float v;
            if (f == 0) v = t;
            else { const int j = (f - 1) & 15; const float band = 1e-4f + (float)j * ((15.0f - 1e-4f) / 15.0f); v = (f <= 16) ? cosf(band * w) : -sinf(band * w); }
            zf[pos * 33 + f] = v;
        }
        __syncthreads();
        for (int it = F.tid; it < 64 * 64; it += NTHR) {
            const int pos = it >> 6, u = it & 63; float s = b1[u];
            for (int f = 0; f < 33; ++f) s += zf[pos * 33 + f] * w1[f * 64 + u];
            a1[pos * 64 + u] = sinf(f1[u] * s);
        }
        __syncthreads();
        for (int it = F.tid; it < 64 * 64; it += NTHR) {
            const int pos = it >> 6, u = it & 63; float s = b2[u];
            for (int v = 0; v < 64; ++v) s += a1[pos * 64 + v] * w2[v * 64 + u];
            a2b[pos * 72 + u] = f2bf(sinf(f2[u] * s));
        }
        __syncthreads();
        bf16x8 af[2][4];
#pragma unroll
        for (int rb = 0; rb < 2; ++rb)
#pragma unroll
            for (int ks = 0; ks < 4; ++ks) af[rb][ks] = *(const LAS bf16x8*)(a2b + (rb * 32 + r32) * 72 + ks * 16 + hi * 8);
#pragma unroll 1
        for (int cb = 0; cb < 8; ++cb) {
            const int gcol = F.wave * 256 + cb * 32 + r32;
            f32x16 acc[2] = {};
#pragma unroll
            for (int ks = 0; ks < 4; ++ks) {
                float wv[8];
#pragma unroll
                for (int j = 0; j < 8; ++j) wv[j] = w3[(size_t)(ks * 16 + hi * 8 + j) * 2048 + gcol];
                u32x4 bw; bw.x = pk_bf16(wv[0], wv[1]); bw.y = pk_bf16(wv[2], wv[3]); bw.z = pk_bf16(wv[4], wv[5]); bw.w = pk_bf16(wv[6], wv[7]);
                const bf16x8 bf = *(bf16x8*)&bw;
                acc[0] = __builtin_amdgcn_mfma_f32_32x32x16_bf16(af[0][ks], bf, acc[0], 0, 0, 0);
                acc[1] = __builtin_amdgcn_mfma_f32_32x32x16_bf16(af[1][ks], bf, acc[1], 0, 0, 0);
            }
            const bool bwd = gcol >= 1024; const int c = gcol & 1023;
            const float dl2 = fabsf(da + (float)c * ((db - da) / 1023.0f)) * 1.4426950408889634f;
            float ps = 0.f;
#pragma unroll
            for (int rb = 0; rb < 2; ++rb)
#pragma unroll
                for (int rr = 0; rr < 16; ++rr) {
                    const int l = l0 + rb * 32 + (rr & 3) + 8 * (rr >> 2) + 4 * hi;
                    const float t = (float)l / (float)(SEQ - 1);
                    const float v = acc[rb][rr] * __builtin_amdgcn_exp2f(-t * dl2);
                    const float vn = dpp_f32_quad_swap1(v);
                    const bool keep = !(bwd && l == 0);
                    if (keep) ps += fabsf(v);
                    if (keep && (r32 & 1) == 0) KZ[(size_t)(bwd ? 2 * SEQ - l : l) * ZP + (c >> 1)] = pk_h2((f32x2){v, vn});
                }
            psum[cb] += ps;
        }
    }
#pragma unroll
    for (int cb = 0; cb < 8; ++cb) {
        auto sw = __builtin_amdgcn_permlane32_swap(__float_as_uint(psum[cb]), __float_as_uint(psum[cb]), false, false);
        const float tot = __uint_as_float(sw[0]) + __uint_as_float(sw[1]);
        if (hi == 0) FPART[(size_t)F.bid * 2048 + F.wave * 256 + cb * 32 + r32] = tot;
    }
    if (F.bid == 0) for (int c = F.tid; c < 512; c += NTHR) KZ[(size_t)SEQ * ZP + c] = 0u;
}
__device__ __forceinline__ void hyena_filter_norm(const Fr& F, const float* FPART, float* FNORM) {
    for (int c = F.bid * 8 + F.wave; c < 1024; c += F.G * 8) {
        float s = 0.f;
        for (int b = F.lane; b < F.G; b += 64) s += FPART[(size_t)b * 2048 + c] + FPART[(size_t)b * 2048 + 1024 + c];
        s = wave_sum(s);
        if (F.lane == 0) FNORM[c] = 1.0f / (s + 1e-6f);
    }
}

template <bool Q8>
__device__ __forceinline__ void norm_rows(const Fr& F, const float* X, int nrows, const float* g, const float* sc, const float* sh, bf16_t* out, unsigned char* out8 = nullptr, float* sa = nullptr) {
    f32x4 cs[8], cb[8];
#pragma unroll
    for (int i = 0; i < 8; ++i) { const int col = i * 256 + F.lane * 4; const f32x4 gg = *(const f32x4*)(g + col), a = *(const f32x4*)(sc + col); cs[i] = gg * (1.0f + a); cb[i] = *(const f32x4*)(sh + col); }
    for (int row0 = (F.bid * 8 + F.wave) * 2; row0 < nrows; row0 += F.G * 16) {
        f32x4 v[2][8];
#pragma unroll
        for (int i = 0; i < 8; ++i) { v[0][i] = *(const f32x4*)(X + (size_t)row0 * DM + i * 256 + F.lane * 4); v[1][i] = *(const f32x4*)(X + (size_t)(row0 + 1) * DM + i * 256 + F.lane * 4); }
        __builtin_amdgcn_sched_barrier(0);
#pragma unroll
        for (int rr = 0; rr < 2; ++rr) {
            float ss = 0.f;
#pragma unroll
            for (int i = 0; i < 8; ++i) ss += v[rr][i][0] * v[rr][i][0] + v[rr][i][1] * v[rr][i][1] + v[rr][i][2] * v[rr][i][2] + v[rr][i][3] * v[rr][i][3];
            ss = wave_sum(ss);
            const float rstd = rsqrtf(ss * (1.0f / DM) + 1e-6f);
            if constexpr (!Q8) {
#pragma unroll
            for (int i = 0; i < 8; ++i) {
                const f32x4 y = v[rr][i] * rstd * cs[i] + cb[i];
                u32x2 w; w.x = pk_bf16(y[0], y[1]); w.y = pk_bf16(y[2], y[3]);
                *(u32x2*)(out + (size_t)(row0 + rr) * DM + i * 256 + F.lane * 4) = w;
            }
            } else {
                float am = 0.f;
#pragma unroll
                for (int i = 0; i < 8; ++i) { v[rr][i] = v[rr][i] * rstd * cs[i] + cb[i]; am = fmaxf(am, fmaxf(fmaxf(fabsf(v[rr][i][0]), fabsf(v[rr][i][1])), fmaxf(fabsf(v[rr][i][2]), fabsf(v[rr][i][3])))); }
#pragma unroll
                for (int o = 32; o >= 1; o >>= 1) am = fmaxf(am, __shfl_xor(am, o));
                const float inv = am > 0.f ? 127.0f / am : 0.f;
#pragma unroll
                for (int i = 0; i < 8; ++i) { int q[4];
#pragma unroll
                    for (int e = 0; e < 4; ++e) q[e] = (int)rintf(v[rr][i][e] * inv);
                    *(unsigned*)(out8 + (size_t)(row0 + rr) * DM + i * 256 + F.lane * 4) = (unsigned)((q[0] & 255) | ((q[1] & 255) << 8) | ((q[2] & 255) << 16) | ((q[3] & 255) << 24)); }
                if (F.lane == 0) sa[row0 + rr] = am > 0.f ? am * (1.0f / 127.0f) : 1.0f;
            }
        }
    }
}

__device__ __forceinline__ void l0_post_proj(const Fr& F, const bf16_t* PB, bf16_t* QN, bf16_t* KVN, bf16_t* KROPE, bf16_t* YCAT,
                                             const float* rc, const float* rs, int nrows) {
    const float* qg = F.in[I_QNG0]; const float* kvg = F.in[I_KVNG0]; const float* cw = F.in[I_CONVW0];
    for (int tb = (F.bid * 8 + F.wave) * 4; tb < nrows; tb += F.G * 32) {
        u32x4 wq[4]; u32x2 wk[4]; bf16_t wr[4]; float rcv[4], rsv[4];
        const int seg = F.lane >> 5, half = (F.lane >> 4) & 1, j = F.lane & 15;
#pragma unroll
        for (int u = 0; u < 4; ++u) { const int t = (tb + u < nrows) ? tb + u : tb; const bf16_t* pr = PB + (size_t)t * 4096;
            wq[u] = (t < SEQ) ? *(const u32x4*)(pr + 3072 + F.lane * 8) : (u32x4){0u, 0u, 0u, 0u};
            wk[u] = *(const u32x2*)(pr + 3584 + F.lane * 4); wr[u] = pr[3840 + F.lane];
            rcv[u] = (t < SEQ) ? rc[(size_t)t * 32 + seg * 16 + j] : 1.f; rsv[u] = (t < SEQ) ? rs[(size_t)t * 32 + seg * 16 + j] : 0.f; }
#pragma unroll
        for (int u = 0; u < 4; ++u) {
            const int t = tb + u; if (t >= nrows) break;
            if (t < SEQ) {
                const u32x4 w = wq[u];
                float v[8] = {bf_lo(w.x), bf_hi(w.x), bf_lo(w.y), bf_hi(w.y), bf_lo(w.z), bf_hi(w.z), bf_lo(w.w), bf_hi(w.w)};
                float ss = 0.f;
#pragma unroll
                for (int e = 0; e < 8; ++e) ss += v[e] * v[e];
                ss = wave_sum(ss);
                const float rstd = rsqrtf(ss * (1.0f / 512.0f) + 1e-6f);
                const f32x4 g0 = *(const f32x4*)(qg + F.lane * 8), g1 = *(const f32x4*)(qg + F.lane * 8 + 4);
                u32x4 o; o.x = pk_bf16(v[0] * rstd * g0[0], v[1] * rstd * g0[1]); o.y = pk_bf16(v[2] * rstd * g0[2], v[3] * rstd * g0[3]);
                o.z = pk_bf16(v[4] * rstd * g1[0], v[5] * rstd * g1[1]); o.w = pk_bf16(v[6] * rstd * g1[2], v[7] * rstd * g1[3]);
                *(u32x4*)(QN + (size_t)t * 512 + F.lane * 8) = o;
            }
            {
                const u32x2 w = wk[u];
                float v[4] = {bf_lo(w.x), bf_hi(w.x), bf_lo(w.y), bf_hi(w.y)};
                float ss = v[0] * v[0] + v[1] * v[1] + v[2] * v[2] + v[3] * v[3];
                ss = wave_sum(ss);
                const float rstd = rsqrtf(ss * (1.0f / 256.0f) + 1e-6f);
                const f32x4 g0 = *(const f32x4*)(kvg + F.lane * 4);
                u32x2 o; o.x = pk_bf16(v[0] * rstd * g0[0], v[1] * rstd * g0[1]); o.y = pk_bf16(v[2] * rstd * g0[2], v[3] * rstd * g0[3]);
                *(u32x2*)(KVN + (size_t)t * 256 + F.lane * 4) = o;
            }
            {
                const float uu = bf1(wr[u]);
                const float up = __shfl_xor(uu, 16);
                const float o = uu * rcv[u] + (half ? up : -up) * rsv[u];
                KROPE[(size_t)t * 64 + F.lane] = f2bf(o);
            }
        }
    }
    {
        const int cg = F.tid & 127, c0 = cg * 8;
        float w0[8], w1[8], w2[8];
#pragma unroll
        for (int e = 0; e < 8; ++e) { w0[e] = cw[c0 + e]; w1[e] = cw[1024 + c0 + e]; w2[e] = cw[2048 + c0 + e]; }
        for (int t = F.bid * 4 + (F.tid >> 7); t < SEQ; t += F.G * 4) {
            u32x4 a[3], h[3];
#pragma unroll
            for (int dt = 0; dt < 3; ++dt) { const int tt = t + dt - 1; const bool ok = (tt >= 0) && (tt < SEQ);
                a[dt] = ok ? *(const u32x4*)(PB + (size_t)tt * 4096 + 1024 + c0) : (u32x4){0u, 0u, 0u, 0u};
                h[dt] = ok ? *(const u32x4*)(PB + (size_t)tt * 4096 + 2048 + c0) : (u32x4){0u, 0u, 0u, 0u}; }
            const u32x4 gb = *(const u32x4*)(PB + (size_t)t * 4096 + c0);
            float y[8];
#pragma unroll
            for (int q = 0; q < 4; ++q) {
                y[2 * q] = bf_lo(gb[q]) * (w0[2 * q] * bf_lo(a[0][q]) * bf_lo(h[0][q]) + w1[2 * q] * bf_lo(a[1][q]) * bf_lo(h[1][q]) + w2[2 * q] * bf_lo(a[2][q]) * bf_lo(h[2][q]));
                y[2 * q + 1] = bf_hi(gb[q]) * (w0[2 * q + 1] * bf_hi(a[0][q]) * bf_hi(h[0][q]) + w1[2 * q + 1] * bf_hi(a[1][q]) * bf_hi(h[1][q]) + w2[2 * q + 1] * bf_hi(a[2][q]) * bf_hi(h[2][q]));
            }
            *(u32x4*)(YCAT + (size_t)t * 2048 + c0) = (u32x4){pk_bf16(y[0], y[1]), pk_bf16(y[2], y[3]), pk_bf16(y[4], y[5]), pk_bf16(y[6], y[7])};
        }
    }
}

struct EpiBf16G {
    static constexpr bool PERM = true, AFTER_DRAIN = false, I8 = false;
    bf16_t* O; int ldc; int act_cols;
    __device__ __forceinline__ void operator()(const f32x4 (&acc)[2][2][4][2], const pg8::Unit& u, int wr, int wc, int fr, int fq) const {
        const int row0 = u.pm * 256 + wr * 64 + fr, col0 = u.pn * 256 + wc * 32 + 8 * fq;
        const bool act = (u.pn * 256) < act_cols;
#pragma unroll
        for (int ai = 0; ai < 2; ++ai)
#pragma unroll
            for (int m = 0; m < 4; ++m) { bf16_t* rowp = O + (size_t)(row0 + ai * 128 + m * 16) * ldc + col0;
#pragma unroll
                for (int bj = 0; bj < 2; ++bj) { f32x4 v0 = acc[ai][bj][m][0], v1 = acc[ai][bj][m][1];
                    if (act) {
#pragma unroll
                        for (int e = 0; e < 4; ++e) { v0[e] = gelu_tanh(v0[e]); v1[e] = gelu_tanh(v1[e]); } }
                    u32x4 w; w.x = pk_bf16(v0[0], v0[1]); w.y = pk_bf16(v0[2], v0[3]); w.z = pk_bf16(v1[0], v1[1]); w.w = pk_bf16(v1[2], v1[3]);
                    *(u32x4*)(rowp + bj * 128) = w; } }
    }
};
struct EpiI8G {
    static constexpr bool PERM = true, AFTER_DRAIN = false, I8 = true;
    bf16_t* O; int ldc; int act_cols; const float* sa; const float* sw;
    __device__ __forceinline__ void operator()(const f32x4 (&acc)[2][2][4][2], const pg8::Unit& u, int wr, int wc, int fr, int fq) const {
        const int row0 = u.pm * 256 + wr * 64 + fr, col0 = u.pn * 256 + wc * 32 + 8 * fq;
        const bool act = (u.pn * 256) < act_cols;
        f32x4 cw[2][2];
#pragma unroll
        for (int bj = 0; bj < 2; ++bj) { cw[bj][0] = *(const f32x4*)(sw + col0 + bj * 128); cw[bj][1] = *(const f32x4*)(sw + col0 + bj * 128 + 4); }
#pragma unroll
        for (int ai = 0; ai < 2; ++ai)
#pragma unroll
            for (int m = 0; m < 4; ++m) { const int row = row0 + ai * 128 + m * 16; bf16_t* rowp = O + (size_t)row * ldc + col0; const float rs = sa[row];
#pragma unroll
                for (int bj = 0; bj < 2; ++bj) { f32x4 v0, v1;
#pragma unroll
                    for (int e = 0; e < 4; ++e) { v0[e] = (float)__float_as_int(acc[ai][bj][m][0][e]) * rs * cw[bj][0][e]; v1[e] = (float)__float_as_int(acc[ai][bj][m][1][e]) * rs * cw[bj][1][e]; }
                    if (act) {
#pragma unroll
                        for (int e = 0; e < 4; ++e) { v0[e] = gelu_tanh(v0[e]); v1[e] = gelu_tanh(v1[e]); } }
                    u32x4 w; w.x = pk_bf16(v0[0], v0[1]); w.y = pk_bf16(v0[2], v0[3]); w.z = pk_bf16(v1[0], v1[1]); w.w = pk_bf16(v1[2], v1[3]);
                    *(u32x4*)(rowp + bj * 128) = w; } }
    }
};
struct EpiQRope {
    static constexpr bool PERM = false, AFTER_DRAIN = false, I8 = false;
    bf16_t* Q; const float* rc; const float* rs;
    __device__ __forceinline__ void operator()(const f32x4 (&acc)[2][2][4][2], const pg8::Unit& u, int wr, int wc, int fr, int fq) const {
#pragma unroll
        for (int ai = 0; ai < 2; ++ai)
#pragma unroll
            for (int m = 0; m < 4; ++m) {
                const int row = u.pm * 256 + ai * 128 + wr * 64 + m * 16 + fr;
#pragma unroll
                for (int bj = 0; bj < 2; ++bj) {
                    const int cbase = u.pn * 256 + bj * 128 + wc * 32;
                    const bool rope = ((cbase >> 6) % 3) == 2; const int seg = (cbase >> 5) & 1;
                    f32x4 v0 = acc[ai][bj][m][0], v1 = acc[ai][bj][m][1];
                    if (rope) {
                        const f32x4 cs = *(const f32x4*)(rc + (size_t)row * 32 + seg * 16 + 4 * fq), sn = *(const f32x4*)(rs + (size_t)row * 32 + seg * 16 + 4 * fq);
                        const f32x4 o0 = v0 * cs - v1 * sn, o1 = v1 * cs + v0 * sn; v0 = o0; v1 = o1;
                    }
                    u32x2 w0, w1; w0.x = pk_bf16(v0[0], v0[1]); w0.y = pk_bf16(v0[2], v0[3]); w1.x = pk_bf16(v1[0], v1[1]); w1.y = pk_bf16(v1[2], v1[3]);
                    bf16_t* p = Q + (size_t)row * 1536 + cbase + 4 * fq;
                    *(u32x2*)p = w0; *(u32x2*)(p + 16) = w1;
                }
            }
    }
};
template <bool BASEF, bool Q8 = false>
struct EpiResid {
    static constexpr bool PERM = true, AFTER_DRAIN = false, I8 = Q8;
    const void* base; bf16_t* out; const float* gate; const float* sa; const float* sw;
    __device__ __forceinline__ void operator()(const f32x4 (&acc)[2][2][4][2], const pg8::Unit& u, int wr, int wc, int fr, int fq) const {
        const int row0 = u.pm * 256 + wr * 64 + fr, col0 = u.pn * 256 + wc * 32 + 8 * fq;
        f32x4 gv[2][2];
#pragma unroll
        for (int bj = 0; bj < 2; ++bj)
#pragma unroll
            for (int n = 0; n < 2; ++n) { gv[bj][n] = *(const f32x4*)(gate + col0 + bj * 128 + n * 4); if (Q8) gv[bj][n] *= *(const f32x4*)(sw + col0 + bj * 128 + n * 4); }
#pragma unroll
        for (int ai = 0; ai < 2; ++ai)
#pragma unroll
            for (int m = 0; m < 4; ++m) { const size_t off = (size_t)(row0 + ai * 128 + m * 16) * DM + col0; const float rs = Q8 ? sa[row0 + ai * 128 + m * 16] : 1.0f;
                f32x4 bs[2][2];
#pragma unroll
                for (int bj = 0; bj < 2; ++bj) {
                    if (BASEF) { bs[bj][0] = *(const f32x4*)((const float*)base + off + bj * 128); bs[bj][1] = *(const f32x4*)((const float*)base + off + bj * 128 + 4); }
                    else { const u32x4 w = *(const u32x4*)((const bf16_t*)base + off + bj * 128); bs[bj][0] = (f32x4){bf_lo(w.x), bf_hi(w.x), bf_lo(w.y), bf_hi(w.y)}; bs[bj][1] = (f32x4){bf_lo(w.z), bf_hi(w.z), bf_lo(w.w), bf_hi(w.w)}; } }
#pragma unroll
                for (int bj = 0; bj < 2; ++bj) { f32x4 a0 = acc[ai][bj][m][0], a1 = acc[ai][bj][m][1];
                    if (Q8) {
#pragma unroll
                        for (int e = 0; e < 4; ++e) { a0[e] = (float)__float_as_int(a0[e]) * rs; a1[e] = (float)__float_as_int(a1[e]) * rs; } }
                    const f32x4 v0 = bs[bj][0] + gv[bj][0] * a0, v1 = bs[bj][1] + gv[bj][1] * a1;
                    u32x4 w; w.x = pk_bf16(v0[0], v0[1]); w.y = pk_bf16(v0[2], v0[3]); w.z = pk_bf16(v1[0], v1[1]); w.w = pk_bf16(v1[2], v1[3]);
                    *(u32x4*)(out + off + bj * 128) = w; } }
    }
};
struct OrderIn0 : pg8::StaticOrder {
    int rounds;
    __device__ void init2(int G_, int c_) { init(SEQ, 4096, G_, c_); rounds = (nwg + G - 1) / G; }
    __device__ bool next(int i, pg8::Unit& u) const {
        if (pg8::StaticOrder::next(i, u)) return true;
        if (i == rounds && c < 2) { u.pm = 64; u.pn = 14 + c; return true; }
        return false;
    }
};

struct OrderKV : pg8::StaticOrder {
    __device__ bool next(int i, pg8::Unit& u) const {
        if (G != 256 || nwg != 520) return pg8::StaticOrder::next(i, u);
        int L;
        if (c >= 128) { if (i > 2) return false; L = i * 128 + (c - 128); }
        else { if (i == 0) L = 384 + c; else if (i == 1 && c < 8) L = 512 + c; else return false; }
        pg8::StaticOrder t = *this; t.c = L % G;
        return t.pg8::StaticOrder::next(L / G, u);
    }
};
namespace att {
constexpr int KVBLK = 64;
constexpr float SCALE = 0.07216878364870322f;
constexpr float THR = 8.f;
constexpr int LDQ = 1536, LDK = 2048, LDKR = 64, LDO = 2048;
#define KSWZ(row, colB) ((row) * 256 + ((colB) ^ (((row) & 15) << 4)))
#define KRSWZ(row, colB) ((row) * 128 + ((colB) ^ ((((row) >> 1) & 7) << 4)))
#define SBAR() __builtin_amdgcn_sched_barrier(0)
__device__ __forceinline__ int crow(int r, int hi) { return (r & 3) + 8 * (r >> 2) + 4 * hi; }

__device__ __forceinline__ void partialSM(f32x16& p0, f32x16& p1, float& m_reg, float& mn, float& alpha) {
    constexpr float C = SCALE * 1.4426950408889634f;
    float pmax = p0[0];
#pragma unroll
    for (int r = 1; r < 16; ++r) pmax = fmaxf(pmax, p0[r]);
#pragma unroll
    for (int r = 0; r < 16; ++r) pmax = fmaxf(pmax, p1[r]);
    { auto rr = __builtin_amdgcn_permlane32_swap(__float_as_uint(pmax), __float_as_uint(pmax), false, false);
      pmax = fmaxf(__uint_as_float(rr[0]), __uint_as_float(rr[1])); }
    const bool keep = __all(pmax - m_reg <= THR / SCALE);
    mn = keep ? m_reg : fmaxf(m_reg, pmax); alpha = __builtin_amdgcn_exp2f((m_reg - mn) * C); m_reg = mn;
    const float mnC = -mn * C;
#pragma unroll
    for (int r = 0; r < 16; ++r) p0[r] = fmaf(p0[r], C, mnC);
#pragma unroll
    for (int r = 0; r < 16; ++r) p1[r] = fmaf(p1[r], C, mnC);
#pragma unroll
    for (int r = 0; r < 8; ++r) p0[r] = __builtin_amdgcn_exp2f(p0[r]);
}
#define PK4(P, BASE, OUT) do { unsigned a0 = pk_bf16(P[BASE + 0], P[BASE + 1]), a1 = pk_bf16(P[BASE + 2], P[BASE + 3]);   \
    unsigned b0 = pk_bf16(P[BASE + 4], P[BASE + 5]), b1 = pk_bf16(P[BASE + 6], P[BASE + 7]);                              \
    auto r0 = __builtin_amdgcn_permlane32_swap(a0, b0, false, false); auto r1 = __builtin_amdgcn_permlane32_swap(a1, b1, false, false); \
    u32x4 w = {r0[0], r1[0], r0[1], r1[1]}; OUT = *reinterpret_cast<bf16x8*>(&w); } while (0)
__device__ __forceinline__ void finishSM(f32x16& p0, f32x16& p1, float alpha, float& l_reg, bf16x8& pa0, bf16x8& pa1, bf16x8& pa2, bf16x8& pa3) {
#pragma unroll
    for (int r = 8; r < 16; ++r) p0[r] = __builtin_amdgcn_exp2f(p0[r]);
#pragma unroll
    for (int r = 0; r < 16; ++r) p1[r] = __builtin_amdgcn_exp2f(p1[r]);
    float ps = 0;
#pragma unroll
    for (int r = 0; r < 16; ++r) ps += p0[r];
#pragma unroll
    for (int r = 0; r < 16; ++r) ps += p1[r];
    { auto rr = __builtin_amdgcn_permlane32_swap(__float_as_uint(ps), __float_as_uint(ps), false, false);
      ps = __uint_as_float(rr[0]) + __uint_as_float(rr[1]); }
    l_reg = l_reg * alpha + ps;
    PK4(p0, 0, pa0); PK4(p0, 8, pa1); PK4(p1, 0, pa2); PK4(p1, 8, pa3);
}
template <int S> __device__ __forceinline__ void fin_piece(f32x16& p0, f32x16& p1, float& ps, bf16x8& pa0, bf16x8& pa1, bf16x8& pa2) {
    if constexpr (S < 8) p0[8 + S] = __builtin_amdgcn_exp2f(p0[8 + S]); else p1[S - 8] = __builtin_amdgcn_exp2f(p1[S - 8]);
    if constexpr (S == 0) ps = p0[0] + p0[1]; else if constexpr (S < 7) ps += p0[S + 1];
    if constexpr (S >= 1 && S <= 8) ps += p0[7 + S]; else if constexpr (S >= 9) ps += p1[S - 9];
    if constexpr (S == 8) PK4(p0, 0, pa0);
    if constexpr (S == 10) PK4(p0, 8, pa1);
    if constexpr (S == 18) PK4(p1, 0, pa2);
}
template <int S> __device__ __forceinline__ void part_piece(f32x16& o0, f32x16& o1, float& ps, float al_old, float& l_reg, bf16x8& pa3,
                                                           f32x16& q0, f32x16& q1, float (&t)[4], float& m_reg, float& mn, float& alpha, float& mnC) {
    constexpr float C = SCALE * 1.4426950408889634f;
    if constexpr (S == 0) { ps += o1[15]; auto rr = __builtin_amdgcn_permlane32_swap(__float_as_uint(ps), __float_as_uint(ps), false, false);
                            ps = __uint_as_float(rr[0]) + __uint_as_float(rr[1]); l_reg = l_reg * al_old + ps; }
    if constexpr (S == 1) PK4(o1, 8, pa3);
    if constexpr (S == 2) { float m = q0[0];
#pragma unroll
        for (int r = 1; r < 8; ++r) m = fmaxf(m, q0[r]); t[0] = m; }
    if constexpr (S == 3) { float m = q0[8];
#pragma unroll
        for (int r = 9; r < 16; ++r) m = fmaxf(m, q0[r]); t[1] = m; }
    if constexpr (S == 4) { float m = q1[0];
#pragma unroll
        for (int r = 1; r < 8; ++r) m = fmaxf(m, q1[r]); t[2] = m; }
    if constexpr (S == 5) { float m = q1[8];
#pragma unroll
        for (int r = 9; r < 16; ++r) m = fmaxf(m, q1[r]); t[3] = m; }
    if constexpr (S == 6) { float pmax = fmaxf(fmaxf(t[0], t[1]), fmaxf(t[2], t[3]));
        auto rr = __builtin_amdgcn_permlane32_swap(__float_as_uint(pmax), __float_as_uint(pmax), false, false);
        t[0] = fmaxf(__uint_as_float(rr[0]), __uint_as_float(rr[1])); }
    if constexpr (S == 7) { const bool keep = __all(t[0] - m_reg <= THR / SCALE);
        mn = keep ? m_reg : fmaxf(m_reg, t[0]); alpha = __builtin_amdgcn_exp2f((m_reg - mn) * C); m_reg = mn; mnC = -mn * C; }
    if constexpr (S >= 8 && S < 12) {
#pragma unroll
        for (int r = 0; r < 4; ++r) q0[(S - 8) * 4 + r] = fmaf(q0[(S - 8) * 4 + r], C, mnC); }
    if constexpr (S >= 12) {
#pragma unroll
        for (int r = 0; r < 4; ++r) q1[(S - 12) * 4 + r] = fmaf(q1[(S - 12) * 4 + r], C, mnC); }
    if constexpr (S >= 9) q0[S - 9] = __builtin_amdgcn_exp2f(q0[S - 9]);
    if constexpr (S == 15) q0[7] = __builtin_amdgcn_exp2f(q0[7]);
}
__device__ __forceinline__ int v_st(int k, int c) { const int kk = (k & ~0xC) | ((k & 4) << 1) | ((k & 8) >> 1); return ((kk >> 3) * 4 + (c >> 5)) * 512 + ((kk & 7) * 32 + (c & 31)) * 2; }
__device__ __forceinline__ int v_rd_base(int lane) { return ((lane & 3) << 3) | (((lane >> 2) & 3) << 6) | (((lane >> 4) & 1) << 5) | (((lane >> 5) & 1) << 8); }
constexpr int v_rd_off(int d0, int ks, int half) { return d0 * 512 + ks * 4096 + half * 2048; }
template <int OFF> __device__ __forceinline__ s16x4 tr_read(int vb) {
    s16x4 r; asm volatile("ds_read_b64_tr_b16 %0, %1 offset:%2" : "=&v"(r) : "v"(vb), "i"(OFF) : "memory"); return r;
}
struct VFrag { s16x4 l0, h0, l1, h1, l2, h2, l3, h3; };
template <int D0> __device__ __forceinline__ void pv_read(VFrag& f, int vb) {
    f.l0 = tr_read<v_rd_off(D0, 0, 0)>(vb); f.h0 = tr_read<v_rd_off(D0, 0, 1)>(vb); f.l1 = tr_read<v_rd_off(D0, 1, 0)>(vb); f.h1 = tr_read<v_rd_off(D0, 1, 1)>(vb);
    f.l2 = tr_read<v_rd_off(D0, 2, 0)>(vb); f.h2 = tr_read<v_rd_off(D0, 2, 1)>(vb); f.l3 = tr_read<v_rd_off(D0, 3, 0)>(vb); f.h3 = tr_read<v_rd_off(D0, 3, 1)>(vb);
}
__device__ __forceinline__ void pv_mma(f32x16& od, const VFrag& f, bf16x8 pa0, bf16x8 pa1, bf16x8 pa2, bf16x8 pa3) {
#define PKV(L, H) (bf16x8){L[0], L[1], L[2], L[3], H[0], H[1], H[2], H[3]}
    od = __builtin_amdgcn_mfma_f32_32x32x16_bf16(pa0, PKV(f.l0, f.h0), od, 0, 0, 0);
    od = __builtin_amdgcn_mfma_f32_32x32x16_bf16(pa1, PKV(f.l1, f.h1), od, 0, 0, 0);
    od = __builtin_amdgcn_mfma_f32_32x32x16_bf16(pa2, PKV(f.l2, f.h2), od, 0, 0, 0);
    od = __builtin_amdgcn_mfma_f32_32x32x16_bf16(pa3, PKV(f.l3, f.h3), od, 0, 0, 0);
#undef PKV
}
__device__ __forceinline__ void pv_d0(f32x16* o, int vb, bf16x8 pa0, bf16x8 pa1, bf16x8 pa2, bf16x8 pa3) {
    VFrag fa, fb;
    pv_read<0>(fa, vb); pv_read<1>(fb, vb);
    asm volatile("s_waitcnt lgkmcnt(8)" ::: "memory"); SBAR(); pv_mma(o[0], fa, pa0, pa1, pa2, pa3); SBAR();
    pv_read<2>(fa, vb);
    asm volatile("s_waitcnt lgkmcnt(8)" ::: "memory"); SBAR(); pv_mma(o[1], fb, pa0, pa1, pa2, pa3); SBAR();
    pv_read<3>(fb, vb);
    asm volatile("s_waitcnt lgkmcnt(8)" ::: "memory"); SBAR(); pv_mma(o[2], fa, pa0, pa1, pa2, pa3); SBAR();
    asm volatile("s_waitcnt lgkmcnt(0)" ::: "memory"); SBAR(); pv_mma(o[3], fb, pa0, pa1, pa2, pa3);
}
constexpr int SLOTB = 40960, S_V = 0, S_KN = 16384, S_KR = 32768, OFF_QR = 3 * SLOTB, OFF_WS2 = OFF_QR + 32768, LDS_ATT2 = OFF_WS2 + 2048;
static_assert(LDS_ATT2 <= LDS_CTL, "attention LDS");
__device__ __forceinline__ void qkt2(f32x16& p0, f32x16& p1, const LAS unsigned char* slot, const LAS unsigned char* qrp, const bf16x8 (&qr)[8], int r32, int hi) {
    p0 = f32x16{}; p1 = f32x16{};
    const LAS unsigned char* Kn = slot + S_KN; const LAS unsigned char* Kr = slot + S_KR;
    bf16x8 a0 = *(const LAS bf16x8*)(Kn + KSWZ(r32, (hi * 8) * 2)), a1 = *(const LAS bf16x8*)(Kn + KSWZ(32 + r32, (hi * 8) * 2));
#pragma unroll
    for (int d0 = 0; d0 < 8; ++d0) {
        bf16x8 n0, n1;
        if (d0 < 7) { const int cb = ((d0 + 1) * 16 + hi * 8) * 2; n0 = *(const LAS bf16x8*)(Kn + KSWZ(r32, cb)); n1 = *(const LAS bf16x8*)(Kn + KSWZ(32 + r32, cb)); }
        else { const int cb = (hi * 8) * 2; n0 = *(const LAS bf16x8*)(Kr + KRSWZ(r32, cb)); n1 = *(const LAS bf16x8*)(Kr + KRSWZ(32 + r32, cb)); }
        p0 = __builtin_amdgcn_mfma_f32_32x32x16_bf16(a0, qr[d0], p0, 0, 0, 0);
        p1 = __builtin_amdgcn_mfma_f32_32x32x16_bf16(a1, qr[d0], p1, 0, 0, 0);
        a0 = n0; a1 = n1;
    }
    bf16x8 qq = *(const LAS bf16x8*)(qrp + (((hi * 8) * 2) ^ (((r32 >> 1) & 7) << 4)));
#pragma unroll
    for (int d0 = 0; d0 < 4; ++d0) {
        bf16x8 n0, n1, nq;
        if (d0 < 3) { const int cb = ((d0 + 1) * 16 + hi * 8) * 2; n0 = *(const LAS bf16x8*)(Kr + KRSWZ(r32, cb)); n1 = *(const LAS bf16x8*)(Kr + KRSWZ(32 + r32, cb)); nq = *(const LAS bf16x8*)(qrp + (cb ^ (((r32 >> 1) & 7) << 4))); }
        p0 = __builtin_amdgcn_mfma_f32_32x32x16_bf16(a0, qq, p0, 0, 0, 0);
        p1 = __builtin_amdgcn_mfma_f32_32x32x16_bf16(a1, qq, p1, 0, 0, 0);
        if (d0 < 3) { a0 = n0; a1 = n1; qq = nq; }
    }
}
__device__ __forceinline__ void s1_step(f32x16& q0, f32x16& q1, const LAS unsigned char* slot, const LAS unsigned char* qrp, const bf16x8 (&qr)[8], int r32, int hi,
                                        f32x16& p0, f32x16& p1, float& ps, bf16x8& pa0, bf16x8& pa1, bf16x8& pa2) {
    q0 = f32x16{}; q1 = f32x16{};
    const LAS unsigned char* Kn = slot + S_KN; const LAS unsigned char* Kr = slot + S_KR;
    bf16x8 a0 = *(const LAS bf16x8*)(Kn + KSWZ(r32, (hi * 8) * 2)), a1 = *(const LAS bf16x8*)(Kn + KSWZ(32 + r32, (hi * 8) * 2)), qq = a0;
#define S1_STEP(D) do { bf16x8 n0 = a0, n1 = a1, nq = qq; \
        if ((D) < 7) { const int cb = (((D) + 1) * 16 + hi * 8) * 2; n0 = *(const LAS bf16x8*)(Kn + KSWZ(r32, cb)); n1 = *(const LAS bf16x8*)(Kn + KSWZ(32 + r32, cb)); } \
        else if ((D) < 11) { const int cb = (((D) - 7) * 16 + hi * 8) * 2; n0 = *(const LAS bf16x8*)(Kr + KRSWZ(r32, cb)); n1 = *(const LAS bf16x8*)(Kr + KRSWZ(32 + r32, cb)); \
                             nq = *(const LAS bf16x8*)(qrp + (cb ^ (((r32 >> 1) & 7) << 4))); } \
        q0 = __builtin_amdgcn_mfma_f32_32x32x16_bf16(a0, (D) < 8 ? qr[(D) & 7] : qq, q0, 0, 0, 0); fin_piece<2 * (D)>(p0, p1, ps, pa0, pa1, pa2); SBAR(); \
        q1 = __builtin_amdgcn_mfma_f32_32x32x16_bf16(a1, (D) < 8 ? qr[(D) & 7] : qq, q1, 0, 0, 0); fin_piece<2 * (D) + 1>(p0, p1, ps, pa0, pa1, pa2); SBAR(); \
        a0 = n0; a1 = n1; qq = nq; } while (0)
    S1_STEP(0); S1_STEP(1); S1_STEP(2); S1_STEP(3); S1_STEP(4); S1_STEP(5); S1_STEP(6); S1_STEP(7); S1_STEP(8); S1_STEP(9); S1_STEP(10); S1_STEP(11);
#undef S1_STEP
}
__device__ __forceinline__ void s2_step(f32x16* o, int vb, bf16x8 pa0, bf16x8 pa1, bf16x8 pa2, bf16x8& pa3, f32x16& po0, f32x16& po1, float& ps, float al_old, float& l_reg,
                                        f32x16& q0, f32x16& q1, float& m_reg, float& mn, float& alpha) {
    VFrag fa, fb; float t[4] = {0.f, 0.f, 0.f, 0.f}, mnC = 0.f;
#define PKV(L, H) (bf16x8){L[0], L[1], L[2], L[3], H[0], H[1], H[2], H[3]}
#define S2_MMA(OD, L, H, PA, S) do { OD = __builtin_amdgcn_mfma_f32_32x32x16_bf16(PA, PKV(L, H), OD, 0, 0, 0); part_piece<S>(po0, po1, ps, al_old, l_reg, pa3, q0, q1, t, m_reg, mn, alpha, mnC); SBAR(); } while (0)
    pv_read<0>(fa, vb); pv_read<1>(fb, vb);
    asm volatile("s_waitcnt lgkmcnt(8)" ::: "memory"); SBAR();
    S2_MMA(o[0], fa.l0, fa.h0, pa0, 0); S2_MMA(o[0], fa.l1, fa.h1, pa1, 1); S2_MMA(o[0], fa.l2, fa.h2, pa2, 2); S2_MMA(o[0], fa.l3, fa.h3, pa3, 3);
    pv_read<2>(fa, vb);
    asm volatile("s_waitcnt lgkmcnt(8)" ::: "memory"); SBAR();
    S2_MMA(o[1], fb.l0, fb.h0, pa0, 4); S2_MMA(o[1], fb.l1, fb.h1, pa1, 5); S2_MMA(o[1], fb.l2, fb.h2, pa2, 6); S2_MMA(o[1], fb.l3, fb.h3, pa3, 7);
    pv_read<3>(fb, vb);
    asm volatile("s_waitcnt lgkmcnt(8)" ::: "memory"); SBAR();
    S2_MMA(o[2], fa.l0, fa.h0, pa0, 8); S2_MMA(o[2], fa.l1, fa.h1, pa1, 9); S2_MMA(o[2], fa.l2, fa.h2, pa2, 10); S2_MMA(o[2], fa.l3, fa.h3, pa3, 11);
    asm volatile("s_waitcnt lgkmcnt(0)" ::: "memory"); SBAR();
    S2_MMA(o[3], fb.l0, fb.h0, pa0, 12); S2_MMA(o[3], fb.l1, fb.h1, pa1, 13); S2_MMA(o[3], fb.l2, fb.h2, pa2, 14); S2_MMA(o[3], fb.l3, fb.h3, pa3, 15);
    asm volatile("" : "+v"(q0), "+v"(q1));
#undef S2_MMA
#undef PKV
}
__device__ __forceinline__ void attn_body(const bf16_t* __restrict__ Qb, const bf16_t* __restrict__ Kh, const bf16_t* __restrict__ Krp, const bf16_t* __restrict__ Vh,
                                          bf16_t* __restrict__ Ob, int seq, LAS unsigned char* lds) {
    int tid = threadIdx.x; asm volatile("" : "+v"(tid));
    const int wid = __builtin_amdgcn_readfirstlane(tid >> 6), lane = tid & 63, r32 = lane & 31, hi = lane >> 5;
    LAS float* ws = (LAS float*)(lds + OFF_WS2) + wid * 64; LAS float* li_l = ws; LAS float* al_l = ws + 32;
    LAS unsigned char* qrp = lds + OFF_QR + (wid * 32 + r32) * 128;
    float m_reg = -1e30f, l_reg = 0; f32x16 o[4] = {}; bf16x8 qr[8];
    const bf16_t* Qw = Qb + (long)(wid * 32 + r32) * LDQ + hi * 8;
#pragma unroll
    for (int d0 = 0; d0 < 8; ++d0) qr[d0] = *(const bf16x8*)(Qw + d0 * 16);
#pragma unroll
    for (int d0 = 0; d0 < 4; ++d0) { const bf16x8 q = *(const bf16x8*)(Qw + 128 + d0 * 16); const int cb = (d0 * 16 + hi * 8) * 2;
        *(LAS bf16x8*)(qrp + (cb ^ (((r32 >> 1) & 7) << 4))) = q; }
#define OFF_V() ({ const int u_ = wid * 64 + lane, sub_ = u_ >> 5, within_ = u_ & 31, kk_ = ((sub_ >> 2) << 3) | (within_ >> 2), c_ = ((sub_ & 3) << 5) | ((within_ & 3) << 3); \
                  const int k_ = (kk_ & ~0xC) | ((kk_ & 4) << 1) | ((kk_ & 8) >> 1); (unsigned)(k_ * LDK + c_); })
#define OFF_K() ({ const int u_ = wid * 64 + lane, row_ = u_ >> 4, sl_ = u_ & 15; (unsigned)(row_ * LDK + ((sl_ ^ (row_ & 15)) << 3)); })
#define OFF_R() ({ const int u_ = wid * 64 + lane, row_ = u_ >> 3, sl_ = u_ & 7; (unsigned)(row_ * LDKR + ((sl_ ^ ((row_ >> 1) & 7)) << 3)); })
    const int vbase = (int)(unsigned)(uintptr_t)lds + v_rd_base(lane);
#define DMA(t, slot) do { const bf16_t* vh_ = Vh + (size_t)(t) * KVBLK * LDK; const bf16_t* kh_ = Kh + (size_t)(t) * KVBLK * LDK; const bf16_t* kr_ = Krp + (size_t)(t) * KVBLK * LDKR; \
    LAS unsigned char* sb_ = lds + (slot) * SLOTB; \
    __builtin_amdgcn_global_load_lds((const unsigned*)(vh_ + OFF_V()), (LAS unsigned*)(sb_ + S_V + wid * 1024), 16, 0, 0); \
    __builtin_amdgcn_global_load_lds((const unsigned*)(vh_ + OFF_V() + 32 * LDK), (LAS unsigned*)(sb_ + S_V + (wid + 8) * 1024), 16, 0, 0); \
    __builtin_amdgcn_global_load_lds((const unsigned*)(kh_ + OFF_K()), (LAS unsigned*)(sb_ + S_KN + wid * 1024), 16, 0, 0); \
    __builtin_amdgcn_global_load_lds((const unsigned*)(kh_ + OFF_K() + 32 * LDK), (LAS unsigned*)(sb_ + S_KN + (wid + 8) * 1024), 16, 0, 0); \
    __builtin_amdgcn_global_load_lds((const unsigned*)(kr_ + OFF_R()), (LAS unsigned*)(sb_ + S_KR + wid * 1024), 16, 0, 0); } while (0)
#define RESC(a) do { if (__any((a) < 1.f)) { if (hi == 0) al_l[r32] = (a); asm volatile("s_waitcnt lgkmcnt(0)" ::: "memory"); \
    _Pragma("unroll") for (int d = 0; d < 4; ++d) _Pragma("unroll") for (int r = 0; r < 16; ++r) o[d][r] *= al_l[crow(r, hi)]; } } while (0)
#define TILE_SYNC() do { asm volatile("s_waitcnt vmcnt(0)" ::: "memory"); __syncthreads(); } while (0)
    f32x16 pA0, pA1, pB0, pB1; float mnA, mnB, alA, alB, psum = 0.f; bf16x8 pa0, pa1, pa2, pa3; const int NT = seq / KVBLK;
    DMA(0, 0); DMA(1, 1);
    TILE_SYNC();
    qkt2(pA0, pA1, lds, qrp, qr, r32, hi); partialSM(pA0, pA1, m_reg, mnA, alA);
    int s_prev = 0, s_cur = 1, s_next = 2;
    for (int j = 1; j + 1 < NT; j += 2) {
        DMA(j + 1, s_next);
        SBAR(); s1_step(pB0, pB1, lds + s_cur * SLOTB, qrp, qr, r32, hi, pA0, pA1, psum, pa0, pa1, pa2);
        s2_step(o, vbase + s_prev * SLOTB, pa0, pa1, pa2, pa3, pA0, pA1, psum, alA, l_reg, pB0, pB1, m_reg, mnB, alB);
        TILE_SYNC(); RESC(alB);
        { const int t_ = s_prev; s_prev = s_cur; s_cur = s_next; s_next = t_; }
        if (j + 2 < NT) DMA(j + 2, s_next);
        SBAR(); s1_step(pA0, pA1, lds + s_cur * SLOTB, qrp, qr, r32, hi, pB0, pB1, psum, pa0, pa1, pa2);
        s2_step(o, vbase + s_prev * SLOTB, pa0, pa1, pa2, pa3, pB0, pB1, psum, alB, l_reg, pA0, pA1, m_reg, mnA, alA);
        TILE_SYNC(); RESC(alA);
        { const int t_ = s_prev; s_prev = s_cur; s_cur = s_next; s_next = t_; }
    }
    SBAR(); qkt2(pB0, pB1, lds + s_cur * SLOTB, qrp, qr, r32, hi);
    finishSM(pA0, pA1, alA, l_reg, pa0, pa1, pa2, pa3); SBAR();
    pv_d0(o, vbase + s_prev * SLOTB, pa0, pa1, pa2, pa3); partialSM(pB0, pB1, m_reg, mnB, alB);
    RESC(alB);
    finishSM(pB0, pB1, alB, l_reg, pa0, pa1, pa2, pa3); SBAR();
    pv_d0(o, vbase + s_cur * SLOTB, pa0, pa1, pa2, pa3);
    if (hi == 0) li_l[r32] = l_reg; asm volatile("s_waitcnt lgkmcnt(0)" ::: "memory");
    float rli[16];
#pragma unroll
    for (int r = 0; r < 16; ++r) rli[r] = __builtin_amdgcn_rcpf(li_l[crow(r, hi)]);
    bf16_t* Ow = Ob + (long)(wid * 32) * LDO;
#pragma unroll
    for (int r = 0; r < 16; ++r) { const int orow = crow(r, hi);
#pragma unroll
        for (int d0 = 0; d0 < 4; ++d0) Ow[(long)orow * LDO + d0 * 32 + r32] = f2bf(o[d0][r] * rli[r]); }
    __syncthreads();
#undef DMA
#undef OFF_V
#undef OFF_K
#undef OFF_R
#undef RESC
#undef TILE_SYNC
}

constexpr int SLOTB8 = 28672, S8_V = 0, S8_KN = 16384, S8_KR = 24576, OFF8_WS = 3 * SLOTB8, OFF8_SK = OFF8_WS + 2048, LDS_ATT8 = OFF8_SK + 2048;
static_assert(LDS_ATT8 <= LDS_CTL, "attention LDS (int8)");
typedef int i32x4v __attribute__((ext_vector_type(4)));
typedef int i32x16v __attribute__((ext_vector_type(16)));
#define K8N_SWZ(row, ch) ((row) * 128 + ((((ch)) ^ (((row) >> 1) & 7)) << 4))
#define K8R_SWZ(row, ch) ((row) * 64 + ((((ch)) ^ (((row) >> 2) & 3)) << 4))
__device__ __forceinline__ unsigned q8pack(float a, float b, float c, float d) {
    const int q0 = (int)rintf(a), q1 = (int)rintf(b), q2 = (int)rintf(c), q3 = (int)rintf(d);
    return (unsigned)((q0 & 255) | ((q1 & 255) << 8) | ((q2 & 255) << 16) | ((q3 & 255) << 24));
}
__device__ __forceinline__ void kq_phase(const Fr& F, const bf16_t* KV, const bf16_t* KR, unsigned char* K8N, unsigned char* K8R, float* SK, int nkey) {
    const int ntile = nkey / 64, kq = F.lane >> 3, ch = F.lane & 7;
    for (int it = F.bid * 8 + F.wave; it < ntile * 8; it += F.G * 8) {
        const int h = it & 7, t = it >> 3;
        u32x4 n[8][2]; u32x4 r[8];
#pragma unroll
        for (int g = 0; g < 8; ++g) { const size_t key = (size_t)t * 64 + g * 8 + kq;
            n[g][0] = *(const u32x4*)(KV + key * LDK + h * 256 + ch * 16); n[g][1] = *(const u32x4*)(KV + key * LDK + h * 256 + ch * 16 + 8);
            r[g] = *(const u32x4*)(KR + key * LDKR + ch * 8); }
        float am = 0.f;
#pragma unroll
        for (int g = 0; g < 8; ++g) {
#pragma unroll
            for (int q = 0; q < 4; ++q) { am = fmaxf(am, fmaxf(fabsf(bf_lo(n[g][0][q])), fabsf(bf_hi(n[g][0][q])))); am = fmaxf(am, fmaxf(fabsf(bf_lo(n[g][1][q])), fabsf(bf_hi(n[g][1][q]))));
                am = fmaxf(am, fmaxf(fabsf(bf_lo(r[g][q])), fabsf(bf_hi(r[g][q])))); } }
#pragma unroll
        for (int o = 32; o >= 1; o >>= 1) am = fmaxf(am, __shfl_xor(am, o));
        const float inv = am > 0.f ? 127.0f / am : 0.f;
#pragma unroll
        for (int g = 0; g < 8; ++g) { const size_t key = (size_t)t * 64 + g * 8 + kq;
            u32x4 w;
            w.x = q8pack(bf_lo(n[g][0].x) * inv, bf_hi(n[g][0].x) * inv, bf_lo(n[g][0].y) * inv, bf_hi(n[g][0].y) * inv);
            w.y = q8pack(bf_lo(n[g][0].z) * inv, bf_hi(n[g][0].z) * inv, bf_lo(n[g][0].w) * inv, bf_hi(n[g][0].w) * inv);
            w.z = q8pack(bf_lo(n[g][1].x) * inv, bf_hi(n[g][1].x) * inv, bf_lo(n[g][1].y) * inv, bf_hi(n[g][1].y) * inv);
            w.w = q8pack(bf_lo(n[g][1].z) * inv, bf_hi(n[g][1].z) * inv, bf_lo(n[g][1].w) * inv, bf_hi(n[g][1].w) * inv);
            *(u32x4*)(K8N + ((size_t)h * nkey + key) * 128 + ch * 16) = w;
            u32x2 v;
            v.x = q8pack(bf_lo(r[g].x) * inv, bf_hi(r[g].x) * inv, bf_lo(r[g].y) * inv, bf_hi(r[g].y) * inv);
            v.y = q8pack(bf_lo(r[g].z) * inv, bf_hi(r[g].z) * inv, bf_lo(r[g].w) * inv, bf_hi(r[g].w) * inv);
            *(u32x2*)(K8R + ((size_t)h * nkey + key) * 64 + ch * 8) = v; }
        if (F.lane == 0) SK[h * ntile + t] = am > 0.f ? am * (1.0f / 127.0f) : 1.0f;
    }
}
#define QK8_FRAG(S, ROW) ((S) < 4 ? *(const LAS i32x4v*)(Kn + K8N_SWZ((ROW), (S) * 2 + hi)) : *(const LAS i32x4v*)(Kr + K8R_SWZ((ROW), ((S) - 4) * 2 + hi)))
__device__ __forceinline__ void qkt8(f32x16& p0, f32x16& p1, const LAS unsigned char* slot, const i32x4v (&qi)[6], int r32, int hi) {
    const LAS unsigned char* Kn = slot + S8_KN; const LAS unsigned char* Kr = slot + S8_KR;
    i32x16v c0 = {}, c1 = {};
    i32x4v a0 = QK8_FRAG(0, r32), a1 = QK8_FRAG(0, 32 + r32);
#pragma unroll
    for (int s = 0; s < 6; ++s) {
        i32x4v n0 = a0, n1 = a1;
        if (s < 5) { n0 = QK8_FRAG(s + 1, r32); n1 = QK8_FRAG(s + 1, 32 + r32); }
        c0 = __builtin_amdgcn_mfma_i32_32x32x32_i8(a0, qi[s], c0, 0, 0, 0);
        c1 = __builtin_amdgcn_mfma_i32_32x32x32_i8(a1, qi[s], c1, 0, 0, 0);
        a0 = n0; a1 = n1;
    }
    p0 = __builtin_bit_cast(f32x16, c0); p1 = __builtin_bit_cast(f32x16, c1);
}
__device__ __forceinline__ void i2f_scores(f32x16& p0, f32x16& p1, float mraw) {
#pragma unroll
    for (int r = 0; r < 16; ++r) { p0[r] = (float)__float_as_int(p0[r]) * mraw; p1[r] = (float)__float_as_int(p1[r]) * mraw; }
}
__device__ __forceinline__ void s1_step8(f32x16& q0, f32x16& q1, const LAS unsigned char* slot, const i32x4v (&qi)[6], int r32, int hi,
                                         f32x16& p0, f32x16& p1, float& ps, bf16x8& pa0, bf16x8& pa1, bf16x8& pa2) {
    const LAS unsigned char* Kn = slot + S8_KN; const LAS unsigned char* Kr = slot + S8_KR;
    i32x16v c0 = {}, c1 = {};
    i32x4v a0 = QK8_FRAG(0, r32), a1 = QK8_FRAG(0, 32 + r32);
#define S1_STEP8(S) do { i32x4v n0 = a0, n1 = a1; \
        if ((S) < 5) { n0 = QK8_FRAG((S) + 1, r32); n1 = QK8_FRAG((S) + 1, 32 + r32); } \
        c0 = __builtin_amdgcn_mfma_i32_32x32x32_i8(a0, qi[S], c0, 0, 0, 0); fin_piece<4 * (S)>(p0, p1, ps, pa0, pa1, pa2); SBAR(); fin_piece<4 * (S) + 1>(p0, p1, ps, pa0, pa1, pa2); SBAR(); \
        c1 = __builtin_amdgcn_mfma_i32_32x32x32_i8(a1, qi[S], c1, 0, 0, 0); fin_piece<4 * (S) + 2>(p0, p1, ps, pa0, pa1, pa2); SBAR(); fin_piece<4 * (S) + 3>(p0, p1, ps, pa0, pa1, pa2); SBAR(); \
        a0 = n0; a1 = n1; } while (0)
    S1_STEP8(0); S1_STEP8(1); S1_STEP8(2); S1_STEP8(3); S1_STEP8(4); S1_STEP8(5);
#undef S1_STEP8
    q0 = __builtin_bit_cast(f32x16, c0); q1 = __builtin_bit_cast(f32x16, c1);
}
template <int S> __device__ __forceinline__ void part_piece8(f32x16& o0, f32x16& o1, float& ps, float al_old, float& l_reg, bf16x8& pa3,
                                                            f32x16& q0, f32x16& q1, int (&ti)[4], float& tf, float mraw, float& m_reg, float& mn, float& alpha, float& mnC) {
    constexpr float C = SCALE * 1.4426950408889634f;
    if constexpr (S == 0) { ps += o1[15]; auto rr = __builtin_amdgcn_permlane32_swap(__float_as_uint(ps), __float_as_uint(ps), false, false);
                            ps = __uint_as_float(rr[0]) + __uint_as_float(rr[1]); l_reg = l_reg * al_old + ps; }
    if constexpr (S == 1) PK4(o1, 8, pa3);
    if constexpr (S == 2) { int m = __float_as_int(q0[0]);
#pragma unroll
        for (int r = 1; r < 8; ++r) m = max(m, __float_as_int(q0[r])); ti[0] = m; }
    if constexpr (S == 3) { int m = __float_as_int(q0[8]);
#pragma unroll
        for (int r = 9; r < 16; ++r) m = max(m, __float_as_int(q0[r])); ti[1] = m; }
    if constexpr (S == 4) { int m = __float_as_int(q1[0]);
#pragma unroll
        for (int r = 1; r < 8; ++r) m = max(m, __float_as_int(q1[r])); ti[2] = m; }
    if constexpr (S == 5) { int m = __float_as_int(q1[8]);
#pragma unroll
        for (int r = 9; r < 16; ++r) m = max(m, __float_as_int(q1[r])); ti[3] = m; }
    if constexpr (S == 6) { const float pmax = (float)max(max(ti[0], ti[1]), max(ti[2], ti[3])) * mraw;
        auto rr = __builtin_amdgcn_permlane32_swap(__float_as_uint(pmax), __float_as_uint(pmax), false, false);
        tf = fmaxf(__uint_as_float(rr[0]), __uint_as_float(rr[1])); }
    if constexpr (S == 7) { const bool keep = __all(tf - m_reg <= THR / SCALE);
        mn = keep ? m_reg : fmaxf(m_reg, tf); alpha = __builtin_amdgcn_exp2f((m_reg - mn) * C); m_reg = mn; mnC = -mn * C; }
    if constexpr (S >= 8 && S < 12) {
#pragma unroll
        for (int r = 0; r < 4; ++r) q0[(S - 8) * 4 + r] = fmaf((float)__float_as_int(q0[(S - 8) * 4 + r]), mraw * C, mnC); }
    if constexpr (S >= 12) {
#pragma unroll
        for (int r = 0; r < 4; ++r) q1[(S - 12) * 4 + r] = fmaf((float)__float_as_int(q1[(S - 12) * 4 + r]), mraw * C, mnC); }
    if constexpr (S >= 9) q0[S - 9] = __builtin_amdgcn_exp2f(q0[S - 9]);
    if constexpr (S == 15) q0[7] = __builtin_amdgcn_exp2f(q0[7]);
}
__device__ __forceinline__ void s2_step8(f32x16* o, int vb, bf16x8 pa0, bf16x8 pa1, bf16x8 pa2, bf16x8& pa3, f32x16& po0, f32x16& po1, float& ps, float al_old, float& l_reg,
                                         f32x16& q0, f32x16& q1, float mraw, float& m_reg, float& mn, float& alpha) {
    VFrag fa, fb; int ti[4] = {0, 0, 0, 0}; float tf = 0.f, mnC = 0.f;
#define PKV(L, H) (bf16x8){L[0], L[1], L[2], L[3], H[0], H[1], H[2], H[3]}
#define S2_MMA(OD, L, H, PA, S) do { OD = __builtin_amdgcn_mfma_f32_32x32x16_bf16(PA, PKV(L, H), OD, 0, 0, 0); part_piece8<S>(po0, po1, ps, al_old, l_reg, pa3, q0, q1, ti, tf, mraw, m_reg, mn, alpha, mnC); SBAR(); } while (0)
    pv_read<0>(fa, vb); pv_read<1>(fb, vb);
    asm volatile("s_waitcnt lgkmcnt(8)" ::: "memory"); SBAR();
    S2_MMA(o[0], fa.l0, fa.h0, pa0, 0); S2_MMA(o[0], fa.l1, fa.h1, pa1, 1); S2_MMA(o[0], fa.l2, fa.h2, pa2, 2); S2_MMA(o[0], fa.l3, fa.h3, pa3, 3);
    pv_read<2>(fa, vb);
    asm volatile("s_waitcnt lgkmcnt(8)" ::: "memory"); SBAR();
    S2_MMA(o[1], fb.l0, fb.h0, pa0, 4); S2_MMA(o[1], fb.l1, fb.h1, pa1, 5); S2_MMA(o[1], fb.l2, fb.h2, pa2, 6); S2_MMA(o[1], fb.l3, fb.h3, pa3, 7);
    pv_read<3>(fb, vb);
    asm volatile("s_waitcnt lgkmcnt(8)" ::: "memory"); SBAR();
    S2_MMA(o[2], fa.l0, fa.h0, pa0, 8); S2_MMA(o[2], fa.l1, fa.h1, pa1, 9); S2_MMA(o[2], fa.l2, fa.h2, pa2, 10); S2_MMA(o[2], fa.l3, fa.h3, pa3, 11);
    asm volatile("s_waitcnt lgkmcnt(0)" ::: "memory"); SBAR();
    S2_MMA(o[3], fb.l0, fb.h0, pa0, 12); S2_MMA(o[3], fb.l1, fb.h1, pa1, 13); S2_MMA(o[3], fb.l2, fb.h2, pa2, 14); S2_MMA(o[3], fb.l3, fb.h3, pa3, 15);
    asm volatile("" : "+v"(q0), "+v"(q1));
#undef S2_MMA
#undef PKV
}
__device__ __forceinline__ void attn_body8(const bf16_t* __restrict__ Qb, const unsigned char* __restrict__ K8n, const unsigned char* __restrict__ K8r, const float* __restrict__ SKh,
                                           const bf16_t* __restrict__ Vh, bf16_t* __restrict__ Ob, int seq, LAS unsigned char* lds) {
    int tid = threadIdx.x; asm volatile("" : "+v"(tid));
    const int wid = __builtin_amdgcn_readfirstlane(tid >> 6), lane = tid & 63, r32 = lane & 31, hi = lane >> 5;
    LAS float* ws = (LAS float*)(lds + OFF8_WS) + wid * 64; LAS float* li_l = ws; LAS float* al_l = ws + 32;
    float m_reg = -1e30f, l_reg = 0; f32x16 o[4] = {}; i32x4v qi[6]; float sq;
    {
        const bf16_t* Qw = Qb + (long)(wid * 32 + r32) * LDQ + hi * 16;
        u32x4 w[6][2];
#pragma unroll
        for (int s = 0; s < 6; ++s) { w[s][0] = *(const u32x4*)(Qw + s * 32); w[s][1] = *(const u32x4*)(Qw + s * 32 + 8); }
        float am = 0.f;
#pragma unroll
        for (int s = 0; s < 6; ++s)
#pragma unroll
            for (int q = 0; q < 4; ++q) { am = fmaxf(am, fmaxf(fabsf(bf_lo(w[s][0][q])), fabsf(bf_hi(w[s][0][q])))); am = fmaxf(am, fmaxf(fabsf(bf_lo(w[s][1][q])), fabsf(bf_hi(w[s][1][q])))); }
        { auto rr = __builtin_amdgcn_permlane32_swap(__float_as_uint(am), __float_as_uint(am), false, false); am = fmaxf(__uint_as_float(rr[0]), __uint_as_float(rr[1])); }
        const float inv = am > 0.f ? 127.0f / am : 0.f; sq = am * (1.0f / 127.0f);
#pragma unroll
        for (int s = 0; s < 6; ++s) {
            qi[s].x = (int)q8pack(bf_lo(w[s][0].x) * inv, bf_hi(w[s][0].x) * inv, bf_lo(w[s][0].y) * inv, bf_hi(w[s][0].y) * inv);
            qi[s].y = (int)q8pack(bf_lo(w[s][0].z) * inv, bf_hi(w[s][0].z) * inv, bf_lo(w[s][0].w) * inv, bf_hi(w[s][0].w) * inv);
            qi[s].z = (int)q8pack(bf_lo(w[s][1].x) * inv, bf_hi(w[s][1].x) * inv, bf_lo(w[s][1].y) * inv, bf_hi(w[s][1].y) * inv);
            qi[s].w = (int)q8pack(bf_lo(w[s][1].z) * inv, bf_hi(w[s][1].z) * inv, bf_lo(w[s][1].w) * inv, bf_hi(w[s][1].w) * inv); }
    }
#define OFF_V() ({ const int u_ = wid * 64 + lane, sub_ = u_ >> 5, within_ = u_ & 31, kk_ = ((sub_ >> 2) << 3) | (within_ >> 2), c_ = ((sub_ & 3) << 5) | ((within_ & 3) << 3); \
                  const int k_ = (kk_ & ~0xC) | ((kk_ & 4) << 1) | ((kk_ & 8) >> 1); (unsigned)(k_ * LDK + c_); })
#define OFF_KN8() ({ const int u_ = wid * 64 + lane, row_ = u_ >> 3, c_ = u_ & 7; (unsigned)(row_ * 128 + ((c_ ^ ((row_ >> 1) & 7)) << 4)); })
#define OFF_KR8() ({ const int u_ = wid * 64 + lane, row_ = u_ >> 2, c_ = u_ & 3; (unsigned)(row_ * 64 + ((c_ ^ ((row_ >> 2) & 3)) << 4)); })
    const int vbase = (int)(unsigned)(uintptr_t)lds + v_rd_base(lane);
#define DMA(t, slot) do { const bf16_t* vh_ = Vh + (size_t)(t) * KVBLK * LDK; LAS unsigned char* sb_ = lds + (slot) * SLOTB8; \
    __builtin_amdgcn_global_load_lds((const unsigned*)(vh_ + OFF_V()), (LAS unsigned*)(sb_ + S8_V + wid * 1024), 16, 0, 0); \
    __builtin_amdgcn_global_load_lds((const unsigned*)(vh_ + OFF_V() + 32 * LDK), (LAS unsigned*)(sb_ + S8_V + (wid + 8) * 1024), 16, 0, 0); \
    __builtin_amdgcn_global_load_lds((const unsigned*)(K8n + (size_t)(t) * 8192 + OFF_KN8()), (LAS unsigned*)(sb_ + S8_KN + wid * 1024), 16, 0, 0); \
    if (wid < 4) __builtin_amdgcn_global_load_lds((const unsigned*)(K8r + (size_t)(t) * 4096 + OFF_KR8()), (LAS unsigned*)(sb_ + S8_KR + wid * 1024), 16, 0, 0); } while (0)
#define RESC(a) do { if (__any((a) < 1.f)) { if (hi == 0) al_l[r32] = (a); asm volatile("s_waitcnt lgkmcnt(0)" ::: "memory"); \
    _Pragma("unroll") for (int d = 0; d < 4; ++d) _Pragma("unroll") for (int r = 0; r < 16; ++r) o[d][r] *= al_l[crow(r, hi)]; } } while (0)
#define TILE_SYNC() do { asm volatile("s_waitcnt vmcnt(0)" ::: "memory"); __syncthreads(); } while (0)
    f32x16 pA0, pA1, pB0, pB1; float mnA, mnB, alA, alB, psum = 0.f; bf16x8 pa0, pa1, pa2, pa3; const int NT = seq / KVBLK;
    LAS float* skl = (LAS float*)(lds + OFF8_SK);
    for (int i = tid; i < NT; i += NTHR) skl[i] = SKh[i];
    DMA(0, 0); DMA(1, 1);
    TILE_SYNC();
    qkt8(pA0, pA1, lds, qi, r32, hi); i2f_scores(pA0, pA1, sq * skl[0]); partialSM(pA0, pA1, m_reg, mnA, alA);
    if (wid >= 4) __builtin_amdgcn_s_setprio(1);
    int s_prev = 0, s_cur = 1, s_next = 2;
    for (int j = 1; j + 1 < NT; j += 2) {
        DMA(j + 1, s_next);
        const float mB = sq * skl[j];
        SBAR(); s1_step8(pB0, pB1, lds + s_cur * SLOTB8, qi, r32, hi, pA0, pA1, psum, pa0, pa1, pa2);
        s2_step8(o, vbase + s_prev * SLOTB8, pa0, pa1, pa2, pa3, pA0, pA1, psum, alA, l_reg, pB0, pB1, mB, m_reg, mnB, alB);
        TILE_SYNC(); RESC(alB);
        { const int t_ = s_prev; s_prev = s_cur; s_cur = s_next; s_next = t_; }
        if (j + 2 < NT) DMA(j + 2, s_next);
        const float mA = sq * skl[j + 1];
        SBAR(); s1_step8(pA0, pA1, lds + s_cur * SLOTB8, qi, r32, hi, pB0, pB1, psum, pa0, pa1, pa2);
        s2_step8(o, vbase + s_prev * SLOTB8, pa0, pa1, pa2, pa3, pB0, pB1, psum, alB, l_reg, pA0, pA1, mA, m_reg, mnA, alA);
        TILE_SYNC(); RESC(alA);
        { const int t_ = s_prev; s_prev = s_cur; s_cur = s_next; s_next = t_; }
    }
    __builtin_amdgcn_s_setprio(0);
    SBAR(); qkt8(pB0, pB1, lds + s_cur * SLOTB8, qi, r32, hi); i2f_scores(pB0, pB1, sq * skl[NT - 1]);
    finishSM(pA0, pA1, alA, l_reg, pa0, pa1, pa2, pa3); SBAR();
    pv_d0(o, vbase + s_prev * SLOTB8, pa0, pa1, pa2, pa3); partialSM(pB0, pB1, m_reg, mnB, alB);
    RESC(alB);
    finishSM(pB0, pB1, alB, l_reg, pa0, pa1, pa2, pa3); SBAR();
    pv_d0(o, vbase + s_cur * SLOTB8, pa0, pa1, pa2, pa3);
    if (hi == 0) li_l[r32] = l_reg; asm volatile("s_waitcnt lgkmcnt(0)" ::: "memory");
    float rli[16];
#pragma unroll
    for (int r = 0; r < 16; ++r) rli[r] = __builtin_amdgcn_rcpf(li_l[crow(r, hi)]);
    bf16_t* Ow = Ob + (long)(wid * 32) * LDO;
#pragma unroll
    for (int r = 0; r < 16; ++r) { const int orow = crow(r, hi);
#pragma unroll
        for (int d0 = 0; d0 < 4; ++d0) Ow[(long)orow * LDO + d0 * 32 + r32] = f2bf(o[d0][r] * rli[r]); }
    __syncthreads();
#undef DMA
#undef OFF_V
#undef OFF_KN8
#undef OFF_KR8
#undef RESC
#undef TILE_SYNC
}
}

__device__ __forceinline__ int crow32(int r, int hi) { return (r & 3) + 8 * (r >> 2) + 4 * hi; }

__device__ __forceinline__ void ce_desc(unsigned& x, unsigned& y) { const unsigned hi = x > y ? x : y, lo = x > y ? y : x; x = hi; y = lo; }
__device__ __forceinline__ unsigned f2key(float s) { const unsigned b = __float_as_uint(s); return b ^ (((unsigned)((int)b >> 31)) | 0x80000000u); }
__device__ __forceinline__ float key2f(unsigned k) { const unsigned b = (k & 0x80000000u) ? (k ^ 0x80000000u) : ~k; return __uint_as_float(b); }
__device__ __forceinline__ void sort16_desc(unsigned (&a)[16]) {
#pragma unroll
    for (int k = 2; k <= 16; k <<= 1)
#pragma unroll
        for (int j = k >> 1; j > 0; j >>= 1)
#pragma unroll
            for (int i = 0; i < 16; ++i) { const int l = i ^ j; if (l > i) { if ((i & k) == 0) ce_desc(a[i], a[l]); else ce_desc(a[l], a[i]); } }
}
__device__ __forceinline__ void merge_top16(unsigned (&a)[16], const unsigned (&b)[16]) {
#pragma unroll
    for (int i = 0; i < 16; ++i) a[i] = a[i] > b[15 - i] ? a[i] : b[15 - i];
#pragma unroll
    for (int j = 8; j > 0; j >>= 1)
#pragma unroll
        for (int i = 0; i < 16; ++i) { const int l = i ^ j; if (l > i) ce_desc(a[i], a[l]); }
}
__device__ __forceinline__ void peer_select(const Fr& F, const bf16_t* PQ, const bf16_t* KEYS, unsigned short* PIDX, float* PGATE) {
    LAS bf16_t* KL = (LAS bf16_t*)F.lds;
    LAS unsigned* LST = (LAS unsigned*)(F.lds + 69632);
    LAS int* IDX = (LAS int*)(F.lds + 69632 + 16384);
    LAS float* GT = (LAS float*)(F.lds + 69632 + 16384 + 8192);
    LAS int* CODE = (LAS int*)(F.lds + 69632 + 16384 + 16384);
    __syncthreads();
    if (F.tid < 64) { int cnt = 0, code = 0; for (int ab = 0; ab < 256; ++ab) { if (((ab >> 4) + 1) * ((ab & 15) + 1) <= 16) { if (cnt == F.tid) code = ab; ++cnt; } } CODE[F.tid] = code; }
    for (int ch = F.tid; ch < 2 * 128 * 16; ch += NTHR) { const int row = ch >> 4, c8 = (ch & 15) * 8; *(LAS u32x4*)(KL + row * 136 + c8) = *(const u32x4*)(KEYS + (size_t)row * 128 + c8); }
    __syncthreads();
    const int r32 = F.lane & 31, hi = F.lane >> 5;
    for (int tile = F.bid; tile < SEQ / 16; tile += F.G) {
        const int t0 = tile * 16;
        {
            const int p = F.wave >> 2, rb = F.wave & 3, r = rb * 32 + r32, tl = r >> 3, h = r & 7;
            const bf16_t* qp = PQ + (size_t)(t0 + tl) * 2048 + h * 256 + p * 128 + hi * 8;
            bf16x8 qa[8];
#pragma unroll
            for (int k = 0; k < 8; ++k) qa[k] = *(const bf16x8*)(qp + k * 16);
            unsigned g[4][16];
#pragma unroll
            for (int nb = 0; nb < 4; ++nb) {
                const LAS bf16_t* kp = KL + (p * 128 + nb * 32 + r32) * 136 + hi * 8;
                f32x16 acc = {};
#pragma unroll
                for (int k = 0; k < 8; ++k) { const bf16x8 kb = *(const LAS bf16x8*)(kp + k * 16); acc = __builtin_amdgcn_mfma_f32_32x32x16_bf16(kb, qa[k], acc, 0, 0, 0); }
#pragma unroll
                for (int rr = 0; rr < 16; ++rr) { const int nbase = nb * 32 + (rr & 3) + 8 * (rr >> 2);
                    g[nb][rr] = (f2key(acc[rr]) & ~127u) | (unsigned)((127 - nbase) - 4 * hi); }
            }
            sort16_desc(g[0]); sort16_desc(g[1]); sort16_desc(g[2]); sort16_desc(g[3]);
            merge_top16(g[0], g[1]); merge_top16(g[2], g[3]); merge_top16(g[0], g[2]);
            unsigned other[16];
#pragma unroll
            for (int k = 0; k < 16; ++k) { auto sw = __builtin_amdgcn_permlane32_swap(g[0][k], g[0][k], false, false); other[k] = hi ? sw[0] : sw[1]; }
            merge_top16(g[0], other);
            if (hi == 0) {
#pragma unroll
                for (int k = 0; k < 16; k += 4) *(LAS u32x4*)(LST + (p * 128 + r) * 16 + k) = (u32x4){g[0][k], g[0][k + 1], g[0][k + 2], g[0][k + 3]};
            }
        }
        __syncthreads();
        if (F.tid < 128) {
            const int j = F.tid, tl = j >> 3, h = j & 7;
            unsigned k1[16], k2[16];
#pragma unroll
            for (int k = 0; k < 16; k += 4) { const u32x4 a = *(const LAS u32x4*)(LST + j * 16 + k), b = *(const LAS u32x4*)(LST + (128 + j) * 16 + k);
                k1[k] = a.x; k1[k + 1] = a.y; k1[k + 2] = a.z; k1[k + 3] = a.w; k2[k] = b.x; k2[k + 1] = b.y; k2[k + 2] = b.z; k2[k + 3] = b.w; }
            float v1[16], v2[16];
#pragma unroll
            for (int k = 0; k < 16; ++k) { v1[k] = key2f(k1[k] & ~127u); v2[k] = key2f(k2[k] & ~127u); }
            unsigned cg[4][16];
            {
                int n = 0;
#pragma unroll
                for (int a = 0; a < 16; ++a)
#pragma unroll
                    for (int b = 0; b < 16; ++b) if ((a + 1) * (b + 1) <= 16) { cg[n >> 4][n & 15] = (f2key(v1[a] + v2[b]) & ~63u) | (unsigned)(63 - n); ++n; }
#pragma unroll
                for (int m = 50; m < 64; ++m) cg[m >> 4][m & 15] = 0u;
            }
            sort16_desc(cg[0]); sort16_desc(cg[1]); sort16_desc(cg[2]); sort16_desc(cg[3]);
            merge_top16(cg[0], cg[1]); merge_top16(cg[2], cg[3]); merge_top16(cg[0], cg[2]);
            float bs[16];
#pragma unroll
            for (int k = 0; k < 16; ++k) bs[k] = key2f(cg[0][k] & ~63u);
            float den = 0.f, ex[16];
#pragma unroll
            for (int k = 0; k < 16; ++k) { ex[k] = __expf(bs[k] - bs[0]); den += ex[k]; }
            const float rden = 1.0f / den;
            unsigned ib = (unsigned)(uintptr_t)(IDX + tl * 128 + h * 2), gb2 = (unsigned)(uintptr_t)(GT + tl * 128 + h * 2), lb = (unsigned)(uintptr_t)(LST + j * 16);
            asm volatile("" : "+v"(ib), "+v"(gb2), "+v"(lb));
            LAS int* ip = (LAS int*)(uintptr_t)ib; LAS float* gp = (LAS float*)(uintptr_t)gb2; LAS unsigned* l1 = (LAS unsigned*)(uintptr_t)lb;
#pragma unroll
            for (int k = 0; k < 16; ++k) {
                const int code = CODE[63 - (int)(cg[0][k] & 63u)]; const int a = code >> 4, b = code & 15;
                const int i1 = 127 - (int)(l1[a] & 127u), i2 = 127 - (int)(l1[128 * 16 + b] & 127u);
                ip[(k & 7) * 16 + (k >> 3)] = i1 * 128 + i2;
                gp[(k & 7) * 16 + (k >> 3)] = ex[k] * rden;
            }
        }
        __syncthreads();
        for (int i = F.tid; i < 16 * 128; i += NTHR) { PIDX[(size_t)t0 * 128 + i] = (unsigned short)IDX[i]; PGATE[(size_t)t0 * 128 + i] = GT[i]; }
        __syncthreads();
    }
}

struct PeerBuf { u32x4 g[8]; };
struct PeerMeta { u32x4 id[2]; u32x4 p[2]; unsigned xr; };
template <int CTRL> __device__ __forceinline__ float dpp_f(float v) { return __int_as_float(__builtin_amdgcn_update_dpp(0, __float_as_int(v), CTRL, 0xf, 0xf, true)); }
__device__ __forceinline__ float xor16_f(float v, bool hi16) { auto r = __builtin_amdgcn_permlane16_swap(__float_as_uint(v), __float_as_uint(v), false, false); return __uint_as_float(hi16 ? r[0] : r[1]); }
__device__ __forceinline__ float xor32_f(float v, bool hi32) { auto r = __builtin_amdgcn_permlane32_swap(__float_as_uint(v), __float_as_uint(v), false, false); return __uint_as_float(hi32 ? r[0] : r[1]); }
template <int HALF>
__device__ __forceinline__ void peer_issue(PeerBuf& b, const unsigned char* tab, unsigned lane_off, const PeerMeta& m) {
#pragma unroll
    for (int i = 0; i < 8; ++i) { const int k = HALF * 8 + i; const unsigned w = m.id[k >> 3][(k >> 1) & 3]; const unsigned idx = (k & 1) ? (w >> 16) : (w & 0xffffu); b.g[i] = *(const u32x4*)(tab + (idx * 128u + lane_off)); }
}
__device__ __forceinline__ void peer_u_quant(const PeerMeta& m, int (&xq)[4], float& sx) {
#pragma unroll
    for (int q = 0; q < 4; ++q) xq[q] = (int)m.p[0][q];
    sx = __uint_as_float(m.p[1].x);
}
template <int HALF>
__device__ __forceinline__ void peer_u_compute(const PeerBuf& b, const int (&xq)[4], float sx, _Float16* pdrow, int q8, int eg) {
    int d[8];
#pragma unroll
    for (int i = 0; i < 8; ++i) { int a = 0;
#pragma unroll
        for (int q = 0; q < 4; ++q) a = __builtin_amdgcn_sdot4((int)b.g[i][q], xq[q], a, false);
        d[i] = a; }
    const bool b2 = (q8 & 4) != 0, b1 = (q8 & 2) != 0, b0 = (q8 & 1) != 0;
    int k4[4], k2[2];
#pragma unroll
    for (int k = 0; k < 4; ++k) { const int keep = b2 ? d[4 + k] : d[k], send = b2 ? d[k] : d[4 + k]; k4[k] = keep + __builtin_amdgcn_update_dpp(0, send, 0x141, 0xf, 0xf, true); }
#pragma unroll
    for (int k = 0; k < 2; ++k) { const int keep = b1 ? k4[2 + k] : k4[k], send = b1 ? k4[k] : k4[2 + k]; k2[k] = keep + __builtin_amdgcn_update_dpp(0, send, 0x4E, 0xf, 0xf, true); }
    const int keep = b0 ? k2[1] : k2[0], send = b0 ? k2[0] : k2[1];
    pdrow[eg * 16 + 8 * HALF + q8] = (_Float16)((float)(keep + __builtin_amdgcn_update_dpp(0, send, 0xB1, 0xf, 0xf, true)) * (sx * 0.0625f));
}
template <int HALF>
__device__ __forceinline__ void peer_v_accum(h2_t (&acc)[8], const PeerBuf& b, const PeerMeta& m) {
#pragma unroll
    for (int i = 0; i < 8; ++i) { const int k = HALF * 8 + i; const unsigned ww = m.p[k >> 3][(k >> 1) & 3];
        const unsigned rep = (k & 1) ? ((ww >> 16) | (ww & 0xffff0000u)) : ((ww & 0xffffu) | (ww << 16));
        const h2_t w2 = *(const h2_t*)&rep;
#pragma unroll
        for (int q = 0; q < 4; ++q) { const unsigned w = b.g[i][q];
            const h2_t lo = __builtin_amdgcn_cvt_scalef32_pk_f16_fp8(w, 1.0f, false), hi2 = __builtin_amdgcn_cvt_scalef32_pk_f16_fp8(w, 1.0f, true);
            acc[2 * q] = __builtin_elementwise_fma(w2, lo, acc[2 * q]); acc[2 * q + 1] = __builtin_elementwise_fma(w2, hi2, acc[2 * q + 1]); } }
}
__device__ __forceinline__ void peer_v_finish(h2_t (&acch)[8], bf16_t* xrow, const unsigned xr, const f32x2 gf, int q8, int eg) {
    float acc[16];
#pragma unroll
    for (int q = 0; q < 8; ++q) { acc[2 * q] = (float)acch[q].x; acc[2 * q + 1] = (float)acch[q].y; acch[q] = (h2_t){(_Float16)0.f, (_Float16)0.f}; }
    const bool c0 = (eg & 1) != 0, c1 = (eg & 2) != 0, c2 = (eg & 4) != 0;
    float k8[8], k4[4], k2[2];
#pragma unroll
    for (int k = 0; k < 8; ++k) { const float keep = c0 ? acc[8 + k] : acc[k], send = c0 ? acc[k] : acc[8 + k]; k8[k] = keep + dpp_f<0x128>(send); }
#pragma unroll
    for (int k = 0; k < 4; ++k) { const float keep = c1 ? k8[4 + k] : k8[k], send = c1 ? k8[k] : k8[4 + k]; k4[k] = keep + xor16_f(send, c1); }
#pragma unroll
    for (int k = 0; k < 2; ++k) { const float keep = c2 ? k4[2 + k] : k4[k], send = c2 ? k4[k] : k4[2 + k]; k2[k] = keep + xor32_f(send, c2); }
    const int dim = q8 * 16 + (c0 ? 8 : 0) + (c1 ? 4 : 0) + (c2 ? 2 : 0);
    *(unsigned*)(xrow + dim) = pk_bf16(bf_lo(xr) + gf.x * (k2[0] * (1.0f / 1024.0f)), bf_hi(xr) + gf.y * (k2[1] * (1.0f / 1024.0f)));
}
template <int MODE>
__device__ __forceinline__ void peer_sliced(const Fr& F, const unsigned char* TAB, const unsigned short* PIDX, const unsigned char* H8, const float* SA, const _Float16* PW, _Float16* PD, bf16_t* XR, const float* gate_f) {
    const bool hw = F.xcc_ok != 0, al = (F.G & 7) == 0;
    const int nr = hw ? F.xcc_n : (al ? (F.G >> 3) : F.G), r = hw ? F.xcc_rank : (al ? (F.bid >> 3) : F.bid);
    const int xs_lo = hw ? F.xcc : (al ? (F.bid & 7) : 0), xs_hi = (hw || al) ? xs_lo + 1 : 8;
    const int q8 = F.lane & 7, eg = F.lane >> 3;
    const int stride = nr * 8, tfirst = r + nr * F.wave;
    const int ntok = tfirst < SEQ ? (SEQ - tfirst + stride - 1) / stride : 0;
    for (int xs = xs_lo; xs < xs_hi; ++xs)
        for (int ps = 0; ps < 2; ++ps) {
            const int s = xs * 2 + ps;
            const unsigned lane_off = (unsigned)(s * 2097152 + q8 * 16);
            PeerBuf b0, b1, b2; PeerMeta m0, m1, m2; h2_t acc[8];
            const int vdim = q8 * 16 + ((eg & 1) ? 8 : 0) + ((eg & 2) ? 4 : 0) + ((eg & 4) ? 2 : 0);
            const f32x2 gfv = (MODE == 1) ? *(const f32x2*)(gate_f + s * 128 + vdim) : (f32x2){0.f, 0.f};
#pragma unroll
            for (int q = 0; q < 8; ++q) acc[q] = (h2_t){(_Float16)0.f, (_Float16)0.f};
#define PEER_META(m, t) do { const u32x4* ip_ = (const u32x4*)(PIDX + (size_t)(t) * 128 + eg * 16); (m).id[0] = ip_[0]; (m).id[1] = ip_[1]; \
    if (MODE == 0) { (m).p[0] = *(const u32x4*)(H8 + (size_t)(t) * 2048 + s * 128 + q8 * 16); (m).p[1].x = __float_as_uint(SA[(t)]); } \
    else { const u32x4* wp_ = (const u32x4*)(PW + (size_t)(t) * 128 + eg * 16); (m).p[0] = wp_[0]; (m).p[1] = wp_[1]; \
           (m).xr = *(const unsigned*)(XR + (size_t)(t) * DM + s * 128 + vdim); } } while (0)
#define PEER_TRIP(mc, mn, ml, bx, by, bz, kk, C2, C1) do { const int t = tfirst + (kk) * stride; int xq_[4] = {0, 0, 0, 0}; float sx_ = 0.f; \
                if (C2) PEER_META(ml, t + 2 * stride); \
                if (C1) peer_issue<0>(bz, TAB, lane_off, mn); \
                if (MODE == 0) { peer_u_quant(mc, xq_, sx_); peer_u_compute<0>(bx, xq_, sx_, PD + ((size_t)s * SEQ + t) * 128, q8, eg); } else peer_v_accum<0>(acc, bx, mc); \
                if (C1) peer_issue<1>(bx, TAB, lane_off, mn); \
                if (MODE == 0) peer_u_compute<1>(by, xq_, sx_, PD + ((size_t)s * SEQ + t) * 128, q8, eg); \
                else { peer_v_accum<1>(acc, by, mc); peer_v_finish(acc, XR + (size_t)t * DM + s * 128, (mc).xr, gfv, q8, eg); } } while (0)
            int k = 0;
            if (ntok >= 5) {
                PEER_META(m0, tfirst); PEER_META(m1, tfirst + stride);
                peer_issue<0>(b0, TAB, lane_off, m0); peer_issue<1>(b1, TAB, lane_off, m0);
                for (; k + 4 < ntok; k += 3) {
                    PEER_TRIP(m0, m1, m2, b0, b1, b2, k, true, true);
                    PEER_TRIP(m1, m2, m0, b2, b0, b1, k + 1, true, true);
                    PEER_TRIP(m2, m0, m1, b1, b2, b0, k + 2, true, true);
                }
            } else if (ntok > 0) {
                PEER_META(m0, tfirst);
                if (ntok > 1) PEER_META(m1, tfirst + stride);
                peer_issue<0>(b0, TAB, lane_off, m0); peer_issue<1>(b1, TAB, lane_off, m0);
            }
            for (; k < ntok; k += 3) {
                PEER_TRIP(m0, m1, m2, b0, b1, b2, k, (k + 2 < ntok), (k + 1 < ntok));
                if (k + 1 < ntok) PEER_TRIP(m1, m2, m0, b2, b0, b1, k + 1, (k + 3 < ntok), (k + 2 < ntok));
                if (k + 2 < ntok) PEER_TRIP(m2, m0, m1, b1, b2, b0, k + 2, (k + 4 < ntok), (k + 3 < ntok));
            }
#undef PEER_TRIP
#undef PEER_META
        }
}
__device__ __forceinline__ void peer_weights(const Fr& F, const _Float16* PD, const unsigned short* PIDX, const float* PGATE, const float* SU, const float* SV, _Float16* PW) {
    typedef _Float16 h4_t __attribute__((ext_vector_type(4)));
    for (int it = F.bid * NTHR + F.tid; it < SEQ * 32; it += F.G * NTHR) {
        const size_t o = (size_t)it * 4;
        f32x4 a = {0.f, 0.f, 0.f, 0.f};
#pragma unroll
        for (int s = 0; s < 16; ++s) { const h4_t h = *(const h4_t*)(PD + (size_t)s * SEQ * 128 + o); a += (f32x4){(float)h[0], (float)h[1], (float)h[2], (float)h[3]}; }
        const u32x2 iw = *(const u32x2*)(PIDX + o); const f32x4 g = *(const f32x4*)(PGATE + o);
        const unsigned idx[4] = {iw.x & 0xffffu, iw.x >> 16, iw.y & 0xffffu, iw.y >> 16};
        h4_t w;
#pragma unroll
        for (int e = 0; e < 4; ++e) w[e] = (_Float16)(g[e] * gelu_tanh(a[e] * (16.0f * SU[idx[e]])) * SV[idx[e]] * 1024.0f);
        *(h4_t*)(PW + o) = w;
    }
}
__device__ __forceinline__ void final_norm_rows(const Fr& F, const bf16_t* X, const float* g, float* out) {
    f32x4 cs[8];
#pragma unroll
    for (int i = 0; i < 4; ++i) { cs[2 * i] = *(const f32x4*)(g + i * 512 + F.lane * 8); cs[2 * i + 1] = *(const f32x4*)(g + i * 512 + F.lane * 8 + 4); }
    for (int row0 = (F.bid * 8 + F.wave) * 2; row0 < SEQ; row0 += F.G * 16) {
        u32x4 w[2][4];
#pragma unroll
        for (int rr = 0; rr < 2; ++rr)
#pragma unroll
            for (int i = 0; i < 4; ++i) w[rr][i] = *(const u32x4*)(X + (size_t)(row0 + rr) * DM + i * 512 + F.lane * 8);
#pragma unroll
        for (int rr = 0; rr < 2; ++rr) {
            f32x4 v[8]; float ss = 0.f;
#pragma unroll
            for (int i = 0; i < 4; ++i) { v[2 * i] = (f32x4){bf_lo(w[rr][i].x), bf_hi(w[rr][i].x), bf_lo(w[rr][i].y), bf_hi(w[rr][i].y)}; v[2 * i + 1] = (f32x4){bf_lo(w[rr][i].z), bf_hi(w[rr][i].z), bf_lo(w[rr][i].w), bf_hi(w[rr][i].w)}; }
#pragma unroll
            for (int i = 0; i < 8; ++i) ss += v[i][0] * v[i][0] + v[i][1] * v[i][1] + v[i][2] * v[i][2] + v[i][3] * v[i][3];
            ss = wave_sum(ss);
            const float rstd = rsqrtf(ss * (1.0f / DM) + 1e-6f);
#pragma unroll
            for (int i = 0; i < 4; ++i) { float* op = out + (size_t)(row0 + rr) * DM + i * 512 + F.lane * 8; *(f32x4*)op = v[2 * i] * rstd * cs[2 * i]; *(f32x4*)(op + 4) = v[2 * i + 1] * rstd * cs[2 * i + 1]; }
        }
    }
}

__device__ __forceinline__ void gmlp_phase(const Fr& F, const bf16_t* PB, const bf16_t* GMWS, bf16_t* YCAT) {
    const float* gng = F.in[I_GMNG1]; const float* gmb = F.in[I_GMB1];
    LAS float* rstd_s = (LAS float*)F.lds;
    LAS bf16_t* VT = (LAS bf16_t*)(F.lds + 1024);
    LAS bf16_t* AT = (LAS bf16_t*)(F.lds + 1024 + 128 * 136 * 2);
    LAS float* ST = (LAS float*)(F.lds + 1024 + 2 * 128 * 136 * 2);
    for (int unit = F.bid; unit < 256; unit += F.G) {
        const int n = unit >> 1, gh = unit & 1, pos0 = n * 128;
        __syncthreads();
#pragma unroll 1
        for (int r0 = F.wave * 16; r0 < F.wave * 16 + 16; r0 += 8) {
            u32x4 a[8], b[8];
#pragma unroll
            for (int q = 0; q < 8; ++q) { const bf16_t* pr = PB + (size_t)(pos0 + r0 + q) * 5120 + 1024 + F.lane * 16; a[q] = *(const u32x4*)pr; b[q] = *(const u32x4*)(pr + 8); }
#pragma unroll
            for (int q = 0; q < 8; ++q) {
                float ss = 0.f;
#pragma unroll
                for (int e = 0; e < 4; ++e) { ss += bf_lo(a[q][e]) * bf_lo(a[q][e]) + bf_hi(a[q][e]) * bf_hi(a[q][e]) + bf_lo(b[q][e]) * bf_lo(b[q][e]) + bf_hi(b[q][e]) * bf_hi(b[q][e]); }
                ss = wave_sum(ss);
                if (F.lane == 0) rstd_s[r0 + q] = rsqrtf(ss * (1.0f / 1024.0f) + 1e-6f);
            }
        }
        __syncthreads();
        for (int g = gh * 4; g < gh * 4 + 4; ++g) {
            { u32x4 a4[4];
#pragma unroll
              for (int k = 0; k < 4; ++k) { const int ch = F.tid + k * NTHR, p = ch >> 4, q8 = (ch & 15) * 8; a4[k] = *(const u32x4*)(GMWS + (size_t)g * 16384 + p * 128 + q8); }
#pragma unroll
              for (int k = 0; k < 4; ++k) { const int ch = F.tid + k * NTHR, p = ch >> 4, q8 = (ch & 15) * 8; *(LAS u32x4*)(AT + p * 136 + q8) = a4[k]; } }
            { const int q = F.tid >> 2, cp = (F.tid & 3) * 32; const float rs = rstd_s[q];
              const bf16_t* pr = PB + (size_t)(pos0 + q) * 5120 + 1024 + g * 128 + cp;
              u32x4 w4[4]; f32x4 gg[8];
#pragma unroll
              for (int i = 0; i < 4; ++i) { w4[i] = *(const u32x4*)(pr + i * 8); gg[2 * i] = *(const f32x4*)(gng + g * 128 + cp + i * 8); gg[2 * i + 1] = *(const f32x4*)(gng + g * 128 + cp + i * 8 + 4); }
#pragma unroll
              for (int i = 0; i < 4; ++i) { const u32x4 w = w4[i];
                  const float v[8] = {bf_lo(w.x), bf_hi(w.x), bf_lo(w.y), bf_hi(w.y), bf_lo(w.z), bf_hi(w.z), bf_lo(w.w), bf_hi(w.w)};
#pragma unroll
                  for (int e = 0; e < 8; ++e) { const int c = cp + i * 8 + e; VT[c * 136 + q] = f2bf(v[e] * rs * gg[2 * i + (e >> 2)][e & 3]); } } }
            __syncthreads();
            { const int pb = F.wave >> 1, cb0 = (F.wave & 1) * 2, r32 = F.lane & 31, hi = F.lane >> 5;
#pragma unroll
              for (int cbi = 0; cbi < 2; ++cbi) { const int cb = cb0 + cbi; f32x16 acc = {};
#pragma unroll
                  for (int k = 0; k < 8; ++k) { const bf16x8 a = *(const LAS bf16x8*)(AT + (pb * 32 + r32) * 136 + k * 16 + hi * 8), b = *(const LAS bf16x8*)(VT + (cb * 32 + r32) * 136 + k * 16 + hi * 8);
                      acc = __builtin_amdgcn_mfma_f32_32x32x16_bf16(a, b, acc, 0, 0, 0); }
#pragma unroll
                  for (int rr = 0; rr < 16; ++rr) { const int p = pb * 32 + crow32(rr, hi); ST[p * 132 + cb * 32 + r32] = acc[rr] + gmb[g * 128 + p]; } } }
            __syncthreads();
            u32x4 u4[4];
#pragma unroll
            for (int k = 0; k < 4; ++k) { const int ch = F.tid + k * NTHR, p = ch >> 4, c8 = (ch & 15) * 8; u4[k] = *(const u32x4*)(PB + (size_t)(pos0 + p) * 5120 + g * 128 + c8); }
#pragma unroll
            for (int k = 0; k < 4; ++k) { const int ch = F.tid + k * NTHR; const int p = ch >> 4, c8 = (ch & 15) * 8; const size_t pos = (size_t)(pos0 + p);
                const f32x4 s0 = *(const LAS f32x4*)(ST + p * 132 + c8), s1 = *(const LAS f32x4*)(ST + p * 132 + c8 + 4);
                const u32x4 uu = u4[k];
                u32x4 y; y.x = pk_bf16(bf_lo(uu.x) * s0[0], bf_hi(uu.x) * s0[1]); y.y = pk_bf16(bf_lo(uu.y) * s0[2], bf_hi(uu.y) * s0[3]);
                y.z = pk_bf16(bf_lo(uu.z) * s1[0], bf_hi(uu.z) * s1[1]); y.w = pk_bf16(bf_lo(uu.w) * s1[2], bf_hi(uu.w) * s1[3]);
                *(u32x4*)(YCAT + pos * 2048 + g * 128 + c8) = y; }
        }
    }
}
__device__ __forceinline__ void hyena_pre(const Fr& F, const bf16_t* PB, unsigned* Z, bf16_t* G1B, bf16_t* X0B) {
    const float* cw = F.in[I_HYCW1]; const float* cb = F.in[I_HYCB1];
    const int cg = F.tid & 127, c0 = cg * 8;
    float w0[3][8], w1[3][8], w2[3][8], bb[3][8];
#pragma unroll
    for (int pt = 0; pt < 3; ++pt)
#pragma unroll
        for (int e = 0; e < 8; ++e) { const int c = pt * 1024 + c0 + e; w0[pt][e] = cw[c]; w1[pt][e] = cw[3072 + c]; w2[pt][e] = cw[6144 + c]; bb[pt][e] = cb[c]; }
    for (int t = F.bid * 4 + (F.tid >> 7); t < SEQ; t += F.G * 4) {
        u32x4 r[3][3];
#pragma unroll
        for (int dt = 0; dt < 3; ++dt) { const int tt = t + dt - 1; const bool ok = (tt >= 0) && (tt < SEQ);
#pragma unroll
            for (int pt = 0; pt < 3; ++pt) r[dt][pt] = ok ? *(const u32x4*)(PB + (size_t)tt * 5120 + 2048 + pt * 1024 + c0) : (u32x4){0u, 0u, 0u, 0u}; }
        float xs[3][8];
#pragma unroll
        for (int pt = 0; pt < 3; ++pt)
#pragma unroll
            for (int q = 0; q < 4; ++q) {
                xs[pt][2 * q] = w0[pt][2 * q] * bf_lo(r[0][pt][q]) + w1[pt][2 * q] * bf_lo(r[1][pt][q]) + w2[pt][2 * q] * bf_lo(r[2][pt][q]) + bb[pt][2 * q];
                xs[pt][2 * q + 1] = w0[pt][2 * q + 1] * bf_hi(r[0][pt][q]) + w1[pt][2 * q + 1] * bf_hi(r[1][pt][q]) + w2[pt][2 * q + 1] * bf_hi(r[2][pt][q]) + bb[pt][2 * q + 1];
            }
        float g1[8];
#pragma unroll
        for (int e = 0; e < 8; ++e) g1[e] = xs[1][e] * xs[2][e];
        *(u32x4*)(Z + (size_t)t * ZP + (c0 >> 1)) = (u32x4){pk_h2((f32x2){g1[0] * 0.125f, g1[1] * 0.125f}), pk_h2((f32x2){g1[2] * 0.125f, g1[3] * 0.125f}),
                                                              pk_h2((f32x2){g1[4] * 0.125f, g1[5] * 0.125f}), pk_h2((f32x2){g1[6] * 0.125f, g1[7] * 0.125f})};
        *(u32x4*)(G1B + (size_t)t * 1024 + c0) = (u32x4){pk_bf16(g1[0], g1[1]), pk_bf16(g1[2], g1[3]), pk_bf16(g1[4], g1[5]), pk_bf16(g1[6], g1[7])};
        *(u32x4*)(X0B + (size_t)t * 1024 + c0) = (u32x4){pk_bf16(xs[0][0], xs[0][1]), pk_bf16(xs[0][2], xs[0][3]), pk_bf16(xs[0][4], xs[0][5]), pk_bf16(xs[0][6], xs[0][7])};
    }
}

__device__ __forceinline__ f32x2 cmul(f32x2 a, f32x2 b) { return (f32x2){a.x * b.x - a.y * b.y, a.x * b.y + a.y * b.x}; }
template <bool INV>
__device__ __forceinline__ void fft32(f32x2 (&v)[32]) {
    constexpr float CS[16] = {1.0f, 0.98078528040323043f, 0.92387953251128674f, 0.83146961230254524f, 0.70710678118654752f, 0.55557023301960218f, 0.38268343236508977f, 0.19509032201612825f,
                              0.0f, -0.19509032201612825f, -0.38268343236508977f, -0.55557023301960218f, -0.70710678118654752f, -0.83146961230254524f, -0.92387953251128674f, -0.98078528040323043f};
    constexpr float SN[16] = {0.0f, 0.19509032201612825f, 0.38268343236508977f, 0.55557023301960218f, 0.70710678118654752f, 0.83146961230254524f, 0.92387953251128674f, 0.98078528040323043f,
                              1.0f, 0.98078528040323043f, 0.92387953251128674f, 0.83146961230254524f, 0.70710678118654752f, 0.55557023301960218f, 0.38268343236508977f, 0.19509032201612825f};
#pragma unroll
    for (int s = 0; s < 5; ++s) {
        const int half = 16 >> s;
#pragma unroll
        for (int i = 0; i < 32; ++i) {
            if ((i & half) == 0) {
                const int j = i | half, tw = (i & (half - 1)) << s;
                const f32x2 a = v[i], b = v[j];
                v[i] = a + b;
                const f32x2 d = a - b;
                const float c = CS[tw], sn = INV ? SN[tw] : -SN[tw];
                v[j] = (f32x2){d.x * c - d.y * sn, d.x * sn + d.y * c};
            }
        }
    }
}
__host__ __device__ constexpr int brev5(int k) { return ((k & 1) << 4) | ((k & 2) << 2) | (k & 4) | ((k & 8) >> 2) | ((k & 16) >> 4); }

template <int MP, bool INV, int MODE>
__device__ __forceinline__ void fft_pass(const Fr& F, const unsigned* Zs, unsigned* Zb, const bf16_t* G1B, const bf16_t* X0B, const float* hbias, bf16_t* YCAT) {
    constexpr int S = 32 * MP, NIT = 1024 * 512;
    const int step = F.G * NTHR;
    int it = F.bid * NTHR + F.tid;
    unsigned raw[32];
#define FFT_LOAD(itx) do { const int cp_ = (itx) & 511, j_ = (itx) >> 9, nl_ = j_ % MP, sb_ = j_ / MP; const size_t b_ = ((size_t)sb_ * S + nl_) * ZP + cp_; \
        _Pragma("unroll") for (int m = 0; m < 32; ++m) raw[m] = (MODE == 1 && m >= 16) ? 0u : Zs[b_ + (size_t)m * MP * ZP]; } while (0)
    if (it < NIT) FFT_LOAD(it);
    for (; it < NIT; it += step) {
        const int cp = it & 511, j = it >> 9, n_lo = j % MP, sblk = j / MP;
        const size_t base = ((size_t)sblk * S + n_lo) * ZP + cp;
        f32x2 v[32];
#pragma unroll
        for (int m = 0; m < 32; ++m) v[m] = un_h2(raw[m]);
        if (it + step < NIT) FFT_LOAD(it + step);
        if (!INV) {
            fft32<false>(v);
#pragma unroll
            for (int k = 0; k < 32; ++k) {
                f32x2 o = v[brev5(k)];
                if (MP > 1 && k > 0) { const float fr = (float)(n_lo * k) * (1.0f / (float)S); const f32x2 w = {__builtin_amdgcn_cosf(fr), -__builtin_amdgcn_sinf(fr)}; o = cmul(o, w); }
                Zb[base + (size_t)k * MP * ZP] = pk_h2(o);
            }
        } else {
            if (MP > 1) {
#pragma unroll
                for (int k = 1; k < 32; ++k) { const float fr = (float)(n_lo * k) * (1.0f / (float)S); const f32x2 w = {__builtin_amdgcn_cosf(fr), __builtin_amdgcn_sinf(fr)}; v[k] = cmul(v[k], w); }
            }
            fft32<true>(v);
#pragma unroll
            for (int m = 0; m < 32; ++m) {
                const f32x2 o = v[brev5(m)];
                if (MODE != 2) Zb[base + (size_t)m * MP * ZP] = pk_h2(o);
                else if (m < 16) {
                    const int nrow = sblk * S + n_lo + m * MP;
                    const unsigned g1w = *(const unsigned*)(G1B + (size_t)nrow * 1024 + cp * 2), x0w = *(const unsigned*)(X0B + (size_t)nrow * 1024 + cp * 2);
                    const f32x2 hb = *(const f32x2*)(hbias + cp * 2);
                    const float ya = bf_lo(x0w) * (o.x * (1.0f / 128.0f) + hb.x * bf_lo(g1w)), yb = bf_hi(x0w) * (o.y * (1.0f / 128.0f) + hb.y * bf_hi(g1w));
                    *(unsigned*)(YCAT + (size_t)nrow * 2048 + 1024 + cp * 2) = pk_bf16(ya, yb);
                }
            }
        }
    }
#undef FFT_LOAD
}
__device__ __forceinline__ int fft_pos(int k) { return ((k & 31) << 10) | (((k >> 5) & 31) << 5) | (k >> 10); }
__device__ __forceinline__ void fft_pointwise(const Fr& F, unsigned* Zb, const unsigned* Kb, const float* FNORM) {
    constexpr int N = 32768, NIT = (N / 2 + 1) * 512;
    const int step = F.G * NTHR;
    for (int it0 = F.bid * NTHR + F.tid; it0 < NIT; it0 += 4 * step) {
        unsigned z1[4], z2[4], q1[4], q2[4]; size_t p1[4], p2[4]; bool ok[4], two[4];
#pragma unroll
        for (int u = 0; u < 4; ++u) { const int it = it0 + u * step; ok[u] = it < NIT; const int itc = ok[u] ? it : it0;
            const int cp = itc & 511, k = itc >> 9, k2 = (N - k) & (N - 1);
            p1[u] = (size_t)fft_pos(k) * ZP + cp; p2[u] = (size_t)fft_pos(k2) * ZP + cp; two[u] = (k2 != k);
            z1[u] = Zb[p1[u]]; z2[u] = Zb[p2[u]]; q1[u] = Kb[p1[u]]; q2[u] = Kb[p2[u]]; }
        const int cp = it0 & 511;
        const float na = FNORM[cp * 2] * (0.25f * 8.0f / 256.0f), nb = FNORM[cp * 2 + 1] * (0.25f * 8.0f / 256.0f);
#pragma unroll
        for (int u = 0; u < 4; ++u) {
            if (!ok[u]) continue;
            const f32x2 a1 = un_h2(z1[u]), a2 = un_h2(z2[u]), b1 = un_h2(q1[u]), b2 = un_h2(q2[u]);
            const f32x2 ga = {a1.x + a2.x, a1.y - a2.y}, gb = {a1.y + a2.y, -(a1.x - a2.x)};
            const f32x2 ka = {(b1.x + b2.x) * na, (b1.y - b2.y) * na}, kb = {(b1.y + b2.y) * nb, -(b1.x - b2.x) * nb};
            const f32x2 ya = cmul(ga, ka), yb = cmul(gb, kb);
            Zb[p1[u]] = pk_h2((f32x2){ya.x - yb.y, ya.y + yb.x});
            if (two[u]) Zb[p2[u]] = pk_h2((f32x2){ya.x + yb.y, -ya.y + yb.x});
        }
    }
}

#ifndef MK_PER_PHASE
#define MK_PER_PHASE 0
#endif
enum { PH_PRO = 0, PH_NORM0, PH_IN0, PH_POST0, PH_UP0, PH_KQ, PH_ATT, PH_QY0, PH_OUT0, PH_PNORM0, PH_PQ0, PH_SEL0, PH_U0, PH_W0, PH_V0, PH_N1,
       PH_IN1, PH_POST1, PH_F1, PH_F2, PH_F3, PH_PWISE, PH_I1, PH_I2, PH_I3, PH_QY1, PH_OUT1, PH_PNORM1, PH_PQ1, PH_SEL1, PH_U1, PH_W1, PH_V1, PH_FIN, NPH };
#ifndef PROBE_SEQ
#define PROBE_SEQ 0
#endif

__global__ void __launch_bounds__(NTHR, 2) mk_fwd(Params P) {
    extern __shared__ __attribute__((aligned(16))) unsigned char lds_raw[];
    Fr F;
    F.in = P.in; F.out = P.out; F.ws = P.ws; F.lds = (LAS unsigned char*)lds_raw;
    F.tid = threadIdx.x; F.lane = F.tid & 63; F.wave = __builtin_amdgcn_readfirstlane(F.tid >> 6); F.G = gridDim.x; F.bid = blockIdx.x;
    unsigned char* ws = P.ws;
    const int lo = P.ph_lo, hi = P.ph_hi;
    volatile LAS unsigned* xbw = (volatile LAS unsigned*)(F.lds + LDS_CTL);
    if (F.tid < 4) xbw[F.tid] = 0u;
    __syncthreads();
    XcdBarrier bar; bar.bar = (unsigned*)(ws + WS_CTL); bar.x = 0; bar.st = xbw;
    if (hi - lo > 1) bar = xcd_barrier_post((unsigned*)(ws + WS_CTL), xbw);
    if (F.tid == 0) { const unsigned x = xb_xcc_id(); xbw[2] = x; xbw[3] = (hi - lo > 1) ? xb_add((unsigned*)(ws + WS_CTL) + 8192 + 64 * x, 1u) : 0u; }
    __syncthreads();
    F.xcc = (int)xbw[2]; F.xcc_rank = (int)xbw[3]; F.xcc_n = 0; F.xcc_ok = 0;
#define XCC_REFRESH() do { const unsigned nl_ = xbw[0], nx_ = xbw[1]; F.xcc_n = (int)nl_; F.xcc_ok = (hi - lo > 1) && nx_ == 8u && nl_ > 0u && F.xcc < 8 && F.xcc_rank < (int)nl_; } while (0)
#ifdef ONLY_PHASE
#define IN(k) ((k) == ONLY_PHASE && lo <= (k) && (k) < hi)
#else
#define IN(k) (lo <= (k) && (k) < hi)
#endif
#define SEAM(k) do { if (IN(k) && IN((k) + 1)) xcd_barrier(bar); } while (0)

    float* MOD0 = (float*)(ws + WS_MOD0); float* MOD1 = (float*)(ws + WS_MOD1); float* MC0 = (float*)(ws + WS_MC0);
    float* ROPEC = (float*)(ws + WS_ROPEC); float* ROPES = (float*)(ws + WS_ROPES);
    float* FPART = (float*)(ws + WS_FPART); float* FNORM = (float*)(ws + WS_FNORM);
    bf16_t* KEYS0 = (bf16_t*)(ws + WS_KEYS0); bf16_t* KEYS1 = (bf16_t*)(ws + WS_KEYS1); bf16_t* GMWS = (bf16_t*)(ws + WS_GMWS);
    bf16_t* WIN0 = (bf16_t*)(ws + WS_WIN0); bf16_t* WUQ = (bf16_t*)(ws + WS_WUQ); bf16_t* WUKV = (bf16_t*)(ws + WS_WUKV);
    bf16_t* WOUT0 = (bf16_t*)(ws + WS_WOUT0); bf16_t* WPQ0 = (bf16_t*)(ws + WS_WPQ0);
    bf16_t* WIN1 = (bf16_t*)(ws + WS_WIN1); bf16_t* WOUT1 = (bf16_t*)(ws + WS_WOUT1); bf16_t* WPQ1 = (bf16_t*)(ws + WS_WPQ1);
    unsigned char* TABU = ws + WS_TABU; unsigned char* TABV = ws + WS_TABV; float* TSC = (float*)(ws + WS_TSC);
    float* SA = (float*)(ws + WS_SA); float* SW = (float*)(ws + WS_SW); unsigned char* H8 = ws + WS_H;
    bf16_t* XR = (bf16_t*)(ws + WS_XR); bf16_t* H = (bf16_t*)(ws + WS_H); bf16_t* PBUF = (bf16_t*)(ws + WS_PBUF);
    bf16_t* QN = (bf16_t*)(ws + WS_QN); bf16_t* KVN = (bf16_t*)(ws + WS_KVN); bf16_t* KROPE = (bf16_t*)(ws + WS_KROPE);
    bf16_t* Q = (bf16_t*)(ws + WS_Q); bf16_t* KV = (bf16_t*)(ws + WS_KV); bf16_t* YCAT = (bf16_t*)(ws + WS_YCAT);
    unsigned* Z = (unsigned*)(ws + WS_Z); unsigned* KZ = (unsigned*)(ws + WS_KZ); unsigned* KZ2 = (unsigned*)(ws + WS_KZ2);
    bf16_t* G1B = (bf16_t*)(ws + WS_G1B); bf16_t* X0B = (bf16_t*)(ws + WS_X0B);
    bf16_t* PQ = PBUF;
    unsigned short* PIDX = (unsigned short*)(ws + WS_YCAT); float* PGATE = (float*)(ws + WS_YCAT + 8388608); _Float16* PW = (_Float16*)(ws + WS_YCAT + 16777216);
    _Float16* PD = (_Float16*)(ws + WS_L0X);

    if (IN(PH_PRO)) {
        const int fl = P.flags;
        if (!(fl & 2)) {
        modgemv(F, P.in[I_C], P.in[I_CCTX], P.in[I_WMOD0], P.in[I_BMOD0], MOD0, MC0, 4096);
        }
        if (!(fl & 4)) {
        colmax_task(F, P.in[I_WIN0], 2048, 3904, 4096, SW);
        tconv_task(F, P.in[I_WUQ0], 512, 1536, 1536, WUQ);
        tconv_task(F, P.in[I_WUKV0], 256, 2048, 2048, WUKV);
        }
        if (!(fl & 16)) {
        cvt_task(F, P.in[I_PKEYS0], KEYS0, 32768 / 8);
        cvt_task(F, P.in[I_PKEYS1], KEYS1, 32768 / 8);
        cvt_task(F, P.in[I_GMWS1], GMWS, 131072 / 8);
        rope_tables(F, ROPEC, ROPES);
        hyena_filter_gen(F, KZ, FPART);
        }
        if (!(fl & 8)) {
        }
    }
    SEAM(PH_PRO);
    if (IN(PH_NORM0)) {
        tconv_q_task(F, P.in[I_WIN0], 2048, 3904, 4096, SW, (unsigned char*)WIN0);
        norm_rows<true>(F, P.in[I_X], SEQ, P.in[I_LN1G0], MOD0 + 2048, MOD0, nullptr, H8, SA);
        norm_rows<true>(F, P.in[I_CTX], CTXL, P.in[I_LN1G0], MC0 + 2048, MC0, nullptr, H8 + (size_t)SEQ * 2048, SA + SEQ);
        hyena_filter_norm(F, FPART, FNORM);
        fft_pass<1024, false, 0>(F, KZ, KZ2, nullptr, nullptr, nullptr, nullptr);
    }
    SEAM(PH_NORM0);
    if (IN(PH_IN0)) {
        pg8::Gemm g{(const bf16_t*)H8, (const bf16_t*)WIN0, SEQ, 4096, 1024}; OrderIn0 S; S.init2(F.G, F.bid);
        EpiI8G E{PBUF, 4096, 0, SA, SW};
        pg8::gemm_phase<EpiI8G, OrderIn0, false>(F.lds, g, S, E, nullptr);
        const bool sh = F.G > 2;
        if (!sh || F.bid >= 2) {
            Fr F2 = F; if (sh) { F2.bid -= 2; F2.G -= 2; }
            __syncthreads();
            colmax_task(F2, P.in[I_WIN1], 2048, 5120, 5120, SW + 6144);
            colmax_task(F2, P.in[I_WOUT1], 2048, 2048, 2048, SW + 15360);
            colmax_task(F2, P.in[I_WOUT0], 2048, 2048, 2048, SW + 13312);
            colmax_task(F2, P.in[I_PWQ1], 2048, 2048, 2048, SW + 11264);
            colmax_task(F2, P.in[I_PWQ0], 2048, 2048, 2048, SW + 4096);
            cvt_table<false>(F2, P.in[I_PU1], TABU + (size_t)33554432, TSC + 32768);
        }
    }
    SEAM(PH_IN0);
    if (IN(PH_POST0)) {
        l0_post_proj(F, PBUF, QN, KVN, KROPE, YCAT, ROPEC, ROPES, NKEY);
        fft_pass<32, false, 0>(F, KZ2, KZ, nullptr, nullptr, nullptr, nullptr);
    }
    SEAM(PH_POST0);
    if (IN(PH_UP0)) {
        { pg8::Gemm g{QN, WUQ, SEQ, 1536, 512}; pg8::StaticOrder S; S.init(SEQ, 1536, F.G, F.bid);
          EpiQRope E{Q, ROPEC, ROPES};
          pg8::gemm_phase<EpiQRope, pg8::StaticOrder, false>(F.lds, g, S, E, nullptr); }
        { pg8::Gemm g{KVN, WUKV, NKEY, 2048, 256}; OrderKV S; S.init(NKEY, 2048, F.G, F.bid);
          EpiBf16G E{KV, 2048, 0};
          pg8::gemm_phase<EpiBf16G, OrderKV, false>(F.lds, g, S, E, nullptr); }
    }
    SEAM(PH_UP0);
    unsigned char* K8N = (unsigned char*)PBUF; unsigned char* K8R = K8N + (size_t)8 * NKEY * 128; float* SKT = (float*)(K8R + (size_t)8 * NKEY * 64);
    if (IN(PH_KQ)) att::kq_phase(F, KV, KROPE, K8N, K8R, SKT, NKEY);
    SEAM(PH_KQ);
    if (IN(PH_ATT)) {
        const int nu = F.bid < 512 ? (512 - F.bid + F.G - 1) / F.G : 0;
        const int grp = (F.bid >> 3) % 3, slot = grp < nu ? grp : nu;
        for (int i = 0; i <= nu; ++i) {
            if (i == slot) {
                Fr F3 = F;
                asm volatile("" : "+v"(F3.tid), "+v"(F3.lane));
                asm volatile("" : "+s"(F3.bid), "+s"(F3.wave), "+s"(F3.G));
                tconv_q_task(F3, P.in[I_WOUT0], 2048, 2048, 2048, SW + 13312, (unsigned char*)WOUT0);
                tconv_q_task(F3, P.in[I_WOUT1], 2048, 2048, 2048, SW + 15360, (unsigned char*)WOUT1);
                tconv_q_task(F3, P.in[I_PWQ0], 2048, 2048, 2048, SW + 4096, (unsigned char*)WPQ0);
                tconv_q_task(F3, P.in[I_PWQ1], 2048, 2048, 2048, SW + 11264, (unsigned char*)WPQ1);
                tconv_q_task(F3, P.in[I_WIN1], 2048, 5120, 5120, SW + 6144, (unsigned char*)WIN1);
                cvt_table<false>(F3, P.in[I_PU0], TABU, TSC);
                cvt_table<true>(F3, P.in[I_PV0], TABV, TSC + 16384);
                cvt_table<true>(F3, P.in[I_PV1], TABV + (size_t)33554432, TSC + 49152);
                modgemv(F3, P.in[I_C], nullptr, P.in[I_WMOD1], P.in[I_BMOD1], MOD1, nullptr, 0);
            }
            if (i < nu) {
                const int u = F.bid + i * F.G, h = u & 7, qb = u >> 3;
                att::attn_body8(Q + (size_t)qb * 256 * 1536 + h * 192, K8N + (size_t)h * NKEY * 128, K8R + (size_t)h * NKEY * 64, SKT + h * (NKEY / 64), KV + h * 256 + 128,
                                YCAT + (size_t)qb * 256 * 2048 + 1024 + h * 128, NKEY, F.lds);
            }
        }
    }
    SEAM(PH_ATT);
    if (IN(PH_QY0)) quant_rows(F, YCAT, H8, SA);
    SEAM(PH_QY0);
    if (IN(PH_OUT0)) {
        pg8::Gemm g{(const bf16_t*)H8, (const bf16_t*)WOUT0, SEQ, 2048, 1024}; pg8::StaticOrder S; S.init(SEQ, 2048, F.G, F.bid);
        EpiResid<true, true> E{P.in[I_X], XR, MOD0 + 4096, SA, SW + 13312};
        pg8::gemm_phase<EpiResid<true, true>, pg8::StaticOrder, false>(F.lds, g, S, E, nullptr);
    }
    SEAM(PH_OUT0);
    if (IN(PH_PNORM0)) {
        norm_rows_b<true>(F, XR, P.in[I_LN2G0], MOD0 + 8192, MOD0 + 6144, nullptr, H8, SA);
        fft_pass<1, false, 0>(F, KZ, KZ2, nullptr, nullptr, nullptr, nullptr);
    }
    SEAM(PH_PNORM0);
    if (IN(PH_PQ0)) {
        pg8::Gemm g{(const bf16_t*)H8, (const bf16_t*)WPQ0, SEQ, 2048, 1024}; pg8::StaticOrder S; S.init(SEQ, 2048, F.G, F.bid);
        EpiI8G E{PQ, 2048, 0, SA, SW + 4096};
        pg8::gemm_phase<EpiI8G, pg8::StaticOrder, false>(F.lds, g, S, E, nullptr);
    }
    SEAM(PH_PQ0);
    if (IN(PH_SEL0)) peer_select(F, PQ, KEYS0, PIDX, PGATE);
    SEAM(PH_SEL0);
    XCC_REFRESH();
    if (IN(PH_U0)) peer_sliced<0>(F, TABU, PIDX, H8, SA, nullptr, PD, nullptr, nullptr);
    SEAM(PH_U0);
    if (IN(PH_W0)) peer_weights(F, PD, PIDX, PGATE, TSC, TSC + 16384, PW);
    SEAM(PH_W0);
    XCC_REFRESH();
    if (IN(PH_V0)) peer_sliced<1>(F, TABV, PIDX, nullptr, nullptr, PW, nullptr, XR, (P.flags & 1) ? (const float*)(ws + WS_CTL + 40960) : MOD0 + 10240);
    SEAM(PH_V0);
    if (IN(PH_N1)) norm_rows_b<true>(F, XR, P.in[I_LN1G1], MOD1 + 2048, MOD1, nullptr, H8, SA);
    SEAM(PH_N1);
    if (IN(PH_IN1)) {
        pg8::Gemm g{(const bf16_t*)H8, (const bf16_t*)WIN1, SEQ, 5120, 1024}; pg8::StaticOrder S; S.init(SEQ, 5120, F.G, F.bid);
        EpiI8G E{PBUF, 5120, 2048, SA, SW + 6144};
        pg8::gemm_phase<EpiI8G, pg8::StaticOrder, false>(F.lds, g, S, E, nullptr);
    }
    SEAM(PH_IN1);
    if (IN(PH_POST1)) {
        gmlp_phase(F, PBUF, GMWS, YCAT);
        hyena_pre(F, PBUF, Z, G1B, X0B);
    }
    SEAM(PH_POST1);
    if (IN(PH_F1)) fft_pass<1024, false, 1>(F, Z, Z, nullptr, nullptr, nullptr, nullptr);
    SEAM(PH_F1);
    if (IN(PH_F2)) fft_pass<32, false, 0>(F, Z, Z, nullptr, nullptr, nullptr, nullptr);
    SEAM(PH_F2);
    if (IN(PH_F3)) fft_pass<1, false, 0>(F, Z, Z, nullptr, nullptr, nullptr, nullptr);
    SEAM(PH_F3);
    if (IN(PH_PWISE)) fft_pointwise(F, Z, KZ2, FNORM);
    SEAM(PH_PWISE);
    if (IN(PH_I1)) fft_pass<1, true, 0>(F, Z, Z, nullptr, nullptr, nullptr, nullptr);
    SEAM(PH_I1);
    if (IN(PH_I2)) fft_pass<32, true, 0>(F, Z, Z, nullptr, nullptr, nullptr, nullptr);
    SEAM(PH_I2);
    if (IN(PH_I3)) fft_pass<1024, true, 2>(F, Z, Z, G1B, X0B, P.in[I_HYBIAS1], YCAT);
    SEAM(PH_I3);
    if (IN(PH_QY1)) quant_rows(F, YCAT, H8, SA);
    SEAM(PH_QY1);
    if (IN(PH_OUT1)) {
        pg8::Gemm g{(const bf16_t*)H8, (const bf16_t*)WOUT1, SEQ, 2048, 1024}; pg8::StaticOrder S; S.init(SEQ, 2048, F.G, F.bid);
        EpiResid<false, true> E{XR, XR, MOD1 + 4096, SA, SW + 15360};
        pg8::gemm_phase<EpiResid<false, true>, pg8::StaticOrder, false>(F.lds, g, S, E, nullptr);
    }
    SEAM(PH_OUT1);
    if (IN(PH_PNORM1)) norm_rows_b<true>(F, XR, P.in[I_LN2G1], MOD1 + 8192, MOD1 + 6144, nullptr, H8, SA);
    SEAM(PH_PNORM1);
    if (IN(PH_PQ1)) {
        pg8::Gemm g{(const bf16_t*)H8, (const bf16_t*)WPQ1, SEQ, 2048, 1024}; pg8::StaticOrder S; S.init(SEQ, 2048, F.G, F.bid);
        EpiI8G E{PQ, 2048, 0, SA, SW + 11264};
        pg8::gemm_phase<EpiI8G, pg8::StaticOrder, false>(F.lds, g, S, E, nullptr);
    }
    SEAM(PH_PQ1);
    if (IN(PH_SEL1)) peer_select(F, PQ, KEYS1, PIDX, PGATE);
    SEAM(PH_SEL1);
    XCC_REFRESH();
    if (IN(PH_U1)) peer_sliced<0>(F, TABU + (size_t)33554432, PIDX, H8, SA, nullptr, PD, nullptr, nullptr);
    SEAM(PH_U1);
    if (IN(PH_W1)) peer_weights(F, PD, PIDX, PGATE, TSC + 32768, TSC + 49152, PW);
    SEAM(PH_W1);
    XCC_REFRESH();
    if (IN(PH_V1)) peer_sliced<1>(F, TABV + (size_t)33554432, PIDX, nullptr, nullptr, PW, nullptr, XR, MOD1 + 10240);
    SEAM(PH_V1);
    if (IN(PH_FIN)) final_norm_rows(F, XR, P.in[I_FINALG], P.out);
#undef IN
#undef SEAM
}

#include <cstdio>
extern "C" void kernel_launch(void* const* d_in, const int* in_sizes, int n_in, void* d_out, int out_size, void* d_ws, size_t ws_size, hipStream_t stream) {
    static int grid = 0;
    if (grid == 0) {
        if (n_in != 43 || in_sizes[0] != SEQ * DM || out_size != SEQ * DM || ws_size < WS_END) {
            fprintf(stderr, "kernel_launch: unexpected shapes: n_in %d in0 %d out %d ws %zu (need %zu)\n", n_in, n_in > 0 ? in_sizes[0] : -1, out_size, ws_size, (size_t)WS_END); grid = -1; return; }
        int dev = 0, cus = 0, per_cu = 0;
        if (hipGetDevice(&dev) != hipSuccess || hipDeviceGetAttribute(&cus, hipDeviceAttributeMultiprocessorCount, dev) != hipSuccess) { grid = -1; return; }
        if (hipFuncSetAttribute((const void*)mk_fwd, hipFuncAttributeMaxDynamicSharedMemorySize, LDS_BYTES) != hipSuccess) { fprintf(stderr, "kernel_launch: hipFuncSetAttribute failed\n"); grid = -1; return; }
        if (hipOccupancyMaxActiveBlocksPerMultiprocessor(&per_cu, (const void*)mk_fwd, NTHR, LDS_BYTES) != hipSuccess || per_cu < 1) { fprintf(stderr, "kernel_launch: occupancy query says %d blocks per CU\n", per_cu); (void)hipGetLastError(); grid = -1; return; }
        grid = cus;
    }
    if (grid < 0) return;
    (void)hipMemsetAsync((char*)d_ws + WS_CTL, 0, 65536, stream);
    Params p{};
    for (int i = 0; i < 43; ++i) p.in[i] = (const float*)d_in[i];
    p.out = (float*)d_out; p.ws = (unsigned char*)d_ws;
#if MK_PER_PHASE
    for (int ph = 0; ph < NPH; ++ph) { p.ph_lo = ph; p.ph_hi = ph + 1; hipLaunchKernelGGL(mk_fwd, dim3(grid), dim3(NTHR), LDS_BYTES, stream, p); }
#else
#if PROBE_SEQ == 0
    p.ph_lo = 0; p.ph_hi = NPH;
    hipLaunchKernelGGL(mk_fwd, dim3(grid), dim3(NTHR), LDS_BYTES, stream, p);
#elif PROBE_SEQ == 40
    p.ph_lo = 0; p.ph_hi = NPH;
    hipLaunchKernelGGL(mk_fwd, dim3(grid), dim3(NTHR), LDS_BYTES, stream, p);
    for (int r = 0; r < 6; ++r) for (int ph = PROBE_LO; ph < PROBE_HI; ++ph) { p.ph_lo = ph; p.ph_hi = ph + 1; p.flags = 32; hipLaunchKernelGGL(mk_fwd, dim3(grid), dim3(NTHR), LDS_BYTES, stream, p); }
#elif PROBE_SEQ >= 20
    p.ph_lo = 0; p.ph_hi = NPH;
    hipLaunchKernelGGL(mk_fwd, dim3(grid), dim3(NTHR), LDS_BYTES, stream, p);
    for (int r = 0; r < 8; ++r) { p.ph_lo = 0; p.ph_hi = 1; p.flags = PROBE_FLAGS; hipLaunchKernelGGL(mk_fwd, dim3(grid), dim3(NTHR), LDS_BYTES, stream, p); }
#else
    static const int seq[][2] = {
#if PROBE_SEQ == 1
        {0, PH_U0 + 1}, {PH_U0, PH_U0 + 1}, {PH_U0 + 1, NPH}
#elif PROBE_SEQ == 2
        {0, PH_SEL0 + 1}, {PH_SEL0, PH_SEL0 + 1}, {PH_SEL0 + 1, NPH}
#elif PROBE_SEQ == 10
        {0, PH_W0 + 1}, {PH_W0, PH_W0 + 1}, {PH_W0 + 1, NPH}
#elif PROBE_SEQ == 11
        {0, 1}, {0, 1}, {1, NPH}
#elif PROBE_SEQ == 12
        {0, PH_POST1 + 1}, {PH_POST1, PH_POST1 + 1}, {PH_POST1 + 1, NPH}
#elif PROBE_SEQ == 13
        {0, PH_OUT1}, {PH_POST1, PH_OUT1}, {PH_OUT1, NPH}
#elif PROBE_SEQ == 15
        {0, PH_PQ0 + 1}, {PH_PQ0, PH_PQ0 + 1}, {PH_PQ0 + 1, NPH}
#elif PROBE_SEQ == 16
        {0, PH_IN0 + 1}, {PH_IN0, PH_IN0 + 1}, {PH_IN0 + 1, NPH}
#elif PROBE_SEQ == 14
        {0, PH_N1 + 1}, {PH_N1, PH_N1 + 1}, {PH_N1 + 1, NPH}
#elif PROBE_SEQ == 99
        {0, 0}
#elif PROBE_SEQ == 3
        {0, PH_UP0 + 1}, {PH_UP0, PH_UP0 + 1}, {PH_UP0 + 1, NPH}
#elif PROBE_SEQ == 5
        {0, PH_IN1 + 1}, {PH_IN1, PH_IN1 + 1}, {PH_IN1 + 1, NPH}
#elif PROBE_SEQ == 6
        {0, PH_OUT0 + 1}, {PH_OUT0, PH_OUT0 + 1}, {PH_OUT0 + 1, NPH}
#elif PROBE_SEQ == 7
        {0, PH_NORM0 + 1}, {PH_NORM0, PH_NORM0 + 1}, {PH_NORM0 + 1, NPH}
#elif PROBE_SEQ == 8
        {0, PH_POST0 + 1}, {PH_POST0, PH_POST0 + 1}, {PH_POST0 + 1, NPH}
#elif PROBE_SEQ == 9
        {0, PH_PNORM0 + 1}, {PH_PNORM0, PH_PNORM0 + 1}, {PH_PNORM0 + 1, NPH}
#elif PROBE_SEQ == 4
        {0, PH_V0 + 1}, {-PH_V0, PH_V0 + 1}, {PH_V0 + 1, NPH}
#endif
    };
#if PROBE_SEQ == 99
    for (int ph = 0; ph < NPH; ++ph) { p.ph_lo = ph; p.ph_hi = ph + 1; hipLaunchKernelGGL(mk_fwd, dim3(grid), dim3(NTHR), LDS_BYTES, stream, p); }
#endif
    for (unsigned i = 0; i < sizeof(seq) / sizeof(seq[0]); ++i) {
        if (PROBE_SEQ == 99) break;
        (void)hipMemsetAsync((char*)d_ws + WS_CTL, 0, 65536, stream);
        p.ph_lo = seq[i][0] < 0 ? -seq[i][0] : seq[i][0]; p.ph_hi = seq[i][1]; p.flags = seq[i][0] < 0 ? 1 : 0;
        hipLaunchKernelGGL(mk_fwd, dim3(grid), dim3(NTHR), LDS_BYTES, stream, p);
    }
#endif
#endif
    const hipError_t le = hipPeekAtLastError();
    if (le != hipSuccess) fprintf(stderr, "kernel_launch: launch failed: %s\n", hipGetErrorName(le));
}
```

```cpp
#include <hip/hip_runtime.h>
namespace pg8 {
#define PG8_LAS __attribute__((address_space(3)))
typedef unsigned short bf16_t;
typedef short bf16x8 __attribute__((ext_vector_type(8)));
typedef float f32x4 __attribute__((ext_vector_type(4)));
typedef unsigned u32x4 __attribute__((ext_vector_type(4)));
constexpr int BM = 256, BK = 64, HALF = 128, HTB = HALF * BK * 2  , STAGE_BYTES = 8 * HTB, NXCD = 8, WGM = 8;

__host__ __device__ __forceinline__ int lds_byte(int r, int c) { const int st = (r >> 4) * 2 + (c >> 5), rr = r & 15, cc = c & 31, ob = rr * 64 + cc * 2; return st * 1024 + (ob ^ (((ob >> 9) & 1) << 5)); }
__host__ __device__ __forceinline__ void stage_rc(int b, int& R, int& C) { const int st = b / 1024, sb = b % 1024, swz = sb ^ (((sb >> 9) & 1) << 5); R = (st >> 1) * 16 + swz / 64; C = (st & 1) * 32 + (swz % 64) / 2; }
__host__ __device__ __forceinline__ int perm32(int rho) { const int n = rho >> 4, i = rho & 15; return 8 * (i >> 2) + 4 * n + (i & 3); }

struct Unit { int pm, pn; };
struct Gemm { const bf16_t* A; const bf16_t* Bt; int M, N, K; };

struct StaticOrder {
    int nM, nN, nwg, G, c;
    __host__ __device__ void init(int M, int N, int G_, int c_) { nM = M / BM; nN = N / BM; nwg = nM * nN; G = G_; c = c_; }
    __host__ __device__ bool next(int i, Unit& u) const {
        const long L = (long)i * G + c; if (L >= nwg) return false;
        int wgid = (int)L; { const int q = nwg / NXCD, r = nwg % NXCD, xcd = wgid % NXCD, off = wgid / NXCD; wgid = (xcd < r ? xcd * (q + 1) : r * (q + 1) + (xcd - r) * q) + off; }
        const int nig = WGM * nN, gid = wgid / nig, fm = gid * WGM, gsz = (nM - fm) < WGM ? (nM - fm) : WGM;
        u.pm = fm + ((wgid % nig) % gsz); u.pn = (wgid % nig) / gsz; return true;
    }
    __device__ __forceinline__ void a_ready(const Unit&) const {}
    __device__ __forceinline__ void done(const Unit&) const {}
};
struct CountedOrder : StaticOrder {
    const unsigned* ready; unsigned need; unsigned* tmo;
    __device__ __forceinline__ void a_ready(const Unit& u) const {
        if (threadIdx.x < 64) {
            const unsigned long long t0 = __builtin_amdgcn_s_memrealtime(); unsigned polls = 0;
            while ((unsigned)__builtin_amdgcn_readfirstlane(__hip_atomic_load(ready + 64 * u.pm, __ATOMIC_RELAXED, __HIP_MEMORY_SCOPE_AGENT)) < need) {
                if ((++polls & 255u) == 0u && __builtin_amdgcn_readfirstlane(__hip_atomic_load(tmo, __ATOMIC_RELAXED, __HIP_MEMORY_SCOPE_AGENT)) != 0u) break;
                if (__builtin_amdgcn_s_memrealtime() - t0 > 2000000ull) {
                    if (threadIdx.x == 0) { unsigned expect = 0u; __hip_atomic_compare_exchange_strong(tmo + 1, &expect, 0x600u | (unsigned)(u.pm & 0xff), __ATOMIC_RELAXED, __ATOMIC_RELAXED, __HIP_MEMORY_SCOPE_AGENT); __hip_atomic_store(tmo, 1u, __ATOMIC_RELAXED, __HIP_MEMORY_SCOPE_AGENT); }
                    break; }
                __builtin_amdgcn_s_sleep(2); }
            __builtin_amdgcn_fence(__ATOMIC_ACQUIRE, "agent");
            asm volatile("s_waitcnt vmcnt(0)" ::: "memory");
        }
#if !defined(BROKEN_HOOK_NO_BARRIER)
        asm volatile("" ::: "memory"); __builtin_amdgcn_s_barrier(); asm volatile("" ::: "memory");
#endif
    }
};

__device__ __forceinline__ unsigned cvt_pk_bf16(float lo, float hi) { unsigned r; asm volatile("v_cvt_pk_bf16_f32 %0, %1, %2" : "=v"(r) : "v"(lo), "v"(hi)); return r; }
typedef float f32x2 __attribute__((ext_vector_type(2)));
__device__ __forceinline__ f32x2 gelu_pk(f32x2 v) {
    const f32x2 av = __builtin_elementwise_abs(v), d = av * 0.2316418882f + 1.0f;
    f32x2 t; t.x = __builtin_amdgcn_rcpf(d.x); t.y = __builtin_amdgcn_rcpf(d.y);
    f32x2 q = t * 0.5307027145f + (-0.7265760135f); q = q * t + 0.7107068705f; q = q * t + (-0.142248368f); q = q * t + 0.127414796f; q = q * t;
    const f32x2 s = (v * v) * (-0.72134752044f);
    f32x2 e; e.x = __builtin_amdgcn_exp2f(s.x); e.y = __builtin_amdgcn_exp2f(s.y);
    const f32x2 m = v * (q * e), r = v - m;
    f32x2 o; o.x = v.x < 0.f ? m.x : r.x; o.y = v.y < 0.f ? m.y : r.y; return o;
}

struct EpiF32 {
    static constexpr bool PERM = false, AFTER_DRAIN = false;
    float* C; int ldc; const float* bias;
    __device__ __forceinline__ void operator()(const f32x4 (&acc)[2][2][4][2], const Unit& u, int wr, int wc, int fr, int fq) const {
        const int row0 = u.pm * BM + wr * 64 + fr, col0 = u.pn * BM + wc * 32 + 4 * fq;
        f32x4 bv[2][2];
#pragma unroll
        for (int bj = 0; bj < 2; ++bj)
#pragma unroll
            for (int n = 0; n < 2; ++n) bv[bj][n] = bias ? *(const f32x4*)(bias + col0 + bj * HALF + n * 16) : (f32x4){0.f, 0.f, 0.f, 0.f};
#pragma unroll
        for (int ai = 0; ai < 2; ++ai)
#pragma unroll
            for (int m = 0; m < 4; ++m) { float* rowp = C + (size_t)(row0 + ai * HALF + m * 16) * ldc + col0;
#pragma unroll
                for (int bj = 0; bj < 2; ++bj)
#pragma unroll
                    for (int n = 0; n < 2; ++n) *(f32x4*)(rowp + bj * HALF + n * 16) = acc[ai][bj][m][n] + bv[bj][n]; }
    }
};
template <int ACT  > struct EpiBf16 {
    static constexpr bool PERM = true, AFTER_DRAIN = false, I8 = false;
    bf16_t* O; int ldc; const float* bias; int split_cols; size_t split_stride;
    __device__ __forceinline__ void operator()(const f32x4 (&acc)[2][2][4][2], const Unit& u, int wr, int wc, int fr, int fq) const {
        const int row0 = u.pm * BM + wr * 64 + fr; int colt = u.pn * BM; bf16_t* base = O;
        if (split_cols) { const int t = colt / split_cols; base += (size_t)t * split_stride; colt -= t * split_cols; }
        const int col0 = colt + wc * 32 + 8 * fq, bcol0 = u.pn * BM + wc * 32 + 8 * fq;
        f32x4 bv[2][2];
#pragma unroll
        for (int bj = 0; bj < 2; ++bj)
#pragma unroll
            for (int n = 0; n < 2; ++n) bv[bj][n] = bias ? *(const f32x4*)(bias + bcol0 + bj * HALF + 4 * n) : (f32x4){0.f, 0.f, 0.f, 0.f};
#pragma unroll
        for (int ai = 0; ai < 2; ++ai)
#pragma unroll
            for (int m = 0; m < 4; ++m) { bf16_t* rowp = base + (size_t)(row0 + ai * HALF + m * 16) * ldc + col0;
#pragma unroll
                for (int bj = 0; bj < 2; ++bj) { f32x4 v0 = acc[ai][bj][m][0] + bv[bj][0], v1 = acc[ai][bj][m][1] + bv[bj][1];
                    if (ACT == 1) { f32x2 a = gelu_pk((f32x2){v0[0], v0[1]}), b = gelu_pk((f32x2){v0[2], v0[3]}), c = gelu_pk((f32x2){v1[0], v1[1]}), d = gelu_pk((f32x2){v1[2], v1[3]});
                        v0 = (f32x4){a.x, a.y, b.x, b.y}; v1 = (f32x4){c.x, c.y, d.x, d.y}; }
                    if (ACT == 2) {
#pragma unroll
                        for (int j = 0; j < 4; ++j) { v0[j] = 0.5f * v0[j] * (1.0f + erff(v0[j] * 0.70710678f)); v1[j] = 0.5f * v1[j] * (1.0f + erff(v1[j] * 0.70710678f)); } }
                    u32x4 w; w.x = cvt_pk_bf16(v0[0], v0[1]); w.y = cvt_pk_bf16(v0[2], v0[3]); w.z = cvt_pk_bf16(v1[0], v1[1]); w.w = cvt_pk_bf16(v1[2], v1[3]);
                    *(u32x4*)(rowp + bj * HALF) = w; } }
    }
};

struct PanelStats {
    unsigned* xbuf;
    unsigned* cnt;
    unsigned* tmo;
    int ntn; float eps;
    unsigned code;
    __device__ __forceinline__ bool run(const f32x4 (&v)[2][2][4][2], const Unit& u, int wr, int wc, int fr, int fq, PG8_LAS unsigned char* lds, int wid, int lane) const {
        typedef float f32x2v __attribute__((ext_vector_type(2)));
        PG8_LAS f32x2v* P = (PG8_LAS f32x2v*)lds;
        PG8_LAS f32x2v* S = (PG8_LAS f32x2v*)(lds + 8192);
        PG8_LAS unsigned* flag = (PG8_LAS unsigned*)(lds + 8192 + 2048);
#pragma unroll
        for (int ai = 0; ai < 2; ++ai)
#pragma unroll
            for (int m = 0; m < 4; ++m) {
                float s = 0.f;
#pragma unroll
                for (int bj = 0; bj < 2; ++bj)
#pragma unroll
                    for (int n = 0; n < 2; ++n) { const f32x4 x = v[ai][bj][m][n]; s += (x[0] + x[1]) + (x[2] + x[3]); }
                s += __shfl_xor(s, 16); s += __shfl_xor(s, 32);
                const float mw = s * (1.0f / 64.0f); float q = 0.f;
#pragma unroll
                for (int bj = 0; bj < 2; ++bj)
#pragma unroll
                    for (int n = 0; n < 2; ++n) { const f32x4 d = v[ai][bj][m][n] - mw; q += (d[0] * d[0] + d[1] * d[1]) + (d[2] * d[2] + d[3] * d[3]); }
                q += __shfl_xor(q, 16); q += __shfl_xor(q, 32);
                if (fq == 0) P[(ai * HALF + wr * 64 + m * 16 + fr) * 4 + wc] = (f32x2v){mw, q};
            }
        asm volatile("s_waitcnt lgkmcnt(0)" ::: "memory"); __builtin_amdgcn_s_barrier(); asm volatile("" ::: "memory");
#if defined(BROKEN_NO_WAIT)
        if (blockIdx.x >= 64) { const long long t0 = clock64(); while (clock64() - t0 < 60000) __builtin_amdgcn_s_sleep(8); }
#endif
        const int row = wid * 32 + (lane & 31);
        if (lane < 32) {
            const f32x2v a = P[row * 4 + 0], b = P[row * 4 + 1], c = P[row * 4 + 2], d = P[row * 4 + 3];
            const float mt = (a.x + b.x + c.x + d.x) * 0.25f;
            const float da = a.x - mt, db = b.x - mt, dc = c.x - mt, dd = d.x - mt;
            const float m2 = (a.y + b.y) + (c.y + d.y) + 64.0f * ((da * da + db * db) + (dc * dc + dd * dd));
            unsigned long long* slot = (unsigned long long*)xbuf + ((size_t)(u.pm * BM + row) * 4 + u.pn);
            __hip_atomic_store(slot, ((unsigned long long)__float_as_uint(m2) << 32) | __float_as_uint(mt), __ATOMIC_RELAXED, __HIP_MEMORY_SCOPE_AGENT);
        }
        asm volatile("s_waitcnt vmcnt(0)" ::: "memory");
        if (lane == 0) __hip_atomic_fetch_add(cnt + 64 * u.pm, 1u, __ATOMIC_RELAXED, __HIP_MEMORY_SCOPE_AGENT);
        if (wid == 0) {
            bool dead = false; const unsigned long long t0 = __builtin_amdgcn_s_memrealtime(); const unsigned want = 8u * (unsigned)ntn;
            for (;;) {
#if defined(BROKEN_NO_WAIT)
                break;
#endif
                if ((unsigned)__builtin_amdgcn_readfirstlane(__hip_atomic_load(cnt + 64 * u.pm, __ATOMIC_RELAXED, __HIP_MEMORY_SCOPE_AGENT)) >= want) break;
                if (__builtin_amdgcn_s_memrealtime() - t0 > 2000000ull) {
                    if (lane == 0) { unsigned expect = 0u; __hip_atomic_compare_exchange_strong(tmo + 1, &expect, code | (unsigned)(u.pm & 0xff), __ATOMIC_RELAXED, __ATOMIC_RELAXED, __HIP_MEMORY_SCOPE_AGENT);
                                     __hip_atomic_store(tmo, 1u, __ATOMIC_RELAXED, __HIP_MEMORY_SCOPE_AGENT); }
                    dead = true; break; }
                __builtin_amdgcn_s_sleep(2);
            }
            __builtin_amdgcn_fence(__ATOMIC_ACQUIRE, "agent");
            if (lane == 0) flag[0] = dead ? 1u : 0u;
        }
        asm volatile("s_waitcnt vmcnt(0) lgkmcnt(0)" ::: "memory"); __builtin_amdgcn_s_barrier(); asm volatile("" ::: "memory");
        const bool bad = flag[0] != 0u;
        if (lane < 32) {
            const unsigned long long* slot = (const unsigned long long*)xbuf + (size_t)(u.pm * BM + row) * 4; float mt[4], m2[4]; float ms = 0.f;
#pragma unroll
            for (int t = 0; t < 4; ++t) { if (t < ntn) { const unsigned long long w = __hip_atomic_load(slot + t, __ATOMIC_RELAXED, __HIP_MEMORY_SCOPE_AGENT); mt[t] = __uint_as_float((unsigned)w); m2[t] = __uint_as_float((unsigned)(w >> 32)); } else { mt[t] = 0.f; m2[t] = 0.f; } ms += mt[t]; }
            const float mean = ms / (float)ntn; float q = 0.f;
#pragma unroll
            for (int t = 0; t < 4; ++t) if (t < ntn) { const float dm = mt[t] - mean; q += m2[t] + 256.0f * dm * dm; }
            S[row] = (f32x2v){mean, 1.0f / sqrtf(q / (256.0f * (float)ntn) + eps)};
        }
        asm volatile("s_waitcnt lgkmcnt(0)" ::: "memory"); __builtin_amdgcn_s_barrier(); asm volatile("" ::: "memory");
        return bad;
    }
};
struct EpiLnRes {
    static constexpr bool PERM = false, AFTER_DRAIN = true;
    const float* base; float* out; int ldc; const float* bias; PanelStats st; unsigned poison;
    __device__ __forceinline__ void refuse(size_t i0, size_t stride, int M, int N) const { const float q = __builtin_nanf(""); for (size_t i = i0; i < (size_t)M * N; i += stride) out[(i / N) * ldc + i % N] = q;
        if (i0 == 0) { unsigned expect = 0u; __hip_atomic_compare_exchange_strong(st.tmo + 1, &expect, 0x7f0u, __ATOMIC_RELAXED, __ATOMIC_RELAXED, __HIP_MEMORY_SCOPE_AGENT); __hip_atomic_store(st.tmo, 1u, __ATOMIC_RELAXED, __HIP_MEMORY_SCOPE_AGENT); } }
    __device__ __forceinline__ void fused(f32x4 (&acc)[2][2][4][2], const Unit& u, int wr, int wc, int fr, int fq, PG8_LAS unsigned char* lds, int wid, int lane) const {
        typedef float f32x2v __attribute__((ext_vector_type(2)));
        const PG8_LAS f32x2v* S = (const PG8_LAS f32x2v*)(lds + 8192);
        const int col0 = u.pn * BM + wc * 32 + 4 * fq;
#pragma unroll
        for (int bj = 0; bj < 2; ++bj)
#pragma unroll
            for (int n = 0; n < 2; ++n) { const f32x4 bv = bias ? *(const f32x4*)(bias + col0 + bj * HALF + n * 16) : (f32x4){0.f, 0.f, 0.f, 0.f};
#pragma unroll
                for (int ai = 0; ai < 2; ++ai)
#pragma unroll
                    for (int m = 0; m < 4; ++m) acc[ai][bj][m][n] += bv; }
        const bool bad = st.run(acc, u, wr, wc, fr, fq, lds, wid, lane) || poison != 0u;
        const float qnan = __builtin_nanf("");
#pragma unroll
        for (int ai = 0; ai < 2; ++ai)
#pragma unroll
            for (int m = 0; m < 4; ++m) { const int r = ai * HALF + wr * 64 + m * 16 + fr; const f32x2v sr = S[r]; const size_t off = (size_t)(u.pm * BM + r) * ldc + col0;
#pragma unroll
                for (int bj = 0; bj < 2; ++bj)
#pragma unroll
                    for (int n = 0; n < 2; ++n) { const f32x4 bs = *(const f32x4*)(base + off + bj * HALF + n * 16); f32x4 o = bs + (acc[ai][bj][m][n] - sr.x) * sr.y;
                        if (bad) o = (f32x4){qnan, qnan, qnan, qnan}; *(f32x4*)(out + off + bj * HALF + n * 16) = o; }
                asm volatile("" ::: "memory"); }
    }
};
struct EpiLnResLn {
    static constexpr bool PERM = false, AFTER_DRAIN = true;
    const float* base; float* out; bf16_t* xn; int ldc; const float* bias; PanelStats st1, st2; unsigned poison;
    __device__ __forceinline__ void refuse(size_t i0, size_t stride, int M, int N) const { const float q = __builtin_nanf(""); for (size_t i = i0; i < (size_t)M * N; i += stride) { const size_t o = (i / N) * ldc + i % N; out[o] = q; xn[o] = (bf16_t)0x7fc0u; }
        if (i0 == 0) { unsigned expect = 0u; __hip_atomic_compare_exchange_strong(st1.tmo + 1, &expect, 0x7f0u, __ATOMIC_RELAXED, __ATOMIC_RELAXED, __HIP_MEMORY_SCOPE_AGENT); __hip_atomic_store(st1.tmo, 1u, __ATOMIC_RELAXED, __HIP_MEMORY_SCOPE_AGENT); } }
    __device__ __forceinline__ void fused(f32x4 (&acc)[2][2][4][2], const Unit& u, int wr, int wc, int fr, int fq, PG8_LAS unsigned char* lds, int wid, int lane) const {
        typedef float f32x2v __attribute__((ext_vector_type(2))); typedef unsigned u32x2v __attribute__((ext_vector_type(2)));
        const PG8_LAS f32x2v* S = (const PG8_LAS f32x2v*)(lds + 8192);
        const int col0 = u.pn * BM + wc * 32 + 4 * fq;
#pragma unroll
        for (int bj = 0; bj < 2; ++bj)
#pragma unroll
            for (int n = 0; n < 2; ++n) { const f32x4 bv = bias ? *(const f32x4*)(bias + col0 + bj * HALF + n * 16) : (f32x4){0.f, 0.f, 0.f, 0.f};
#pragma unroll
                for (int ai = 0; ai < 2; ++ai)
#pragma unroll
                    for (int m = 0; m < 4; ++m) acc[ai][bj][m][n] += bv; }
        bool bad = st1.run(acc, u, wr, wc, fr, fq, lds, wid, lane) || poison != 0u;
        const float qnan = __builtin_nanf("");
#pragma unroll
        for (int ai = 0; ai < 2; ++ai)
#pragma unroll
            for (int m = 0; m < 4; ++m) { const int r = ai * HALF + wr * 64 + m * 16 + fr; const f32x2v sr = S[r]; const size_t off = (size_t)(u.pm * BM + r) * ldc + col0;
#pragma unroll
                for (int bj = 0; bj < 2; ++bj)
#pragma unroll
                    for (int n = 0; n < 2; ++n) { const f32x4 bs = *(const f32x4*)(base + off + bj * HALF + n * 16); acc[ai][bj][m][n] = bs + (acc[ai][bj][m][n] - sr.x) * sr.y; }
                asm volatile("" : "+v"(acc[ai][0][m][0]), "+v"(acc[ai][0][m][1]), "+v"(acc[ai][1][m][0]), "+v"(acc[ai][1][m][1]));
                if (m & 1) asm volatile("" ::: "memory"); }
        const bool bad1 = bad;
        bad = st2.run(acc, u, wr, wc, fr, fq, lds, wid, lane) || bad;
#pragma unroll
        for (int ai = 0; ai < 2; ++ai)
#pragma unroll
            for (int m = 0; m < 4; ++m) { const int r = ai * HALF + wr * 64 + m * 16 + fr; const f32x2v sr = S[r]; const size_t off = (size_t)(u.pm * BM + r) * ldc + col0;
#pragma unroll
                for (int bj = 0; bj < 2; ++bj)
#pragma unroll
                    for (int n = 0; n < 2; ++n) { const f32x4 x1 = acc[ai][bj][m][n]; *(f32x4*)(out + off + bj * HALF + n * 16) = bad1 ? (f32x4){qnan, qnan, qnan, qnan} : x1;
                        const f32x4 o = (x1 - sr.x) * sr.y; u32x2v w; w.x = cvt_pk_bf16(o[0], o[1]); w.y = cvt_pk_bf16(o[2], o[3]);
                        if (bad) { w.x = 0x7fc07fc0u; w.y = 0x7fc07fc0u; } *(u32x2v*)(xn + off + bj * HALF + n * 16) = w; }
                asm volatile("" ::: "memory"); }
    }
};

typedef int i32x4_t __attribute__((ext_vector_type(4)));
template <bool I8> __device__ __forceinline__ f32x4 mma_step(const bf16x8& b, const bf16x8& a, const f32x4& c) {
    if constexpr (I8) { const i32x4_t r = __builtin_amdgcn_mfma_i32_16x16x64_i8(__builtin_bit_cast(i32x4_t, b), __builtin_bit_cast(i32x4_t, a), __builtin_bit_cast(i32x4_t, c), 0, 0, 0); return __builtin_bit_cast(f32x4, r); }
    else return __builtin_amdgcn_mfma_f32_16x16x32_bf16(b, a, c, 0, 0, 0);
}
template <class Epi, class Sched, bool STAMP = false>
__device__ __forceinline__ void gemm_phase(PG8_LAS unsigned char* lds, const Gemm g, const Sched& S, const Epi& E, unsigned long long* stamps) {
    const int tid = threadIdx.x, wid = __builtin_amdgcn_readfirstlane(tid >> 6), lane = tid & 63, wr = wid >> 2, wc = wid & 3, fr = lane & 15, fq = lane >> 4;
    const int K = g.K, nt = K / BK;
    int ts_lo = 0, ts_hi = 0, nts = 0; const unsigned long long rt_entry = STAMP ? (unsigned long long)wall_clock64() : 0ull;
#define PG8_STAMP() do { if (STAMP && wid == 0 && nts < 64) { const unsigned long long _c = (unsigned long long)clock64(); \
        ts_lo = (lane == nts) ? (int)(unsigned)_c : ts_lo; ts_hi = (lane == nts) ? (int)(unsigned)(_c >> 32) : ts_hi; ++nts; } } while (0)
    PG8_STAMP();
    unsigned voffA[2], voffB[2];
#pragma unroll
    for (int i = 0; i < 2; ++i) { int R, C; stage_rc(tid * 16 + i * 8192, R, C); const int Rb = Epi::PERM ? ((R & ~31) + perm32(R & 31)) : R;
        voffA[i] = (unsigned)(R * K + C) * 2u; voffB[i] = (unsigned)(Rb * K + C) * 2u; }
    const size_t kstep = (size_t)(BK * 2);
    const size_t hstep = (size_t)HALF * K * 2;
    const size_t tstep = 2 * hstep;
    const unsigned ldsw = (unsigned)wid * 1024u;
    const int aoff = lds_byte(wr * 64 + fr, fq * 8), boff = lds_byte(wc * 32 + fr, fq * 8);
#define PG8_SA(b, h) (((b) * 2 + (h)) * HTB)
#define PG8_SB(b, h) ((4 + (b) * 2 + (h)) * HTB)
#define PG8_STAGE(bufoff, gbase, voff) do { _Pragma("unroll") for (int _i = 0; _i < 2; ++_i) \
        __builtin_amdgcn_global_load_lds((const unsigned*)((const char*)(gbase) + (voff)[_i]), (PG8_LAS unsigned*)(lds + (bufoff) + ldsw + _i * 8192), 16, 0, 0); } while (0)
#define PG8_LDA(dst, b, h) do { _Pragma("unroll") for (int m = 0; m < 4; ++m) _Pragma("unroll") for (int k = 0; k < 2; ++k) dst[m][k] = *(const PG8_LAS bf16x8*)(lds + PG8_SA(b, h) + aoff + m * 2048 + k * 1024); } while (0)
#define PG8_LDB(dst, b, h) do { _Pragma("unroll") for (int n = 0; n < 2; ++n) _Pragma("unroll") for (int k = 0; k < 2; ++k) dst[n][k] = *(const PG8_LAS bf16x8*)(lds + PG8_SB(b, h) + boff + n * 2048 + k * 1024); } while (0)
#define PG8_MMA(ai, bj, At, Bt) do { __builtin_amdgcn_s_setprio(1); _Pragma("unroll") for (int m = 0; m < 4; ++m) _Pragma("unroll") for (int n = 0; n < 2; ++n) _Pragma("unroll") for (int k = 0; k < 2; ++k) \
        acc[ai][bj][m][n] = mma_step<Epi::I8>(Bt[n][k], At[m][k], acc[ai][bj][m][n]); __builtin_amdgcn_s_setprio(0); } while (0)
#define PG8_WAIT_V(n) asm volatile("s_waitcnt vmcnt(" #n ")" ::: "memory")
#define PG8_WAIT_L(n) asm volatile("s_waitcnt lgkmcnt(" #n ")" ::: "memory")
#define PG8_BAR __builtin_amdgcn_s_barrier()
#define PG8_SCHED __builtin_amdgcn_sched_barrier(0)
    Unit cur, nxt; int ui = 0;
    if (!S.next(0, cur)) return;
    f32x4 acc[2][2][4][2];
#pragma unroll
    for (int a = 0; a < 2; ++a)
#pragma unroll
        for (int b = 0; b < 2; ++b)
#pragma unroll
            for (int m = 0; m < 4; ++m)
#pragma unroll
                for (int n = 0; n < 2; ++n) acc[a][b][m][n] = (f32x4){0.f, 0.f, 0.f, 0.f};
    bf16x8 At[4][2], B0[2][2], B1[2][2];
    const char* cA = (const char*)g.A + (size_t)cur.pm * tstep; const char* cB = (const char*)g.Bt + (size_t)cur.pn * tstep;
    S.a_ready(cur);
    PG8_STAGE(PG8_SB(0, 0), cB, voffB); PG8_STAGE(PG8_SA(0, 0), cA, voffA); PG8_STAGE(PG8_SB(0, 1), cB + hstep, voffB); PG8_STAGE(PG8_SA(0, 1), cA + hstep, voffA);
    if (wr == 1) PG8_BAR;
    PG8_WAIT_V(4); PG8_BAR;
    PG8_STAGE(PG8_SB(1, 0), cB + kstep, voffB); PG8_STAGE(PG8_SA(1, 0), cA + kstep, voffA); PG8_STAGE(PG8_SB(1, 1), cB + hstep + kstep, voffB);
    PG8_WAIT_V(6); PG8_BAR;
    PG8_STAMP();
    for (;;) {
        const bool has_next = S.next(ui + 1, nxt);
        const char* nA = has_next ? (const char*)g.A + (size_t)nxt.pm * tstep : cA; const char* nB = has_next ? (const char*)g.Bt + (size_t)nxt.pn * tstep : cB;
        for (int t = 0; t < nt; t += 2) {
            const bool last = (t == nt - 2);
            const char* a1 = cA + (size_t)(t + 1) * kstep;
            const char* a2 = last ? nA : cA + (size_t)(t + 2) * kstep; const char* b2 = last ? nB : cB + (size_t)(t + 2) * kstep;
            const char* a3 = a2 + kstep; const char* b3 = b2 + kstep;
            if (last && has_next) S.a_ready(nxt);
            PG8_LDB(B0, 0, 0); PG8_SCHED; PG8_LDA(At, 0, 0); PG8_STAGE(PG8_SA(1, 1), a1 + hstep, voffA);
            PG8_WAIT_L(8); PG8_BAR; PG8_WAIT_L(0); PG8_MMA(0, 0, At, B0); PG8_BAR; PG8_SCHED;
            PG8_LDB(B1, 0, 1); PG8_STAGE(PG8_SB(0, 0), b2, voffB);
            PG8_BAR; PG8_WAIT_L(0); PG8_MMA(0, 1, At, B1); PG8_BAR;
            PG8_LDA(At, 0, 1); PG8_STAGE(PG8_SA(0, 0), a2, voffA);
            PG8_BAR; PG8_WAIT_L(0); PG8_MMA(1, 0, At, B0); PG8_BAR; PG8_SCHED;
            PG8_STAGE(PG8_SB(0, 1), b2 + hstep, voffB);
            PG8_WAIT_V(6); PG8_BAR; PG8_MMA(1, 1, At, B1); PG8_BAR;
            PG8_LDB(B0, 1, 0); PG8_SCHED; PG8_LDA(At, 1, 0); PG8_STAGE(PG8_SA(0, 1), a2 + hstep, voffA);
            PG8_WAIT_L(8); PG8_BAR; PG8_WAIT_L(0); PG8_MMA(0, 0, At, B0); PG8_BAR; PG8_SCHED;
            PG8_LDB(B1, 1, 1); PG8_STAGE(PG8_SB(1, 0), b3, voffB);
            PG8_BAR; PG8_WAIT_L(0); PG8_MMA(0, 1, At, B1); PG8_BAR;
            PG8_LDA(At, 1, 1); PG8_STAGE(PG8_SA(1, 0), a3, voffA);
            PG8_BAR; PG8_WAIT_L(0); PG8_MMA(1, 0, At, B0); PG8_BAR; PG8_SCHED;
            PG8_STAGE(PG8_SB(1, 1), b3 + hstep, voffB);
            PG8_WAIT_V(6); PG8_BAR; PG8_MMA(1, 1, At, B1); PG8_BAR;
        }
        PG8_STAMP();
        if constexpr (!Epi::AFTER_DRAIN) { E(acc, cur, wr, wc, fr, fq); S.done(cur); }
        PG8_STAMP();
        if (!has_next) break;
#pragma unroll
        for (int a = 0; a < 2; ++a)
#pragma unroll
            for (int b = 0; b < 2; ++b)
#pragma unroll
                for (int m = 0; m < 4; ++m)
#pragma unroll
                    for (int n = 0; n < 2; ++n) acc[a][b][m][n] = (f32x4){0.f, 0.f, 0.f, 0.f};
        cur = nxt; cA = nA; cB = nB; ++ui;
    }
    PG8_WAIT_V(0);
    if (wr == 0) PG8_BAR;
    PG8_BAR;
    if constexpr (Epi::AFTER_DRAIN) { E.fused(acc, cur, wr, wc, fr, fq, lds, wid, lane); S.done(cur); }
    PG8_STAMP();
    if (STAMP && wid == 0) { stamps[lane] = lane < nts ? (((unsigned long long)(unsigned)ts_hi << 32) | (unsigned)ts_lo) : 0ull;
        if (lane == 62) stamps[62] = rt_entry; if (lane == 63) stamps[63] = (unsigned long long)wall_clock64(); }
#undef PG8_STAMP
#undef PG8_SA
#undef PG8_SB
#undef PG8_STAGE
#undef PG8_LDA
#undef PG8_LDB
#undef PG8_MMA
#undef PG8_WAIT_V
#undef PG8_WAIT_L
#undef PG8_BAR
#undef PG8_SCHED
}
}

#define LAS __attribute__((address_space(3)))
typedef unsigned short bf16_t;
typedef short bf16x8 __attribute__((ext_vector_type(8)));
typedef short s16x4 __attribute__((ext_vector_type(4)));
typedef float f32x4 __attribute__((ext_vector_type(4)));
typedef float f32x2 __attribute__((ext_vector_type(2)));
typedef float f32x16 __attribute__((ext_vector_type(16)));
typedef unsigned u32x4 __attribute__((ext_vector_type(4)));
typedef unsigned u32x2 __attribute__((ext_vector_type(2)));
typedef __bf16 bf2_t __attribute__((ext_vector_type(2)));

constexpr int SEQ = 16384, DM = 2048, CTXL = 256, NKEY = SEQ + CTXL;
constexpr int NTHR = 512;
constexpr int ZP = 512;
constexpr int LDS_BYTES = 163840;
constexpr int LDS_CTL = LDS_BYTES - 256;

__device__ __forceinline__ float wave_sum(float v) {
#pragma unroll
    for (int o = 32; o >= 1; o >>= 1) v += __shfl_xor(v, o);
    return v;
}
__device__ __forceinline__ unsigned pk_bf16(float lo, float hi) { unsigned r; asm volatile("v_cvt_pk_bf16_f32 %0, %1, %2" : "=v"(r) : "v"(lo), "v"(hi)); return r; }
__device__ __forceinline__ float bf_lo(unsigned w) { return __uint_as_float(w << 16); }
__device__ __forceinline__ float bf_hi(unsigned w) { return __uint_as_float(w & 0xffff0000u); }
__device__ __forceinline__ float bf1(bf16_t h) { return __uint_as_float(((unsigned)h) << 16); }
__device__ __forceinline__ bf16_t f2bf(float f) { return (bf16_t)(pk_bf16(f, 0.f) & 0xffffu); }
__device__ __forceinline__ float gelu_tanh(float x) {
    const float u = 1.5957691216057308f * (x + 0.044715f * x * x * x);
    return x / (1.f + __expf(-u));
}
__device__ __forceinline__ float silu_f(float v) { return v / (1.f + __expf(-v)); }
__device__ __forceinline__ float dpp_f32_quad_swap1(float v) { return __int_as_float(__builtin_amdgcn_update_dpp(0, __float_as_int(v), 0xB1, 0xf, 0xf, true)); }
typedef _Float16 h2_t __attribute__((ext_vector_type(2)));
__device__ __forceinline__ unsigned pk_h2(f32x2 v) { h2_t h; h.x = (_Float16)v.x; h.y = (_Float16)v.y; return *(unsigned*)&h; }
__device__ __forceinline__ f32x2 un_h2(unsigned u) { h2_t h = *(h2_t*)&u; return (f32x2){(float)h.x, (float)h.y}; }

#define XB_TMO      128
#define XB_XCNT(j)  (256  + 64 * (j))
#define XB_XSUB(j)  (1280 + 64 * (j))
#define XB_XGEN(j)  (2304 + 64 * (j))
#define XB_TOP      3328
#define XB_TOPGEN   3392
#define XCD_BAR_WORDS 3456
#define XB_SPIN_CAP (1u << 22)
__device__ __forceinline__ unsigned xb_ld(unsigned* p)              { return __hip_atomic_load(p, __ATOMIC_RELAXED, __HIP_MEMORY_SCOPE_AGENT); }
__device__ __forceinline__ unsigned xb_add(unsigned* p, unsigned v) { return __hip_atomic_fetch_add(p, v, __ATOMIC_RELAXED, __HIP_MEMORY_SCOPE_AGENT); }
__device__ __forceinline__ unsigned xb_xcc_id() { return (unsigned)__builtin_amdgcn_s_getreg((3 << 11) | 20) & 0xFu; }
#define XB_SPIN(cond, bar) do { unsigned _sp = 0; while (cond) { __builtin_amdgcn_s_sleep(1); \
    if ((++_sp & 255u) == 0u) { if (xb_ld(&(bar)[XB_TMO])) break; if (_sp > XB_SPIN_CAP) { atomicAdd(&(bar)[XB_TMO], 1u); break; } } } } while (0)
struct XcdBarrier { unsigned* bar; unsigned x; volatile LAS unsigned* st; };
__device__ __forceinline__ XcdBarrier xcd_barrier_post(unsigned* bar, volatile LAS unsigned* st) {
    XcdBarrier b; b.bar = bar; b.x = xb_xcc_id(); b.st = st;
    if (threadIdx.x == 0) (void)xb_add(&bar[XB_XCNT(b.x)], 1u);
    return b;
}
__device__ __forceinline__ void xcd_barrier_complete(unsigned* bar, unsigned x, unsigned& nloc, unsigned& nx) {
    const unsigned G = gridDim.x * gridDim.y * gridDim.z;
    unsigned sum, cnt, mine, sp = 0u;
    for (;;) {
        sum = 0u; cnt = 0u; mine = 0u;
#pragma unroll
        for (unsigned j = 0; j < 16; ++j) { const unsigned c = xb_ld(&bar[XB_XCNT(j)]); sum += c; cnt += (c > 0u) ? 1u : 0u; mine = (j == x) ? c : mine; }
        if (sum == G) break;
        __builtin_amdgcn_s_sleep(1);
        if ((++sp & 255u) == 0u) { if (xb_ld(&bar[XB_TMO])) break; if (sp > XB_SPIN_CAP) { atomicAdd(&bar[XB_TMO], 1u); break; } }
    }
    nloc = mine > 0u ? mine : 1u; nx = cnt > 0u ? cnt : 1u;
}
__device__ __forceinline__ void xcd_barrier(const XcdBarrier& b) {
    asm volatile("s_waitcnt vmcnt(0)" ::: "memory");
    __syncthreads();
    if (threadIdx.x == 0) {
        unsigned* bar = b.bar;
        __builtin_amdgcn_s_waitcnt(0);
        unsigned nloc = b.st[0], nx = b.st[1];
        if (nloc == 0u) { xcd_barrier_complete(bar, b.x, nloc, nx); b.st[0] = nloc; b.st[1] = nx; }
        const unsigned old = xb_add(&bar[XB_XSUB(b.x)], 1u);
        const unsigned gen = old / nloc;
        if (old + 1u == (gen + 1u) * nloc) {
            __builtin_amdgcn_fence(__ATOMIC_RELEASE, "agent");
            asm volatile("s_waitcnt vmcnt(0)" ::: "memory");
            const unsigned og = xb_add(&bar[XB_TOP], 1u);
            const unsigned tg = og / nx;
            if (og + 1u == (tg + 1u) * nx) xb_add(&bar[XB_TOPGEN], 1u);
            else XB_SPIN(xb_ld(&bar[XB_TOPGEN]) == tg, bar);
            __builtin_amdgcn_fence(__ATOMIC_ACQUIRE, "agent");
            xb_add(&bar[XB_XGEN(b.x)], 1u);
            asm volatile("s_waitcnt vmcnt(0)" ::: "memory");
        } else {
            XB_SPIN(xb_ld(&bar[XB_XGEN(b.x)]) == gen, bar);
            __builtin_amdgcn_fence(__ATOMIC_ACQUIRE, "agent");
            asm volatile("s_waitcnt vmcnt(0)" ::: "memory");
        }
    }
    __syncthreads();
}

constexpr size_t WS_CTL   = 0;
constexpr size_t WS_MOD0  = 65536;
constexpr size_t WS_MOD1  = WS_MOD0 + 49152;
constexpr size_t WS_MC0   = WS_MOD1 + 49152;
constexpr size_t WS_ROPEC = WS_MC0 + 16384;
constexpr size_t WS_ROPES = WS_ROPEC + 2097152;
constexpr size_t WS_FPART = WS_ROPES + 2097152;
constexpr size_t WS_FNORM = WS_FPART + 4194304;
constexpr size_t WS_TSC   = WS_FNORM + 4096;
constexpr size_t WS_SA    = WS_TSC + 262144;
constexpr size_t WS_SW    = WS_SA + 69632;
constexpr size_t WS_KEYS0 = WS_SW + 131072;
constexpr size_t WS_KEYS1 = WS_KEYS0 + 65536;
constexpr size_t WS_GMWS  = WS_KEYS1 + 65536;
constexpr size_t WS_WIN0  = WS_GMWS + 262144;
constexpr size_t WS_WUQ   = WS_WIN0 + (size_t)4096 * 2048 * 2;
constexpr size_t WS_WUKV  = WS_WUQ + (size_t)1536 * 512 * 2;
constexpr size_t WS_WOUT0 = WS_WUKV + (size_t)2048 * 256 * 2;
constexpr size_t WS_WPQ0  = WS_WOUT0 + (size_t)2048 * 2048 * 2;
constexpr size_t WS_WIN1  = WS_WPQ0 + (size_t)2048 * 2048 * 2;
constexpr size_t WS_WOUT1 = WS_WIN1 + (size_t)5120 * 2048 * 2;
constexpr size_t WS_WPQ1  = WS_WOUT1 + (size_t)2048 * 2048 * 2;
constexpr size_t WS_TABU  = WS_WPQ1 + (size_t)2048 * 2048 * 2;
constexpr size_t WS_TABV  = WS_TABU + (size_t)16384 * 2048 * 2;
constexpr size_t WS_XR    = WS_TABV + (size_t)16384 * 2048 * 2;
constexpr size_t WS_H     = WS_XR + (size_t)16384 * 2048 * 4;
constexpr size_t WS_PBUF  = WS_H + (size_t)NKEY * 2048 * 2;
constexpr size_t WS_L0X   = WS_PBUF + (size_t)16384 * 5120 * 2;
constexpr size_t WS_QN    = WS_L0X;
constexpr size_t WS_KVN   = WS_QN + (size_t)16384 * 512 * 2;
constexpr size_t WS_KROPE = WS_KVN + (size_t)NKEY * 256 * 2;
constexpr size_t WS_Q     = WS_KROPE + (size_t)NKEY * 64 * 2;
constexpr size_t WS_KV    = WS_Q + (size_t)16384 * 1536 * 2;
constexpr size_t WS_L0END = WS_KV + (size_t)NKEY * 2048 * 2;
constexpr size_t WS_Z     = WS_L0X;
static_assert(WS_L0END - WS_L0X >= (size_t)32768 * ZP * 4, "Z alias");
static_assert(WS_L0END - WS_L0X >= (size_t)16 * 16384 * 128 * 4, "PD alias");
static_assert((size_t)NKEY * 4096 * 2 <= (size_t)16384 * 5120 * 2, "PBUF");
constexpr size_t WS_YCAT  = WS_L0END;
constexpr size_t WS_KZ    = WS_YCAT + (size_t)16384 * 2048 * 2;
constexpr size_t WS_KZ2   = WS_KZ + (size_t)32768 * ZP * 4;
constexpr size_t WS_END   = WS_KZ2 + (size_t)32768 * ZP * 4;
constexpr size_t WS_G1B   = WS_H;
constexpr size_t WS_X0B   = WS_H + (size_t)16384 * 1024 * 2;
static_assert(WS_END < (size_t)1000000000, "workspace budget");

struct Params { const float* in[43]; float* out; unsigned char* ws; int ph_lo, ph_hi, flags, pad; };
struct Fr { const float* const* in; float* out; unsigned char* ws; LAS unsigned char* lds; int tid, lane, wave, G, bid; int xcc, xcc_rank, xcc_n, xcc_ok; };

enum { I_X = 0, I_C, I_CTX, I_CCTX, I_LN1G0, I_WMOD0, I_BMOD0, I_WIN0, I_CONVW0, I_QNG0, I_WUQ0, I_KVNG0, I_WUKV0, I_WOUT0, I_LN2G0, I_PWQ0, I_PKEYS0, I_PU0, I_PV0,
       I_LN1G1, I_WMOD1, I_BMOD1, I_WIN1, I_GMNG1, I_GMWS1, I_GMB1, I_HYCW1, I_HYCB1, I_HYW1, I_HYB1, I_HYF1, I_HYW2, I_HYB2, I_HYF2, I_HYW3, I_HYBIAS1, I_WOUT1, I_LN2G1, I_PWQ1, I_PKEYS1, I_PU1, I_PV1, I_FINALG };

__device__ __forceinline__ void tconv_task(const Fr& F, const float* W, int K, int N, int Npad, bf16_t* Bt) {
    LAS float* tile = (LAS float*)F.lds;
    const int tn = Npad / 64, tk = K / 64, nt = tn * tk;
    for (int t0 = F.bid * 4; t0 < nt; t0 += F.G * 4) {
        const int i = F.tid >> 3, jq = F.tid & 7;
        f32x4 a[4], b[4];
#pragma unroll
        for (int q = 0; q < 4; ++q) { const int t = t0 + q; a[q] = (f32x4){0.f, 0.f, 0.f, 0.f}; b[q] = a[q];
            if (t < nt) { const int n0 = (t % tn) * 64, k0 = (t / tn) * 64;
                if (n0 < N) { const float* p = W + (size_t)(k0 + i) * N + n0 + jq * 8; a[q] = *(const f32x4*)p; b[q] = *(const f32x4*)(p + 4); } } }
        __syncthreads();
#pragma unroll
        for (int q = 0; q < 4; ++q)
#pragma unroll
            for (int e = 0; e < 4; ++e) { tile[q * 4160 + i * 65 + jq * 8 + e] = a[q][e]; tile[q * 4160 + i * 65 + jq * 8 + 4 + e] = b[q][e]; }
        __syncthreads();
        const int j = F.tid >> 3, ic = F.tid & 7;
#pragma unroll
        for (int q = 0; q < 4; ++q) { const int t = t0 + q;
            if (t < nt) { const int n0 = (t % tn) * 64, k0 = (t / tn) * 64;
                float v[8];
#pragma unroll
                for (int e = 0; e < 8; ++e) v[e] = tile[q * 4160 + (ic * 8 + e) * 65 + j];
                u32x4 w; w.x = pk_bf16(v[0], v[1]); w.y = pk_bf16(v[2], v[3]); w.z = pk_bf16(v[4], v[5]); w.w = pk_bf16(v[6], v[7]);
                *(u32x4*)(Bt + (size_t)(n0 + j) * K + k0 + ic * 8) = w; } }
    }
    __syncthreads();
}
__device__ __forceinline__ void colmax_task(const Fr& F, const float* W, int K, int N, int Npad, float* SW) {
    LAS float* red = (LAS float*)F.lds;
    const int i = F.tid >> 3, jq = F.tid & 7;
    for (int st = F.bid; st < Npad / 32; st += F.G) {
        const int n0 = st * 32;
        f32x4 cm = {0.f, 0.f, 0.f, 0.f};
        if (n0 < N) {
            const float* p = W + (size_t)i * N + n0 + jq * 4;
#pragma unroll 8
            for (int k = 0; k < K; k += 64) { const f32x4 w = *(const f32x4*)(p + (size_t)k * N);
                cm[0] = fmaxf(cm[0], fabsf(w[0])); cm[1] = fmaxf(cm[1], fabsf(w[1])); cm[2] = fmaxf(cm[2], fabsf(w[2])); cm[3] = fmaxf(cm[3], fabsf(w[3])); }
        }
        __syncthreads();
#pragma unroll
        for (int e = 0; e < 4; ++e) red[i * 33 + jq * 4 + e] = cm[e];
        __syncthreads();
        if (F.tid < 32) { float m = 0.f; for (int q = 0; q < 64; ++q) m = fmaxf(m, red[q * 33 + F.tid]); SW[n0 + F.tid] = m > 0.f ? m * (1.0f / 127.0f) : 1.0f; }
    }
    __syncthreads();
}
__device__ __forceinline__ void tconv_q_task(const Fr& F, const float* W, int K, int N, int Npad, const float* SW, unsigned char* Bt8) {
    LAS float* tile = (LAS float*)F.lds;
    const int tn = Npad / 64, tk = K / 64, nt = tn * tk;
    for (int t0 = F.bid * 4; t0 < nt; t0 += F.G * 4) {
        const int i = F.tid >> 3, jq = F.tid & 7;
        f32x4 a[4], b[4]; float sw4[4];
#pragma unroll
        for (int q = 0; q < 4; ++q) { const int t = t0 + q; a[q] = (f32x4){0.f, 0.f, 0.f, 0.f}; b[q] = a[q]; sw4[q] = 1.0f;
            if (t < nt) { const int n0 = (t % tn) * 64, k0 = (t / tn) * 64;
                sw4[q] = SW[n0 + (F.tid >> 3)];
                if (n0 < N) { const float* p = W + (size_t)(k0 + i) * N + n0 + jq * 8; a[q] = *(const f32x4*)p; b[q] = *(const f32x4*)(p + 4); } } }
        __syncthreads();
#pragma unroll
        for (int q = 0; q < 4; ++q)
#pragma unroll
            for (int e = 0; e < 4; ++e) { tile[q * 4160 + i * 65 + jq * 8 + e] = a[q][e]; tile[q * 4160 + i * 65 + jq * 8 + 4 + e] = b[q][e]; }
        __syncthreads();
        const int j = F.tid >> 3, ic = F.tid & 7;
#pragma unroll
        for (int q = 0; q < 4; ++q) { const int t = t0 + q;
            if (t < nt) { const int n0 = (t % tn) * 64, k0 = (t / tn) * 64;
                const float inv = 1.0f / sw4[q];
                int qv[8];
#pragma unroll
                for (int e = 0; e < 8; ++e) { const int r = (int)rintf(tile[q * 4160 + (ic * 8 + e) * 65 + j] * inv); qv[e] = r < -127 ? -127 : (r > 127 ? 127 : r); }
                u32x2 w; w.x = (unsigned)((qv[0] & 255) | ((qv[1] & 255) << 8) | ((qv[2] & 255) << 16) | ((qv[3] & 255) << 24));
                w.y = (unsigned)((qv[4] & 255) | ((qv[5] & 255) << 8) | ((qv[6] & 255) << 16) | ((qv[7] & 255) << 24));
                *(u32x2*)(Bt8 + (size_t)(n0 + j) * K + k0 + ic * 8) = w; } }
    }
    __syncthreads();
}
__device__ __forceinline__ void cvt_task(const Fr& F, const float* src, bf16_t* dst, size_t n8) {
    for (size_t i = (size_t)F.bid * NTHR + F.tid; i < n8; i += (size_t)F.G * NTHR) {
        const f32x4 a = *(const f32x4*)(src + i * 8), b = *(const f32x4*)(src + i * 8 + 4);
        u32x4 w; w.x = pk_bf16(a[0], a[1]); w.y = pk_bf16(a[2], a[3]); w.z = pk_bf16(b[0], b[1]); w.w = pk_bf16(b[2], b[3]);
        *(u32x4*)(dst + i * 8) = w;
    }
}
template <bool FP8>
__device__ __forceinline__ void cvt_table(const Fr& F, const float* src, unsigned char* dst, float* scale) {
    const int rstep = F.G * 16;
    f32x4 vn[2][8];
#define CT_LOAD(R0) do { _Pragma("unroll") for (int rr = 0; rr < 2; ++rr) _Pragma("unroll") for (int i = 0; i < 8; ++i) vn[rr][i] = *(const f32x4*)(src + (size_t)((R0) + rr) * 2048 + i * 256 + F.lane * 4); } while (0)
    { const int rf = (F.bid * 8 + F.wave) * 2; if (rf < 16384) CT_LOAD(rf); }
    for (int row0 = (F.bid * 8 + F.wave) * 2; row0 < 16384; row0 += rstep) {
        f32x4 v[2][8];
#pragma unroll
        for (int rr = 0; rr < 2; ++rr)
#pragma unroll
            for (int i = 0; i < 8; ++i) v[rr][i] = vn[rr][i];
        if (row0 + rstep < 16384) CT_LOAD(row0 + rstep);
#pragma unroll
        for (int rr = 0; rr < 2; ++rr) {
            const int row = row0 + rr; float am = 0.f;
#pragma unroll
            for (int i = 0; i < 8; ++i) am = fmaxf(am, fmaxf(fmaxf(fabsf(v[rr][i][0]), fabsf(v[rr][i][1])), fmaxf(fabsf(v[rr][i][2]), fabsf(v[rr][i][3]))));
#pragma unroll
            for (int o = 32; o >= 1; o >>= 1) am = fmaxf(am, __shfl_xor(am, o));
            const float top = FP8 ? 400.0f : 127.0f;
            const float sc = am > 0.f ? am * (1.0f / top) : 1.0f, inv = am > 0.f ? top / am : 1.0f;
#pragma unroll
            for (int i = 0; i < 8; ++i) {
                int p;
                if (FP8) { p = 0; p = __builtin_amdgcn_cvt_pk_fp8_f32(v[rr][i][0] * inv, v[rr][i][1] * inv, p, false); p = __builtin_amdgcn_cvt_pk_fp8_f32(v[rr][i][2] * inv, v[rr][i][3] * inv, p, true); }
                else { int q[4];
#pragma unroll
                    for (int e = 0; e < 4; ++e) { const int t = (int)rintf(v[rr][i][e] * inv); q[e] = t < -127 ? -127 : (t > 127 ? 127 : t); }
                    p = (q[0] & 255) | ((q[1] & 255) << 8) | ((q[2] & 255) << 16) | ((q[3] & 255) << 24); }
                const int e0 = i * 256 + F.lane * 4;
                *(int*)(dst + (size_t)(e0 >> 7) * 2097152 + (size_t)row * 128 + (e0 & 127)) = p; }
            if (F.lane == 0) scale[row] = sc;
        }
    }
#undef CT_LOAD
}
__device__ __forceinline__ void modgemv(const Fr& F, const float* c, const float* c2, const float* W, const float* b, float* out, float* out2, int ncol2) {
    LAS float* s1 = (LAS float*)F.lds;
    LAS float* s2 = s1 + 2048;
    LAS float* red = s2 + 2048;
    LAS float* red2 = red + 42 * 48;
    __syncthreads();
    for (int k = F.tid; k < 2048; k += NTHR) { s1[k] = silu_f(c[k]); s2[k] = c2 ? silu_f(c2[k]) : 0.f; }
    __syncthreads();
    for (int chunk = F.bid; chunk < 256; chunk += F.G) {
        const int col0 = chunk * 48, cq = F.tid % 12, kl = F.tid / 12;
        const bool do2 = (c2 != nullptr) && (col0 < ncol2);
        if (kl < 42) {
            f32x4 a1 = {0.f, 0.f, 0.f, 0.f}, a2 = {0.f, 0.f, 0.f, 0.f};
            const float* wp = W + col0 + cq * 4;
#pragma unroll 8
            for (int k = kl; k < 2048; k += 42) { const f32x4 w = *(const f32x4*)(wp + (size_t)k * 12288); a1 += s1[k] * w; a2 += s2[k] * w; }
#pragma unroll
            for (int e = 0; e < 4; ++e) { red[kl * 48 + cq * 4 + e] = a1[e]; red2[kl * 48 + cq * 4 + e] = a2[e]; }
        }
        __syncthreads();
        if (F.tid < 48) {
            float r1 = 0.f, r2 = 0.f;
            for (int q = 0; q < 42; ++q) { r1 += red[q * 48 + F.tid]; r2 += red2[q * 48 + F.tid]; }
            const float bb = b[col0 + F.tid];
            out[col0 + F.tid] = r1 + bb;
            if (do2 && col0 + F.tid < ncol2) out2[col0 + F.tid] = r2 + bb;
        }
        __syncthreads();
    }
}
__device__ __forceinline__ void rope_tables(const Fr& F, float* rc, float* rs) {
    for (int it = F.bid * NTHR + F.tid; it < SEQ * 32; it += F.G * NTHR) {
        const int t = it >> 5, jj = it & 31, seg = jj >> 4, j = jj & 15;
        const int pos = seg ? (t & 63) : (t >> 6);
        const float inv = powf(10000.0f, -(float)j / 16.0f);
        const float ang = (float)pos * inv;
        float s, c; sincosf(ang, &s, &c);
        rc[it] = c; rs[it] = s;
    }
}
__device__ __forceinline__ void quant_rows(const Fr& F, const bf16_t* X, unsigned char* out8, float* sa) {
    for (int row0 = (F.bid * 8 + F.wave) * 2; row0 < SEQ; row0 += F.G * 16) {
        u32x4 w[2][4];
#pragma unroll
        for (int rr = 0; rr < 2; ++rr)
#pragma unroll
            for (int i = 0; i < 4; ++i) w[rr][i] = *(const u32x4*)(X + (size_t)(row0 + rr) * DM + i * 512 + F.lane * 8);
        __builtin_amdgcn_sched_barrier(0);
#pragma unroll
        for (int rr = 0; rr < 2; ++rr) {
            f32x4 v[8]; float am = 0.f;
#pragma unroll
            for (int i = 0; i < 4; ++i) { v[2 * i] = (f32x4){bf_lo(w[rr][i].x), bf_hi(w[rr][i].x), bf_lo(w[rr][i].y), bf_hi(w[rr][i].y)}; v[2 * i + 1] = (f32x4){bf_lo(w[rr][i].z), bf_hi(w[rr][i].z), bf_lo(w[rr][i].w), bf_hi(w[rr][i].w)}; }
#pragma unroll
            for (int i = 0; i < 8; ++i) am = fmaxf(am, fmaxf(fmaxf(fabsf(v[i][0]), fabsf(v[i][1])), fmaxf(fabsf(v[i][2]), fabsf(v[i][3]))));
#pragma unroll
            for (int o = 32; o >= 1; o >>= 1) am = fmaxf(am, __shfl_xor(am, o));
            const float inv = am > 0.f ? 127.0f / am : 0.f;
#pragma unroll
            for (int i = 0; i < 4; ++i) { u32x2 o;
                { int q[4];
#pragma unroll
                  for (int e = 0; e < 4; ++e) q[e] = (int)rintf(v[2 * i][e] * inv);
                  o.x = (unsigned)((q[0] & 255) | ((q[1] & 255) << 8) | ((q[2] & 255) << 16) | ((q[3] & 255) << 24)); }
                { int q[4];
#pragma unroll
                  for (int e = 0; e < 4; ++e) q[e] = (int)rintf(v[2 * i + 1][e] * inv);
                  o.y = (unsigned)((q[0] & 255) | ((q[1] & 255) << 8) | ((q[2] & 255) << 16) | ((q[3] & 255) << 24)); }
                *(u32x2*)(out8 + (size_t)(row0 + rr) * DM + i * 512 + F.lane * 8) = o; }
            if (F.lane == 0) sa[row0 + rr] = am > 0.f ? am * (1.0f / 127.0f) : 1.0f;
        }
    }
}
template <bool Q8>
__device__ __forceinline__ void norm_rows_b(const Fr& F, const bf16_t* X, const float* g, const float* sc, const float* sh, bf16_t* out, unsigned char* out8 = nullptr, float* sa = nullptr) {
    f32x4 cs[8], cb[8];
#pragma unroll
    for (int i = 0; i < 4; ++i)
#pragma unroll
        for (int hf = 0; hf < 2; ++hf) { const int col = i * 512 + F.lane * 8 + hf * 4; const f32x4 gg = *(const f32x4*)(g + col), a = *(const f32x4*)(sc + col); cs[i * 2 + hf] = gg * (1.0f + a); cb[i * 2 + hf] = *(const f32x4*)(sh + col); }
    for (int row0 = (F.bid * 8 + F.wave) * 2; row0 < SEQ; row0 += F.G * 16) {
        u32x4 w[2][4];
#pragma unroll
        for (int rr = 0; rr < 2; ++rr)
#pragma unroll
            for (int i = 0; i < 4; ++i) w[rr][i] = *(const u32x4*)(X + (size_t)(row0 + rr) * DM + i * 512 + F.lane * 8);
        __builtin_amdgcn_sched_barrier(0);
#pragma unroll
        for (int rr = 0; rr < 2; ++rr) {
            f32x4 v[8]; float ss = 0.f;
#pragma unroll
            for (int i = 0; i < 4; ++i) { v[2 * i] = (f32x4){bf_lo(w[rr][i].x), bf_hi(w[rr][i].x), bf_lo(w[rr][i].y), bf_hi(w[rr][i].y)}; v[2 * i + 1] = (f32x4){bf_lo(w[rr][i].z), bf_hi(w[rr][i].z), bf_lo(w[rr][i].w), bf_hi(w[rr][i].w)}; }
#pragma unroll
            for (int i = 0; i < 8; ++i) ss += v[i][0] * v[i][0] + v[i][1] * v[i][1] + v[i][2] * v[i][2] + v[i][3] * v[i][3];
            ss = wave_sum(ss);
            const float rstd = rsqrtf(ss * (1.0f / DM) + 1e-6f);
            if constexpr (!Q8) {
#pragma unroll
            for (int i = 0; i < 4; ++i) {
                const f32x4 y0 = v[2 * i] * rstd * cs[2 * i] + cb[2 * i], y1 = v[2 * i + 1] * rstd * cs[2 * i + 1] + cb[2 * i + 1];
                u32x4 o; o.x = pk_bf16(y0[0], y0[1]); o.y = pk_bf16(y0[2], y0[3]); o.z = pk_bf16(y1[0], y1[1]); o.w = pk_bf16(y1[2], y1[3]);
                *(u32x4*)(out + (size_t)(row0 + rr) * DM + i * 512 + F.lane * 8) = o;
            }
            } else {
                float am = 0.f;
#pragma unroll
                for (int i = 0; i < 8; ++i) { v[i] = v[i] * rstd * cs[i] + cb[i]; am = fmaxf(am, fmaxf(fmaxf(fabsf(v[i][0]), fabsf(v[i][1])), fmaxf(fabsf(v[i][2]), fabsf(v[i][3])))); }
#pragma unroll
                for (int o = 32; o >= 1; o >>= 1) am = fmaxf(am, __shfl_xor(am, o));
                const float inv = am > 0.f ? 127.0f / am : 0.f;
#pragma unroll
                for (int i = 0; i < 4; ++i) { u32x2 o;
                    { int q[4];
#pragma unroll
                      for (int e = 0; e < 4; ++e) q[e] = (int)rintf(v[2 * i][e] * inv);
                      o.x = (unsigned)((q[0] & 255) | ((q[1] & 255) << 8) | ((q[2] & 255) << 16) | ((q[3] & 255) << 24)); }
                    { int q[4];
#pragma unroll
                      for (int e = 0; e < 4; ++e) q[e] = (int)rintf(v[2 * i + 1][e] * inv);
                      o.y = (unsigned)((q[0] & 255) | ((q[1] & 255) << 8) | ((q[2] & 255) << 16) | ((q[3] & 255) << 24)); }
                    *(u32x2*)(out8 + (size_t)(row0 + rr) * DM + i * 512 + F.lane * 8) = o; }
                if (F.lane == 0) sa[row0 + rr] = am > 0.f ? am * (1.0f / 127.0f) : 1.0f;
            }
        }
    }
}
__device__ __forceinline__ void hyena_filter_gen(const Fr& F, unsigned* KZ, float* FPART) {
    const float* w1 = F.in[I_HYW1]; const float* b1 = F.in[I_HYB1]; const float* f1 = F.in[I_HYF1];
    const float* w2 = F.in[I_HYW2]; const float* b2 = F.in[I_HYB2]; const float* f2 = F.in[I_HYF2];
    const float* w3 = F.in[I_HYW3];
    LAS float* zf = (LAS float*)F.lds;
    LAS float* a1 = zf + 64 * 33;
    LAS bf16_t* a2b = (LAS bf16_t*)(a1 + 64 * 64);
    const int r32 = F.lane & 31, hi = F.lane >> 5;
    const float da = -3.0701134573253944f, db = -15.350567286626972f;
    float psum[8];
#pragma unroll
    for (int cb = 0; cb < 8; ++cb) psum[cb] = 0.f;
    for (int pb = F.bid; pb < SEQ / 64; pb += F.G) {
        const int l0 = pb * 64;
        __syncthreads();
        for (int it = F.tid; it < 64 * 33; it += NTHR) {
            const int pos = it / 33, f = it % 33; const int l = l0 + pos;
            const float t = (float)l / (float)(SEQ - 1);
            const float w = (6.283185307179586f / (float)SEQ) * (float)l;
            float v;
            if (f == 0) v = t;
            else { const int j = (f - 1) & 15; const float band = 1e-4f + (float)j * ((15.0f - 1e-4f) / 15.0f); v = (f <= 16) ? cosf(band * w) : -sinf(band * w); }
            zf[pos * 33 + f] = v;
        }
        __syncthreads();
        for (int it = F.tid; it < 64 * 64; it += NTHR) {
            const int pos = it >> 6, u = it & 63; float s = b1[u];
            for (int f = 0; f < 33; ++f) s += zf[pos * 33 + f] * w1[f * 64 + u];
            a1[pos * 64 + u] = sinf(f1[u] * s);
        }
        __syncthreads();
        for (int it = F.tid; it < 64 * 64; it += NTHR) {
            const int pos = it >> 6, u = it & 63; float s = b2[u];
            for (int v = 0; v < 64; ++v) s += a1[pos * 64 + v] * w2[v * 64 + u];
            a2b[pos * 72 + u] = f2bf(sinf(f2[u] * s));
        }
        __syncthreads();
        bf16x8 af[2][4];
#pragma unroll
        for (int rb = 0; rb < 2; ++rb)
#pragma unroll
            for (int ks = 0; ks < 4; ++ks) af[rb][ks] = *(const LAS bf16x8*)(a2b + (rb * 32 + r32) * 72 + ks * 16 + hi * 8);
#pragma unroll 1
        for (int cb = 0; cb < 8; ++cb) {
            const int gcol = F.wave * 256 + cb * 32 + r32;
            f32x16 acc[2] = {};
#pragma unroll
            for (int ks = 0; ks < 4; ++ks) {
                float wv[8];
#pragma unroll
                for (int j = 0; j < 8; ++j) wv[j] = w3[(size_t)(ks * 16 + hi * 8 + j) * 2048 + gcol];
                u32x4 bw; bw.x = pk_bf16(wv[0], wv[1]); bw.y = pk_bf16(wv[2], wv[3]); bw.z = pk_bf16(wv[4], wv[5]); bw.w = pk_bf16(wv[6], wv[7]);
                const bf16x8 bf = *(bf16x8*)&bw;
                acc[0] = __builtin_amdgcn_mfma_f32_32x32x16_bf16(af[0][ks], bf, acc[0], 0, 0, 0);
                acc[1] = __builtin_amdgcn_mfma_f32_32x32x16_bf16(af[1][ks], bf, acc[1], 0, 0, 0);
            }
            const bool bwd = gcol >= 1024; const int c = gcol & 1023;
            const float dl2 = fabsf(da + (float)c * ((db - da) / 1023.0f)) * 1.4426950408889634f;
            float ps = 0.f;
#pragma unroll
            for (int rb = 0; rb < 2; ++rb)
#pragma unroll
                for (int rr = 0; rr < 16; ++rr) {
                    const int l = l0 + rb * 32 + (rr & 3) + 8 * (rr >> 2) + 4 * hi;
                    const float t = (float)l / (float)(SEQ - 1);
                    const float v = acc[rb][rr] * __builtin_amdgcn_exp2f(-t * dl2);
                    const float vn = dpp_f32_quad_swap1(v);
                    const bool keep = !(bwd && l == 0);
                    if (keep) ps += fabsf(v);
                    if (keep && (r32 & 1) == 0) KZ[(size_t)(bwd ? 2 * SEQ - l : l) * ZP + (c >> 1)] = pk_h2((f32x2){v, vn});
                }
            psum[cb] += ps;
        }
    }
#pragma unroll
    for (int cb = 0; cb < 8; ++cb) {
        auto sw = __builtin_amdgcn_permlane32_swap(__float_as_uint(psum[cb]), __float_as_uint(psum[cb]), false, false);
        const float tot = __uint_as_float(sw[0]) + __uint_as_float(sw[1]);
        if (hi == 0) FPART[(size_t)F.bid * 2048 + F.wave * 256 + cb * 32 + r32] = tot;
    }
    if (F.bid == 0) for (int c = F.tid; c < 512; c += NTHR) KZ[(size_t)SEQ * ZP + c] = 0u;
}
__device__ __forceinline__ void hyena_filter_norm(const Fr& F, const float* FPART, float* FNORM) {
    for (int c = F.bid * 8 + F.wave; c < 1024; c += F.G * 8) {
        float s = 0.f;
        for (int b = F.lane; b < F.G; b += 64) s += FPART[(size_t)b * 2048 + c] + FPART[(size_t)b * 2048 + 1024 + c];
        s = wave_sum(s);
        if (F.lane == 0) FNORM[c] = 1.0f / (s + 1e-6f);
    }
}

template <bool Q8>
__device__ __forceinline__ void norm_rows(const Fr& F, const float* X, int nrows, const float* g, const float* sc, const float* sh, bf16_t* out, unsigned char* out8 = nullptr, float* sa = nullptr) {
    f32x4 cs[8], cb[8];
#pragma unroll
    for (int i = 0; i < 8; ++i) { const int col = i * 256 + F.lane * 4; const f32x4 gg = *(const f32x4*)(g + col), a = *(const f32x4*)(sc + col); cs[i] = gg * (1.0f + a); cb[i] = *(const f32x4*)(sh + col); }
    for (int row0 = (F.bid * 8 + F.wave) * 2; row0 < nrows; row0 += F.G * 16) {
        f32x4 v[2][8];
#pragma unroll
        for (int i = 0; i < 8; ++i) { v[0][i] = *(const f32x4*)(X + (size_t)row0 * DM + i * 256 + F.lane * 4); v[1][i] = *(const f32x4*)(X + (size_t)(row0 + 1) * DM + i * 256 + F.lane * 4); }
        __builtin_amdgcn_sched_barrier(0);
#pragma unroll
        for (int rr = 0; rr < 2; ++rr) {
            float ss = 0.f;
#pragma unroll
            for (int i = 0; i < 8; ++i) ss += v[rr][i][0] * v[rr][i][0] + v[rr][i][1] * v[rr][i][1] + v[rr][i][2] * v[rr][i][2] + v[rr][i][3] * v[rr][i][3];
            ss = wave_sum(ss);
            const float rstd = rsqrtf(ss * (1.0f / DM) + 1e-6f);
            if constexpr (!Q8) {
#pragma unroll
            for (int i = 0; i < 8; ++i) {
                const f32x4 y = v[rr][i] * rstd * cs[i] + cb[i];
                u32x2 w; w.x = pk_bf16(y[0], y[1]); w.y = pk_bf16(y[2], y[3]);
                *(u32x2*)(out + (size_t)(row0 + rr) * DM + i * 256 + F.lane * 4) = w;
            }
            } else {
                float am = 0.f;
#pragma unroll
                for (int i = 0; i < 8; ++i) { v[rr][i] = v[rr][i] * rstd * cs[i] + cb[i]; am = fmaxf(am, fmaxf(fmaxf(fabsf(v[rr][i][0]), fabsf(v[rr][i][1])), fmaxf(fabsf(v[rr][i][2]), fabsf(v[rr][i][3])))); }
#pragma unroll
                for (int o = 32; o >= 1; o >>= 1) am = fmaxf(am, __shfl_xor(am, o));
                const float inv = am > 0.f ? 127.0f / am : 0.f;
#pragma unroll
                for (int i = 0; i < 8; ++i) { int q[4];
#pragma unroll
                    for (int e = 0; e < 4; ++e) q[e] = (int)rintf(v[rr][i][e] * inv);
                    *(unsigned*)(out8 + (size_t)(row0 + rr) * DM + i * 256 + F.lane * 4) = (unsigned)((q[0] & 255) | ((q[1] & 255) << 8) | ((q[2] & 255) << 16) | ((q[3] & 255) << 24)); }
                if (F.lane == 0) sa[row0 + rr] = am > 0.f ? am * (1.0f / 127.0f) : 1.0f;
            }
        }
    }
}

__device__ __forceinline__ void l0_post_proj(const Fr& F, const bf16_t* PB, bf16_t* QN, bf16_t* KVN, bf16_t* KROPE, bf16_t* YCAT,
                                             const float* rc, const float* rs, int nrows) {
    const float* qg = F.in[I_QNG0]; const float* kvg = F.in[I_KVNG0]; const float* cw = F.in[I_CONVW0];
    for (int tb = (F.bid * 8 + F.wave) * 4; tb < nrows; tb += F.G * 32) {
        u32x4 wq[4]; u32x2 wk[4]; bf16_t wr[4]; float rcv[4], rsv[4];
        const int seg = F.lane >> 5, half = (F.lane >> 4) & 1, j = F.lane & 15;
#pragma unroll
        for (int u = 0; u < 4; ++u) { const int t = (tb + u < nrows) ? tb + u : tb; const bf16_t* pr = PB + (size_t)t * 4096;
            wq[u] = (t < SEQ) ? *(const u32x4*)(pr + 3072 + F.lane * 8) : (u32x4){0u, 0u, 0u, 0u};
            wk[u] = *(const u32x2*)(pr + 3584 + F.lane * 4); wr[u] = pr[3840 + F.lane];
            rcv[u] = (t < SEQ) ? rc[(size_t)t * 32 + seg * 16 + j] : 1.f; rsv[u] = (t < SEQ) ? rs[(size_t)t * 32 + seg * 16 + j] : 0.f; }
#pragma unroll
        for (int u = 0; u < 4; ++u) {
            const int t = tb + u; if (t >= nrows) break;
            if (t < SEQ) {
                const u32x4 w = wq[u];
                float v[8] = {bf_lo(w.x), bf_hi(w.x), bf_lo(w.y), bf_hi(w.y), bf_lo(w.z), bf_hi(w.z), bf_lo(w.w), bf_hi(w.w)};
                float ss = 0.f;
#pragma unroll
                for (int e = 0; e < 8; ++e) ss += v[e] * v[e];
                ss = wave_sum(ss);
                const float rstd = rsqrtf(ss * (1.0f / 512.0f) + 1e-6f);
                const f32x4 g0 = *(const f32x4*)(qg + F.lane * 8), g1 = *(const f32x4*)(qg + F.lane * 8 + 4);
                u32x4 o; o.x = pk_bf16(v[0] * rstd * g0[0], v[1] * rstd * g0[1]); o.y = pk_bf16(v[2] * rstd * g0[2], v[3] * rstd * g0[3]);
                o.z = pk_bf16(v[4] * rstd * g1[0], v[5] * rstd * g1[1]); o.w = pk_bf16(v[6] * rstd * g1[2], v[7] * rstd * g1[3]);
                *(u32x4*)(QN + (size_t)t * 512 + F.lane * 8) = o;
            }
            {
                const u32x2 w = wk[u];
                float v[4] = {bf_lo(w.x), bf_hi(w.x), bf_lo(w.y), bf_hi(w.y)};
                float ss = v[0] * v[0] + v[1] * v[1] + v[2] * v[2] + v[3] * v[3];
                ss = wave_sum(ss);
                const float rstd = rsqrtf(ss * (1.0f / 256.0f) + 1e-6f);
                const f32x4 g0 = *(const f32x4*)(kvg + F.lane * 4);
                u32x2 o; o.x = pk_bf16(v[0] * rstd * g0[0], v[1] * rstd * g0[1]); o.y = pk_bf16(v[2] * rstd * g0[2], v[3] * rstd * g0[3]);
                *(u32x2*)(KVN + (size_t)t * 256 + F.lane * 4) = o;
            }
            {
                const float uu = bf1(wr[u]);
                const float up = __shfl_xor(uu, 16);
                const float o = uu * rcv[u] + (half ? up : -up) * rsv[u];
                KROPE[(size_t)t * 64 + F.lane] = f2bf(o);
            }
        }
    }
    {
        const int cg = F.tid & 127, c0 = cg * 8;
        float w0[8], w1[8], w2[8];
#pragma unroll
        for (int e = 0; e < 8; ++e) { w0[e] = cw[c0 + e]; w1[e] = cw[1024 + c0 + e]; w2[e] = cw[2048 + c0 + e]; }
        for (int t = F.bid * 4 + (F.tid >> 7); t < SEQ; t += F.G * 4) {
            u32x4 a[3], h[3];
#pragma unroll
            for (int dt = 0; dt < 3; ++dt) { const int tt = t + dt - 1; const bool ok = (tt >= 0) && (tt < SEQ);
                a[dt] = ok ? *(const u32x4*)(PB + (size_t)tt * 4096 + 1024 + c0) : (u32x4){0u, 0u, 0u, 0u};
                h[dt] = ok ? *(const u32x4*)(PB + (size_t)tt * 4096 + 2048 + c0) : (u32x4){0u, 0u, 0u, 0u}; }
            const u32x4 gb = *(const u32x4*)(PB + (size_t)t * 4096 + c0);
            float y[8];
#pragma unroll
            for (int q = 0; q < 4; ++q) {
                y[2 * q] = bf_lo(gb[q]) * (w0[2 * q] * bf_lo(a[0][q]) * bf_lo(h[0][q]) + w1[2 * q] * bf_lo(a[1][q]) * bf_lo(h[1][q]) + w2[2 * q] * bf_lo(a[2][q]) * bf_lo(h[2][q]));
                y[2 * q + 1] = bf_hi(gb[q]) * (w0[2 * q + 1] * bf_hi(a[0][q]) * bf_hi(h[0][q]) + w1[2 * q + 1] * bf_hi(a[1][q]) * bf_hi(h[1][q]) + w2[2 * q + 1] * bf_hi(a[2][q]) * bf_hi(h[2][q]));
            }
            *(u32x4*)(YCAT + (size_t)t * 2048 + c0) = (u32x4){pk_bf16(y[0], y[1]), pk_bf16(y[2], y[3]), pk_bf16(y[4], y[5]), pk_bf16(y[6], y[7])};
        }
    }
}

struct EpiBf16G {
    static constexpr bool PERM = true, AFTER_DRAIN = false, I8 = false;
    bf16_t* O; int ldc; int act_cols;
    __device__ __forceinline__ void operator()(const f32x4 (&acc)[2][2][4][2], const pg8::Unit& u, int wr, int wc, int fr, int fq) const {
        const int row0 = u.pm * 256 + wr * 64 + fr, col0 = u.pn * 256 + wc * 32 + 8 * fq;
        const bool act = (u.pn * 256) < act_cols;
#pragma unroll
        for (int ai = 0; ai < 2; ++ai)
#pragma unroll
            for (int m = 0; m < 4; ++m) { bf16_t* rowp = O + (size_t)(row0 + ai * 128 + m * 16) * ldc + col0;
#pragma unroll
                for (int bj = 0; bj < 2; ++bj) { f32x4 v0 = acc[ai][bj][m][0], v1 = acc[ai][bj][m][1];
                    if (act) {
#pragma unroll
                        for (int e = 0; e < 4; ++e) { v0[e] = gelu_tanh(v0[e]); v1[e] = gelu_tanh(v1[e]); } }
                    u32x4 w; w.x = pk_bf16(v0[0], v0[1]); w.y = pk_bf16(v0[2], v0[3]); w.z = pk_bf16(v1[0], v1[1]); w.w = pk_bf16(v1[2], v1[3]);
                    *(u32x4*)(rowp + bj * 128) = w; } }
    }
};
struct EpiI8G {
    static constexpr bool PERM = true, AFTER_DRAIN = false, I8 = true;
    bf16_t* O; int ldc; int act_cols; const float* sa; const float* sw;
    __device__ __forceinline__ void operator()(const f32x4 (&acc)[2][2][4][2], const pg8::Unit& u, int wr, int wc, int fr, int fq) const {
        const int row0 = u.pm * 256 + wr * 64 + fr, col0 = u.pn * 256 + wc * 32 + 8 * fq;
        const bool act = (u.pn * 256) < act_cols;
        f32x4 cw[2][2];
#pragma unroll
        for (int bj = 0; bj < 2; ++bj) { cw[bj][0] = *(const f32x4*)(sw + col0 + bj * 128); cw[bj][1] = *(const f32x4*)(sw + col0 + bj * 128 + 4); }
#pragma unroll
        for (int ai = 0; ai < 2; ++ai)
#pragma unroll
            for (int m = 0; m < 4; ++m) { const int row = row0 + ai * 128 + m * 16; bf16_t* rowp = O + (size_t)row * ldc + col0; const float rs = sa[row];
#pragma unroll
                for (int bj = 0; bj < 2; ++bj) { f32x4 v0, v1;
#pragma unroll
                    for (int e = 0; e < 4; ++e) { v0[e] = (float)__float_as_int(acc[ai][bj][m][0][e]) * rs * cw[bj][0][e]; v1[e] = (float)__float_as_int(acc[ai][bj][m][1][e]) * rs * cw[bj][1][e]; }
                    if (act) {
#pragma unroll
                        for (int e = 0; e < 4; ++e) { v0[e] = gelu_tanh(v0[e]); v1[e] = gelu_tanh(v1[e]); } }
                    u32x4 w; w.x = pk_bf16(v0[0], v0[1]); w.y = pk_bf16(v0[2], v0[3]); w.z = pk_bf16(v1[0], v1[1]); w.w = pk_bf16(v1[2], v1[3]);
                    *(u32x4*)(rowp + bj * 128) = w; } }
    }
};
struct EpiQRope {
    static constexpr bool PERM = false, AFTER_DRAIN = false, I8 = false;
    bf16_t* Q; const float* rc; const float* rs;
    __device__ __forceinline__ void operator()(const f32x4 (&acc)[2][2][4][2], const pg8::Unit& u, int wr, int wc, int fr, int fq) const {
#pragma unroll
        for (int ai = 0; ai < 2; ++ai)
#pragma unroll
            for (int m = 0; m < 4; ++m) {
                const int row = u.pm * 256 + ai * 128 + wr * 64 + m * 16 + fr;
#pragma unroll
                for (int bj = 0; bj < 2; ++bj) {
                    const int cbase = u.pn * 256 + bj * 128 + wc * 32;
                    const bool rope = ((cbase >> 6) % 3) == 2; const int seg = (cbase >> 5) & 1;
                    f32x4 v0 = acc[ai][bj][m][0], v1 = acc[ai][bj][m][1];
                    if (rope) {
                        const f32x4 cs = *(const f32x4*)(rc + (size_t)row * 32 + seg * 16 + 4 * fq), sn = *(const f32x4*)(rs + (size_t)row * 32 + seg * 16 + 4 * fq);
                        const f32x4 o0 = v0 * cs - v1 * sn, o1 = v1 * cs + v0 * sn; v0 = o0; v1 = o1;
                    }
                    u32x2 w0, w1; w0.x = pk_bf16(v0[0], v0[1]); w0.y = pk_bf16(v0[2], v0[3]); w1.x = pk_bf16(v1[0], v1[1]); w1.y = pk_bf16(v1[2], v1[3]);
                    bf16_t* p = Q + (size_t)row * 1536 + cbase + 4 * fq;
                    *(u32x2*)p = w0; *(u32x2*)(p + 16) = w1;
                }
            }
    }
};
template <bool BASEF, bool Q8 = false>
struct EpiResid {
    static constexpr bool PERM = true, AFTER_DRAIN = false, I8 = Q8;
    const void* base; bf16_t* out; const float* gate; const float* sa; const float* sw;
    __device__ __forceinline__ void operator()(const f32x4 (&acc)[2][2][4][2], const pg8::Unit& u, int wr, int wc, int fr, int fq) const {
        const int row0 = u.pm * 256 + wr * 64 + fr, col0 = u.pn * 256 + wc * 32 + 8 * fq;
        f32x4 gv[2][2];
#pragma unroll
        for (int bj = 0; bj < 2; ++bj)
#pragma unroll
            for (int n = 0; n < 2; ++n) { gv[bj][n] = *(const f32x4*)(gate + col0 + bj * 128 + n * 4); if (Q8) gv[bj][n] *= *(const f32x4*)(sw + col0 + bj * 128 + n * 4); }
#pragma unroll
        for (int ai = 0; ai < 2; ++ai)
#pragma unroll
            for (int m = 0; m < 4; ++m) { const size_t off = (size_t)(row0 + ai * 128 + m * 16) * DM + col0; const float rs = Q8 ? sa[row0 + ai * 128 + m * 16] : 1.0f;
                f32x4 bs[2][2];
#pragma unroll
                for (int bj = 0; bj < 2; ++bj) {
                    if (BASEF) { bs[bj][0] = *(const f32x4*)((const float*)base + off + bj * 128); bs[bj][1] = *(const f32x4*)((const float*)base + off + bj * 128 + 4); }
                    else { const u32x4 w = *(const u32x4*)((const bf16_t*)base + off + bj * 128); bs[bj][0] = (f32x4){bf_lo(w.x), bf_hi(w.x), bf_lo(w.y), bf_hi(w.y)}; bs[bj][1] = (f32x4){bf_lo(w.z), bf_hi(w.z), bf_lo(w.w), bf_hi(w.w)}; } }
#pragma unroll
                for (int bj = 0; bj < 2; ++bj) { f32x4 a0 = acc[ai][bj][m][0], a1 = acc[ai][bj][m][1];
                    if (Q8) {
#pragma unroll
                        for (int e = 0; e < 4; ++e) { a0[e] = (float)__float_as_int(a0[e]) * rs; a1[e] = (float)__float_as_int(a1[e]) * rs; } }
                    const f32x4 v0 = bs[bj][0] + gv[bj][0] * a0, v1 = bs[bj][1] + gv[bj][1] * a1;
                    u32x4 w; w.x = pk_bf16(v0[0], v0[1]); w.y = pk_bf16(v0[2], v0[3]); w.z = pk_bf16(v1[0], v1[1]); w.w = pk_bf16(v1[2], v1[3]);
                    *(u32x4*)(out + off + bj * 128) = w; } }
    }
};
struct OrderIn0 : pg8::StaticOrder {
    int rounds;
    __device__ void init2(int G_, int c_) { init(SEQ, 4096, G_, c_); rounds = (nwg + G - 1) / G; }
    __device__ bool next(int i, pg8::Unit& u) const {
        if (pg8::StaticOrder::next(i, u)) return true;
        if (i == rounds && c < 2) { u.pm = 64; u.pn = 14 + c; return true; }
        return false;
    }
};

struct OrderKV : pg8::StaticOrder {
    __device__ bool next(int i, pg8::Unit& u) const {
        if (G != 256 || nwg != 520) return pg8::StaticOrder::next(i, u);
        int L;
        if (c >= 128) { if (i > 2) return false; L = i * 128 + (c - 128); }
        else { if (i == 0) L = 384 + c; else if (i == 1 && c < 8) L = 512 + c; else return false; }
        pg8::StaticOrder t = *this; t.c = L % G;
        return t.pg8::StaticOrder::next(L / G, u);
    }
};
namespace att {
constexpr int KVBLK = 64;
constexpr float SCALE = 0.07216878364870322f;
constexpr float THR = 8.f;
constexpr int LDQ = 1536, LDK = 2048, LDKR = 64, LDO = 2048;
#define KSWZ(row, colB) ((row) * 256 + ((colB) ^ (((row) & 15) << 4)))
#define KRSWZ(row, colB) ((row) * 128 + ((colB) ^ ((((row) >> 1) & 7) << 4)))
#define SBAR() __builtin_amdgcn_sched_barrier(0)
__device__ __forceinline__ int crow(int r, int hi) { return (r & 3) + 8 * (r >> 2) + 4 * hi; }

__device__ __forceinline__ void partialSM(f32x16& p0, f32x16& p1, float& m_reg, float& mn, float& alpha) {
    constexpr float C = SCALE * 1.4426950408889634f;
    float pmax = p0[0];
#pragma unroll
    for (int r = 1; r < 16; ++r) pmax = fmaxf(pmax, p0[r]);
#pragma unroll
    for (int r = 0; r < 16; ++r) pmax = fmaxf(pmax, p1[r]);
    { auto rr = __builtin_amdgcn_permlane32_swap(__float_as_uint(pmax), __float_as_uint(pmax), false, false);
      pmax = fmaxf(__uint_as_float(rr[0]), __uint_as_float(rr[1])); }
    const bool keep = __all(pmax - m_reg <= THR / SCALE);
    mn = keep ? m_reg : fmaxf(m_reg, pmax); alpha = __builtin_amdgcn_exp2f((m_reg - mn) * C); m_reg = mn;
    const float mnC = -mn * C;
#pragma unroll
    for (int r = 0; r < 16; ++r) p0[r] = fmaf(p0[r], C, mnC);
#pragma unroll
    for (int r = 0; r < 16; ++r) p1[r] = fmaf(p1[r], C, mnC);
#pragma unroll
    for (int r = 0; r < 8; ++r) p0[r] = __builtin_amdgcn_exp2f(p0[r]);
}
#define PK4(P, BASE, OUT) do { unsigned a0 = pk_bf16(P[BASE + 0], P[BASE + 1]), a1 = pk_bf16(P[BASE + 2], P[BASE + 3]);   \
    unsigned b0 = pk_bf16(P[BASE + 4], P[BASE + 5]), b1 = pk_bf16(P[BASE + 6], P[BASE + 7]);                              \
    auto r0 = __builtin_amdgcn_permlane32_swap(a0, b0, false, false); auto r1 = __builtin_amdgcn_permlane32_swap(a1, b1, false, false); \
    u32x4 w = {r0[0], r1[0], r0[1], r1[1]}; OUT = *reinterpret_cast<bf16x8*>(&w); } while (0)
__device__ __forceinline__ void finishSM(f32x16& p0, f32x16& p1, float alpha, float& l_reg, bf16x8& pa0, bf16x8& pa1, bf16x8& pa2, bf16x8& pa3) {
#pragma unroll
    for (int r = 8; r < 16; ++r) p0[r] = __builtin_amdgcn_exp2f(p0[r]);
#pragma unroll
    for (int r = 0; r < 16; ++r) p1[r] = __builtin_amdgcn_exp2f(p1[r]);
    float ps = 0;
#pragma unroll
    for (int r = 0; r < 16; ++r) ps += p0[r];
#pragma unroll
    for (int r = 0; r < 16; ++r) ps += p1[r];
    { auto rr = __builtin_amdgcn_permlane32_swap(__float_as_uint(ps), __float_as_uint(ps), false, false);
      ps = __uint_as_float(rr[0]) + __uint_as_float(rr[1]); }
    l_reg = l_reg * alpha + ps;
    PK4(p0, 0, pa0); PK4(p0, 8, pa1); PK4(p1, 0, pa2); PK4(p1, 8, pa3);
}
template <int S> __device__ __forceinline__ void fin_piece(f32x16& p0, f32x16& p1, float& ps, bf16x8& pa0, bf16x8& pa1, bf16x8& pa2) {
    if constexpr (S < 8) p0[8 + S] = __builtin_amdgcn_exp2f(p0[8 + S]); else p1[S - 8] = __builtin_amdgcn_exp2f(p1[S - 8]);
    if constexpr (S == 0) ps = p0[0] + p0[1]; else if constexpr (S < 7) ps += p0[S + 1];
    if constexpr (S >= 1 && S <= 8) ps += p0[7 + S]; else if constexpr (S >= 9) ps += p1[S - 9];
    if constexpr (S == 8) PK4(p0, 0, pa0);
    if constexpr (S == 10) PK4(p0, 8, pa1);
    if constexpr (S == 18) PK4(p1, 0, pa2);
}
template <int S> __device__ __forceinline__ void part_piece(f32x16& o0, f32x16& o1, float& ps, float al_old, float& l_reg, bf16x8& pa3,
                                                           f32x16& q0, f32x16& q1, float (&t)[4], float& m_reg, float& mn, float& alpha, float& mnC) {
    constexpr float C = SCALE * 1.4426950408889634f;
    if constexpr (S == 0) { ps += o1[15]; auto rr = __builtin_amdgcn_permlane32_swap(__float_as_uint(ps), __float_as_uint(ps), false, false);
                            ps = __uint_as_float(rr[0]) + __uint_as_float(rr[1]); l_reg = l_reg * al_old + ps; }
    if constexpr (S == 1) PK4(o1, 8, pa3);
    if constexpr (S == 2) { float m = q0[0];
#pragma unroll
        for (int r = 1; r < 8; ++r) m = fmaxf(m, q0[r]); t[0] = m; }
    if constexpr (S == 3) { float m = q0[8];
#pragma unroll
        for (int r = 9; r < 16; ++r) m = fmaxf(m, q0[r]); t[1] = m; }
    if constexpr (S == 4) { float m = q1[0];
#pragma unroll
        for (int r = 1; r < 8; ++r) m = fmaxf(m, q1[r]); t[2] = m; }
    if constexpr (S == 5) { float m = q1[8];
#pragma unroll
        for (int r = 9; r < 16; ++r) m = fmaxf(m, q1[r]); t[3] = m; }
    if constexpr (S == 6) { float pmax = fmaxf(fmaxf(t[0], t[1]), fmaxf(t[2], t[3]));
        auto rr = __builtin_amdgcn_permlane32_swap(__float_as_uint(pmax), __float_as_uint(pmax), false, false);
        t[0] = fmaxf(__uint_as_float(rr[0]), __uint_as_float(rr[1])); }
    if constexpr (S == 7) { const bool keep = __all(t[0] - m_reg <= THR / SCALE);
        mn = keep ? m_reg : fmaxf(m_reg, t[0]); alpha = __builtin_amdgcn_exp2f((m_reg - mn) * C); m_reg = mn; mnC = -mn * C; }
    if constexpr (S >= 8 && S < 12) {
#pragma unroll
        for (int r = 0; r < 4; ++r) q0[(S - 8) * 4 + r] = fmaf(q0[(S - 8) * 4 + r], C, mnC); }
    if constexpr (S >= 12) {
#pragma unroll
        for (int r = 0; r < 4; ++r) q1[(S - 12) * 4 + r] = fmaf(q1[(S - 12) * 4 + r], C, mnC); }
    if constexpr (S >= 9) q0[S - 9] = __builtin_amdgcn_exp2f(q0[S - 9]);
    if constexpr (S == 15) q0[7] = __builtin_amdgcn_exp2f(q0[7]);
}
__device__ __forceinline__ int v_st(int k, int c) { const int kk = (k & ~0xC) | ((k & 4) << 1) | ((k & 8) >> 1); return ((kk >> 3) * 4 + (c >> 5)) * 512 + ((kk & 7) * 32 + (c & 31)) * 2; }
__device__ __forceinline__ int v_rd_base(int lane) { return ((lane & 3) << 3) | (((lane >> 2) & 3) << 6) | (((lane >> 4) & 1) << 5) | (((lane >> 5) & 1) << 8); }
constexpr int v_rd_off(int d0, int ks, int half) { return d0 * 512 + ks * 4096 + half * 2048; }
template <int OFF> __device__ __forceinline__ s16x4 tr_read(int vb) {
    s16x4 r; asm volatile("ds_read_b64_tr_b16 %0, %1 offset:%2" : "=&v"(r) : "v"(vb), "i"(OFF) : "memory"); return r;
}
struct VFrag { s16x4 l0, h0, l1, h1, l2, h2, l3, h3; };
template <int D0> __device__ __forceinline__ void pv_read(VFrag& f, int vb) {
    f.l0 = tr_read<v_rd_off(D0, 0, 0)>(vb); f.h0 = tr_read<v_rd_off(D0, 0, 1)>(vb); f.l1 = tr_read<v_rd_off(D0, 1, 0)>(vb); f.h1 = tr_read<v_rd_off(D0, 1, 1)>(vb);
    f.l2 = tr_read<v_rd_off(D0, 2, 0)>(vb); f.h2 = tr_read<v_rd_off(D0, 2, 1)>(vb); f.l3 = tr_read<v_rd_off(D0, 3, 0)>(vb); f.h3 = tr_read<v_rd_off(D0, 3, 1)>(vb);
}
__device__ __forceinline__ void pv_mma(f32x16& od, const VFrag& f, bf16x8 pa0, bf16x8 pa1, bf16x8 pa2, bf16x8 pa3) {
#define PKV(L, H) (bf16x8){L[0], L[1], L[2], L[3], H[0], H[1], H[2], H[3]}
    od = __builtin_amdgcn_mfma_f32_32x32x16_bf16(pa0, PKV(f.l0, f.h0), od, 0, 0, 0);
    od = __builtin_amdgcn_mfma_f32_32x32x16_bf16(pa1, PKV(f.l1, f.h1), od, 0, 0, 0);
    od = __builtin_amdgcn_mfma_f32_32x32x16_bf16(pa2, PKV(f.l2, f.h2), od, 0, 0, 0);
    od = __builtin_amdgcn_mfma_f32_32x32x16_bf16(pa3, PKV(f.l3, f.h3), od, 0, 0, 0);
#undef PKV
}
__device__ __forceinline__ void pv_d0(f32x16* o, int vb, bf16x8 pa0, bf16x8 pa1, bf16x8 pa2, bf16x8 pa3) {
    VFrag fa, fb;
    pv_read<0>(fa, vb); pv_read<1>(fb, vb);
    asm volatile("s_waitcnt lgkmcnt(8)" ::: "memory"); SBAR(); pv_mma(o[0], fa, pa0, pa1, pa2, pa3); SBAR();
    pv_read<2>(fa, vb);
    asm volatile("s_waitcnt lgkmcnt(8)" ::: "memory"); SBAR(); pv_mma(o[1], fb, pa0, pa1, pa2, pa3); SBAR();
    pv_read<3>(fb, vb);
    asm volatile("s_waitcnt lgkmcnt(8)" ::: "memory"); SBAR(); pv_mma(o[2], fa, pa0, pa1, pa2, pa3); SBAR();
    asm volatile("s_waitcnt lgkmcnt(0)" ::: "memory"); SBAR(); pv_mma(o[3], fb, pa0, pa1, pa2, pa3);
}
constexpr int SLOTB = 40960, S_V = 0, S_KN = 16384, S_KR = 32768, OFF_QR = 3 * SLOTB, OFF_WS2 = OFF_QR + 32768, LDS_ATT2 = OFF_WS2 + 2048;
static_assert(LDS_ATT2 <= LDS_CTL, "attention LDS");
__device__ __forceinline__ void qkt2(f32x16& p0, f32x16& p1, const LAS unsigned char* slot, const LAS unsigned char* qrp, const bf16x8 (&qr)[8], int r32, int hi) {
    p0 = f32x16{}; p1 = f32x16{};
    const LAS unsigned char* Kn = slot + S_KN; const LAS unsigned char* Kr = slot + S_KR;
    bf16x8 a0 = *(const LAS bf16x8*)(Kn + KSWZ(r32, (hi * 8) * 2)), a1 = *(const LAS bf16x8*)(Kn + KSWZ(32 + r32, (hi * 8) * 2));
#pragma unroll
    for (int d0 = 0; d0 < 8; ++d0) {
        bf16x8 n0, n1;
        if (d0 < 7) { const int cb = ((d0 + 1) * 16 + hi * 8) * 2; n0 = *(const LAS bf16x8*)(Kn + KSWZ(r32, cb)); n1 = *(const LAS bf16x8*)(Kn + KSWZ(32 + r32, cb)); }
        else { const int cb = (hi * 8) * 2; n0 = *(const LAS bf16x8*)(Kr + KRSWZ(r32, cb)); n1 = *(const LAS bf16x8*)(Kr + KRSWZ(32 + r32, cb)); }
        p0 = __builtin_amdgcn_mfma_f32_32x32x16_bf16(a0, qr[d0], p0, 0, 0, 0);
        p1 = __builtin_amdgcn_mfma_f32_32x32x16_bf16(a1, qr[d0], p1, 0, 0, 0);
        a0 = n0; a1 = n1;
    }
    bf16x8 qq = *(const LAS bf16x8*)(qrp + (((hi * 8) * 2) ^ (((r32 >> 1) & 7) << 4)));
#pragma unroll
    for (int d0 = 0; d0 < 4; ++d0) {
        bf16x8 n0, n1, nq;
        if (d0 < 3) { const int cb = ((d0 + 1) * 16 + hi * 8) * 2; n0 = *(const LAS bf16x8*)(Kr + KRSWZ(r32, cb)); n1 = *(const LAS bf16x8*)(Kr + KRSWZ(32 + r32, cb)); nq = *(const LAS bf16x8*)(qrp + (cb ^ (((r32 >> 1) & 7) << 4))); }
        p0 = __builtin_amdgcn_mfma_f32_32x32x16_bf16(a0, qq, p0, 0, 0, 0);
        p1 = __builtin_amdgcn_mfma_f32_32x32x16_bf16(a1, qq, p1, 0, 0, 0);
        if (d0 < 3) { a0 = n0; a1 = n1; qq = nq; }
    }
}
__device__ __forceinline__ void s1_step(f32x16& q0, f32x16& q1, const LAS unsigned char* slot, const LAS unsigned char* qrp, const bf16x8 (&qr)[8], int r32, int hi,
                                        f32x16& p0, f32x16& p1, float& ps, bf16x8& pa0, bf16x8& pa1, bf16x8& pa2) {
    q0 = f32x16{}; q1 = f32x16{};
    const LAS unsigned char* Kn = slot + S_KN; const LAS unsigned char* Kr = slot + S_KR;
    bf16x8 a0 = *(const LAS bf16x8*)(Kn + KSWZ(r32, (hi * 8) * 2)), a1 = *(const LAS bf16x8*)(Kn + KSWZ(32 + r32, (hi * 8) * 2)), qq = a0;
#define S1_STEP(D) do { bf16x8 n0 = a0, n1 = a1, nq = qq; \
        if ((D) < 7) { const int cb = (((D) + 1) * 16 + hi * 8) * 2; n0 = *(const LAS bf16x8*)(Kn + KSWZ(r32, cb)); n1 = *(const LAS bf16x8*)(Kn + KSWZ(32 + r32, cb)); } \
        else if ((D) < 11) { const int cb = (((D) - 7) * 16 + hi * 8) * 2; n0 = *(const LAS bf16x8*)(Kr + KRSWZ(r32, cb)); n1 = *(const LAS bf16x8*)(Kr + KRSWZ(32 + r32, cb)); \
                             nq = *(const LAS bf16x8*)(qrp + (cb ^ (((r32 >> 1) & 7) << 4))); } \
        q0 = __builtin_amdgcn_mfma_f32_32x32x16_bf16(a0, (D) < 8 ? qr[(D) & 7] : qq, q0, 0, 0, 0); fin_piece<2 * (D)>(p0, p1, ps, pa0, pa1, pa2); SBAR(); \
        q1 = __builtin_amdgcn_mfma_f32_32x32x16_bf16(a1, (D) < 8 ? qr[(D) & 7] : qq, q1, 0, 0, 0); fin_piece<2 * (D) + 1>(p0, p1, ps, pa0, pa1, pa2); SBAR(); \
        a0 = n0; a1 = n1; qq = nq; } while (0)
    S1_STEP(0); S1_STEP(1); S1_STEP(2); S1_STEP(3); S1_STEP(4); S1_STEP(5); S1_STEP(6); S1_STEP(7); S1_STEP(8); S1_STEP(9); S1_STEP(10); S1_STEP(11);
#undef S1_STEP
}
__device__ __forceinline__ void s2_step(f32x16* o, int vb, bf16x8 pa0, bf16x8 pa1, bf16x8 pa2, bf16x8& pa3, f32x16& po0, f32x16& po1, float& ps, float al_old, float& l_reg,
                                        f32x16& q0, f32x16& q1, float& m_reg, float& mn, float& alpha) {
    VFrag fa, fb; float t[4] = {0.f, 0.f, 0.f, 0.f}, mnC = 0.f;
#define PKV(L, H) (bf16x8){L[0], L[1], L[2], L[3], H[0], H[1], H[2], H[3]}
#define S2_MMA(OD, L, H, PA, S) do { OD = __builtin_amdgcn_mfma_f32_32x32x16_bf16(PA, PKV(L, H), OD, 0, 0, 0); part_piece<S>(po0, po1, ps, al_old, l_reg, pa3, q0, q1, t, m_reg, mn, alpha, mnC); SBAR(); } while (0)
    pv_read<0>(fa, vb); pv_read<1>(fb, vb);
    asm volatile("s_waitcnt lgkmcnt(8)" ::: "memory"); SBAR();
    S2_MMA(o[0], fa.l0, fa.h0, pa0, 0); S2_MMA(o[0], fa.l1, fa.h1, pa1, 1); S2_MMA(o[0], fa.l2, fa.h2, pa2, 2); S2_MMA(o[0], fa.l3, fa.h3, pa3, 3);
    pv_read<2>(fa, vb);
    asm volatile("s_waitcnt lgkmcnt(8)" ::: "memory"); SBAR();
    S2_MMA(o[1], fb.l0, fb.h0, pa0, 4); S2_MMA(o[1], fb.l1, fb.h1, pa1, 5); S2_MMA(o[1], fb.l2, fb.h2, pa2, 6); S2_MMA(o[1], fb.l3, fb.h3, pa3, 7);
    pv_read<3>(fb, vb);
    asm volatile("s_waitcnt lgkmcnt(8)" ::: "memory"); SBAR();
    S2_MMA(o[2], fa.l0, fa.h0, pa0, 8); S2_MMA(o[2], fa.l1, fa.h1, pa1, 9); S2_MMA(o[2], fa.l2, fa.h2, pa2, 10); S2_MMA(o[2], fa.l3, fa.h3, pa3, 11);
    asm volatile("s_waitcnt lgkmcnt(0)" ::: "memory"); SBAR();
    S2_MMA(o[3], fb.l0, fb.h0, pa0, 12); S2_MMA(o[3], fb.l1, fb.h1, pa1, 13); S2_MMA(o[3], fb.l2, fb.h2, pa2, 14); S2_MMA(o[3], fb.l3, fb.h3, pa3, 15);
    asm volatile("" : "+v"(q0), "+v"(q1));
#undef S2_MMA
#undef PKV
}
__device__ __forceinline__ void attn_body(const bf16_t* __restrict__ Qb, const bf16_t* __restrict__ Kh, const bf16_t* __restrict__ Krp, const bf16_t* __restrict__ Vh,
                                          bf16_t* __restrict__ Ob, int seq, LAS unsigned char* lds) {
    int tid = threadIdx.x; asm volatile("" : "+v"(tid));
    const int wid = __builtin_amdgcn_readfirstlane(tid >> 6), lane = tid & 63, r32 = lane & 31, hi = lane >> 5;
    LAS float* ws = (LAS float*)(lds + OFF_WS2) + wid * 64; LAS float* li_l = ws; LAS float* al_l = ws + 32;
    LAS unsigned char* qrp = lds + OFF_QR + (wid * 32 + r32) * 128;
    float m_reg = -1e30f, l_reg = 0; f32x16 o[4] = {}; bf16x8 qr[8];
    const bf16_t* Qw = Qb + (long)(wid * 32 + r32) * LDQ + hi * 8;
#pragma unroll
    for (int d0 = 0; d0 < 8; ++d0) qr[d0] = *(const bf16x8*)(Qw + d0 * 16);
#pragma unroll
    for (int d0 = 0; d0 < 4; ++d0) { const bf16x8 q = *(const bf16x8*)(Qw + 128 + d0 * 16); const int cb = (d0 * 16 + hi * 8) * 2;
        *(LAS bf16x8*)(qrp + (cb ^ (((r32 >> 1) & 7) << 4))) = q; }
#define OFF_V() ({ const int u_ = wid * 64 + lane, sub_ = u_ >> 5, within_ = u_ & 31, kk_ = ((sub_ >> 2) << 3) | (within_ >> 2), c_ = ((sub_ & 3) << 5) | ((within_ & 3) << 3); \
                  const int k_ = (kk_ & ~0xC) | ((kk_ & 4) << 1) | ((kk_ & 8) >> 1); (unsigned)(k_ * LDK + c_); })
#define OFF_K() ({ const int u_ = wid * 64 + lane, row_ = u_ >> 4, sl_ = u_ & 15; (unsigned)(row_ * LDK + ((sl_ ^ (row_ & 15)) << 3)); })
#define OFF_R() ({ const int u_ = wid * 64 + lane, row_ = u_ >> 3, sl_ = u_ & 7; (unsigned)(row_ * LDKR + ((sl_ ^ ((row_ >> 1) & 7)) << 3)); })
    const int vbase = (int)(unsigned)(uintptr_t)lds + v_rd_base(lane);
#define DMA(t, slot) do { const bf16_t* vh_ = Vh + (size_t)(t) * KVBLK * LDK; const bf16_t* kh_ = Kh + (size_t)(t) * KVBLK * LDK; const bf16_t* kr_ = Krp + (size_t)(t) * KVBLK * LDKR; \
    LAS unsigned char* sb_ = lds + (slot) * SLOTB; \
    __builtin_amdgcn_global_load_lds((const unsigned*)(vh_ + OFF_V()), (LAS unsigned*)(sb_ + S_V + wid * 1024), 16, 0, 0); \
    __builtin_amdgcn_global_load_lds((const unsigned*)(vh_ + OFF_V() + 32 * LDK), (LAS unsigned*)(sb_ + S_V + (wid + 8) * 1024), 16, 0, 0); \
    __builtin_amdgcn_global_load_lds((const unsigned*)(kh_ + OFF_K()), (LAS unsigned*)(sb_ + S_KN + wid * 1024), 16, 0, 0); \
    __builtin_amdgcn_global_load_lds((const unsigned*)(kh_ + OFF_K() + 32 * LDK), (LAS unsigned*)(sb_ + S_KN + (wid + 8) * 1024), 16, 0, 0); \
    __builtin_amdgcn_global_load_lds((const unsigned*)(kr_ + OFF_R()), (LAS unsigned*)(sb_ + S_KR + wid * 1024), 16, 0, 0); } while (0)
#define RESC(a) do { if (__any((a) < 1.f)) { if (hi == 0) al_l[r32] = (a); asm volatile("s_waitcnt lgkmcnt(0)" ::: "memory"); \
    _Pragma("unroll") for (int d = 0; d < 4; ++d) _Pragma("unroll") for (int r = 0; r < 16; ++r) o[d][r] *= al_l[crow(r, hi)]; } } while (0)
#define TILE_SYNC() do { asm volatile("s_waitcnt vmcnt(0)" ::: "memory"); __syncthreads(); } while (0)
    f32x16 pA0, pA1, pB0, pB1; float mnA, mnB, alA, alB, psum = 0.f; bf16x8 pa0, pa1, pa2, pa3; const int NT = seq / KVBLK;
    DMA(0, 0); DMA(1, 1);
    TILE_SYNC();
    qkt2(pA0, pA1, lds, qrp, qr, r32, hi); partialSM(pA0, pA1, m_reg, mnA, alA);
    int s_prev = 0, s_cur = 1, s_next = 2;
    for (int j = 1; j + 1 < NT; j += 2) {
        DMA(j + 1, s_next);
        SBAR(); s1_step(pB0, pB1, lds + s_cur * SLOTB, qrp, qr, r32, hi, pA0, pA1, psum, pa0, pa1, pa2);
        s2_step(o, vbase + s_prev * SLOTB, pa0, pa1, pa2, pa3, pA0, pA1, psum, alA, l_reg, pB0, pB1, m_reg, mnB, alB);
        TILE_SYNC(); RESC(alB);
        { const int t_ = s_prev; s_prev = s_cur; s_cur = s_next; s_next = t_; }
        if (j + 2 < NT) DMA(j + 2, s_next);
        SBAR(); s1_step(pA0, pA1, lds + s_cur * SLOTB, qrp, qr, r32, hi, pB0, pB1, psum, pa0, pa1, pa2);
        s2_step(o, vbase + s_prev * SLOTB, pa0, pa1, pa2, pa3, pB0, pB1, psum, alB, l_reg, pA0, pA1, m_reg, mnA, alA);
        TILE_SYNC(); RESC(alA);
        { const int t_ = s_prev; s_prev = s_cur; s_cur = s_next; s_next = t_; }
    }
    SBAR(); qkt2(pB0, pB1, lds + s_cur * SLOTB, qrp, qr, r32, hi);
    finishSM(pA0, pA1, alA, l_reg, pa0, pa1, pa2, pa3); SBAR();
    pv_d0(o, vbase + s_prev * SLOTB, pa0, pa1, pa2, pa3); partialSM(pB0, pB1, m_reg, mnB, alB);
    RESC(alB);
    finishSM(pB0, pB1, alB, l_reg, pa0, pa1, pa2, pa3); SBAR();
    pv_d0(o, vbase + s_cur * SLOTB, pa0, pa1, pa2, pa3);
    if (hi == 0) li_l[r32] = l_reg; asm volatile("s_waitcnt lgkmcnt(0)" ::: "memory");
    float rli[16];
#pragma unroll
    for (int r = 0; r < 16; ++r) rli[r] = __builtin_amdgcn_rcpf(li_l[crow(r, hi)]);
    bf16_t* Ow = Ob + (long)(wid * 32) * LDO;
#pragma unroll
    for (int r = 0; r < 16; ++r) { const int orow = crow(r, hi);
#pragma unroll
        for (int d0 = 0; d0 < 4; ++d0) Ow[(long)orow * LDO + d0 * 32 + r32] = f2bf(o[d0][r] * rli[r]); }
    __syncthreads();
#undef DMA
#undef OFF_V
#undef OFF_K
#undef OFF_R
#undef RESC
#undef TILE_SYNC
}

constexpr int SLOTB8 = 28672, S8_V = 0, S8_KN = 16384, S8_KR = 24576, OFF8_WS = 3 * SLOTB8, OFF8_SK = OFF8_WS + 2048, LDS_ATT8 = OFF8_SK + 2048;
static_assert(LDS_ATT8 <= LDS_CTL, "attention LDS (int8)");
typedef int i32x4v __attribute__((ext_vector_type(4)));
typedef int i32x16v __attribute__((ext_vector_type(16)));
#define K8N_SWZ(row, ch) ((row) * 128 + ((((ch)) ^ (((row) >> 1) & 7)) << 4))
#define K8R_SWZ(row, ch) ((row) * 64 + ((((ch)) ^ (((row) >> 2) & 3)) << 4))
__device__ __forceinline__ unsigned q8pack(float a, float b, float c, float d) {
    const int q0 = (int)rintf(a), q1 = (int)rintf(b), q2 = (int)rintf(c), q3 = (int)rintf(d);
    return (unsigned)((q0 & 255) | ((q1 & 255) << 8) | ((q2 & 255) << 16) | ((q3 & 255) << 24));
}
__device__ __forceinline__ void kq_phase(const Fr& F, const bf16_t* KV, const bf16_t* KR, unsigned char* K8N, unsigned char* K8R, float* SK, int nkey) {
    const int ntile = nkey / 64, kq = F.lane >> 3, ch = F.lane & 7;
    for (int it = F.bid * 8 + F.wave; it < ntile * 8; it += F.G * 8) {
        const int h = it & 7, t = it >> 3;
        u32x4 n[8][2]; u32x4 r[8];
#pragma unroll
        for (int g = 0; g < 8; ++g) { const size_t key = (size_t)t * 64 + g * 8 + kq;
            n[g][0] = *(const u32x4*)(KV + key * LDK + h * 256 + ch * 16); n[g][1] = *(const u32x4*)(KV + key * LDK + h * 256 + ch * 16 + 8);
            r[g] = *(const u32x4*)(KR + key * LDKR + ch * 8); }
        float am = 0.f;
#pragma unroll
        for (int g = 0; g < 8; ++g) {
#pragma unroll
            for (int q = 0; q < 4; ++q) { am = fmaxf(am, fmaxf(fabsf(bf_lo(n[g][0][q])), fabsf(bf_hi(n[g][0][q])))); am = fmaxf(am, fmaxf(fabsf(bf_lo(n[g][1][q])), fabsf(bf_hi(n[g][1][q]))));
                am = fmaxf(am, fmaxf(fabsf(bf_lo(r[g][q])), fabsf(bf_hi(r[g][q])))); } }
#pragma unroll
        for (int o = 32; o >= 1; o >>= 1) am = fmaxf(am, __shfl_xor(am, o));
        const float inv = am > 0.f ? 127.0f / am : 0.f;
#pragma unroll
        for (int g = 0; g < 8; ++g) { const size_t key = (size_t)t * 64 + g * 8 + kq;
            u32x4 w;
            w.x = q8pack(bf_lo(n[g][0].x) * inv, bf_hi(n[g][0].x) * inv, bf_lo(n[g][0].y) * inv, bf_hi(n[g][0].y) * inv);
            w.y = q8pack(bf_lo(n[g][0].z) * inv, bf_hi(n[g][0].z) * inv, bf_lo(n[g][0].w) * inv, bf_hi(n[g][0].w) * inv);
            w.z = q8pack(bf_lo(n[g][1].x) * inv, bf_hi(n[g][1].x) * inv, bf_lo(n[g][1].y) * inv, bf_hi(n[g][1].y) * inv);
            w.w = q8pack(bf_lo(n[g][1].z) * inv, bf_hi(n[g][1].z) * inv, bf_lo(n[g][1].w) * inv, bf_hi(n[g][1].w) * inv);
            *(u32x4*)(K8N + ((size_t)h * nkey + key) * 128 + ch * 16) = w;
            u32x2 v;
            v.x = q8pack(bf_lo(r[g].x) * inv, bf_hi(r[g].x) * inv, bf_lo(r[g].y) * inv, bf_hi(r[g].y) * inv);
            v.y = q8pack(bf_lo(r[g].z) * inv, bf_hi(r[g].z) * inv, bf_lo(r[g].w) * inv, bf_hi(r[g].w) * inv);
            *(u32x2*)(K8R + ((size_t)h * nkey + key) * 64 + ch * 8) = v; }
        if (F.lane == 0) SK[h * ntile + t] = am > 0.f ? am * (1.0f / 127.0f) : 1.0f;
    }
}
#define QK8_FRAG(S, ROW) ((S) < 4 ? *(const LAS i32x4v*)(Kn + K8N_SWZ((ROW), (S) * 2 + hi)) : *(const LAS i32x4v*)(Kr + K8R_SWZ((ROW), ((S) - 4) * 2 + hi)))
__device__ __forceinline__ void qkt8(f32x16& p0, f32x16& p1, const LAS unsigned char* slot, const i32x4v (&qi)[6], int r32, int hi) {
    const LAS unsigned char* Kn = slot + S8_KN; const LAS unsigned char* Kr = slot + S8_KR;
    i32x16v c0 = {}, c1 = {};
    i32x4v a0 = QK8_FRAG(0, r32), a1 = QK8_FRAG(0, 32 + r32);
#pragma unroll
    for (int s = 0; s < 6; ++s) {
        i32x4v n0 = a0, n1 = a1;
        if (s < 5) { n0 = QK8_FRAG(s + 1, r32); n1 = QK8_FRAG(s + 1, 32 + r32); }
        c0 = __builtin_amdgcn_mfma_i32_32x32x32_i8(a0, qi[s], c0, 0, 0, 0);
        c1 = __builtin_amdgcn_mfma_i32_32x32x32_i8(a1, qi[s], c1, 0, 0, 0);
        a0 = n0; a1 = n1;
    }
    p0 = __builtin_bit_cast(f32x16, c0); p1 = __builtin_bit_cast(f32x16, c1);
}
__device__ __forceinline__ void i2f_scores(f32x16& p0, f32x16& p1, float mraw) {
#pragma unroll
    for (int r = 0; r < 16; ++r) { p0[r] = (float)__float_as_int(p0[r]) * mraw; p1[r] = (float)__float_as_int(p1[r]) * mraw; }
}
__device__ __forceinline__ void s1_step8(f32x16& q0, f32x16& q1, const LAS unsigned char* slot, const i32x4v (&qi)[6], int r32, int hi,
                                         f32x16& p0, f32x16& p1, float& ps, bf16x8& pa0, bf16x8& pa1, bf16x8& pa2) {
    const LAS unsigned char* Kn = slot + S8_KN; const LAS unsigned char* Kr = slot + S8_KR;
    i32x16v c0 = {}, c1 = {};
    i32x4v a0 = QK8_FRAG(0, r32), a1 = QK8_FRAG(0, 32 + r32);
#define S1_STEP8(S) do { i32x4v n0 = a0, n1 = a1; \
        if ((S) < 5) { n0 = QK8_FRAG((S) + 1, r32); n1 = QK8_FRAG((S) + 1, 32 + r32); } \
        c0 = __builtin_amdgcn_mfma_i32_32x32x32_i8(a0, qi[S], c0, 0, 0, 0); fin_piece<4 * (S)>(p0, p1, ps, pa0, pa1, pa2); SBAR(); fin_piece<4 * (S) + 1>(p0, p1, ps, pa0, pa1, pa2); SBAR(); \
        c1 = __builtin_amdgcn_mfma_i32_32x32x32_i8(a1, qi[S], c1, 0, 0, 0); fin_piece<4 * (S) + 2>(p0, p1, ps, pa0, pa1, pa2); SBAR(); fin_piece<4 * (S) + 3>(p0, p1, ps, pa0, pa1, pa2); SBAR(); \
        a0 = n0; a1 = n1; } while (0)
    S1_STEP8(0); S1_STEP8(1); S1_STEP8(2); S1_STEP8(3); S1_STEP8(4); S1_STEP8(5);
#undef S1_STEP8
    q0 = __builtin_bit_cast(f32x16, c0); q1 = __builtin_bit_cast(f32x16, c1);
}
template <int S> __device__ __forceinline__ void part_piece8(f32x16& o0, f32x16& o1, float& ps, float al_old, float& l_reg, bf16x8& pa3,
                                                            f32x16& q0, f32x16& q1, int (&ti)[4], float& tf, float mraw, float& m_reg, float& mn, float& alpha, float& mnC) {
    constexpr float C = SCALE * 1.4426950408889634f;
    if constexpr (S == 0) { ps += o1[15]; auto rr = __builtin_amdgcn_permlane32_swap(__float_as_uint(ps), __float_as_uint(ps), false, false);
                            ps = __uint_as_float(rr[0]) + __uint_as_float(rr[1]); l_reg = l_reg * al_old + ps; }
    if constexpr (S == 1) PK4(o1, 8, pa3);
    if constexpr (S == 2) { int m = __float_as_int(q0[0]);
#pragma unroll
        for (int r = 1; r < 8; ++r) m = max(m, __float_as_int(q0[r])); ti[0] = m; }
    if constexpr (S == 3) { int m = __float_as_int(q0[8]);
#pragma unroll
        for (int r = 9; r < 16; ++r) m = max(m, __float_as_int(q0[r])); ti[1] = m; }
    if constexpr (S == 4) { int m = __float_as_int(q1[0]);
#pragma unroll
        for (int r = 1; r < 8; ++r) m = max(m, __float_as_int(q1[r])); ti[2] = m; }
    if constexpr (S == 5) { int m = __float_as_int(q1[8]);
#pragma unroll
        for (int r = 9; r < 16; ++r) m = max(m, __float_as_int(q1[r])); ti[3] = m; }
    if constexpr (S == 6) { const float pmax = (float)max(max(ti[0], ti[1]), max(ti[2], ti[3])) * mraw;
        auto rr = __builtin_amdgcn_permlane32_swap(__float_as_uint(pmax), __float_as_uint(pmax), false, false);
        tf = fmaxf(__uint_as_float(rr[0]), __uint_as_float(rr[1])); }
    if constexpr (S == 7) { const bool keep = __all(tf - m_reg <= THR / SCALE);
        mn = keep ? m_reg : fmaxf(m_reg, tf); alpha = __builtin_amdgcn_exp2f((m_reg - mn) * C); m_reg = mn; mnC = -mn * C; }
    if constexpr (S >= 8 && S < 12) {
#pragma unroll
        for (int r = 0; r < 4; ++r) q0[(S - 8) * 4 + r] = fmaf((float)__float_as_int(q0[(S - 8) * 4 + r]), mraw * C, mnC); }
    if constexpr (S >= 12) {
#pragma unroll
        for (int r = 0; r < 4; ++r) q1[(S - 12) * 4 + r] = fmaf((float)__float_as_int(q1[(S - 12) * 4 + r]), mraw * C, mnC); }
    if constexpr (S >= 9) q0[S - 9] = __builtin_amdgcn_exp2f(q0[S - 9]);
    if constexpr (S == 15) q0[7] = __builtin_amdgcn_exp2f(q0[7]);
}
__device__ __forceinline__ void s2_step8(f32x16* o, int vb, bf16x8 pa0, bf16x8 pa1, bf16x8 pa2, bf16x8& pa3, f32x16& po0, f32x16& po1, float& ps, float al_old, float& l_reg,
                                         f32x16& q0, f32x16& q1, float mraw, float& m_reg, float& mn, float& alpha) {
    VFrag fa, fb; int ti[4] = {0, 0, 0, 0}; float tf = 0.f, mnC = 0.f;
#define PKV(L, H) (bf16x8){L[0], L[1], L[2], L[3], H[0], H[1], H[2], H[3]}
#define S2_MMA(OD, L, H, PA, S) do { OD = __builtin_amdgcn_mfma_f32_32x32x16_bf16(PA, PKV(L, H), OD, 0, 0, 0); part_piece8<S>(po0, po1, ps, al_old, l_reg, pa3, q0, q1, ti, tf, mraw, m_reg, mn, alpha, mnC); SBAR(); } while (0)
    pv_read<0>(fa, vb); pv_read<1>(fb, vb);
    asm volatile("s_waitcnt lgkmcnt(8)" ::: "memory"); SBAR();
    S2_MMA(o[0], fa.l0, fa.h0, pa0, 0); S2_MMA(o[0], fa.l1, fa.h1, pa1, 1); S2_MMA(o[0], fa.l2, fa.h2, pa2, 2); S2_MMA(o[0], fa.l3, fa.h3, pa3, 3);
    pv_read<2>(fa, vb);
    asm volatile("s_waitcnt lgkmcnt(8)" ::: "memory"); SBAR();
    S2_MMA(o[1], fb.l0, fb.h0, pa0, 4); S2_MMA(o[1], fb.l1, fb.h1, pa1, 5); S2_MMA(o[1], fb.l2, fb.h2, pa2, 6); S2_MMA(o[1], fb.l3, fb.h3, pa3, 7);
    pv_read<3>(fb, vb);
    asm volatile("s_waitcnt lgkmcnt(8)" ::: "memory"); SBAR();
    S2_MMA(o[2], fa.l0, fa.h0, pa0, 8); S2_MMA(o[2], fa.l1, fa.h1, pa1, 9); S2_MMA(o[2], fa.l2, fa.h2, pa2, 10); S2_MMA(o[2], fa.l3, fa.h3, pa3, 11);
    asm volatile("s_waitcnt lgkmcnt(0)" ::: "memory"); SBAR();
    S2_MMA(o[3], fb.l0, fb.h0, pa0, 12); S2_MMA(o[3], fb.l1, fb.h1, pa1, 13); S2_MMA(o[3], fb.l2, fb.h2, pa2, 14); S2_MMA(o[3], fb.l3, fb.h3, pa3, 15);
    asm volatile("" : "+v"(q0), "+v"(q1));
#undef S2_MMA
#undef PKV
}
__device__ __forceinline__ void attn_body8(const bf16_t* __restrict__ Qb, const unsigned char* __restrict__ K8n, const unsigned char* __restrict__ K8r, const float* __restrict__ SKh,
                                           const bf16_t* __restrict__ Vh, bf16_t* __restrict__ Ob, int seq, LAS unsigned char* lds) {
    int tid = threadIdx.x; asm volatile("" : "+v"(tid));
    const int wid = __builtin_amdgcn_readfirstlane(tid >> 6), lane = tid & 63, r32 = lane & 31, hi = lane >> 5;
    LAS float* ws = (LAS float*)(lds + OFF8_WS) + wid * 64; LAS float* li_l = ws; LAS float* al_l = ws + 32;
    float m_reg = -1e30f, l_reg = 0; f32x16 o[4] = {}; i32x4v qi[6]; float sq;
    {
        const bf16_t* Qw = Qb + (long)(wid * 32 + r32) * LDQ + hi * 16;
        u32x4 w[6][2];
#pragma unroll
        for (int s = 0; s < 6; ++s) { w[s][0] = *(const u32x4*)(Qw + s * 32); w[s][1] = *(const u32x4*)(Qw + s * 32 + 8); }
        float am = 0.f;
#pragma unroll
        for (int s = 0; s < 6; ++s)
#pragma unroll
            for (int q = 0; q < 4; ++q) { am = fmaxf(am, fmaxf(fabsf(bf_lo(w[s][0][q])), fabsf(bf_hi(w[s][0][q])))); am = fmaxf(am, fmaxf(fabsf(bf_lo(w[s][1][q])), fabsf(bf_hi(w[s][1][q])))); }
        { auto rr = __builtin_amdgcn_permlane32_swap(__float_as_uint(am), __float_as_uint(am), false, false); am = fmaxf(__uint_as_float(rr[0]), __uint_as_float(rr[1])); }
        const float inv = am > 0.f ? 127.0f / am : 0.f; sq = am * (1.0f / 127.0f);
#pragma unroll
        for (int s = 0; s < 6; ++s) {
            qi[s].x = (int)q8pack(bf_lo(w[s][0].x) * inv, bf_hi(w[s][0].x) * inv, bf_lo(w[s][0].y) * inv, bf_hi(w[s][0].y) * inv);
            qi[s].y = (int)q8pack(bf_lo(w[s][0].z) * inv, bf_hi(w[s][0].z) * inv, bf_lo(w[s][0].w) * inv, bf_hi(w[s][0].w) * inv);
            qi[s].z = (int)q8pack(bf_lo(w[s][1].x) * inv, bf_hi(w[s][1].x) * inv, bf_lo(w[s][1].y) * inv, bf_hi(w[s][1].y) * inv);
            qi[s].w = (int)q8pack(bf_lo(w[s][1].z) * inv, bf_hi(w[s][1].z) * inv, bf_lo(w[s][1].w) * inv, bf_hi(w[s][1].w) * inv); }
    }
#define OFF_V() ({ const int u_ = wid * 64 + lane, sub_ = u_ >> 5, within_ = u_ & 31, kk_ = ((sub_ >> 2) << 3) | (within_ >> 2), c_ = ((sub_ & 3) << 5) | ((within_ & 3) << 3); \
                  const int k_ = (kk_ & ~0xC) | ((kk_ & 4) << 1) | ((kk_ & 8) >> 1); (unsigned)(k_ * LDK + c_); })
#define OFF_KN8() ({ const int u_ = wid * 64 + lane, row_ = u_ >> 3, c_ = u_ & 7; (unsigned)(row_ * 128 + ((c_ ^ ((row_ >> 1) & 7)) << 4)); })
#define OFF_KR8() ({ const int u_ = wid * 64 + lane, row_ = u_ >> 2, c_ = u_ & 3; (unsigned)(row_ * 64 + ((c_ ^ ((row_ >> 2) & 3)) << 4)); })
    const int vbase = (int)(unsigned)(uintptr_t)lds + v_rd_base(lane);
#define DMA(t, slot) do { const bf16_t* vh_ = Vh + (size_t)(t) * KVBLK * LDK; LAS unsigned char* sb_ = lds + (slot) * SLOTB8; \
    __builtin_amdgcn_global_load_lds((const unsigned*)(vh_ + OFF_V()), (LAS unsigned*)(sb_ + S8_V + wid * 1024), 16, 0, 0); \
    __builtin_amdgcn_global_load_lds((const unsigned*)(vh_ + OFF_V() + 32 * LDK), (LAS unsigned*)(sb_ + S8_V + (wid + 8) * 1024), 16, 0, 0); \
    __builtin_amdgcn_global_load_lds((const unsigned*)(K8n + (size_t)(t) * 8192 + OFF_KN8()), (LAS unsigned*)(sb_ + S8_KN + wid * 1024), 16, 0, 0); \
    if (wid < 4) __builtin_amdgcn_global_load_lds((const unsigned*)(K8r + (size_t)(t) * 4096 + OFF_KR8()), (LAS unsigned*)(sb_ + S8_KR + wid * 1024), 16, 0, 0); } while (0)
#define RESC(a) do { if (__any((a) < 1.f)) { if (hi == 0) al_l[r32] = (a); asm volatile("s_waitcnt lgkmcnt(0)" ::: "memory"); \
    _Pragma("unroll") for (int d = 0; d < 4; ++d) _Pragma("unroll") for (int r = 0; r < 16; ++r) o[d][r] *= al_l[crow(r, hi)]; } } while (0)
#define TILE_SYNC() do { asm volatile("s_waitcnt vmcnt(0)" ::: "memory"); __syncthreads(); } while (0)
    f32x16 pA0, pA1, pB0, pB1; float mnA, mnB, alA, alB, psum = 0.f; bf16x8 pa0, pa1, pa2, pa3; const int NT = seq / KVBLK;
    LAS float* skl = (LAS float*)(lds + OFF8_SK);
    for (int i = tid; i < NT; i += NTHR) skl[i] = SKh[i];
    DMA(0, 0); DMA(1, 1);
    TILE_SYNC();
    qkt8(pA0, pA1, lds, qi, r32, hi); i2f_scores(pA0, pA1, sq * skl[0]); partialSM(pA0, pA1, m_reg, mnA, alA);
    if (wid >= 4) __builtin_amdgcn_s_setprio(1);
    int s_prev = 0, s_cur = 1, s_next = 2;
    for (int j = 1; j + 1 < NT; j += 2) {
        DMA(j + 1, s_next);
        const float mB = sq * skl[j];
        SBAR(); s1_step8(pB0, pB1, lds + s_cur * SLOTB8, qi, r32, hi, pA0, pA1, psum, pa0, pa1, pa2);
        s2_step8(o, vbase + s_prev * SLOTB8, pa0, pa1, pa2, pa3, pA0, pA1, psum, alA, l_reg, pB0, pB1, mB, m_reg, mnB, alB);
        TILE_SYNC(); RESC(alB);
        { const int t_ = s_prev; s_prev = s_cur; s_cur = s_next; s_next = t_; }
        if (j + 2 < NT) DMA(j + 2, s_next);
        const float mA = sq * skl[j + 1];
        SBAR(); s1_step8(pA0, pA1, lds + s_cur * SLOTB8, qi, r32, hi, pB0, pB1, psum, pa0, pa1, pa2);
        s2_step8(o, vbase + s_prev * SLOTB8, pa0, pa1, pa2, pa3, pB0, pB1, psum, alB, l_reg, pA0, pA1, mA, m_reg, mnA, alA);
        TILE_SYNC(); RESC(alA);
        { const int t_ = s_prev; s_prev = s_cur; s_cur = s_next; s_next = t_; }
    }
    __builtin_amdgcn_s_setprio(0);
    SBAR(); qkt8(pB0, pB1, lds + s_cur * SLOTB8, qi, r32, hi); i2f_scores(pB0, pB1, sq * skl[NT - 1]);
    finishSM(pA0, pA1, alA, l_reg, pa0, pa1, pa2, pa3); SBAR();
    pv_d0(o, vbase + s_prev * SLOTB8, pa0, pa1, pa2, pa3); partialSM(pB0, pB1, m_reg, mnB, alB);
    RESC(alB);
    finishSM(pB0, pB1, alB, l_reg, pa0, pa1, pa2, pa3); SBAR();
    pv_d0(o, vbase + s_cur * SLOTB8, pa0, pa1, pa2, pa3);
    if (hi == 0) li_l[r32] = l_reg; asm volatile("s_waitcnt lgkmcnt(0)" ::: "memory");
    float rli[16];
#pragma unroll
    for (int r = 0; r < 16; ++r) rli[r] = __builtin_amdgcn_rcpf(li_l[crow(r, hi)]);
    bf16_t* Ow = Ob + (long)(wid * 32) * LDO;
#pragma unroll
    for (int r = 0; r < 16; ++r) { const int orow = crow(r, hi);
#pragma unroll
        for (int d0 = 0; d0 < 4; ++d0) Ow[(long)orow * LDO + d0 * 32 + r32] = f2bf(o[d0][r] * rli[r]); }
    __syncthreads();
#undef DMA
#undef OFF_V
#undef OFF_KN8
#undef OFF_KR8
#undef RESC
#undef TILE_SYNC
}
}

__device__ __forceinline__ int crow32(int r, int hi) { return (r & 3) + 8 * (r >> 2) + 4 * hi; }

__device__ __forceinline__ void ce_desc(unsigned& x, unsigned& y) { const unsigned hi = x > y ? x : y, lo = x > y ? y : x; x = hi; y = lo; }
__device__ __forceinline__ unsigned f2key(float s) { const unsigned b = __float_as_uint(s); return b ^ (((unsigned)((int)b >> 31)) | 0x80000000u); }
__device__ __forceinline__ float key2f(unsigned k) { const unsigned b = (k & 0x80000000u) ? (k ^ 0x80000000u) : ~k; return __uint_as_float(b); }
__device__ __forceinline__ void sort16_desc(unsigned (&a)[16]) {
#pragma unroll
    for (int k = 2; k <= 16; k <<= 1)
#pragma unroll
        for (int j = k >> 1; j > 0; j >>= 1)
#pragma unroll
            for (int i = 0; i < 16; ++i) { const int l = i ^ j; if (l > i) { if ((i & k) == 0) ce_desc(a[i], a[l]); else ce_desc(a[l], a[i]); } }
}
__device__ __forceinline__ void merge_top16(unsigned (&a)[16], const unsigned (&b)[16]) {
#pragma unroll
    for (int i = 0; i < 16; ++i) a[i] = a[i] > b[15 - i] ? a[i] : b[15 - i];
#pragma unroll
    for (int j = 8; j > 0; j >>= 1)
#pragma unroll
        for (int i = 0; i < 16; ++i) { const int l = i ^ j; if (l > i) ce_desc(a[i], a[l]); }
}
__device__ __forceinline__ void peer_select(const Fr& F, const bf16_t* PQ, const bf16_t* KEYS, unsigned short* PIDX, float* PGATE) {
    LAS bf16_t* KL = (LAS bf16_t*)F.lds;
    LAS unsigned* LST = (LAS unsigned*)(F.lds + 69632);
    LAS int* IDX = (LAS int*)(F.lds + 69632 + 16384);
    LAS float* GT = (LAS float*)(F.lds + 69632 + 16384 + 8192);
    LAS int* CODE = (LAS int*)(F.lds + 69632 + 16384 + 16384);
    __syncthreads();
    if (F.tid < 64) { int cnt = 0, code = 0; for (int ab = 0; ab < 256; ++ab) { if (((ab >> 4) + 1) * ((ab & 15) + 1) <= 16) { if (cnt == F.tid) code = ab; ++cnt; } } CODE[F.tid] = code; }
    for (int ch = F.tid; ch < 2 * 128 * 16; ch += NTHR) { const int row = ch >> 4, c8 = (ch & 15) * 8; *(LAS u32x4*)(KL + row * 136 + c8) = *(const u32x4*)(KEYS + (size_t)row * 128 + c8); }
    __syncthreads();
    const int r32 = F.lane & 31, hi = F.lane >> 5;
    for (int tile = F.bid; tile < SEQ / 16; tile += F.G) {
        const int t0 = tile * 16;
        {
            const int p = F.wave >> 2, rb = F.wave & 3, r = rb * 32 + r32, tl = r >> 3, h = r & 7;
            const bf16_t* qp = PQ + (size_t)(t0 + tl) * 2048 + h * 256 + p * 128 + hi * 8;
            bf16x8 qa[8];
#pragma unroll
            for (int k = 0; k < 8; ++k) qa[k] = *(const bf16x8*)(qp + k * 16);
            unsigned g[4][16];
#pragma unroll
            for (int nb = 0; nb < 4; ++nb) {
                const LAS bf16_t* kp = KL + (p * 128 + nb * 32 + r32) * 136 + hi * 8;
                f32x16 acc = {};
#pragma unroll
                for (int k = 0; k < 8; ++k) { const bf16x8 kb = *(const LAS bf16x8*)(kp + k * 16); acc = __builtin_amdgcn_mfma_f32_32x32x16_bf16(kb, qa[k], acc, 0, 0, 0); }
#pragma unroll
                for (int rr = 0; rr < 16; ++rr) { const int nbase = nb * 32 + (rr & 3) + 8 * (rr >> 2);
                    g[nb][rr] = (f2key(acc[rr]) & ~127u) | (unsigned)((127 - nbase) - 4 * hi); }
            }
            sort16_desc(g[0]); sort16_desc(g[1]); sort16_desc(g[2]); sort16_desc(g[3]);
            merge_top16(g[0], g[1]); merge_top16(g[2], g[3]); merge_top16(g[0], g[2]);
            unsigned other[16];
#pragma unroll
            for (int k = 0; k < 16; ++k) { auto sw = __builtin_amdgcn_permlane32_swap(g[0][k], g[0][k], false, false); other[k] = hi ? sw[0] : sw[1]; }
            merge_top16(g[0], other);
            if (hi == 0) {
#pragma unroll
                for (int k = 0; k < 16; k += 4) *(LAS u32x4*)(LST + (p * 128 + r) * 16 + k) = (u32x4){g[0][k], g[0][k + 1], g[0][k + 2], g[0][k + 3]};
            }
        }
        __syncthreads();
        if (F.tid < 128) {
            const int j = F.tid, tl = j >> 3, h = j & 7;
            unsigned k1[16], k2[16];
#pragma unroll
            for (int k = 0; k < 16; k += 4) { const u32x4 a = *(const LAS u32x4*)(LST + j * 16 + k), b = *(const LAS u32x4*)(LST + (128 + j) * 16 + k);
                k1[k] = a.x; k1[k + 1] = a.y; k1[k + 2] = a.z; k1[k + 3] = a.w; k2[k] = b.x; k2[k + 1] = b.y; k2[k + 2] = b.z; k2[k + 3] = b.w; }
            float v1[16], v2[16];
#pragma unroll
            for (int k = 0; k < 16; ++k) { v1[k] = key2f(k1[k] & ~127u); v2[k] = key2f(k2[k] & ~127u); }
            unsigned cg[4][16];
            {
                int n = 0;
#pragma unroll
                for (int a = 0; a < 16; ++a)
#pragma unroll
                    for (int b = 0; b < 16; ++b) if ((a + 1) * (b + 1) <= 16) { cg[n >> 4][n & 15] = (f2key(v1[a] + v2[b]) & ~63u) | (unsigned)(63 - n); ++n; }
#pragma unroll
                for (int m = 50; m < 64; ++m) cg[m >> 4][m & 15] = 0u;
            }
            sort16_desc(cg[0]); sort16_desc(cg[1]); sort16_desc(cg[2]); sort16_desc(cg[3]);
            merge_top16(cg[0], cg[1]); merge_top16(cg[2], cg[3]); merge_top16(cg[0], cg[2]);
            float bs[16];
#pragma unroll
            for (int k = 0; k < 16; ++k) bs[k] = key2f(cg[0][k] & ~63u);
            float den = 0.f, ex[16];
#pragma unroll
            for (int k = 0; k < 16; ++k) { ex[k] = __expf(bs[k] - bs[0]); den += ex[k]; }
            const float rden = 1.0f / den;
            unsigned ib = (unsigned)(uintptr_t)(IDX + tl * 128 + h * 2), gb2 = (unsigned)(uintptr_t)(GT + tl * 128 + h * 2), lb = (unsigned)(uintptr_t)(LST + j * 16);
            asm volatile("" : "+v"(ib), "+v"(gb2), "+v"(lb));
            LAS int* ip = (LAS int*)(uintptr_t)ib; LAS float* gp = (LAS float*)(uintptr_t)gb2; LAS unsigned* l1 = (LAS unsigned*)(uintptr_t)lb;
#pragma unroll
            for (int k = 0; k < 16; ++k) {
                const int code = CODE[63 - (int)(cg[0][k] & 63u)]; const int a = code >> 4, b = code & 15;
                const int i1 = 127 - (int)(l1[a] & 127u), i2 = 127 - (int)(l1[128 * 16 + b] & 127u);
                ip[(k & 7) * 16 + (k >> 3)] = i1 * 128 + i2;
                gp[(k & 7) * 16 + (k >> 3)] = ex[k] * rden;
            }
        }
        __syncthreads();
        for (int i = F.tid; i < 16 * 128; i += NTHR) { PIDX[(size_t)t0 * 128 + i] = (unsigned short)IDX[i]; PGATE[(size_t)t0 * 128 + i] = GT[i]; }
        __syncthreads();
    }
}

struct PeerBuf { u32x4 g[8]; };
struct PeerMeta { u32x4 id[2]; u32x4 p[2]; unsigned xr; };
template <int CTRL> __device__ __forceinline__ float dpp_f(float v) { return __int_as_float(__builtin_amdgcn_update_dpp(0, __float_as_int(v), CTRL, 0xf, 0xf, true)); }
__device__ __forceinline__ float xor16_f(float v, bool hi16) { auto r = __builtin_amdgcn_permlane16_swap(__float_as_uint(v), __float_as_uint(v), false, false); return __uint_as_float(hi16 ? r[0] : r[1]); }
__device__ __forceinline__ float xor32_f(float v, bool hi32) { auto r = __builtin_amdgcn_permlane32_swap(__float_as_uint(v), __float_as_uint(v), false, false); return __uint_as_float(hi32 ? r[0] : r[1]); }
template <int HALF>
__device__ __forceinline__ void peer_issue(PeerBuf& b, const unsigned char* tab, unsigned lane_off, const PeerMeta& m) {
#pragma unroll
    for (int i = 0; i < 8; ++i) { const int k = HALF * 8 + i; const unsigned w = m.id[k >> 3][(k >> 1) & 3]; const unsigned idx = (k & 1) ? (w >> 16) : (w & 0xffffu); b.g[i] = *(const u32x4*)(tab + (idx * 128u + lane_off)); }
}
__device__ __forceinline__ void peer_u_quant(const PeerMeta& m, int (&xq)[4], float& sx) {
#pragma unroll
    for (int q = 0; q < 4; ++q) xq[q] = (int)m.p[0][q];
    sx = __uint_as_float(m.p[1].x);
}
template <int HALF>
__device__ __forceinline__ void peer_u_compute(const PeerBuf& b, const int (&xq)[4], float sx, _Float16* pdrow, int q8, int eg) {
    int d[8];
#pragma unroll
    for (int i = 0; i < 8; ++i) { int a = 0;
#pragma unroll
        for (int q = 0; q < 4; ++q) a = __builtin_amdgcn_sdot4((int)b.g[i][q], xq[q], a, false);
        d[i] = a; }
    const bool b2 = (q8 & 4) != 0, b1 = (q8 & 2) != 0, b0 = (q8 & 1) != 0;
    int k4[4], k2[2];
#pragma unroll
    for (int k = 0; k < 4; ++k) { const int keep = b2 ? d[4 + k] : d[k], send = b2 ? d[k] : d[4 + k]; k4[k] = keep + __builtin_amdgcn_update_dpp(0, send, 0x141, 0xf, 0xf, true); }
#pragma unroll
    for (int k = 0; k < 2; ++k) { const int keep = b1 ? k4[2 + k] : k4[k], send = b1 ? k4[k] : k4[2 + k]; k2[k] = keep + __builtin_amdgcn_update_dpp(0, send, 0x4E, 0xf, 0xf, true); }
    const int keep = b0 ? k2[1] : k2[0], send = b0 ? k2[0] : k2[1];
    pdrow[eg * 16 + 8 * HALF + q8] = (_Float16)((float)(keep + __builtin_amdgcn_update_dpp(0, send, 0xB1, 0xf, 0xf, true)) * (sx * 0.0625f));
}
template <int HALF>
__device__ __forceinline__ void peer_v_accum(h2_t (&acc)[8], const PeerBuf& b, const PeerMeta& m) {
#pragma unroll
    for (int i = 0; i < 8; ++i) { const int k = HALF * 8 + i; const unsigned ww = m.p[k >> 3][(k >> 1) & 3];
        const unsigned rep = (k & 1) ? ((ww >> 16) | (ww & 0xffff0000u)) : ((ww & 0xffffu) | (ww << 16));
        const h2_t w2 = *(const h2_t*)&rep;
#pragma unroll
        for (int q = 0; q < 4; ++q) { const unsigned w = b.g[i][q];
            const h2_t lo = __builtin_amdgcn_cvt_scalef32_pk_f16_fp8(w, 1.0f, false), hi2 = __builtin_amdgcn_cvt_scalef32_pk_f16_fp8(w, 1.0f, true);
            acc[2 * q] = __builtin_elementwise_fma(w2, lo, acc[2 * q]); acc[2 * q + 1] = __builtin_elementwise_fma(w2, hi2, acc[2 * q + 1]); } }
}
__device__ __forceinline__ void peer_v_finish(h2_t (&acch)[8], bf16_t* xrow, const unsigned xr, const f32x2 gf, int q8, int eg) {
    float acc[16];
#pragma unroll
    for (int q = 0; q < 8; ++q) { acc[2 * q] = (float)acch[q].x; acc[2 * q + 1] = (float)acch[q].y; acch[q] = (h2_t){(_Float16)0.f, (_Float16)0.f}; }
    const bool c0 = (eg & 1) != 0, c1 = (eg & 2) != 0, c2 = (eg & 4) != 0;
    float k8[8], k4[4], k2[2];
#pragma unroll
    for (int k = 0; k < 8; ++k) { const float keep = c0 ? acc[8 + k] : acc[k], send = c0 ? acc[k] : acc[8 + k]; k8[k] = keep + dpp_f<0x128>(send); }
#pragma unroll
    for (int k = 0; k < 4; ++k) { const float keep = c1 ? k8[4 + k] : k8[k], send = c1 ? k8[k] : k8[4 + k]; k4[k] = keep + xor16_f(send, c1); }
#pragma unroll
    for (int k = 0; k < 2; ++k) { const float keep = c2 ? k4[2 + k] : k4[k], send = c2 ? k4[k] : k4[2 + k]; k2[k] = keep + xor32_f(send, c2); }
    const int dim = q8 * 16 + (c0 ? 8 : 0) + (c1 ? 4 : 0) + (c2 ? 2 : 0);
    *(unsigned*)(xrow + dim) = pk_bf16(bf_lo(xr) + gf.x * (k2[0] * (1.0f / 1024.0f)), bf_hi(xr) + gf.y * (k2[1] * (1.0f / 1024.0f)));
}
template <int MODE>
__device__ __forceinline__ void peer_sliced(const Fr& F, const unsigned char* TAB, const unsigned short* PIDX, const unsigned char* H8, const float* SA, const _Float16* PW, _Float16* PD, bf16_t* XR, const float* gate_f) {
    const bool hw = F.xcc_ok != 0, al = (F.G & 7) == 0;
    const int nr = hw ? F.xcc_n : (al ? (F.G >> 3) : F.G), r = hw ? F.xcc_rank : (al ? (F.bid >> 3) : F.bid);
    const int xs_lo = hw ? F.xcc : (al ? (F.bid & 7) : 0), xs_hi = (hw || al) ? xs_lo + 1 : 8;
    const int q8 = F.lane & 7, eg = F.lane >> 3;
    const int stride = nr * 8, tfirst = r + nr * F.wave;
    const int ntok = tfirst < SEQ ? (SEQ - tfirst + stride - 1) / stride : 0;
    for (int xs = xs_lo; xs < xs_hi; ++xs)
        for (int ps = 0; ps < 2; ++ps) {
            const int s = xs * 2 + ps;
            const unsigned lane_off = (unsigned)(s * 2097152 + q8 * 16);
            PeerBuf b0, b1, b2; PeerMeta m0, m1, m2; h2_t acc[8];
            const int vdim = q8 * 16 + ((eg & 1) ? 8 : 0) + ((eg & 2) ? 4 : 0) + ((eg & 4) ? 2 : 0);
            const f32x2 gfv = (MODE == 1) ? *(const f32x2*)(gate_f + s * 128 + vdim) : (f32x2){0.f, 0.f};
#pragma unroll
            for (int q = 0; q < 8; ++q) acc[q] = (h2_t){(_Float16)0.f, (_Float16)0.f};
#define PEER_META(m, t) do { const u32x4* ip_ = (const u32x4*)(PIDX + (size_t)(t) * 128 + eg * 16); (m).id[0] = ip_[0]; (m).id[1] = ip_[1]; \
    if (MODE == 0) { (m).p[0] = *(const u32x4*)(H8 + (size_t)(t) * 2048 + s * 128 + q8 * 16); (m).p[1].x = __float_as_uint(SA[(t)]); } \
    else { const u32x4* wp_ = (const u32x4*)(PW + (size_t)(t) * 128 + eg * 16); (m).p[0] = wp_[0]; (m).p[1] = wp_[1]; \
           (m).xr = *(const unsigned*)(XR + (size_t)(t) * DM + s * 128 + vdim); } } while (0)
#define PEER_TRIP(mc, mn, ml, bx, by, bz, kk, C2, C1) do { const int t = tfirst + (kk) * stride; int xq_[4] = {0, 0, 0, 0}; float sx_ = 0.f; \
                if (C2) PEER_META(ml, t + 2 * stride); \
                if (C1) peer_issue<0>(bz, TAB, lane_off, mn); \
                if (MODE == 0) { peer_u_quant(mc, xq_, sx_); peer_u_compute<0>(bx, xq_, sx_, PD + ((size_t)s * SEQ + t) * 128, q8, eg); } else peer_v_accum<0>(acc, bx, mc); \
                if (C1) peer_issue<1>(bx, TAB, lane_off, mn); \
                if (MODE == 0) peer_u_compute<1>(by, xq_, sx_, PD + ((size_t)s * SEQ + t) * 128, q8, eg); \
                else { peer_v_accum<1>(acc, by, mc); peer_v_finish(acc, XR + (size_t)t * DM + s * 128, (mc).xr, gfv, q8, eg); } } while (0)
            int k = 0;
            if (ntok >= 5) {
                PEER_META(m0, tfirst); PEER_META(m1, tfirst + stride);
                peer_issue<0>(b0, TAB, lane_off, m0); peer_issue<1>(b1, TAB, lane_off, m0);
                for (; k + 4 < ntok; k += 3) {
                    PEER_TRIP(m0, m1, m2, b0, b1, b2, k, true, true);
                    PEER_TRIP(m1, m2, m0, b2, b0, b1, k + 1, true, true);
                    PEER_TRIP(m2, m0, m1, b1, b2, b0, k + 2, true, true);
                }
            } else if (ntok > 0) {
                PEER_META(m0, tfirst);
                if (ntok > 1) PEER_META(m1, tfirst + stride);
                peer_issue<0>(b0, TAB, lane_off, m0); peer_issue<1>(b1, TAB, lane_off, m0);
            }
            for (; k < ntok; k += 3) {
                PEER_TRIP(m0, m1, m2, b0, b1, b2, k, (k + 2 < ntok), (k + 1 < ntok));
                if (k + 1 < ntok) PEER_TRIP(m1, m2, m0, b2, b0, b1, k + 1, (k + 3 < ntok), (k + 2 < ntok));
                if (k + 2 < ntok) PEER_TRIP(m2, m0, m1, b1, b2, b0, k + 2, (k + 4 < ntok), (k + 3 < ntok));
            }
#undef PEER_TRIP
#undef PEER_META
        }
}
__device__ __forceinline__ void peer_weights(const Fr& F, const _Float16* PD, const unsigned short* PIDX, const float* PGATE, const float* SU, const float* SV, _Float16* PW) {
    typedef _Float16 h4_t __attribute__((ext_vector_type(4)));
    const int step = F.G * NTHR, total = SEQ * 32;
    for (int it0 = F.bid * NTHR + F.tid; it0 < total; it0 += 2 * step) {
        const bool two = it0 + step < total;
        const size_t o[2] = {(size_t)it0 * 4, (size_t)(two ? it0 + step : it0) * 4};
        h4_t h[2][16]; u32x2 iw[2]; f32x4 g[2];
#pragma unroll
        for (int k = 0; k < 2; ++k) {
#pragma unroll
            for (int s = 0; s < 16; ++s) h[k][s] = *(const h4_t*)(PD + (size_t)s * SEQ * 128 + o[k]);
            iw[k] = *(const u32x2*)(PIDX + o[k]); g[k] = *(const f32x4*)(PGATE + o[k]); }
        float su[2][4], sv[2][4];
#pragma unroll
        for (int k = 0; k < 2; ++k) { const unsigned idx[4] = {iw[k].x & 0xffffu, iw[k].x >> 16, iw[k].y & 0xffffu, iw[k].y >> 16};
#pragma unroll
            for (int e = 0; e < 4; ++e) { su[k][e] = SU[idx[e]]; sv[k][e] = SV[idx[e]]; } }
#pragma unroll
        for (int k = 0; k < 2; ++k) {
            if (k == 1 && !two) break;
            f32x4 a = {0.f, 0.f, 0.f, 0.f};
#pragma unroll
            for (int s = 0; s < 16; ++s) a += (f32x4){(float)h[k][s][0], (float)h[k][s][1], (float)h[k][s][2], (float)h[k][s][3]};
            h4_t w;
#pragma unroll
            for (int e = 0; e < 4; ++e) w[e] = (_Float16)(g[k][e] * gelu_tanh(a[e] * (16.0f * su[k][e])) * sv[k][e] * 1024.0f);
            *(h4_t*)(PW + o[k]) = w;
        }
    }
}
__device__ __forceinline__ void final_norm_rows(const Fr& F, const bf16_t* X, const float* g, float* out) {
    f32x4 cs[8];
#pragma unroll
    for (int i = 0; i < 4; ++i) { cs[2 * i] = *(const f32x4*)(g + i * 512 + F.lane * 8); cs[2 * i + 1] = *(const f32x4*)(g + i * 512 + F.lane * 8 + 4); }
    for (int row0 = (F.bid * 8 + F.wave) * 2; row0 < SEQ; row0 += F.G * 16) {
        u32x4 w[2][4];
#pragma unroll
        for (int rr = 0; rr < 2; ++rr)
#pragma unroll
            for (int i = 0; i < 4; ++i) w[rr][i] = *(const u32x4*)(X + (size_t)(row0 + rr) * DM + i * 512 + F.lane * 8);
#pragma unroll
        for (int rr = 0; rr < 2; ++rr) {
            f32x4 v[8]; float ss = 0.f;
#pragma unroll
            for (int i = 0; i < 4; ++i) { v[2 * i] = (f32x4){bf_lo(w[rr][i].x), bf_hi(w[rr][i].x), bf_lo(w[rr][i].y), bf_hi(w[rr][i].y)}; v[2 * i + 1] = (f32x4){bf_lo(w[rr][i].z), bf_hi(w[rr][i].z), bf_lo(w[rr][i].w), bf_hi(w[rr][i].w)}; }
#pragma unroll
            for (int i = 0; i < 8; ++i) ss += v[i][0] * v[i][0] + v[i][1] * v[i][1] + v[i][2] * v[i][2] + v[i][3] * v[i][3];
            ss = wave_sum(ss);
            const float rstd = rsqrtf(ss * (1.0f / DM) + 1e-6f);
#pragma unroll
            for (int i = 0; i < 4; ++i) { float* op = out + (size_t)(row0 + rr) * DM + i * 512 + F.lane * 8; *(f32x4*)op = v[2 * i] * rstd * cs[2 * i]; *(f32x4*)(op + 4) = v[2 * i + 1] * rstd * cs[2 * i + 1]; }
        }
    }
}

__device__ __forceinline__ void gmlp_phase(const Fr& F, const bf16_t* PB, const bf16_t* GMWS, bf16_t* YCAT) {
    const float* gng = F.in[I_GMNG1]; const float* gmb = F.in[I_GMB1];
    LAS float* rstd_s = (LAS float*)F.lds;
    LAS bf16_t* VT = (LAS bf16_t*)(F.lds + 1024);
    LAS bf16_t* AT = (LAS bf16_t*)(F.lds + 1024 + 128 * 136 * 2);
    LAS float* ST = (LAS float*)(F.lds + 1024 + 2 * 128 * 136 * 2);
    for (int unit = F.bid; unit < 256; unit += F.G) {
        const int n = unit >> 1, gh = unit & 1, pos0 = n * 128;
        __syncthreads();
#pragma unroll 1
        for (int r0 = F.wave * 16; r0 < F.wave * 16 + 16; r0 += 8) {
            u32x4 a[8], b[8];
#pragma unroll
            for (int q = 0; q < 8; ++q) { const bf16_t* pr = PB + (size_t)(pos0 + r0 + q) * 5120 + 1024 + F.lane * 16; a[q] = *(const u32x4*)pr; b[q] = *(const u32x4*)(pr + 8); }
#pragma unroll
            for (int q = 0; q < 8; ++q) {
                float ss = 0.f;
#pragma unroll
                for (int e = 0; e < 4; ++e) { ss += bf_lo(a[q][e]) * bf_lo(a[q][e]) + bf_hi(a[q][e]) * bf_hi(a[q][e]) + bf_lo(b[q][e]) * bf_lo(b[q][e]) + bf_hi(b[q][e]) * bf_hi(b[q][e]); }
                ss = wave_sum(ss);
                if (F.lane == 0) rstd_s[r0 + q] = rsqrtf(ss * (1.0f / 1024.0f) + 1e-6f);
            }
        }
        __syncthreads();
        for (int g = gh * 4; g < gh * 4 + 4; ++g) {
            { u32x4 a4[4];
#pragma unroll
              for (int k = 0; k < 4; ++k) { const int ch = F.tid + k * NTHR, p = ch >> 4, q8 = (ch & 15) * 8; a4[k] = *(const u32x4*)(GMWS + (size_t)g * 16384 + p * 128 + q8); }
#pragma unroll
              for (int k = 0; k < 4; ++k) { const int ch = F.tid + k * NTHR, p = ch >> 4, q8 = (ch & 15) * 8; *(LAS u32x4*)(AT + p * 136 + q8) = a4[k]; } }
            { const int q = F.tid >> 2, cp = (F.tid & 3) * 32; const float rs = rstd_s[q];
              const bf16_t* pr = PB + (size_t)(pos0 + q) * 5120 + 1024 + g * 128 + cp;
              u32x4 w4[4]; f32x4 gg[8];
#pragma unroll
              for (int i = 0; i < 4; ++i) { w4[i] = *(const u32x4*)(pr + i * 8); gg[2 * i] = *(const f32x4*)(gng + g * 128 + cp + i * 8); gg[2 * i + 1] = *(const f32x4*)(gng + g * 128 + cp + i * 8 + 4); }
#pragma unroll
              for (int i = 0; i < 4; ++i) { const u32x4 w = w4[i];
                  const float v[8] = {bf_lo(w.x), bf_hi(w.x), bf_lo(w.y), bf_hi(w.y), bf_lo(w.z), bf_hi(w.z), bf_lo(w.w), bf_hi(w.w)};
#pragma unroll
                  for (int e = 0; e < 8; ++e) { const int c = cp + i * 8 + e; VT[c * 136 + q] = f2bf(v[e] * rs * gg[2 * i + (e >> 2)][e & 3]); } } }
            __syncthreads();
            { const int pb = F.wave >> 1, cb0 = (F.wave & 1) * 2, r32 = F.lane & 31, hi = F.lane >> 5;
#pragma unroll
              for (int cbi = 0; cbi < 2; ++cbi) { const int cb = cb0 + cbi; f32x16 acc = {};
#pragma unroll
                  for (int k = 0; k < 8; ++k) { const bf16x8 a = *(const LAS bf16x8*)(AT + (pb * 32 + r32) * 136 + k * 16 + hi * 8), b = *(const LAS bf16x8*)(VT + (cb * 32 + r32) * 136 + k * 16 + hi * 8);
                      acc = __builtin_amdgcn_mfma_f32_32x32x16_bf16(a, b, acc, 0, 0, 0); }
#pragma unroll
                  for (int rr = 0; rr < 16; ++rr) { const int p = pb * 32 + crow32(rr, hi); ST[p * 132 + cb * 32 + r32] = acc[rr] + gmb[g * 128 + p]; } } }
            __syncthreads();
            u32x4 u4[4];
#pragma unroll
            for (int k = 0; k < 4; ++k) { const int ch = F.tid + k * NTHR, p = ch >> 4, c8 = (ch & 15) * 8; u4[k] = *(const u32x4*)(PB + (size_t)(pos0 + p) * 5120 + g * 128 + c8); }
#pragma unroll
            for (int k = 0; k < 4; ++k) { const int ch = F.tid + k * NTHR; const int p = ch >> 4, c8 = (ch & 15) * 8; const size_t pos = (size_t)(pos0 + p);
                const f32x4 s0 = *(const LAS f32x4*)(ST + p * 132 + c8), s1 = *(const LAS f32x4*)(ST + p * 132 + c8 + 4);
                const u32x4 uu = u4[k];
                u32x4 y; y.x = pk_bf16(bf_lo(uu.x) * s0[0], bf_hi(uu.x) * s0[1]); y.y = pk_bf16(bf_lo(uu.y) * s0[2], bf_hi(uu.y) * s0[3]);
                y.z = pk_bf16(bf_lo(uu.z) * s1[0], bf_hi(uu.z) * s1[1]); y.w = pk_bf16(bf_lo(uu.w) * s1[2], bf_hi(uu.w) * s1[3]);
                *(u32x4*)(YCAT + pos * 2048 + g * 128 + c8) = y; }
        }
    }
}
__device__ __forceinline__ void hyena_pre(const Fr& F, const bf16_t* PB, unsigned* Z, bf16_t* G1B, bf16_t* X0B) {
    const float* cw = F.in[I_HYCW1]; const float* cb = F.in[I_HYCB1];
    const int cg = F.tid & 127, c0 = cg * 8;
    float w0[3][8], w1[3][8], w2[3][8], bb[3][8];
#pragma unroll
    for (int pt = 0; pt < 3; ++pt)
#pragma unroll
        for (int e = 0; e < 8; ++e) { const int c = pt * 1024 + c0 + e; w0[pt][e] = cw[c]; w1[pt][e] = cw[3072 + c]; w2[pt][e] = cw[6144 + c]; bb[pt][e] = cb[c]; }
    for (int t = F.bid * 4 + (F.tid >> 7); t < SEQ; t += F.G * 4) {
        u32x4 r[3][3];
#pragma unroll
        for (int dt = 0; dt < 3; ++dt) { const int tt = t + dt - 1; const bool ok = (tt >= 0) && (tt < SEQ);
#pragma unroll
            for (int pt = 0; pt < 3; ++pt) r[dt][pt] = ok ? *(const u32x4*)(PB + (size_t)tt * 5120 + 2048 + pt * 1024 + c0) : (u32x4){0u, 0u, 0u, 0u}; }
        float xs[3][8];
#pragma unroll
        for (int pt = 0; pt < 3; ++pt)
#pragma unroll
            for (int q = 0; q < 4; ++q) {
                xs[pt][2 * q] = w0[pt][2 * q] * bf_lo(r[0][pt][q]) + w1[pt][2 * q] * bf_lo(r[1][pt][q]) + w2[pt][2 * q] * bf_lo(r[2][pt][q]) + bb[pt][2 * q];
                xs[pt][2 * q + 1] = w0[pt][2 * q + 1] * bf_hi(r[0][pt][q]) + w1[pt][2 * q + 1] * bf_hi(r[1][pt][q]) + w2[pt][2 * q + 1] * bf_hi(r[2][pt][q]) + bb[pt][2 * q + 1];
            }
        float g1[8];
#pragma unroll
        for (int e = 0; e < 8; ++e) g1[e] = xs[1][e] * xs[2][e];
        *(u32x4*)(Z + (size_t)t * ZP + (c0 >> 1)) = (u32x4){pk_h2((f32x2){g1[0] * 0.125f, g1[1] * 0.125f}), pk_h2((f32x2){g1[2] * 0.125f, g1[3] * 0.125f}),
                                                              pk_h2((f32x2){g1[4] * 0.125f, g1[5] * 0.125f}), pk_h2((f32x2){g1[6] * 0.125f, g1[7] * 0.125f})};
        *(u32x4*)(G1B + (size_t)t * 1024 + c0) = (u32x4){pk_bf16(g1[0], g1[1]), pk_bf16(g1[2], g1[3]), pk_bf16(g1[4], g1[5]), pk_bf16(g1[6], g1[7])};
        *(u32x4*)(X0B + (size_t)t * 1024 + c0) = (u32x4){pk_bf16(xs[0][0], xs[0][1]), pk_bf16(xs[0][2], xs[0][3]), pk_bf16(xs[0][4], xs[0][5]), pk_bf16(xs[0][6], xs[0][7])};
    }
}

__device__ __forceinline__ f32x2 cmul(f32x2 a, f32x2 b) { return (f32x2){a.x * b.x - a.y * b.y, a.x * b.y + a.y * b.x}; }
template <bool INV>
__device__ __forceinline__ void fft32(f32x2 (&v)[32]) {
    constexpr float CS[16] = {1.0f, 0.98078528040323043f, 0.92387953251128674f, 0.83146961230254524f, 0.70710678118654752f, 0.55557023301960218f, 0.38268343236508977f, 0.19509032201612825f,
                              0.0f, -0.19509032201612825f, -0.38268343236508977f, -0.55557023301960218f, -0.70710678118654752f, -0.83146961230254524f, -0.92387953251128674f, -0.98078528040323043f};
    constexpr float SN[16] = {0.0f, 0.19509032201612825f, 0.38268343236508977f, 0.55557023301960218f, 0.70710678118654752f, 0.83146961230254524f, 0.92387953251128674f, 0.98078528040323043f,
                              1.0f, 0.98078528040323043f, 0.92387953251128674f, 0.83146961230254524f, 0.70710678118654752f, 0.55557023301960218f, 0.38268343236508977f, 0.19509032201612825f};
#pragma unroll
    for (int s = 0; s < 5; ++s) {
        const int half = 16 >> s;
#pragma unroll
        for (int i = 0; i < 32; ++i) {
            if ((i & half) == 0) {
                const int j = i | half, tw = (i & (half - 1)) << s;
                const f32x2 a = v[i], b = v[j];
                v[i] = a + b;
                const f32x2 d = a - b;
                const float c = CS[tw], sn = INV ? SN[tw] : -SN[tw];
                v[j] = (f32x2){d.x * c - d.y * sn, d.x * sn + d.y * c};
            }
        }
    }
}
__host__ __device__ constexpr int brev5(int k) { return ((k & 1) << 4) | ((k & 2) << 2) | (k & 4) | ((k & 8) >> 2) | ((k & 16) >> 4); }

template <int MP, bool INV, int MODE>
__device__ __forceinline__ void fft_pass(const Fr& F, const unsigned* Zs, unsigned* Zb, const bf16_t* G1B, const bf16_t* X0B, const float* hbias, bf16_t* YCAT) {
    constexpr int S = 32 * MP, NIT = 1024 * 512;
    const int step = F.G * NTHR;
    int it = F.bid * NTHR + F.tid;
    unsigned raw[32];
#define FFT_LOAD(itx) do { const int cp_ = (itx) & 511, j_ = (itx) >> 9, nl_ = j_ % MP, sb_ = j_ / MP; const size_t b_ = ((size_t)sb_ * S + nl_) * ZP + cp_; \
        _Pragma("unroll") for (int m = 0; m < 32; ++m) raw[m] = (MODE == 1 && m >= 16) ? 0u : Zs[b_ + (size_t)m * MP * ZP]; } while (0)
    if (it < NIT) FFT_LOAD(it);
    for (; it < NIT; it += step) {
        const int cp = it & 511, j = it >> 9, n_lo = j % MP, sblk = j / MP;
        const size_t base = ((size_t)sblk * S + n_lo) * ZP + cp;
        f32x2 v[32];
#pragma unroll
        for (int m = 0; m < 32; ++m) v[m] = un_h2(raw[m]);
        if (it + step < NIT) FFT_LOAD(it + step);
        if (!INV) {
            fft32<false>(v);
#pragma unroll
            for (int k = 0; k < 32; ++k) {
                f32x2 o = v[brev5(k)];
                if (MP > 1 && k > 0) { const float fr = (float)(n_lo * k) * (1.0f / (float)S); const f32x2 w = {__builtin_amdgcn_cosf(fr), -__builtin_amdgcn_sinf(fr)}; o = cmul(o, w); }
                Zb[base + (size_t)k * MP * ZP] = pk_h2(o);
            }
        } else {
            if (MP > 1) {
#pragma unroll
                for (int k = 1; k < 32; ++k) { const float fr = (float)(n_lo * k) * (1.0f / (float)S); const f32x2 w = {__builtin_amdgcn_cosf(fr), __builtin_amdgcn_sinf(fr)}; v[k] = cmul(v[k], w); }
            }
            fft32<true>(v);
#pragma unroll
            for (int m = 0; m < 32; ++m) {
                const f32x2 o = v[brev5(m)];
                if (MODE != 2) Zb[base + (size_t)m * MP * ZP] = pk_h2(o);
                else if (m < 16) {
                    const int nrow = sblk * S + n_lo + m * MP;
                    const unsigned g1w = *(const unsigned*)(G1B + (size_t)nrow * 1024 + cp * 2), x0w = *(const unsigned*)(X0B + (size_t)nrow * 1024 + cp * 2);
                    const f32x2 hb = *(const f32x2*)(hbias + cp * 2);
                    const float ya = bf_lo(x0w) * (o.x * (1.0f / 128.0f) + hb.x * bf_lo(g1w)), yb = bf_hi(x0w) * (o.y * (1.0f / 128.0f) + hb.y * bf_hi(g1w));
                    *(unsigned*)(YCAT + (size_t)nrow * 2048 + 1024 + cp * 2) = pk_bf16(ya, yb);
                }
            }
        }
    }
#undef FFT_LOAD
}
__device__ __forceinline__ int fft_pos(int k) { return ((k & 31) << 10) | (((k >> 5) & 31) << 5) | (k >> 10); }
__device__ __forceinline__ void fft_pointwise(const Fr& F, unsigned* Zb, const unsigned* Kb, const float* FNORM) {
    constexpr int N = 32768, NIT = (N / 2 + 1) * 512;
    const int step = F.G * NTHR;
    for (int it0 = F.bid * NTHR + F.tid; it0 < NIT; it0 += 4 * step) {
        unsigned z1[4], z2[4], q1[4], q2[4]; size_t p1[4], p2[4]; bool ok[4], two[4];
#pragma unroll
        for (int u = 0; u < 4; ++u) { const int it = it0 + u * step; ok[u] = it < NIT; const int itc = ok[u] ? it : it0;
            const int cp = itc & 511, k = itc >> 9, k2 = (N - k) & (N - 1);
            p1[u] = (size_t)fft_pos(k) * ZP + cp; p2[u] = (size_t)fft_pos(k2) * ZP + cp; two[u] = (k2 != k);
            z1[u] = Zb[p1[u]]; z2[u] = Zb[p2[u]]; q1[u] = Kb[p1[u]]; q2[u] = Kb[p2[u]]; }
        const int cp = it0 & 511;
        const float na = FNORM[cp * 2] * (0.25f * 8.0f / 256.0f), nb = FNORM[cp * 2 + 1] * (0.25f * 8.0f / 256.0f);
#pragma unroll
        for (int u = 0; u < 4; ++u) {
            if (!ok[u]) continue;
            const f32x2 a1 = un_h2(z1[u]), a2 = un_h2(z2[u]), b1 = un_h2(q1[u]), b2 = un_h2(q2[u]);
            const f32x2 ga = {a1.x + a2.x, a1.y - a2.y}, gb = {a1.y + a2.y, -(a1.x - a2.x)};
            const f32x2 ka = {(b1.x + b2.x) * na, (b1.y - b2.y) * na}, kb = {(b1.y + b2.y) * nb, -(b1.x - b2.x) * nb};
            const f32x2 ya = cmul(ga, ka), yb = cmul(gb, kb);
            Zb[p1[u]] = pk_h2((f32x2){ya.x - yb.y, ya.y + yb.x});
            if (two[u]) Zb[p2[u]] = pk_h2((f32x2){ya.x + yb.y, -ya.y + yb.x});
        }
    }
}

#ifndef MK_PER_PHASE
#define MK_PER_PHASE 0
#endif
enum { PH_PRO = 0, PH_NORM0, PH_IN0, PH_POST0, PH_UP0, PH_KQ, PH_ATT, PH_QY0, PH_OUT0, PH_PNORM0, PH_PQ0, PH_SEL0, PH_U0, PH_W0, PH_V0, PH_N1,
       PH_IN1, PH_POST1, PH_F1, PH_F2, PH_F3, PH_PWISE, PH_I1, PH_I2, PH_I3, PH_QY1, PH_OUT1, PH_PNORM1, PH_PQ1, PH_SEL1, PH_U1, PH_W1, PH_V1, PH_FIN, NPH };
#ifndef PROBE_SEQ
#define PROBE_SEQ 0
#endif

__global__ void __launch_bounds__(NTHR, 2) mk_fwd(Params P) {
    extern __shared__ __attribute__((aligned(16))) unsigned char lds_raw[];
    Fr F;
    F.in = P.in; F.out = P.out; F.ws = P.ws; F.lds = (LAS unsigned char*)lds_raw;
    F.tid = threadIdx.x; F.lane = F.tid & 63; F.wave = __builtin_amdgcn_readfirstlane(F.tid >> 6); F.G = gridDim.x; F.bid = blockIdx.x;
    unsigned char* ws = P.ws;
    const int lo = P.ph_lo, hi = P.ph_hi;
    volatile LAS unsigned* xbw = (volatile LAS unsigned*)(F.lds + LDS_CTL);
    if (F.tid < 4) xbw[F.tid] = 0u;
    __syncthreads();
    XcdBarrier bar; bar.bar = (unsigned*)(ws + WS_CTL); bar.x = 0; bar.st = xbw;
    if (hi - lo > 1) bar = xcd_barrier_post((unsigned*)(ws + WS_CTL), xbw);
    if (F.tid == 0) { const unsigned x = xb_xcc_id(); xbw[2] = x; xbw[3] = (hi - lo > 1) ? xb_add((unsigned*)(ws + WS_CTL) + 8192 + 64 * x, 1u) : 0u; }
    __syncthreads();
    F.xcc = (int)xbw[2]; F.xcc_rank = (int)xbw[3]; F.xcc_n = 0; F.xcc_ok = 0;
#define XCC_REFRESH() do { const unsigned nl_ = xbw[0], nx_ = xbw[1]; F.xcc_n = (int)nl_; F.xcc_ok = (hi - lo > 1) && nx_ == 8u && nl_ > 0u && F.xcc < 8 && F.xcc_rank < (int)nl_; } while (0)
#ifdef ONLY_PHASE
#define IN(k) ((k) == ONLY_PHASE && lo <= (k) && (k) < hi)
#else
#define IN(k) (lo <= (k) && (k) < hi)
#endif
#define SEAM(k) do { if (IN(k) && IN((k) + 1)) xcd_barrier(bar); } while (0)

    float* MOD0 = (float*)(ws + WS_MOD0); float* MOD1 = (float*)(ws + WS_MOD1); float* MC0 = (float*)(ws + WS_MC0);
    float* ROPEC = (float*)(ws + WS_ROPEC); float* ROPES = (float*)(ws + WS_ROPES);
    float* FPART = (float*)(ws + WS_FPART); float* FNORM = (float*)(ws + WS_FNORM);
    bf16_t* KEYS0 = (bf16_t*)(ws + WS_KEYS0); bf16_t* KEYS1 = (bf16_t*)(ws + WS_KEYS1); bf16_t* GMWS = (bf16_t*)(ws + WS_GMWS);
    bf16_t* WIN0 = (bf16_t*)(ws + WS_WIN0); bf16_t* WUQ = (bf16_t*)(ws + WS_WUQ); bf16_t* WUKV = (bf16_t*)(ws + WS_WUKV);
    bf16_t* WOUT0 = (bf16_t*)(ws + WS_WOUT0); bf16_t* WPQ0 = (bf16_t*)(ws + WS_WPQ0);
    bf16_t* WIN1 = (bf16_t*)(ws + WS_WIN1); bf16_t* WOUT1 = (bf16_t*)(ws + WS_WOUT1); bf16_t* WPQ1 = (bf16_t*)(ws + WS_WPQ1);
    unsigned char* TABU = ws + WS_TABU; unsigned char* TABV = ws + WS_TABV; float* TSC = (float*)(ws + WS_TSC);
    float* SA = (float*)(ws + WS_SA); float* SW = (float*)(ws + WS_SW); unsigned char* H8 = ws + WS_H;
    bf16_t* XR = (bf16_t*)(ws + WS_XR); bf16_t* H = (bf16_t*)(ws + WS_H); bf16_t* PBUF = (bf16_t*)(ws + WS_PBUF);
    bf16_t* QN = (bf16_t*)(ws + WS_QN); bf16_t* KVN = (bf16_t*)(ws + WS_KVN); bf16_t* KROPE = (bf16_t*)(ws + WS_KROPE);
    bf16_t* Q = (bf16_t*)(ws + WS_Q); bf16_t* KV = (bf16_t*)(ws + WS_KV); bf16_t* YCAT = (bf16_t*)(ws + WS_YCAT);
    unsigned* Z = (unsigned*)(ws + WS_Z); unsigned* KZ = (unsigned*)(ws + WS_KZ); unsigned* KZ2 = (unsigned*)(ws + WS_KZ2);
    bf16_t* G1B = (bf16_t*)(ws + WS_G1B); bf16_t* X0B = (bf16_t*)(ws + WS_X0B);
    bf16_t* PQ = PBUF;
    unsigned short* PIDX = (unsigned short*)(ws + WS_YCAT); float* PGATE = (float*)(ws + WS_YCAT + 8388608); _Float16* PW = (_Float16*)(ws + WS_YCAT + 16777216);
    _Float16* PD = (_Float16*)(ws + WS_L0X);

    if (IN(PH_PRO)) {
        const int fl = P.flags;
        if (!(fl & 2)) {
        modgemv(F, P.in[I_C], P.in[I_CCTX], P.in[I_WMOD0], P.in[I_BMOD0], MOD0, MC0, 4096);
        }
        if (!(fl & 4)) {
        colmax_task(F, P.in[I_WIN0], 2048, 3904, 4096, SW);
        tconv_task(F, P.in[I_WUQ0], 512, 1536, 1536, WUQ);
        tconv_task(F, P.in[I_WUKV0], 256, 2048, 2048, WUKV);
        }
        if (!(fl & 16)) {
        cvt_task(F, P.in[I_PKEYS0], KEYS0, 32768 / 8);
        cvt_task(F, P.in[I_PKEYS1], KEYS1, 32768 / 8);
        cvt_task(F, P.in[I_GMWS1], GMWS, 131072 / 8);
        rope_tables(F, ROPEC, ROPES);
        hyena_filter_gen(F, KZ, FPART);
        }
        if (!(fl & 8)) {
        }
    }
    SEAM(PH_PRO);
    if (IN(PH_NORM0)) {
        tconv_q_task(F, P.in[I_WIN0], 2048, 3904, 4096, SW, (unsigned char*)WIN0);
        norm_rows<true>(F, P.in[I_X], SEQ, P.in[I_LN1G0], MOD0 + 2048, MOD0, nullptr, H8, SA);
        norm_rows<true>(F, P.in[I_CTX], CTXL, P.in[I_LN1G0], MC0 + 2048, MC0, nullptr, H8 + (size_t)SEQ * 2048, SA + SEQ);
        hyena_filter_norm(F, FPART, FNORM);
        fft_pass<1024, false, 0>(F, KZ, KZ2, nullptr, nullptr, nullptr, nullptr);
    }
    SEAM(PH_NORM0);
    if (IN(PH_IN0)) {
        pg8::Gemm g{(const bf16_t*)H8, (const bf16_t*)WIN0, SEQ, 4096, 1024}; OrderIn0 S; S.init2(F.G, F.bid);
        EpiI8G E{PBUF, 4096, 0, SA, SW};
        pg8::gemm_phase<EpiI8G, OrderIn0, false>(F.lds, g, S, E, nullptr);
        const bool sh = F.G > 2;
        if (!sh || F.bid >= 2) {
            Fr F2 = F; if (sh) { F2.bid -= 2; F2.G -= 2; }
            __syncthreads();
            colmax_task(F2, P.in[I_WIN1], 2048, 5120, 5120, SW + 6144);
            colmax_task(F2, P.in[I_WOUT1], 2048, 2048, 2048, SW + 15360);
            colmax_task(F2, P.in[I_WOUT0], 2048, 2048, 2048, SW + 13312);
            colmax_task(F2, P.in[I_PWQ1], 2048, 2048, 2048, SW + 11264);
            colmax_task(F2, P.in[I_PWQ0], 2048, 2048, 2048, SW + 4096);
            cvt_table<false>(F2, P.in[I_PU1], TABU + (size_t)33554432, TSC + 32768);
        }
    }
    SEAM(PH_IN0);
    if (IN(PH_POST0)) {
        l0_post_proj(F, PBUF, QN, KVN, KROPE, YCAT, ROPEC, ROPES, NKEY);
        fft_pass<32, false, 0>(F, KZ2, KZ, nullptr, nullptr, nullptr, nullptr);
    }
    SEAM(PH_POST0);
    if (IN(PH_UP0)) {
        { pg8::Gemm g{QN, WUQ, SEQ, 1536, 512}; pg8::StaticOrder S; S.init(SEQ, 1536, F.G, F.bid);
          EpiQRope E{Q, ROPEC, ROPES};
          pg8::gemm_phase<EpiQRope, pg8::StaticOrder, false>(F.lds, g, S, E, nullptr); }
        { pg8::Gemm g{KVN, WUKV, NKEY, 2048, 256}; OrderKV S; S.init(NKEY, 2048, F.G, F.bid);
          EpiBf16G E{KV, 2048, 0};
          pg8::gemm_phase<EpiBf16G, OrderKV, false>(F.lds, g, S, E, nullptr); }
    }
    SEAM(PH_UP0);
    unsigned char* K8N = (unsigned char*)PBUF; unsigned char* K8R = K8N + (size_t)8 * NKEY * 128; float* SKT = (float*)(K8R + (size_t)8 * NKEY * 64);
    if (IN(PH_KQ)) att::kq_phase(F, KV, KROPE, K8N, K8R, SKT, NKEY);
    SEAM(PH_KQ);
    if (IN(PH_ATT)) {
        const int nu = F.bid < 512 ? (512 - F.bid + F.G - 1) / F.G : 0;
        const int grp = (F.bid >> 3) % 3, slot = grp < nu ? grp : nu;
        for (int i = 0; i <= nu; ++i) {
            if (i == slot) {
                Fr F3 = F;
                asm volatile("" : "+v"(F3.tid), "+v"(F3.lane));
                asm volatile("" : "+s"(F3.bid), "+s"(F3.wave), "+s"(F3.G));
                tconv_q_task(F3, P.in[I_WOUT0], 2048, 2048, 2048, SW + 13312, (unsigned char*)WOUT0);
                tconv_q_task(F3, P.in[I_WOUT1], 2048, 2048, 2048, SW + 15360, (unsigned char*)WOUT1);
                tconv_q_task(F3, P.in[I_PWQ0], 2048, 2048, 2048, SW + 4096, (unsigned char*)WPQ0);
                tconv_q_task(F3, P.in[I_PWQ1], 2048, 2048, 2048, SW + 11264, (unsigned char*)WPQ1);
                tconv_q_task(F3, P.in[I_WIN1], 2048, 5120, 5120, SW + 6144, (unsigned char*)WIN1);
                cvt_table<false>(F3, P.in[I_PU0], TABU, TSC);
                cvt_table<true>(F3, P.in[I_PV0], TABV, TSC + 16384);
                cvt_table<true>(F3, P.in[I_PV1], TABV + (size_t)33554432, TSC + 49152);
                modgemv(F3, P.in[I_C], nullptr, P.in[I_WMOD1], P.in[I_BMOD1], MOD1, nullptr, 0);
            }
            if (i < nu) {
                const int u = F.bid + i * F.G, h = u & 7, qb = u >> 3;
                att::attn_body8(Q + (size_t)qb * 256 * 1536 + h * 192, K8N + (size_t)h * NKEY * 128, K8R + (size_t)h * NKEY * 64, SKT + h * (NKEY / 64), KV + h * 256 + 128,
                                YCAT + (size_t)qb * 256 * 2048 + 1024 + h * 128, NKEY, F.lds);
            }
        }
    }
    SEAM(PH_ATT);
    if (IN(PH_QY0)) quant_rows(F, YCAT, H8, SA);
    SEAM(PH_QY0);
    if (IN(PH_OUT0)) {
        pg8::Gemm g{(const bf16_t*)H8, (const bf16_t*)WOUT0, SEQ, 2048, 1024}; pg8::StaticOrder S; S.init(SEQ, 2048, F.G, F.bid);
        EpiResid<true, true> E{P.in[I_X], XR, MOD0 + 4096, SA, SW + 13312};
        pg8::gemm_phase<EpiResid<true, true>, pg8::StaticOrder, false>(F.lds, g, S, E, nullptr);
    }
    SEAM(PH_OUT0);
    if (IN(PH_PNORM0)) {
        norm_rows_b<true>(F, XR, P.in[I_LN2G0], MOD0 + 8192, MOD0 + 6144, nullptr, H8, SA);
        fft_pass<1, false, 0>(F, KZ, KZ2, nullptr, nullptr, nullptr, nullptr);
    }
    SEAM(PH_PNORM0);
    if (IN(PH_PQ0)) {
        pg8::Gemm g{(const bf16_t*)H8, (const bf16_t*)WPQ0, SEQ, 2048, 1024}; pg8::StaticOrder S; S.init(SEQ, 2048, F.G, F.bid);
        EpiI8G E{PQ, 2048, 0, SA, SW + 4096};
        pg8::gemm_phase<EpiI8G, pg8::StaticOrder, false>(F.lds, g, S, E, nullptr);
    }
    SEAM(PH_PQ0);
    if (IN(PH_SEL0)) peer_select(F, PQ, KEYS0, PIDX, PGATE);
    SEAM(PH_SEL0);
    XCC_REFRESH();
    if (IN(PH_U0)) peer_sliced<0>(F, TABU, PIDX, H8, SA, nullptr, PD, nullptr, nullptr);
    SEAM(PH_U0);
    if (IN(PH_W0)) peer_weights(F, PD, PIDX, PGATE, TSC, TSC + 16384, PW);
    SEAM(PH_W0);
    XCC_REFRESH();
    if (IN(PH_V0)) peer_sliced<1>(F, TABV, PIDX, nullptr, nullptr, PW, nullptr, XR, (P.flags & 1) ? (const float*)(ws + WS_CTL + 40960) : MOD0 + 10240);
    SEAM(PH_V0);
    if (IN(PH_N1)) norm_rows_b<true>(F, XR, P.in[I_LN1G1], MOD1 + 2048, MOD1, nullptr, H8, SA);
    SEAM(PH_N1);
    if (IN(PH_IN1)) {
        pg8::Gemm g{(const bf16_t*)H8, (const bf16_t*)WIN1, SEQ, 5120, 1024}; pg8::StaticOrder S; S.init(SEQ, 5120, F.G, F.bid);
        EpiI8G E{PBUF, 5120, 2048, SA, SW + 6144};
        pg8::gemm_phase<EpiI8G, pg8::StaticOrder, false>(F.lds, g, S, E, nullptr);
    }
    SEAM(PH_IN1);
    if (IN(PH_POST1)) {
        gmlp_phase(F, PBUF, GMWS, YCAT);
        hyena_pre(F, PBUF, Z, G1B, X0B);
    }
    SEAM(PH_POST1);
    if (IN(PH_F1)) fft_pass<1024, false, 1>(F, Z, Z, nullptr, nullptr, nullptr, nullptr);
    SEAM(PH_F1);
    if (IN(PH_F2)) fft_pass<32, false, 0>(F, Z, Z, nullptr, nullptr, nullptr, nullptr);
    SEAM(PH_F2);
    if (IN(PH_F3)) fft_pass<1, false, 0>(F, Z, Z, nullptr, nullptr, nullptr, nullptr);
    SEAM(PH_F3);
    if (IN(PH_PWISE)) fft_pointwise(F, Z, KZ2, FNORM);
    SEAM(PH_PWISE);
    if (IN(PH_I1)) fft_pass<1, true, 0>(F, Z, Z, nullptr, nullptr, nullptr, nullptr);
    SEAM(PH_I1);
    if (IN(PH_I2)) fft_pass<32, true, 0>(F, Z, Z, nullptr, nullptr, nullptr, nullptr);
    SEAM(PH_I2);
    if (IN(PH_I3)) fft_pass<1024, true, 2>(F, Z, Z, G1B, X0B, P.in[I_HYBIAS1], YCAT);
    SEAM(PH_I3);
    if (IN(PH_QY1)) quant_rows(F, YCAT, H8, SA);
    SEAM(PH_QY1);
    if (IN(PH_OUT1)) {
        pg8::Gemm g{(const bf16_t*)H8, (const bf16_t*)WOUT1, SEQ, 2048, 1024}; pg8::StaticOrder S; S.init(SEQ, 2048, F.G, F.bid);
        EpiResid<false, true> E{XR, XR, MOD1 + 4096, SA, SW + 15360};
        pg8::gemm_phase<EpiResid<false, true>, pg8::StaticOrder, false>(F.lds, g, S, E, nullptr);
    }
    SEAM(PH_OUT1);
    if (IN(PH_PNORM1)) norm_rows_b<true>(F, XR, P.in[I_LN2G1], MOD1 + 8192, MOD1 + 6144, nullptr, H8, SA);
    SEAM(PH_PNORM1);
    if (IN(PH_PQ1)) {
        pg8::Gemm g{(const bf16_t*)H8, (const bf16_t*)WPQ1, SEQ, 2048, 1024}; pg8::StaticOrder S; S.init(SEQ, 2048, F.G, F.bid);
        EpiI8G E{PQ, 2048, 0, SA, SW + 11264};
        pg8::gemm_phase<EpiI8G, pg8::StaticOrder, false>(F.lds, g, S, E, nullptr);
    }
    SEAM(PH_PQ1);
    if (IN(PH_SEL1)) peer_select(F, PQ, KEYS1, PIDX, PGATE);
    SEAM(PH_SEL1);
    XCC_REFRESH();
    if (IN(PH_U1)) peer_sliced<0>(F, TABU + (size_t)33554432, PIDX, H8, SA, nullptr, PD, nullptr, nullptr);
    SEAM(PH_U1);
    if (IN(PH_W1)) peer_weights(F, PD, PIDX, PGATE, TSC + 32768, TSC + 49152, PW);
    SEAM(PH_W1);
    XCC_REFRESH();
    if (IN(PH_V1)) peer_sliced<1>(F, TABV + (size_t)33554432, PIDX, nullptr, nullptr, PW, nullptr, XR, MOD1 + 10240);
    SEAM(PH_V1);
    if (IN(PH_FIN)) final_norm_rows(F, XR, P.in[I_FINALG], P.out);
#undef IN
#undef SEAM
}

#include <cstdio>
extern "C" void kernel_launch(void* const* d_in, const int* in_sizes, int n_in, void* d_out, int out_size, void* d_ws, size_t ws_size, hipStream_t stream) {
    static int grid = 0;
    if (grid == 0) {
        if (n_in != 43 || in_sizes[0] != SEQ * DM || out_size != SEQ * DM || ws_size < WS_END) {
            fprintf(stderr, "kernel_launch: unexpected shapes: n_in %d in0 %d out %d ws %zu (need %zu)\n", n_in, n_in > 0 ? in_sizes[0] : -1, out_size, ws_size, (size_t)WS_END); grid = -1; return; }
        int dev = 0, cus = 0, per_cu = 0;
        if (hipGetDevice(&dev) != hipSuccess || hipDeviceGetAttribute(&cus, hipDeviceAttributeMultiprocessorCount, dev) != hipSuccess) { grid = -1; return; }
        if (hipFuncSetAttribute((const void*)mk_fwd, hipFuncAttributeMaxDynamicSharedMemorySize, LDS_BYTES) != hipSuccess) { fprintf(stderr, "kernel_launch: hipFuncSetAttribute failed\n"); grid = -1; return; }
        if (hipOccupancyMaxActiveBlocksPerMultiprocessor(&per_cu, (const void*)mk_fwd, NTHR, LDS_BYTES) != hipSuccess || per_cu < 1) { fprintf(stderr, "kernel_launch: occupancy query says %d blocks per CU\n", per_cu); (void)hipGetLastError(); grid = -1; return; }
        grid = cus;
    }
    if (grid < 0) return;
    (void)hipMemsetAsync((char*)d_ws + WS_CTL, 0, 65536, stream);
    Params p{};
    for (int i = 0; i < 43; ++i) p.in[i] = (const float*)d_in[i];
    p.out = (float*)d_out; p.ws = (unsigned char*)d_ws;
#if MK_PER_PHASE
    for (int ph = 0; ph < NPH; ++ph) { p.ph_lo = ph; p.ph_hi = ph + 1; hipLaunchKernelGGL(mk_fwd, dim3(grid), dim3(NTHR), LDS_BYTES, stream, p); }
#else
#if PROBE_SEQ == 0
    p.ph_lo = 0; p.ph_hi = NPH;
    hipLaunchKernelGGL(mk_fwd, dim3(grid), dim3(NTHR), LDS_BYTES, stream, p);
#elif PROBE_SEQ == 40
    p.ph_lo = 0; p.ph_hi = NPH;
    hipLaunchKernelGGL(mk_fwd, dim3(grid), dim3(NTHR), LDS_BYTES, stream, p);
    for (int r = 0; r < 6; ++r) for (int ph = PROBE_LO; ph < PROBE_HI; ++ph) { p.ph_lo = ph; p.ph_hi = ph + 1; p.flags = 32; hipLaunchKernelGGL(mk_fwd, dim3(grid), dim3(NTHR), LDS_BYTES, stream, p); }
#elif PROBE_SEQ >= 20
    p.ph_lo = 0; p.ph_hi = NPH;
    hipLaunchKernelGGL(mk_fwd, dim3(grid), dim3(NTHR), LDS_BYTES, stream, p);
    for (int r = 0; r < 8; ++r) { p.ph_lo = 0; p.ph_hi = 1; p.flags = PROBE_FLAGS; hipLaunchKernelGGL(mk_fwd, dim3(grid), dim3(NTHR), LDS_BYTES, stream, p); }
#else
    static const int seq[][2] = {
#if PROBE_SEQ == 1
        {0, PH_U0 + 1}, {PH_U0, PH_U0 + 1}, {PH_U0 + 1, NPH}
#elif PROBE_SEQ == 2
        {0, PH_SEL0 + 1}, {PH_SEL0, PH_SEL0 + 1}, {PH_SEL0 + 1, NPH}
#elif PROBE_SEQ == 10
        {0, PH_W0 + 1}, {PH_W0, PH_W0 + 1}, {PH_W0 + 1, NPH}
#elif PROBE_SEQ == 11
        {0, 1}, {0, 1}, {1, NPH}
#elif PROBE_SEQ == 12
        {0, PH_POST1 + 1}, {PH_POST1, PH_POST1 + 1}, {PH_POST1 + 1, NPH}
#elif PROBE_SEQ == 13
        {0, PH_OUT1}, {PH_POST1, PH_OUT1}, {PH_OUT1, NPH}
#elif PROBE_SEQ == 15
        {0, PH_PQ0 + 1}, {PH_PQ0, PH_PQ0 + 1}, {PH_PQ0 + 1, NPH}
#elif PROBE_SEQ == 16
        {0, PH_IN0 + 1}, {PH_IN0, PH_IN0 + 1}, {PH_IN0 + 1, NPH}
#elif PROBE_SEQ == 14
        {0, PH_N1 + 1}, {PH_N1, PH_N1 + 1}, {PH_N1 + 1, NPH}
#elif PROBE_SEQ == 99
        {0, 0}
#elif PROBE_SEQ == 3
        {0, PH_UP0 + 1}, {PH_UP0, PH_UP0 + 1}, {PH_UP0 + 1, NPH}
#elif PROBE_SEQ == 5
        {0, PH_IN1 + 1}, {PH_IN1, PH_IN1 + 1}, {PH_IN1 + 1, NPH}
#elif PROBE_SEQ == 6
        {0, PH_OUT0 + 1}, {PH_OUT0, PH_OUT0 + 1}, {PH_OUT0 + 1, NPH}
#elif PROBE_SEQ == 7
        {0, PH_NORM0 + 1}, {PH_NORM0, PH_NORM0 + 1}, {PH_NORM0 + 1, NPH}
#elif PROBE_SEQ == 8
        {0, PH_POST0 + 1}, {PH_POST0, PH_POST0 + 1}, {PH_POST0 + 1, NPH}
#elif PROBE_SEQ == 9
        {0, PH_PNORM0 + 1}, {PH_PNORM0, PH_PNORM0 + 1}, {PH_PNORM0 + 1, NPH}
#elif PROBE_SEQ == 4
        {0, PH_V0 + 1}, {-PH_V0, PH_V0 + 1}, {PH_V0 + 1, NPH}
#endif
    };
#if PROBE_SEQ == 99
    for (int ph = 0; ph < NPH; ++ph) { p.ph_lo = ph; p.ph_hi = ph + 1; hipLaunchKernelGGL(mk_fwd, dim3(grid), dim3(NTHR), LDS_BYTES, stream, p); }
#endif
    for (unsigned i = 0; i < sizeof(seq) / sizeof(seq[0]); ++i) {
        if (PROBE_SEQ == 99) break;
        (void)hipMemsetAsync((char*)d_ws + WS_CTL, 0, 65536, stream);
        p.ph_lo = seq[i][0] < 0 ? -seq[i][0] : seq[i][0]; p.ph_hi = seq[i][1]; p.flags = seq[i][0] < 0 ? 1 : 0;
        hipLaunchKernelGGL(mk_fwd, dim3(grid), dim3(NTHR), LDS_BYTES, stream, p);
    }
#endif
#endif
    const hipError_t le = hipPeekAtLastError();
    if (le != hipSuccess) fprintf(stderr, "kernel_launch: launch failed: %s\n", hipGetErrorName(le));
}
```

```cpp
#include <hip/hip_runtime.h>
namespace pg8 {
#define PG8_LAS __attribute__((address_space(3)))
typedef unsigned short bf16_t;
typedef short bf16x8 __attribute__((ext_vector_type(8)));
typedef float f32x4 __attribute__((ext_vector_type(4)));
typedef unsigned u32x4 __attribute__((ext_vector_type(4)));
constexpr int BM = 256, BK = 64, HALF = 128, HTB = HALF * BK * 2  , STAGE_BYTES = 8 * HTB, NXCD = 8, WGM = 8;

__host__ __device__ __forceinline__ int lds_byte(int r, int c) { const int st = (r >> 4) * 2 + (c >> 5), rr = r & 15, cc = c & 31, ob = rr * 64 + cc * 2; return st * 1024 + (ob ^ (((ob >> 9) & 1) << 5)); }
__host__ __device__ __forceinline__ void stage_rc(int b, int& R, int& C) { const int st = b / 1024, sb = b % 1024, swz = sb ^ (((sb >> 9) & 1) << 5); R = (st >> 1) * 16 + swz / 64; C = (st & 1) * 32 + (swz % 64) / 2; }
__host__ __device__ __forceinline__ int perm32(int rho) { const int n = rho >> 4, i = rho & 15; return 8 * (i >> 2) + 4 * n + (i & 3); }

struct Unit { int pm, pn; };
struct Gemm { const bf16_t* A; const bf16_t* Bt; int M, N, K; };

struct StaticOrder {
    int nM, nN, nwg, G, c;
    __host__ __device__ void init(int M, int N, int G_, int c_) { nM = M / BM; nN = N / BM; nwg = nM * nN; G = G_; c = c_; }
    __host__ __device__ bool next(int i, Unit& u) const {
        const long L = (long)i * G + c; if (L >= nwg) return false;
        int wgid = (int)L; { const int q = nwg / NXCD, r = nwg % NXCD, xcd = wgid % NXCD, off = wgid / NXCD; wgid = (xcd < r ? xcd * (q + 1) : r * (q + 1) + (xcd - r) * q) + off; }
        const int nig = WGM * nN, gid = wgid / nig, fm = gid * WGM, gsz = (nM - fm) < WGM ? (nM - fm) : WGM;
        u.pm = fm + ((wgid % nig) % gsz); u.pn = (wgid % nig) / gsz; return true;
    }
    __device__ __forceinline__ void a_ready(const Unit&) const {}
    __device__ __forceinline__ void done(const Unit&) const {}
};
struct CountedOrder : StaticOrder {
    const unsigned* ready; unsigned need; unsigned* tmo;
    __device__ __forceinline__ void a_ready(const Unit& u) const {
        if (threadIdx.x < 64) {
            const unsigned long long t0 = __builtin_amdgcn_s_memrealtime(); unsigned polls = 0;
            while ((unsigned)__builtin_amdgcn_readfirstlane(__hip_atomic_load(ready + 64 * u.pm, __ATOMIC_RELAXED, __HIP_MEMORY_SCOPE_AGENT)) < need) {
                if ((++polls & 255u) == 0u && __builtin_amdgcn_readfirstlane(__hip_atomic_load(tmo, __ATOMIC_RELAXED, __HIP_MEMORY_SCOPE_AGENT)) != 0u) break;
                if (__builtin_amdgcn_s_memrealtime() - t0 > 2000000ull) {
                    if (threadIdx.x == 0) { unsigned expect = 0u; __hip_atomic_compare_exchange_strong(tmo + 1, &expect, 0x600u | (unsigned)(u.pm & 0xff), __ATOMIC_RELAXED, __ATOMIC_RELAXED, __HIP_MEMORY_SCOPE_AGENT); __hip_atomic_store(tmo, 1u, __ATOMIC_RELAXED, __HIP_MEMORY_SCOPE_AGENT); }
                    break; }
                __builtin_amdgcn_s_sleep(2); }
            __builtin_amdgcn_fence(__ATOMIC_ACQUIRE, "agent");
            asm volatile("s_waitcnt vmcnt(0)" ::: "memory");
        }
#if !defined(BROKEN_HOOK_NO_BARRIER)
        asm volatile("" ::: "memory"); __builtin_amdgcn_s_barrier(); asm volatile("" ::: "memory");
#endif
    }
};

__device__ __forceinline__ unsigned cvt_pk_bf16(float lo, float hi) { unsigned r; asm volatile("v_cvt_pk_bf16_f32 %0, %1, %2" : "=v"(r) : "v"(lo), "v"(hi)); return r; }
typedef float f32x2 __attribute__((ext_vector_type(2)));
__device__ __forceinline__ f32x2 gelu_pk(f32x2 v) {
    const f32x2 av = __builtin_elementwise_abs(v), d = av * 0.2316418882f + 1.0f;
    f32x2 t; t.x = __builtin_amdgcn_rcpf(d.x); t.y = __builtin_amdgcn_rcpf(d.y);
    f32x2 q = t * 0.5307027145f + (-0.7265760135f); q = q * t + 0.7107068705f; q = q * t + (-0.142248368f); q = q * t + 0.127414796f; q = q * t;
    const f32x2 s = (v * v) * (-0.72134752044f);
    f32x2 e; e.x = __builtin_amdgcn_exp2f(s.x); e.y = __builtin_amdgcn_exp2f(s.y);
    const f32x2 m = v * (q * e), r = v - m;
    f32x2 o; o.x = v.x < 0.f ? m.x : r.x; o.y = v.y < 0.f ? m.y : r.y; return o;
}

struct EpiF32 {
    static constexpr bool PERM = false, AFTER_DRAIN = false;
    float* C; int ldc; const float* bias;
    __device__ __forceinline__ void operator()(const f32x4 (&acc)[2][2][4][2], const Unit& u, int wr, int wc, int fr, int fq) const {
        const int row0 = u.pm * BM + wr * 64 + fr, col0 = u.pn * BM + wc * 32 + 4 * fq;
        f32x4 bv[2][2];
#pragma unroll
        for (int bj = 0; bj < 2; ++bj)
#pragma unroll
            for (int n = 0; n < 2; ++n) bv[bj][n] = bias ? *(const f32x4*)(bias + col0 + bj * HALF + n * 16) : (f32x4){0.f, 0.f, 0.f, 0.f};
#pragma unroll
        for (int ai = 0; ai < 2; ++ai)
#pragma unroll
            for (int m = 0; m < 4; ++m) { float* rowp = C + (size_t)(row0 + ai * HALF + m * 16) * ldc + col0;
#pragma unroll
                for (int bj = 0; bj < 2; ++bj)
#pragma unroll
                    for (int n = 0; n < 2; ++n) *(f32x4*)(rowp + bj * HALF + n * 16) = acc[ai][bj][m][n] + bv[bj][n]; }
    }
};
template <int ACT  > struct EpiBf16 {
    static constexpr bool PERM = true, AFTER_DRAIN = false, I8 = false;
    bf16_t* O; int ldc; const float* bias; int split_cols; size_t split_stride;
    __device__ __forceinline__ void operator()(const f32x4 (&acc)[2][2][4][2], const Unit& u, int wr, int wc, int fr, int fq) const {
        const int row0 = u.pm * BM + wr * 64 + fr; int colt = u.pn * BM; bf16_t* base = O;
        if (split_cols) { const int t = colt / split_cols; base += (size_t)t * split_stride; colt -= t * split_cols; }
        const int col0 = colt + wc * 32 + 8 * fq, bcol0 = u.pn * BM + wc * 32 + 8 * fq;
        f32x4 bv[2][2];
#pragma unroll
        for (int bj = 0; bj < 2; ++bj)
#pragma unroll
            for (int n = 0; n < 2; ++n) bv[bj][n] = bias ? *(const f32x4*)(bias + bcol0 + bj * HALF + 4 * n) : (f32x4){0.f, 0.f, 0.f, 0.f};
#pragma unroll
        for (int ai = 0; ai < 2; ++ai)
#pragma unroll
            for (int m = 0; m < 4; ++m) { bf16_t* rowp = base + (size_t)(row0 + ai * HALF + m * 16) * ldc + col0;
#pragma unroll
                for (int bj = 0; bj < 2; ++bj) { f32x4 v0 = acc[ai][bj][m][0] + bv[bj][0], v1 = acc[ai][bj][m][1] + bv[bj][1];
                    if (ACT == 1) { f32x2 a = gelu_pk((f32x2){v0[0], v0[1]}), b = gelu_pk((f32x2){v0[2], v0[3]}), c = gelu_pk((f32x2){v1[0], v1[1]}), d = gelu_pk((f32x2){v1[2], v1[3]});
                        v0 = (f32x4){a.x, a.y, b.x, b.y}; v1 = (f32x4){c.x, c.y, d.x, d.y}; }
                    if (ACT == 2) {
#pragma unroll
                        for (int j = 0; j < 4; ++j) { v0[j] = 0.5f * v0[j] * (1.0f + erff(v0[j] * 0.70710678f)); v1[j] = 0.5f * v1[j] * (1.0f + erff(v1[j] * 0.70710678f)); } }
                    u32x4 w; w.x = cvt_pk_bf16(v0[0], v0[1]); w.y = cvt_pk_bf16(v0[2], v0[3]); w.z = cvt_pk_bf16(v1[0], v1[1]); w.w = cvt_pk_bf16(v1[2], v1[3]);
                    *(u32x4*)(rowp + bj * HALF) = w; } }
    }
};

struct PanelStats {
    unsigned* xbuf;
    unsigned* cnt;
    unsigned* tmo;
    int ntn; float eps;
    unsigned code;
    __device__ __forceinline__ bool run(const f32x4 (&v)[2][2][4][2], const Unit& u, int wr, int wc, int fr, int fq, PG8_LAS unsigned char* lds, int wid, int lane) const {
        typedef float f32x2v __attribute__((ext_vector_type(2)));
        PG8_LAS f32x2v* P = (PG8_LAS f32x2v*)lds;
        PG8_LAS f32x2v* S = (PG8_LAS f32x2v*)(lds + 8192);
        PG8_LAS unsigned* flag = (PG8_LAS unsigned*)(lds + 8192 + 2048);
#pragma unroll
        for (int ai = 0; ai < 2; ++ai)
#pragma unroll
            for (int m = 0; m < 4; ++m) {
                float s = 0.f;
#pragma unroll
                for (int bj = 0; bj < 2; ++bj)
#pragma unroll
                    for (int n = 0; n < 2; ++n) { const f32x4 x = v[ai][bj][m][n]; s += (x[0] + x[1]) + (x[2] + x[3]); }
                s += __shfl_xor(s, 16); s += __shfl_xor(s, 32);
                const float mw = s * (1.0f / 64.0f); float q = 0.f;
#pragma unroll
                for (int bj = 0; bj < 2; ++bj)
#pragma unroll
                    for (int n = 0; n < 2; ++n) { const f32x4 d = v[ai][bj][m][n] - mw; q += (d[0] * d[0] + d[1] * d[1]) + (d[2] * d[2] + d[3] * d[3]); }
                q += __shfl_xor(q, 16); q += __shfl_xor(q, 32);
                if (fq == 0) P[(ai * HALF + wr * 64 + m * 16 + fr) * 4 + wc] = (f32x2v){mw, q};
            }
        asm volatile("s_waitcnt lgkmcnt(0)" ::: "memory"); __builtin_amdgcn_s_barrier(); asm volatile("" ::: "memory");
#if defined(BROKEN_NO_WAIT)
        if (blockIdx.x >= 64) { const long long t0 = clock64(); while (clock64() - t0 < 60000) __builtin_amdgcn_s_sleep(8); }
#endif
        const int row = wid * 32 + (lane & 31);
        if (lane < 32) {
            const f32x2v a = P[row * 4 + 0], b = P[row * 4 + 1], c = P[row * 4 + 2], d = P[row * 4 + 3];
            const float mt = (a.x + b.x + c.x + d.x) * 0.25f;
            const float da = a.x - mt, db = b.x - mt, dc = c.x - mt, dd = d.x - mt;
            const float m2 = (a.y + b.y) + (c.y + d.y) + 64.0f * ((da * da + db * db) + (dc * dc + dd * dd));
            unsigned long long* slot = (unsigned long long*)xbuf + ((size_t)(u.pm * BM + row) * 4 + u.pn);
            __hip_atomic_store(slot, ((unsigned long long)__float_as_uint(m2) << 32) | __float_as_uint(mt), __ATOMIC_RELAXED, __HIP_MEMORY_SCOPE_AGENT);
        }
        asm volatile("s_waitcnt vmcnt(0)" ::: "memory");
        if (lane == 0) __hip_atomic_fetch_add(cnt + 64 * u.pm, 1u, __ATOMIC_RELAXED, __HIP_MEMORY_SCOPE_AGENT);
        if (wid == 0) {
            bool dead = false; const unsigned long long t0 = __builtin_amdgcn_s_memrealtime(); const unsigned want = 8u * (unsigned)ntn;
            for (;;) {
#if defined(BROKEN_NO_WAIT)
                break;
#endif
                if ((unsigned)__builtin_amdgcn_readfirstlane(__hip_atomic_load(cnt + 64 * u.pm, __ATOMIC_RELAXED, __HIP_MEMORY_SCOPE_AGENT)) >= want) break;
                if (__builtin_amdgcn_s_memrealtime() - t0 > 2000000ull) {
                    if (lane == 0) { unsigned expect = 0u; __hip_atomic_compare_exchange_strong(tmo + 1, &expect, code | (unsigned)(u.pm & 0xff), __ATOMIC_RELAXED, __ATOMIC_RELAXED, __HIP_MEMORY_SCOPE_AGENT);
                                     __hip_atomic_store(tmo, 1u, __ATOMIC_RELAXED, __HIP_MEMORY_SCOPE_AGENT); }
                    dead = true; break; }
                __builtin_amdgcn_s_sleep(2);
            }
            __builtin_amdgcn_fence(__ATOMIC_ACQUIRE, "agent");
            if (lane == 0) flag[0] = dead ? 1u : 0u;
        }
        asm volatile("s_waitcnt vmcnt(0) lgkmcnt(0)" ::: "memory"); __builtin_amdgcn_s_barrier(); asm volatile("" ::: "memory");
        const bool bad = flag[0] != 0u;
        if (lane < 32) {
            const unsigned long long* slot = (const unsigned long long*)xbuf + (size_t)(u.pm * BM + row) * 4; float mt[4], m2[4]; float ms = 0.f;
#pragma unroll
            for (int t = 0; t < 4; ++t) { if (t < ntn) { const unsigned long long w = __hip_atomic_load(slot + t, __ATOMIC_RELAXED, __HIP_MEMORY_SCOPE_AGENT); mt[t] = __uint_as_float((unsigned)w); m2[t] = __uint_as_float((unsigned)(w >> 32)); } else { mt[t] = 0.f; m2[t] = 0.f; } ms += mt[t]; }
            const float mean = ms / (float)ntn; float q = 0.f;
#pragma unroll
            for (int t = 0; t < 4; ++t) if (t < ntn) { const float dm = mt[t] - mean; q += m2[t] + 256.0f * dm * dm; }
            S[row] = (f32x2v){mean, 1.0f / sqrtf(q / (256.0f * (float)ntn) + eps)};
        }
        asm volatile("s_waitcnt lgkmcnt(0)" ::: "memory"); __builtin_amdgcn_s_barrier(); asm volatile("" ::: "memory");
        return bad;
    }
};
struct EpiLnRes {
    static constexpr bool PERM = false, AFTER_DRAIN = true;
    const float* base; float* out; int ldc; const float* bias; PanelStats st; unsigned poison;
    __device__ __forceinline__ void refuse(size_t i0, size_t stride, int M, int N) const { const float q = __builtin_nanf(""); for (size_t i = i0; i < (size_t)M * N; i += stride) out[(i / N) * ldc + i % N] = q;
        if (i0 == 0) { unsigned expect = 0u; __hip_atomic_compare_exchange_strong(st.tmo + 1, &expect, 0x7f0u, __ATOMIC_RELAXED, __ATOMIC_RELAXED, __HIP_MEMORY_SCOPE_AGENT); __hip_atomic_store(st.tmo, 1u, __ATOMIC_RELAXED, __HIP_MEMORY_SCOPE_AGENT); } }
    __device__ __forceinline__ void fused(f32x4 (&acc)[2][2][4][2], const Unit& u, int wr, int wc, int fr, int fq, PG8_LAS unsigned char* lds, int wid, int lane) const {
        typedef float f32x2v __attribute__((ext_vector_type(2)));
        const PG8_LAS f32x2v* S = (const PG8_LAS f32x2v*)(lds + 8192);
        const int col0 = u.pn * BM + wc * 32 + 4 * fq;
#pragma unroll
        for (int bj = 0; bj < 2; ++bj)
#pragma unroll
            for (int n = 0; n < 2; ++n) { const f32x4 bv = bias ? *(const f32x4*)(bias + col0 + bj * HALF + n * 16) : (f32x4){0.f, 0.f, 0.f, 0.f};
#pragma unroll
                for (int ai = 0; ai < 2; ++ai)
#pragma unroll
                    for (int m = 0; m < 4; ++m) acc[ai][bj][m][n] += bv; }
        const bool bad = st.run(acc, u, wr, wc, fr, fq, lds, wid, lane) || poison != 0u;
        const float qnan = __builtin_nanf("");
#pragma unroll
        for (int ai = 0; ai < 2; ++ai)
#pragma unroll
            for (int m = 0; m < 4; ++m) { const int r = ai * HALF + wr * 64 + m * 16 + fr; const f32x2v sr = S[r]; const size_t off = (size_t)(u.pm * BM + r) * ldc + col0;
#pragma unroll
                for (int bj = 0; bj < 2; ++bj)
#pragma unroll
                    for (int n = 0; n < 2; ++n) { const f32x4 bs = *(const f32x4*)(base + off + bj * HALF + n * 16); f32x4 o = bs + (acc[ai][bj][m][n] - sr.x) * sr.y;
                        if (bad) o = (f32x4){qnan, qnan, qnan, qnan}; *(f32x4*)(out + off + bj * HALF + n * 16) = o; }
                asm volatile("" ::: "memory"); }
    }
};
struct EpiLnResLn {
    static constexpr bool PERM = false, AFTER_DRAIN = true;
    const float* base; float* out; bf16_t* xn; int ldc; const float* bias; PanelStats st1, st2; unsigned poison;
    __device__ __forceinline__ void refuse(size_t i0, size_t stride, int M, int N) const { const float q = __builtin_nanf(""); for (size_t i = i0; i < (size_t)M * N; i += stride) { const size_t o = (i / N) * ldc + i % N; out[o] = q; xn[o] = (bf16_t)0x7fc0u; }
        if (i0 == 0) { unsigned expect = 0u; __hip_atomic_compare_exchange_strong(st1.tmo + 1, &expect, 0x7f0u, __ATOMIC_RELAXED, __ATOMIC_RELAXED, __HIP_MEMORY_SCOPE_AGENT); __hip_atomic_store(st1.tmo, 1u, __ATOMIC_RELAXED, __HIP_MEMORY_SCOPE_AGENT); } }
    __device__ __forceinline__ void fused(f32x4 (&acc)[2][2][4][2], const Unit& u, int wr, int wc, int fr, int fq, PG8_LAS unsigned char* lds, int wid, int lane) const {
        typedef float f32x2v __attribute__((ext_vector_type(2))); typedef unsigned u32x2v __attribute__((ext_vector_type(2)));
        const PG8_LAS f32x2v* S = (const PG8_LAS f32x2v*)(lds + 8192);
        const int col0 = u.pn * BM + wc * 32 + 4 * fq;
#pragma unroll
        for (int bj = 0; bj < 2; ++bj)
#pragma unroll
            for (int n = 0; n < 2; ++n) { const f32x4 bv = bias ? *(const f32x4*)(bias + col0 + bj * HALF + n * 16) : (f32x4){0.f, 0.f, 0.f, 0.f};
#pragma unroll
                for (int ai = 0; ai < 2; ++ai)
#pragma unroll
                    for (int m = 0; m < 4; ++m) acc[ai][bj][m][n] += bv; }
        bool bad = st1.run(acc, u, wr, wc, fr, fq, lds, wid, lane) || poison != 0u;
        const float qnan = __builtin_nanf("");
#pragma unroll
        for (int ai = 0; ai < 2; ++ai)
#pragma unroll
            for (int m = 0; m < 4; ++m) { const int r = ai * HALF + wr * 64 + m * 16 + fr; const f32x2v sr = S[r]; const size_t off = (size_t)(u.pm * BM + r) * ldc + col0;
#pragma unroll
                for (int bj = 0; bj < 2; ++bj)
#pragma unroll
                    for (int n = 0; n < 2; ++n) { const f32x4 bs = *(const f32x4*)(base + off + bj * HALF + n * 16); acc[ai][bj][m][n] = bs + (acc[ai][bj][m][n] - sr.x) * sr.y; }
                asm volatile("" : "+v"(acc[ai][0][m][0]), "+v"(acc[ai][0][m][1]), "+v"(acc[ai][1][m][0]), "+v"(acc[ai][1][m][1]));
                if (m & 1) asm volatile("" ::: "memory"); }
        const bool bad1 = bad;
        bad = st2.run(acc, u, wr, wc, fr, fq, lds, wid, lane) || bad;
#pragma unroll
        for (int ai = 0; ai < 2; ++ai)
#pragma unroll
            for (int m = 0; m < 4; ++m) { const int r = ai * HALF + wr * 64 + m * 16 + fr; const f32x2v sr = S[r]; const size_t off = (size_t)(u.pm * BM + r) * ldc + col0;
#pragma unroll
                for (int bj = 0; bj < 2; ++bj)
#pragma unroll
                    for (int n = 0; n < 2; ++n) { const f32x4 x1 = acc[ai][bj][m][n]; *(f32x4*)(out + off + bj * HALF + n * 16) = bad1 ? (f32x4){qnan, qnan, qnan, qnan} : x1;
                        const f32x4 o = (x1 - sr.x) * sr.y; u32x2v w; w.x = cvt_pk_bf16(o[0], o[1]); w.y = cvt_pk_bf16(o[2], o[3]);
                        if (bad) { w.x = 0x7fc07fc0u; w.y = 0x7fc07fc0u; } *(u32x2v*)(xn + off + bj * HALF + n * 16) = w; }
                asm volatile("" ::: "memory"); }
    }
};

typedef int i32x4_t __attribute__((ext_vector_type(4)));
template <bool I8> __device__ __forceinline__ f32x4 mma_step(const bf16x8& b, const bf16x8& a, const f32x4& c) {
    if constexpr (I8) { const i32x4_t r = __builtin_amdgcn_mfma_i32_16x16x64_i8(__builtin_bit_cast(i32x4_t, b), __builtin_bit_cast(i32x4_t, a), __builtin_bit_cast(i32x4_t, c), 0, 0, 0); return __builtin_bit_cast(f32x4, r); }
    else return __builtin_amdgcn_mfma_f32_16x16x32_bf16(b, a, c, 0, 0, 0);
}
template <class Epi, class Sched, bool STAMP = false>
__device__ __forceinline__ void gemm_phase(PG8_LAS unsigned char* lds, const Gemm g, const Sched& S, const Epi& E, unsigned long long* stamps) {
    const int tid = threadIdx.x, wid = __builtin_amdgcn_readfirstlane(tid >> 6), lane = tid & 63, wr = wid >> 2, wc = wid & 3, fr = lane & 15, fq = lane >> 4;
    const int K = g.K, nt = K / BK;
    int ts_lo = 0, ts_hi = 0, nts = 0; const unsigned long long rt_entry = STAMP ? (unsigned long long)wall_clock64() : 0ull;
#define PG8_STAMP() do { if (STAMP && wid == 0 && nts < 64) { const unsigned long long _c = (unsigned long long)clock64(); \
        ts_lo = (lane == nts) ? (int)(unsigned)_c : ts_lo; ts_hi = (lane == nts) ? (int)(unsigned)(_c >> 32) : ts_hi; ++nts; } } while (0)
    PG8_STAMP();
    unsigned voffA[2], voffB[2];
#pragma unroll
    for (int i = 0; i < 2; ++i) { int R, C; stage_rc(tid * 16 + i * 8192, R, C); const int Rb = Epi::PERM ? ((R & ~31) + perm32(R & 31)) : R;
        voffA[i] = (unsigned)(R * K + C) * 2u; voffB[i] = (unsigned)(Rb * K + C) * 2u; }
    const size_t kstep = (size_t)(BK * 2);
    const size_t hstep = (size_t)HALF * K * 2;
    const size_t tstep = 2 * hstep;
    const unsigned ldsw = (unsigned)wid * 1024u;
    const int aoff = lds_byte(wr * 64 + fr, fq * 8), boff = lds_byte(wc * 32 + fr, fq * 8);
#define PG8_SA(b, h) (((b) * 2 + (h)) * HTB)
#define PG8_SB(b, h) ((4 + (b) * 2 + (h)) * HTB)
#define PG8_STAGE(bufoff, gbase, voff) do { _Pragma("unroll") for (int _i = 0; _i < 2; ++_i) \
        __builtin_amdgcn_global_load_lds((const unsigned*)((const char*)(gbase) + (voff)[_i]), (PG8_LAS unsigned*)(lds + (bufoff) + ldsw + _i * 8192), 16, 0, 0); } while (0)
#define PG8_LDA(dst, b, h) do { _Pragma("unroll") for (int m = 0; m < 4; ++m) _Pragma("unroll") for (int k = 0; k < 2; ++k) dst[m][k] = *(const PG8_LAS bf16x8*)(lds + PG8_SA(b, h) + aoff + m * 2048 + k * 1024); } while (0)
#define PG8_LDB(dst, b, h) do { _Pragma("unroll") for (int n = 0; n < 2; ++n) _Pragma("unroll") for (int k = 0; k < 2; ++k) dst[n][k] = *(const PG8_LAS bf16x8*)(lds + PG8_SB(b, h) + boff + n * 2048 + k * 1024); } while (0)
#define PG8_MMA(ai, bj, At, Bt) do { __builtin_amdgcn_s_setprio(1); _Pragma("unroll") for (int m = 0; m < 4; ++m) _Pragma("unroll") for (int n = 0; n < 2; ++n) _Pragma("unroll") for (int k = 0; k < 2; ++k) \
        acc[ai][bj][m][n] = mma_step<Epi::I8>(Bt[n][k], At[m][k], acc[ai][bj][m][n]); __builtin_amdgcn_s_setprio(0); } while (0)
#define PG8_WAIT_V(n) asm volatile("s_waitcnt vmcnt(" #n ")" ::: "memory")
#define PG8_WAIT_L(n) asm volatile("s_waitcnt lgkmcnt(" #n ")" ::: "memory")
#define PG8_BAR __builtin_amdgcn_s_barrier()
#define PG8_SCHED __builtin_amdgcn_sched_barrier(0)
    Unit cur, nxt; int ui = 0;
    if (!S.next(0, cur)) return;
    f32x4 acc[2][2][4][2];
#pragma unroll
    for (int a = 0; a < 2; ++a)
#pragma unroll
        for (int b = 0; b < 2; ++b)
#pragma unroll
            for (int m = 0; m < 4; ++m)
#pragma unroll
                for (int n = 0; n < 2; ++n) acc[a][b][m][n] = (f32x4){0.f, 0.f, 0.f, 0.f};
    bf16x8 At[4][2], B0[2][2], B1[2][2];
    const char* cA = (const char*)g.A + (size_t)cur.pm * tstep; const char* cB = (const char*)g.Bt + (size_t)cur.pn * tstep;
    S.a_ready(cur);
    PG8_STAGE(PG8_SB(0, 0), cB, voffB); PG8_STAGE(PG8_SA(0, 0), cA, voffA); PG8_STAGE(PG8_SB(0, 1), cB + hstep, voffB); PG8_STAGE(PG8_SA(0, 1), cA + hstep, voffA);
    if (wr == 1) PG8_BAR;
    PG8_WAIT_V(4); PG8_BAR;
    PG8_STAGE(PG8_SB(1, 0), cB + kstep, voffB); PG8_STAGE(PG8_SA(1, 0), cA + kstep, voffA); PG8_STAGE(PG8_SB(1, 1), cB + hstep + kstep, voffB);
    PG8_WAIT_V(6); PG8_BAR;
    PG8_STAMP();
    for (;;) {
        const bool has_next = S.next(ui + 1, nxt);
        const char* nA = has_next ? (const char*)g.A + (size_t)nxt.pm * tstep : cA; const char* nB = has_next ? (const char*)g.Bt + (size_t)nxt.pn * tstep : cB;
        for (int t = 0; t < nt; t += 2) {
            const bool last = (t == nt - 2);
            const char* a1 = cA + (size_t)(t + 1) * kstep;
            const char* a2 = last ? nA : cA + (size_t)(t + 2) * kstep; const char* b2 = last ? nB : cB + (size_t)(t + 2) * kstep;
            const char* a3 = a2 + kstep; const char* b3 = b2 + kstep;
            if (last && has_next) S.a_ready(nxt);
            PG8_LDB(B0, 0, 0); PG8_SCHED; PG8_LDA(At, 0, 0); PG8_STAGE(PG8_SA(1, 1), a1 + hstep, voffA);
            PG8_WAIT_L(8); PG8_BAR; PG8_WAIT_L(0); PG8_MMA(0, 0, At, B0); PG8_BAR; PG8_SCHED;
            PG8_LDB(B1, 0, 1); PG8_STAGE(PG8_SB(0, 0), b2, voffB);
            PG8_BAR; PG8_WAIT_L(0); PG8_MMA(0, 1, At, B1); PG8_BAR;
            PG8_LDA(At, 0, 1); PG8_STAGE(PG8_SA(0, 0), a2, voffA);
            PG8_BAR; PG8_WAIT_L(0); PG8_MMA(1, 0, At, B0); PG8_BAR; PG8_SCHED;
            PG8_STAGE(PG8_SB(0, 1), b2 + hstep, voffB);
            PG8_WAIT_V(6); PG8_BAR; PG8_MMA(1, 1, At, B1); PG8_BAR;
            PG8_LDB(B0, 1, 0); PG8_SCHED; PG8_LDA(At, 1, 0); PG8_STAGE(PG8_SA(0, 1), a2 + hstep, voffA);
            PG8_WAIT_L(8); PG8_BAR; PG8_WAIT_L(0); PG8_MMA(0, 0, At, B0); PG8_BAR; PG8_SCHED;
            PG8_LDB(B1, 1, 1); PG8_STAGE(PG8_SB(1, 0), b3, voffB);
            PG8_BAR; PG8_WAIT_L(0); PG8_MMA(0, 1, At, B1); PG8_BAR;
            PG8_LDA(At, 1, 1); PG8_STAGE(PG8_SA(1, 0), a3, voffA);
            PG8_BAR; PG8_WAIT_L(0); PG8_MMA(1, 0, At, B0); PG8_BAR; PG8_SCHED;
            PG8_STAGE(PG8_SB(1, 1), b3 + hstep, voffB);
            PG8_WAIT_V(6); PG8_BAR; PG8_MMA(1, 1, At, B1); PG8_BAR;
        }
        PG8_STAMP();
        if constexpr (!Epi::AFTER_DRAIN) { E(acc, cur, wr, wc, fr, fq); S.done(cur); }
        PG8_STAMP();
        if (!has_next) break;
#pragma unroll
        for (int a = 0; a < 2; ++a)
#pragma unroll
            for (int b = 0; b < 2; ++b)
#pragma unroll
                for (int m = 0; m < 4; ++m)
#pragma unroll
                    for (int n = 0; n < 2; ++n) acc[a][b][m][n] = (f32x4){0.f, 0.f, 0.f, 0.f};
        cur = nxt; cA = nA; cB = nB; ++ui;
    }
    PG8_WAIT_V(0);
    if (wr == 0) PG8_BAR;
    PG8_BAR;
    if constexpr (Epi::AFTER_DRAIN) { E.fused(acc, cur, wr, wc, fr, fq, lds, wid, lane); S.done(cur); }
    PG8_STAMP();
    if (STAMP && wid == 0) { stamps[lane] = lane < nts ? (((unsigned long long)(unsigned)ts_hi << 32) | (unsigned)ts_lo) : 0ull;
        if (lane == 62) stamps[62] = rt_entry; if (lane == 63) stamps[63] = (unsigned long long)wall_clock64(); }
#undef PG8_STAMP
#undef PG8_SA
#undef PG8_SB
#undef PG8_STAGE
#undef PG8_LDA
#undef PG8_LDB
#undef PG8_MMA
#undef PG8_WAIT_V
#undef PG8_WAIT_L
#undef PG8_BAR
#undef PG8_SCHED
}
}

#define LAS __attribute__((address_space(3)))
typedef unsigned short bf16_t;
typedef short bf16x8 __attribute__((ext_vector_type(8)));
typedef short s16x4 __attribute__((ext_vector_type(4)));
typedef float f32x4 __attribute__((ext_vector_type(4)));
typedef float f32x2 __attribute__((ext_vector_type(2)));
typedef float f32x16 __attribute__((ext_vector_type(16)));
typedef unsigned u32x4 __attribute__((ext_vector_type(4)));
typedef unsigned u32x2 __attribute__((ext_vector_type(2)));
typedef __bf16 bf2_t __attribute__((ext_vector_type(2)));

constexpr int SEQ = 16384, DM = 2048, CTXL = 256, NKEY = SEQ + CTXL;
constexpr int NTHR = 512;
constexpr int ZP = 512;
constexpr int LDS_BYTES = 163840;
constexpr int LDS_CTL = LDS_BYTES - 256;

__device__ __forceinline__ float wave_sum(float v) {
#pragma unroll
    for (int o = 32; o >= 1; o >>= 1) v += __shfl_xor(v, o);
    return v;
}
__device__ __forceinline__ unsigned pk_bf16(float lo, float hi) { unsigned r; asm volatile("v_cvt_pk_bf16_f32 %0, %1, %2" : "=v"(r) : "v"(lo), "v"(hi)); return r; }
__device__ __forceinline__ float bf_lo(unsigned w) { return __uint_as_float(w << 16); }
__device__ __forceinline__ float bf_hi(unsigned w) { return __uint_as_float(w & 0xffff0000u); }
__device__ __forceinline__ float bf1(bf16_t h) { return __uint_as_float(((unsigned)h) << 16); }
__device__ __forceinline__ bf16_t f2bf(float f) { return (bf16_t)(pk_bf16(f, 0.f) & 0xffffu); }
__device__ __forceinline__ float gelu_tanh(float x) {
    const float u = 1.5957691216057308f * (x + 0.044715f * x * x * x);
    return x / (1.f + __expf(-u));
}
__device__ __forceinline__ float silu_f(float v) { return v / (1.f + __expf(-v)); }
__device__ __forceinline__ float dpp_f32_quad_swap1(float v) { return __int_as_float(__builtin_amdgcn_update_dpp(0, __float_as_int(v), 0xB1, 0xf, 0xf, true)); }
typedef _Float16 h2_t __attribute__((ext_vector_type(2)));
__device__ __forceinline__ unsigned pk_h2(f32x2 v) { h2_t h; h.x = (_Float16)v.x; h.y = (_Float16)v.y; return *(unsigned*)&h; }
__device__ __forceinline__ f32x2 un_h2(unsigned u) { h2_t h = *(h2_t*)&u; return (f32x2){(float)h.x, (float)h.y}; }

#define XB_TMO      128
#define XB_XCNT(j)  (256  + 64 * (j))
#define XB_XSUB(j)  (1280 + 64 * (j))
#define XB_XGEN(j)  (2304 + 64 * (j))
#define XB_TOP      3328
#define XB_TOPGEN   3392
#define XCD_BAR_WORDS 3456
#define XB_SPIN_CAP (1u << 22)
__device__ __forceinline__ unsigned xb_ld(unsigned* p)              { return __hip_atomic_load(p, __ATOMIC_RELAXED, __HIP_MEMORY_SCOPE_AGENT); }
__device__ __forceinline__ unsigned xb_add(unsigned* p, unsigned v) { return __hip_atomic_fetch_add(p, v, __ATOMIC_RELAXED, __HIP_MEMORY_SCOPE_AGENT); }
__device__ __forceinline__ unsigned xb_xcc_id() { return (unsigned)__builtin_amdgcn_s_getreg((3 << 11) | 20) & 0xFu; }
#define XB_SPIN(cond, bar) do { unsigned _sp = 0; while (cond) { __builtin_amdgcn_s_sleep(1); \
    if ((++_sp & 255u) == 0u) { if (xb_ld(&(bar)[XB_TMO])) break; if (_sp > XB_SPIN_CAP) { atomicAdd(&(bar)[XB_TMO], 1u); break; } } } } while (0)
struct XcdBarrier { unsigned* bar; unsigned x; volatile LAS unsigned* st; };
__device__ __forceinline__ XcdBarrier xcd_barrier_post(unsigned* bar, volatile LAS unsigned* st) {
    XcdBarrier b; b.bar = bar; b.x = xb_xcc_id(); b.st = st;
    if (threadIdx.x == 0) (void)xb_add(&bar[XB_XCNT(b.x)], 1u);
    return b;
}
__device__ __forceinline__ void xcd_barrier_complete(unsigned* bar, unsigned x, unsigned& nloc, unsigned& nx) {
    const unsigned G = gridDim.x * gridDim.y * gridDim.z;
    unsigned sum, cnt, mine, sp = 0u;
    for (;;) {
        sum = 0u; cnt = 0u; mine = 0u;
#pragma unroll
        for (unsigned j = 0; j < 16; ++j) { const unsigned c = xb_ld(&bar[XB_XCNT(j)]); sum += c; cnt += (c > 0u) ? 1u : 0u; mine = (j == x) ? c : mine; }
        if (sum == G) break;
        __builtin_amdgcn_s_sleep(1);
        if ((++sp & 255u) == 0u) { if (xb_ld(&bar[XB_TMO])) break; if (sp > XB_SPIN_CAP) { atomicAdd(&bar[XB_TMO], 1u); break; } }
    }
    nloc = mine > 0u ? mine : 1u; nx = cnt > 0u ? cnt : 1u;
}
__device__ __forceinline__ void xcd_barrier(const XcdBarrier& b) {
    asm volatile("s_waitcnt vmcnt(0)" ::: "memory");
    __syncthreads();
    if (threadIdx.x == 0) {
        unsigned* bar = b.bar;
        __builtin_amdgcn_s_waitcnt(0);
        unsigned nloc = b.st[0], nx = b.st[1];
        if (nloc == 0u) { xcd_barrier_complete(bar, b.x, nloc, nx); b.st[0] = nloc; b.st[1] = nx; }
        const unsigned old = xb_add(&bar[XB_XSUB(b.x)], 1u);
        const unsigned gen = old / nloc;
        if (old + 1u == (gen + 1u) * nloc) {
            __builtin_amdgcn_fence(__ATOMIC_RELEASE, "agent");
            asm volatile("s_waitcnt vmcnt(0)" ::: "memory");
            const unsigned og = xb_add(&bar[XB_TOP], 1u);
            const unsigned tg = og / nx;
            if (og + 1u == (tg + 1u) * nx) xb_add(&bar[XB_TOPGEN], 1u);
            else XB_SPIN(xb_ld(&bar[XB_TOPGEN]) == tg, bar);
            __builtin_amdgcn_fence(__ATOMIC_ACQUIRE, "agent");
            xb_add(&bar[XB_XGEN(b.x)], 1u);
            asm volatile("s_waitcnt vmcnt(0)" ::: "memory");
        } else {
            XB_SPIN(xb_ld(&bar[XB_XGEN(b.x)]) == gen, bar);
            __builtin_amdgcn_fence(__ATOMIC_ACQUIRE, "agent");
            asm volatile("s_waitcnt vmcnt(0)" ::: "memory");
        }
    }
    __syncthreads();
}

constexpr size_t WS_CTL   = 0;
constexpr size_t WS_MOD0  = 65536;
constexpr size_t WS_MOD1  = WS_MOD0 + 49152;
constexpr size_t WS_MC0   = WS_MOD1 + 49152;
constexpr size_t WS_ROPEC = WS_MC0 + 16384;
constexpr size_t WS_ROPES = WS_ROPEC + 2097152;
constexpr size_t WS_FPART = WS_ROPES + 2097152;
constexpr size_t WS_FNORM = WS_FPART + 4194304;
constexpr size_t WS_TSC   = WS_FNORM + 4096;
constexpr size_t WS_SA    = WS_TSC + 262144;
constexpr size_t WS_SW    = WS_SA + 69632;
constexpr size_t WS_KEYS0 = WS_SW + 131072;
constexpr size_t WS_KEYS1 = WS_KEYS0 + 65536;
constexpr size_t WS_GMWS  = WS_KEYS1 + 65536;
constexpr size_t WS_WIN0  = WS_GMWS + 262144;
constexpr size_t WS_WUQ   = WS_WIN0 + (size_t)4096 * 2048 * 2;
constexpr size_t WS_WUKV  = WS_WUQ + (size_t)1536 * 512 * 2;
constexpr size_t WS_WOUT0 = WS_WUKV + (size_t)2048 * 256 * 2;
constexpr size_t WS_WPQ0  = WS_WOUT0 + (size_t)2048 * 2048 * 2;
constexpr size_t WS_WIN1  = WS_WPQ0 + (size_t)2048 * 2048 * 2;
constexpr size_t WS_WOUT1 = WS_WIN1 + (size_t)5120 * 2048 * 2;
constexpr size_t WS_WPQ1  = WS_WOUT1 + (size_t)2048 * 2048 * 2;
constexpr size_t WS_TABU  = WS_WPQ1 + (size_t)2048 * 2048 * 2;
constexpr size_t WS_TABV  = WS_TABU + (size_t)16384 * 2048 * 2;
constexpr size_t WS_XR    = WS_TABV + (size_t)16384 * 2048 * 2;
constexpr size_t WS_H     = WS_XR + (size_t)16384 * 2048 * 4;
constexpr size_t WS_PBUF  = WS_H + (size_t)NKEY * 2048 * 2;
constexpr size_t WS_L0X   = WS_PBUF + (size_t)16384 * 5120 * 2;
constexpr size_t WS_QN    = WS_L0X;
constexpr size_t WS_KVN   = WS_QN + (size_t)16384 * 512 * 2;
constexpr size_t WS_KROPE = WS_KVN + (size_t)NKEY * 256 * 2;
constexpr size_t WS_Q     = WS_KROPE + (size_t)NKEY * 64 * 2;
constexpr size_t WS_KV    = WS_Q + (size_t)16384 * 1536 * 2;
constexpr size_t WS_L0END = WS_KV + (size_t)NKEY * 2048 * 2;
constexpr size_t WS_Z     = WS_L0X;
static_assert(WS_L0END - WS_L0X >= (size_t)32768 * ZP * 4, "Z alias");
static_assert(WS_L0END - WS_L0X >= (size_t)16 * 16384 * 128 * 4, "PD alias");
static_assert((size_t)NKEY * 4096 * 2 <= (size_t)16384 * 5120 * 2, "PBUF");
constexpr size_t WS_YCAT  = WS_L0END;
constexpr size_t WS_KZ    = WS_YCAT + (size_t)16384 * 2048 * 2;
constexpr size_t WS_KZ2   = WS_KZ + (size_t)32768 * ZP * 4;
constexpr size_t WS_END   = WS_KZ2 + (size_t)32768 * ZP * 4;
constexpr size_t WS_G1B   = WS_H;
constexpr size_t WS_X0B   = WS_H + (size_t)16384 * 1024 * 2;
static_assert(WS_END < (size_t)1000000000, "workspace budget");

struct Params { const float* in[43]; float* out; unsigned char* ws; int ph_lo, ph_hi, flags, pad; };
struct Fr { const float* const* in; float* out; unsigned char* ws; LAS unsigned char* lds; int tid, lane, wave, G, bid; int xcc, xcc_rank, xcc_n, xcc_ok; };

enum { I_X = 0, I_C, I_CTX, I_CCTX, I_LN1G0, I_WMOD0, I_BMOD0, I_WIN0, I_CONVW0, I_QNG0, I_WUQ0, I_KVNG0, I_WUKV0, I_WOUT0, I_LN2G0, I_PWQ0, I_PKEYS0, I_PU0, I_PV0,
       I_LN1G1, I_WMOD1, I_BMOD1, I_WIN1, I_GMNG1, I_GMWS1, I_GMB1, I_HYCW1, I_HYCB1, I_HYW1, I_HYB1, I_HYF1, I_HYW2, I_HYB2, I_HYF2, I_HYW3, I_HYBIAS1, I_WOUT1, I_LN2G1, I_PWQ1, I_PKEYS1, I_PU1, I_PV1, I_FINALG };

__device__ __forceinline__ void tconv_task(const Fr& F, const float* W, int K, int N, int Npad, bf16_t* Bt) {
    LAS float* tile = (LAS float*)F.lds;
    const int tn = Npad / 64, tk = K / 64, nt = tn * tk;
    for (int t0 = F.bid * 4; t0 < nt; t0 += F.G * 4) {
        const int i = F.tid >> 3, jq = F.tid & 7;
        f32x4 a[4], b[4];
#pragma unroll
        for (int q = 0; q < 4; ++q) { const int t = t0 + q; a[q] = (f32x4){0.f, 0.f, 0.f, 0.f}; b[q] = a[q];
            if (t < nt) { const int n0 = (t % tn) * 64, k0 = (t / tn) * 64;
                if (n0 < N) { const float* p = W + (size_t)(k0 + i) * N + n0 + jq * 8; a[q] = *(const f32x4*)p; b[q] = *(const f32x4*)(p + 4); } } }
        __syncthreads();
#pragma unroll
        for (int q = 0; q < 4; ++q)
#pragma unroll
            for (int e = 0; e < 4; ++e) { tile[q * 4160 + i * 65 + jq * 8 + e] = a[q][e]; tile[q * 4160 + i * 65 + jq * 8 + 4 + e] = b[q][e]; }
        __syncthreads();
        const int j = F.tid >> 3, ic = F.tid & 7;
#pragma unroll
        for (int q = 0; q < 4; ++q) { const int t = t0 + q;
            if (t < nt) { const int n0 = (t % tn) * 64, k0 = (t / tn) * 64;
                float v[8];
#pragma unroll
                for (int e = 0; e < 8; ++e) v[e] = tile[q * 4160 + (ic * 8 + e) * 65 + j];
                u32x4 w; w.x = pk_bf16(v[0], v[1]); w.y = pk_bf16(v[2], v[3]); w.z = pk_bf16(v[4], v[5]); w.w = pk_bf16(v[6], v[7]);
                *(u32x4*)(Bt + (size_t)(n0 + j) * K + k0 + ic * 8) = w; } }
    }
    __syncthreads();
}
__device__ __forceinline__ void colmax_task(const Fr& F, const float* W, int K, int N, int Npad, float* SW) {
    LAS float* red = (LAS float*)F.lds;
    const int i = F.tid >> 3, jq = F.tid & 7;
    for (int st = F.bid; st < Npad / 32; st += F.G) {
        const int n0 = st * 32;
        f32x4 cm = {0.f, 0.f, 0.f, 0.f};
        if (n0 < N) {
            const float* p = W + (size_t)i * N + n0 + jq * 4;
#pragma unroll 8
            for (int k = 0; k < K; k += 64) { const f32x4 w = *(const f32x4*)(p + (size_t)k * N);
                cm[0] = fmaxf(cm[0], fabsf(w[0])); cm[1] = fmaxf(cm[1], fabsf(w[1])); cm[2] = fmaxf(cm[2], fabsf(w[2])); cm[3] = fmaxf(cm[3], fabsf(w[3])); }
        }
        __syncthreads();
#pragma unroll
        for (int e = 0; e < 4; ++e) red[i * 33 + jq * 4 + e] = cm[e];
        __syncthreads();
        if (F.tid < 32) { float m = 0.f; for (int q = 0; q < 64; ++q) m = fmaxf(m, red[q * 33 + F.tid]); SW[n0 + F.tid] = m > 0.f ? m * (1.0f / 127.0f) : 1.0f; }
    }
    __syncthreads();
}
__device__ __forceinline__ void tconv_q_task(const Fr& F, const float* W, int K, int N, int Npad, const float* SW, unsigned char* Bt8) {
    LAS float* tile = (LAS float*)F.lds;
    const int tn = Npad / 64, tk = K / 64, nt = tn * tk;
    for (int t0 = F.bid * 4; t0 < nt; t0 += F.G * 4) {
        const int i = F.tid >> 3, jq = F.tid & 7;
        f32x4 a[4], b[4]; float sw4[4];
#pragma unroll
        for (int q = 0; q < 4; ++q) { const int t = t0 + q; a[q] = (f32x4){0.f, 0.f, 0.f, 0.f}; b[q] = a[q]; sw4[q] = 1.0f;
            if (t < nt) { const int n0 = (t % tn) * 64, k0 = (t / tn) * 64;
                sw4[q] = SW[n0 + (F.tid >> 3)];
                if (n0 < N) { const float* p = W + (size_t)(k0 + i) * N + n0 + jq * 8; a[q] = *(const f32x4*)p; b[q] = *(const f32x4*)(p + 4); } } }
        __syncthreads();
#pragma unroll
        for (int q = 0; q < 4; ++q)
#pragma unroll
            for (int e = 0; e < 4; ++e) { tile[q * 4160 + i * 65 + jq * 8 + e] = a[q][e]; tile[q * 4160 + i * 65 + jq * 8 + 4 + e] = b[q][e]; }
        __syncthreads();
        const int j = F.tid >> 3, ic = F.tid & 7;
#pragma unroll
        for (int q = 0; q < 4; ++q) { const int t = t0 + q;
            if (t < nt) { const int n0 = (t % tn) * 64, k0 = (t / tn) * 64;
                const float inv = 1.0f / sw4[q];
                int qv[8];
#pragma unroll
                for (int e = 0; e < 8; ++e) { const int r = (int)rintf(tile[q * 4160 + (ic * 8 + e) * 65 + j] * inv); qv[e] = r < -127 ? -127 : (r > 127 ? 127 : r); }
                u32x2 w; w.x = (unsigned)((qv[0] & 255) | ((qv[1] & 255) << 8) | ((qv[2] & 255) << 16) | ((qv[3] & 255) << 24));
                w.y = (unsigned)((qv[4] & 255) | ((qv[5] & 255) << 8) | ((qv[6] & 255) << 16) | ((qv[7] & 255) << 24));
                *(u32x2*)(Bt8 + (size_t)(n0 + j) * K + k0 + ic * 8) = w; } }
    }
    __syncthreads();
}
__device__ __forceinline__ void cvt_task(const Fr& F, const float* src, bf16_t* dst, size_t n8) {
    for (size_t i = (size_t)F.bid * NTHR + F.tid; i < n8; i += (size_t)F.G * NTHR) {
        const f32x4 a = *(const f32x4*)(src + i * 8), b = *(const f32x4*)(src + i * 8 + 4);
        u32x4 w; w.x = pk_bf16(a[0], a[1]); w.y = pk_bf16(a[2], a[3]); w.z = pk_bf16(b[0], b[1]); w.w = pk_bf16(b[2], b[3]);
        *(u32x4*)(dst + i * 8) = w;
    }
}
template <bool FP8>
__device__ __forceinline__ void cvt_table(const Fr& F, const float* src, unsigned char* dst, float* scale) {
    const int rstep = F.G * 16;
    f32x4 vn[2][8];
#define CT_LOAD(R0) do { _Pragma("unroll") for (int rr = 0; rr < 2; ++rr) _Pragma("unroll") for (int i = 0; i < 8; ++i) vn[rr][i] = *(const f32x4*)(src + (size_t)((R0) + rr) * 2048 + i * 256 + F.lane * 4); } while (0)
    { const int rf = (F.bid * 8 + F.wave) * 2; if (rf < 16384) CT_LOAD(rf); }
    for (int row0 = (F.bid * 8 + F.wave) * 2; row0 < 16384; row0 += rstep) {
        f32x4 v[2][8];
#pragma unroll
        for (int rr = 0; rr < 2; ++rr)
#pragma unroll
            for (int i = 0; i < 8; ++i) v[rr][i] = vn[rr][i];
        if (row0 + rstep < 16384) CT_LOAD(row0 + rstep);
#pragma unroll
        for (int rr = 0; rr < 2; ++rr) {
            const int row = row0 + rr; float am = 0.f;
#pragma unroll
            for (int i = 0; i < 8; ++i) am = fmaxf(am, fmaxf(fmaxf(fabsf(v[rr][i][0]), fabsf(v[rr][i][1])), fmaxf(fabsf(v[rr][i][2]), fabsf(v[rr][i][3]))));
#pragma unroll
            for (int o = 32; o >= 1; o >>= 1) am = fmaxf(am, __shfl_xor(am, o));
            const float top = FP8 ? 400.0f : 127.0f;
            const float sc = am > 0.f ? am * (1.0f / top) : 1.0f, inv = am > 0.f ? top / am : 1.0f;
#pragma unroll
            for (int i = 0; i < 8; ++i) {
                int p;
                if (FP8) { p = 0; p = __builtin_amdgcn_cvt_pk_fp8_f32(v[rr][i][0] * inv, v[rr][i][1] * inv, p, false); p = __builtin_amdgcn_cvt_pk_fp8_f32(v[rr][i][2] * inv, v[rr][i][3] * inv, p, true); }
                else { int q[4];
#pragma unroll
                    for (int e = 0; e < 4; ++e) { const int t = (int)rintf(v[rr][i][e] * inv); q[e] = t < -127 ? -127 : (t > 127 ? 127 : t); }
                    p = (q[0] & 255) | ((q[1] & 255) << 8) | ((q[2] & 255) << 16) | ((q[3] & 255) << 24); }
                const int e0 = i * 256 + F.lane * 4;
                *(int*)(dst + (size_t)(e0 >> 7) * 2097152 + (size_t)row * 128 + (e0 & 127)) = p; }
            if (F.lane == 0) scale[row] = sc;
        }
    }
#undef CT_LOAD
}
__device__ __forceinline__ void modgemv(const Fr& F, const float* c, const float* c2, const float* W, const float* b, float* out, float* out2, int ncol2) {
    LAS float* s1 = (LAS float*)F.lds;
    LAS float* s2 = s1 + 2048;
    LAS float* red = s2 + 2048;
    LAS float* red2 = red + 42 * 48;
    __syncthreads();
    for (int k = F.tid; k < 2048; k += NTHR) { s1[k] = silu_f(c[k]); s2[k] = c2 ? silu_f(c2[k]) : 0.f; }
    __syncthreads();
    for (int chunk = F.bid; chunk < 256; chunk += F.G) {
        const int col0 = chunk * 48, cq = F.tid % 12, kl = F.tid / 12;
        const bool do2 = (c2 != nullptr) && (col0 < ncol2);
        if (kl < 42) {
            f32x4 a1 = {0.f, 0.f, 0.f, 0.f}, a2 = {0.f, 0.f, 0.f, 0.f};
            const float* wp = W + col0 + cq * 4;
#pragma unroll 8
            for (int k = kl; k < 2048; k += 42) { const f32x4 w = *(const f32x4*)(wp + (size_t)k * 12288); a1 += s1[k] * w; a2 += s2[k] * w; }
#pragma unroll
            for (int e = 0; e < 4; ++e) { red[kl * 48 + cq * 4 + e] = a1[e]; red2[kl * 48 + cq * 4 + e] = a2[e]; }
        }
        __syncthreads();
        if (F.tid < 48) {
            float r1 = 0.f, r2 = 0.f;
            for (int q = 0; q < 42; ++q) { r1 += red[q * 48 + F.tid]; r2 += red2[q * 48 + F.tid]; }
            const float bb = b[col0 + F.tid];
            out[col0 + F.tid] = r1 + bb;
            if (do2 && col0 + F.tid < ncol2) out2[col0 + F.tid] = r2 + bb;
        }
        __syncthreads();
    }
}
__device__ __forceinline__ void rope_tables(const Fr& F, float* rc, float* rs) {
    for (int it = F.bid * NTHR + F.tid; it < SEQ * 32; it += F.G * NTHR) {
        const int t = it >> 5, jj = it & 31, seg = jj >> 4, j = jj & 15;
        const int pos = seg ? (t & 63) : (t >> 6);
        const float inv = powf(10000.0f, -(float)j / 16.0f);
        const float ang = (float)pos * inv;
        float s, c; sincosf(ang, &s, &c);
        rc[it] = c; rs[it] = s;
    }
}
__device__ __forceinline__ void quant_rows(const Fr& F, const bf16_t* X, unsigned char* out8, float* sa) {
    for (int row0 = (F.bid * 8 + F.wave) * 2; row0 < SEQ; row0 += F.G * 16) {
        u32x4 w[2][4];
#pragma unroll
        for (int rr = 0; rr < 2; ++rr)
#pragma unroll
            for (int i = 0; i < 4; ++i) w[rr][i] = *(const u32x4*)(X + (size_t)(row0 + rr) * DM + i * 512 + F.lane * 8);
        __builtin_amdgcn_sched_barrier(0);
#pragma unroll
        for (int rr = 0; rr < 2; ++rr) {
            f32x4 v[8]; float am = 0.f;
#pragma unroll
            for (int i = 0; i < 4; ++i) { v[2 * i] = (f32x4){bf_lo(w[rr][i].x), bf_hi(w[rr][i].x), bf_lo(w[rr][i].y), bf_hi(w[rr][i].y)}; v[2 * i + 1] = (f32x4){bf_lo(w[rr][i].z), bf_hi(w[rr][i].z), bf_lo(w[rr][i].w), bf_hi(w[rr][i].w)}; }
#pragma unroll
            for (int i = 0; i < 8; ++i) am = fmaxf(am, fmaxf(fmaxf(fabsf(v[i][0]), fabsf(v[i][1])), fmaxf(fabsf(v[i][2]), fabsf(v[i][3]))));
#pragma unroll
            for (int o = 32; o >= 1; o >>= 1) am = fmaxf(am, __shfl_xor(am, o));
            const float inv = am > 0.f ? 127.0f / am : 0.f;
#pragma unroll
            for (int i = 0; i < 4; ++i) { u32x2 o;
                { int q[4];
#pragma unroll
                  for (int e = 0; e < 4; ++e) q[e] = (int)rintf(v[2 * i][e] * inv);
                  o.x = (unsigned)((q[0] & 255) | ((q[1] & 255) << 8) | ((q[2] & 255) << 16) | ((q[3] & 255) << 24)); }
                { int q[4];
#pragma unroll
                  for (int e = 0; e < 4; ++e) q[e] = (int)rintf(v[2 * i + 1][e] * inv);
                  o.y = (unsigned)((q[0] & 255) | ((q[1] & 255) << 8) | ((q[2] & 255) << 16) | ((q[3] & 255) << 24)); }
                *(u32x2*)(out8 + (size_t)(row0 + rr) * DM + i * 512 + F.lane * 8) = o; }
            if (F.lane == 0) sa[row0 + rr] = am > 0.f ? am * (1.0f / 127.0f) : 1.0f;
        }
    }
}
template <bool Q8>
__device__ __forceinline__ void norm_rows_b(const Fr& F, const bf16_t* X, const float* g, const float* sc, const float* sh, bf16_t* out, unsigned char* out8 = nullptr, float* sa = nullptr) {
    f32x4 cs[8], cb[8];
#pragma unroll
    for (int i = 0; i < 4; ++i)
#pragma unroll
        for (int hf = 0; hf < 2; ++hf) { const int col = i * 512 + F.lane * 8 + hf * 4; const f32x4 gg = *(const f32x4*)(g + col), a = *(const f32x4*)(sc + col); cs[i * 2 + hf] = gg * (1.0f + a); cb[i * 2 + hf] = *(const f32x4*)(sh + col); }
    for (int row0 = (F.bid * 8 + F.wave) * 2; row0 < SEQ; row0 += F.G * 16) {
        u32x4 w[2][4];
#pragma unroll
        for (int rr = 0; rr < 2; ++rr)
#pragma unroll
            for (int i = 0; i < 4; ++i) w[rr][i] = *(const u32x4*)(X + (size_t)(row0 + rr) * DM + i * 512 + F.lane * 8);
        __builtin_amdgcn_sched_barrier(0);
#pragma unroll
        for (int rr = 0; rr < 2; ++rr) {
            f32x4 v[8]; float ss = 0.f;
#pragma unroll
            for (int i = 0; i < 4; ++i) { v[2 * i] = (f32x4){bf_lo(w[rr][i].x), bf_hi(w[rr][i].x), bf_lo(w[rr][i].y), bf_hi(w[rr][i].y)}; v[2 * i + 1] = (f32x4){bf_lo(w[rr][i].z), bf_hi(w[rr][i].z), bf_lo(w[rr][i].w), bf_hi(w[rr][i].w)}; }
#pragma unroll
            for (int i = 0; i < 8; ++i) ss += v[i][0] * v[i][0] + v[i][1] * v[i][1] + v[i][2] * v[i][2] + v[i][3] * v[i][3];
            ss = wave_sum(ss);
            const float rstd = rsqrtf(ss * (1.0f / DM) + 1e-6f);
            if constexpr (!Q8) {
#pragma unroll
            for (int i = 0; i < 4; ++i) {
                const f32x4 y0 = v[2 * i] * rstd * cs[2 * i] + cb[2 * i], y1 = v[2 * i + 1] * rstd * cs[2 * i + 1] + cb[2 * i + 1];
                u32x4 o; o.x = pk_bf16(y0[0], y0[1]); o.y = pk_bf16(y0[2], y0[3]); o.z = pk_bf16(y1[0], y1[1]); o.w = pk_bf16(y1[2], y1[3]);
                *(u32x4*)(out + (size_t)(row0 + rr) * DM + i * 512 + F.lane * 8) = o;
            }
            } else {
                float am = 0.f;
#pragma unroll
                for (int i = 0; i < 8; ++i) { v[i] = v[i] * rstd * cs[i] + cb[i]; am = fmaxf(am, fmaxf(fmaxf(fabsf(v[i][0]), fabsf(v[i][1])), fmaxf(fabsf(v[i][2]), fabsf(v[i][3])))); }
#pragma unroll
                for (int o = 32; o >= 1; o >>= 1) am = fmaxf(am, __shfl_xor(am, o));
                const float inv = am > 0.f ? 127.0f / am : 0.f;
#pragma unroll
                for (int i = 0; i < 4; ++i) { u32x2 o;
                    { int q[4];
#pragma unroll
                      for (int e = 0; e < 4; ++e) q[e] = (int)rintf(v[2 * i][e] * inv);
                      o.x = (unsigned)((q[0] & 255) | ((q[1] & 255) << 8) | ((q[2] & 255) << 16) | ((q[3] & 255) << 24)); }
                    { int q[4];
#pragma unroll
                      for (int e = 0; e < 4; ++e) q[e] = (int)rintf(v[2 * i + 1][e] * inv);
                      o.y = (unsigned)((q[0] & 255) | ((q[1] & 255) << 8) | ((q[2] & 255) << 16) | ((q[3] & 255) << 24)); }
                    *(u32x2*)(out8 + (size_t)(row0 + rr) * DM + i * 512 + F.lane * 8) = o; }
                if (F.lane == 0) sa[row0 + rr] = am > 0.f ? am * (1.0f / 127.0f) : 1.0f;
            }
        }
    }
}
__device__ __forceinline__ void hyena_filter_gen(const Fr& F, unsigned* KZ, float* FPART) {
    const float* w1 = F.in[I_HYW1]; const float* b1 = F.in[I_HYB1]; const float* f1 = F.in[I_HYF1];
    const float* w2 = F.in[I_HYW2]; const float* b2 = F.in[I_HYB2]; const float* f2 = F.in[I_HYF2];
    const float* w3 = F.in[I_HYW3];
    LAS float* zf = (LAS float*)F.lds;
    LAS float* a1 = zf + 64 * 33;
    LAS bf16_t* a2b = (LAS bf16_t*)(a1 + 64 * 64);
    const int r32 = F.lane & 31, hi = F.lane >> 5;
    const float da = -3.0701134573253944f, db = -15.350567286626972f;
    float psum[8];
#pragma unroll
    for (int cb = 0; cb < 8; ++cb) psum[cb] = 0.f;
    for (int pb = F.bid; pb < SEQ / 64; pb += F.G) {
        const int l0 = pb * 64;
        __syncthreads();
        for (int it = F.tid; it < 64 * 33; it += NTHR) {
            const int pos = it / 33, f = it % 33; const int l = l0 + pos;
            const float t = (float)l / (float)(SEQ - 1);
            const float w = (6.283185307179586f / (float)SEQ) * (float)l;
            float v;
            if (f == 0) v = t;
            else { const int j = (f - 1) & 15; const float band = 1e-4f + (float)j * ((15.0f - 1e-4f) / 15.0f); v = (f <= 16) ? cosf(band * w) : -sinf(band * w); }
            zf[pos * 33 + f] = v;
        }
        __syncthreads();
        for (int it = F.tid; it < 64 * 64; it += NTHR) {
            const int pos = it >> 6, u = it & 63; float s = b1[u];
            for (int f = 0; f < 33; ++f) s += zf[pos * 33 + f] * w1[f * 64 + u];
            a1[pos * 64 + u] = sinf(f1[u] * s);
        }
        __syncthreads();
        for (int it = F.tid; it < 64 * 64; it += NTHR) {
            const int pos = it >> 6, u = it & 63; float s = b2[u];
            for (int v = 0; v < 64; ++v) s += a1[pos * 64 + v] * w2[v * 64 + u];
            a2b[pos * 72 + u] = f2bf(sinf(f2[u] * s));
        }
        __syncthreads();
        bf16x8 af[2][4];
#pragma unroll
        for (int rb = 0; rb < 2; ++rb)
#pragma unroll
            for (int ks = 0; ks < 4; ++ks) af[rb][ks] = *(const LAS bf16x8*)(a2b + (rb * 32 + r32) * 72 + ks * 16 + hi * 8);
#pragma unroll 1
        for (int cb = 0; cb < 8; ++cb) {
            const int gcol = F.wave * 256 + cb * 32 + r32;
            f32x16 acc[2] = {};
#pragma unroll
            for (int ks = 0; ks < 4; ++ks) {
                float wv[8];
#pragma unroll
                for (int j = 0; j < 8; ++j) wv[j] = w3[(size_t)(ks * 16 + hi * 8 + j) * 2048 + gcol];
                u32x4 bw; bw.x = pk_bf16(wv[0], wv[1]); bw.y = pk_bf16(wv[2], wv[3]); bw.z = pk_bf16(wv[4], wv[5]); bw.w = pk_bf16(wv[6], wv[7]);
                const bf16x8 bf = *(bf16x8*)&bw;
                acc[0] = __builtin_amdgcn_mfma_f32_32x32x16_bf16(af[0][ks], bf, acc[0], 0, 0, 0);
                acc[1] = __builtin_amdgcn_mfma_f32_32x32x16_bf16(af[1][ks], bf, acc[1], 0, 0, 0);
            }
            const bool bwd = gcol >= 1024; const int c = gcol & 1023;
            const float dl2 = fabsf(da + (float)c * ((db - da) / 1023.0f)) * 1.4426950408889634f;
            float ps = 0.f;
#pragma unroll
            for (int rb = 0; rb < 2; ++rb)
#pragma unroll
                for (int rr = 0; rr < 16; ++rr) {
                    const int l = l0 + rb * 32 + (rr & 3) + 8 * (rr >> 2) + 4 * hi;
                    const float t = (float)l / (float)(SEQ - 1);
                    const float v = acc[rb][rr] * __builtin_amdgcn_exp2f(-t * dl2);
                    const float vn = dpp_f32_quad_swap1(v);
                    const bool keep = !(bwd && l == 0);
                    if (keep) ps += fabsf(v);
                    if (keep && (r32 & 1) == 0) KZ[(size_t)(bwd ? 2 * SEQ - l : l) * ZP + (c >> 1)] = pk_h2((f32x2){v, vn});
                }
            psum[cb] += ps;
        }
    }
#pragma unroll
    for (int cb = 0; cb < 8; ++cb) {
        auto sw = __builtin_amdgcn_permlane32_swap(__float_as_uint(psum[cb]), __float_as_uint(psum[cb]), false, false);
        const float tot = __uint_as_float(sw[0]) + __uint_as_float(sw[1]);
        if (hi == 0) FPART[(size_t)F.bid * 2048 + F.wave * 256 + cb * 32 + r32] = tot;
    }
    if (F.bid == 0) for (int c = F.tid; c < 512; c += NTHR) KZ[(size_t)SEQ * ZP + c] = 0u;
}
__device__ __forceinline__ void hyena_filter_norm(const Fr& F, const float* FPART, float* FNORM) {
    for (int c = F.bid * 8 + F.wave; c < 1024; c += F.G * 8) {
        float s = 0.f;
        for (int b = F.lane; b < F.G; b += 64) s += FPART[(size_t)b * 2048 + c] + FPART[(size_t)b * 2048 + 1024 + c];
        s = wave_sum(s);
        if (F.lane == 0) FNORM[c] = 1.0f / (s + 1e-6f);
    }
}

template <bool Q8>
__device__ __forceinline__ void norm_rows(const Fr& F, const float* X, int nrows, const float* g, const float* sc, const float* sh, bf16_t* out, unsigned char* out8 = nullptr, float* sa = nullptr) {
    f32x4 cs[8], cb[8];
#pragma unroll
    for (int i = 0; i < 8; ++i) { const int col = i * 256 + F.lane * 4; const f32x4 gg = *(const f32x4*)(g + col), a = *(const f32x4*)(sc + col); cs[i] = gg * (1.0f + a); cb[i] = *(const f32x4*)(sh + col); }
    for (int row0 = (F.bid * 8 + F.wave) * 2; row0 < nrows; row0 += F.G * 16) {
        f32x4 v[2][8];
#pragma unroll
        for (int i = 0; i < 8; ++i) { v[0][i] = *(const f32x4*)(X + (size_t)row0 * DM + i * 256 + F.lane * 4); v[1][i] = *(const f32x4*)(X + (size_t)(row0 + 1) * DM + i * 256 + F.lane * 4); }
        __builtin_amdgcn_sched_barrier(0);
#pragma unroll
        for (int rr = 0; rr < 2; ++rr) {
            float ss = 0.f;
#pragma unroll
            for (int i = 0; i < 8; ++i) ss += v[rr][i][0] * v[rr][i][0] + v[rr][i][1] * v[rr][i][1] + v[rr][i][2] * v[rr][i][2] + v[rr][i][3] * v[rr][i][3];
            ss = wave_sum(ss);
            const float rstd = rsqrtf(ss * (1.0f / DM) + 1e-6f);
            if constexpr (!Q8) {
#pragma unroll
            for (int i = 0; i < 8; ++i) {
                const f32x4 y = v[rr][i] * rstd * cs[i] + cb[i];
                u32x2 w; w.x = pk_bf16(y[0], y[1]); w.y = pk_bf16(y[2], y[3]);
                *(u32x2*)(out + (size_t)(row0 + rr) * DM + i * 256 + F.lane * 4) = w;
            }
            } else {
                float am = 0.f;
#pragma unroll
                for (int i = 0; i < 8; ++i) { v[rr][i] = v[rr][i] * rstd * cs[i] + cb[i]; am = fmaxf(am, fmaxf(fmaxf(fabsf(v[rr][i][0]), fabsf(v[rr][i][1])), fmaxf(fabsf(v[rr][i][2]), fabsf(v[rr][i][3])))); }
#pragma unroll
                for (int o = 32; o >= 1; o >>= 1) am = fmaxf(am, __shfl_xor(am, o));
                const float inv = am > 0.f ? 127.0f / am : 0.f;
#pragma unroll
                for (int i = 0; i < 8; ++i) { int q[4];
#pragma unroll
                    for (int e = 0; e < 4; ++e) q[e] = (int)rintf(v[rr][i][e] * inv);
                    *(unsigned*)(out8 + (size_t)(row0 + rr) * DM + i * 256 + F.lane * 4) = (unsigned)((q[0] & 255) | ((q[1] & 255) << 8) | ((q[2] & 255) << 16) | ((q[3] & 255) << 24)); }
                if (F.lane == 0) sa[row0 + rr] = am > 0.f ? am * (1.0f / 127.0f) : 1.0f;
            }
        }
    }
}

__device__ __forceinline__ void l0_post_proj(const Fr& F, const bf16_t* PB, bf16_t* QN, bf16_t* KVN, bf16_t* KROPE, bf16_t* YCAT,
                                             const float* rc, const float* rs, int nrows) {
    const float* qg = F.in[I_QNG0]; const float* kvg = F.in[I_KVNG0]; const float* cw = F.in[I_CONVW0];
    for (int tb = (F.bid * 8 + F.wave) * 4; tb < nrows; tb += F.G * 32) {
        u32x4 wq[4]; u32x2 wk[4]; bf16_t wr[4]; float rcv[4], rsv[4];
        const int seg = F.lane >> 5, half = (F.lane >> 4) & 1, j = F.lane & 15;
#pragma unroll
        for (int u = 0; u < 4; ++u) { const int t = (tb + u < nrows) ? tb + u : tb; const bf16_t* pr = PB + (size_t)t * 4096;
            wq[u] = (t < SEQ) ? *(const u32x4*)(pr + 3072 + F.lane * 8) : (u32x4){0u, 0u, 0u, 0u};
            wk[u] = *(const u32x2*)(pr + 3584 + F.lane * 4); wr[u] = pr[3840 + F.lane];
            rcv[u] = (t < SEQ) ? rc[(size_t)t * 32 + seg * 16 + j] : 1.f; rsv[u] = (t < SEQ) ? rs[(size_t)t * 32 + seg * 16 + j] : 0.f; }
#pragma unroll
        for (int u = 0; u < 4; ++u) {
            const int t = tb + u; if (t >= nrows) break;
            if (t < SEQ) {
                const u32x4 w = wq[u];
                float v[8] = {bf_lo(w.x), bf_hi(w.x), bf_lo(w.y), bf_hi(w.y), bf_lo(w.z), bf_hi(w.z), bf_lo(w.w), bf_hi(w.w)};
                float ss = 0.f;
#pragma unroll
                for (int e = 0; e < 8; ++e) ss += v[e] * v[e];
                ss = wave_sum(ss);
                const float rstd = rsqrtf(ss * (1.0f / 512.0f) + 1e-6f);
                const f32x4 g0 = *(const f32x4*)(qg + F.lane * 8), g1 = *(const f32x4*)(qg + F.lane * 8 + 4);
                u32x4 o; o.x = pk_bf16(v[0] * rstd * g0[0], v[1] * rstd * g0[1]); o.y = pk_bf16(v[2] * rstd * g0[2], v[3] * rstd * g0[3]);
                o.z = pk_bf16(v[4] * rstd * g1[0], v[5] * rstd * g1[1]); o.w = pk_bf16(v[6] * rstd * g1[2], v[7] * rstd * g1[3]);
                *(u32x4*)(QN + (size_t)t * 512 + F.lane * 8) = o;
            }
            {
                const u32x2 w = wk[u];
                float v[4] = {bf_lo(w.x), bf_hi(w.x), bf_lo(w.y), bf_hi(w.y)};
                float ss = v[0] * v[0] + v[1] * v[1] + v[2] * v[2] + v[3] * v[3];
                ss = wave_sum(ss);
                const float rstd = rsqrtf(ss * (1.0f / 256.0f) + 1e-6f);
                const f32x4 g0 = *(const f32x4*)(kvg + F.lane * 4);
                u32x2 o; o.x = pk_bf16(v[0] * rstd * g0[0], v[1] * rstd * g0[1]); o.y = pk_bf16(v[2] * rstd * g0[2], v[3] * rstd * g0[3]);
                *(u32x2*)(KVN + (size_t)t * 256 + F.lane * 4) = o;
            }
            {
                const float uu = bf1(wr[u]);
                const float up = __shfl_xor(uu, 16);
                const float o = uu * rcv[u] + (half ? up : -up) * rsv[u];
                KROPE[(size_t)t * 64 + F.lane] = f2bf(o);
            }
        }
    }
    {
        const int cg = F.tid & 127, c0 = cg * 8;
        float w0[8], w1[8], w2[8];
#pragma unroll
        for (int e = 0; e < 8; ++e) { w0[e] = cw[c0 + e]; w1[e] = cw[1024 + c0 + e]; w2[e] = cw[2048 + c0 + e]; }
        for (int t = F.bid * 4 + (F.tid >> 7); t < SEQ; t += F.G * 4) {
            u32x4 a[3], h[3];
#pragma unroll
            for (int dt = 0; dt < 3; ++dt) { const int tt = t + dt - 1; const bool ok = (tt >= 0) && (tt < SEQ);
                a[dt] = ok ? *(const u32x4*)(PB + (size_t)tt * 4096 + 1024 + c0) : (u32x4){0u, 0u, 0u, 0u};
                h[dt] = ok ? *(const u32x4*)(PB + (size_t)tt * 4096 + 2048 + c0) : (u32x4){0u, 0u, 0u, 0u}; }
            const u32x4 gb = *(const u32x4*)(PB + (size_t)t * 4096 + c0);
            float y[8];
#pragma unroll
            for (int q = 0; q < 4; ++q) {
                y[2 * q] = bf_lo(gb[q]) * (w0[2 * q] * bf_lo(a[0][q]) * bf_lo(h[0][q]) + w1[2 * q] * bf_lo(a[1][q]) * bf_lo(h[1][q]) + w2[2 * q] * bf_lo(a[2][q]) * bf_lo(h[2][q]));
                y[2 * q + 1] = bf_hi(gb[q]) * (w0[2 * q + 1] * bf_hi(a[0][q]) * bf_hi(h[0][q]) + w1[2 * q + 1] * bf_hi(a[1][q]) * bf_hi(h[1][q]) + w2[2 * q + 1] * bf_hi(a[2][q]) * bf_hi(h[2][q]));
            }
            *(u32x4*)(YCAT + (size_t)t * 2048 + c0) = (u32x4){pk_bf16(y[0], y[1]), pk_bf16(y[2], y[3]), pk_bf16(y[4], y[5]), pk_bf16(y[6], y[7])};
        }
    }
}

struct EpiBf16G {
    static constexpr bool PERM = true, AFTER_DRAIN = false, I8 = false;
    bf16_t* O; int ldc; int act_cols;
    __device__ __forceinline__ void operator()(const f32x4 (&acc)[2][2][4][2], const pg8::Unit& u, int wr, int wc, int fr, int fq) const {
        const int row0 = u.pm * 256 + wr * 64 + fr, col0 = u.pn * 256 + wc * 32 + 8 * fq;
        const bool act = (u.pn * 256) < act_cols;
#pragma unroll
        for (int ai = 0; ai < 2; ++ai)
#pragma unroll
            for (int m = 0; m < 4; ++m) { bf16_t* rowp = O + (size_t)(row0 + ai * 128 + m * 16) * ldc + col0;
#pragma unroll
                for (int bj = 0; bj < 2; ++bj) { f32x4 v0 = acc[ai][bj][m][0], v1 = acc[ai][bj][m][1];
                    if (act) {
#pragma unroll
                        for (int e = 0; e < 4; ++e) { v0[e] = gelu_tanh(v0[e]); v1[e] = gelu_tanh(v1[e]); } }
                    u32x4 w; w.x = pk_bf16(v0[0], v0[1]); w.y = pk_bf16(v0[2], v0[3]); w.z = pk_bf16(v1[0], v1[1]); w.w = pk_bf16(v1[2], v1[3]);
                    *(u32x4*)(rowp + bj * 128) = w; } }
    }
};
struct EpiI8G {
    static constexpr bool PERM = true, AFTER_DRAIN = false, I8 = true;
    bf16_t* O; int ldc; int act_cols; const float* sa; const float* sw;
    __device__ __forceinline__ void operator()(const f32x4 (&acc)[2][2][4][2], const pg8::Unit& u, int wr, int wc, int fr, int fq) const {
        const int row0 = u.pm * 256 + wr * 64 + fr, col0 = u.pn * 256 + wc * 32 + 8 * fq;
        const bool act = (u.pn * 256) < act_cols;
        f32x4 cw[2][2];
#pragma unroll
        for (int bj = 0; bj < 2; ++bj) { cw[bj][0] = *(const f32x4*)(sw + col0 + bj * 128); cw[bj][1] = *(const f32x4*)(sw + col0 + bj * 128 + 4); }
#pragma unroll
        for (int ai = 0; ai < 2; ++ai)
#pragma unroll
            for (int m = 0; m < 4; ++m) { const int row = row0 + ai * 128 + m * 16; bf16_t* rowp = O + (size_t)row * ldc + col0; const float rs = sa[row];
#pragma unroll
                for (int bj = 0; bj < 2; ++bj) { f32x4 v0, v1;
#pragma unroll
                    for (int e = 0; e < 4; ++e) { v0[e] = (float)__float_as_int(acc[ai][bj][m][0][e]) * rs * cw[bj][0][e]; v1[e] = (float)__float_as_int(acc[ai][bj][m][1][e]) * rs * cw[bj][1][e]; }
                    if (act) {
#pragma unroll
                        for (int e = 0; e < 4; ++e) { v0[e] = gelu_tanh(v0[e]); v1[e] = gelu_tanh(v1[e]); } }
                    u32x4 w; w.x = pk_bf16(v0[0], v0[1]); w.y = pk_bf16(v0[2], v0[3]); w.z = pk_bf16(v1[0], v1[1]); w.w = pk_bf16(v1[2], v1[3]);
                    *(u32x4*)(rowp + bj * 128) = w; } }
    }
};
struct EpiQRope {
    static constexpr bool PERM = false, AFTER_DRAIN = false, I8 = false;
    bf16_t* Q; const float* rc; const float* rs;
    __device__ __forceinline__ void operator()(const f32x4 (&acc)[2][2][4][2], const pg8::Unit& u, int wr, int wc, int fr, int fq) const {
#pragma unroll
        for (int ai = 0; ai < 2; ++ai)
#pragma unroll
            for (int m = 0; m < 4; ++m) {
                const int row = u.pm * 256 + ai * 128 + wr * 64 + m * 16 + fr;
#pragma unroll
                for (int bj = 0; bj < 2; ++bj) {
                    const int cbase = u.pn * 256 + bj * 128 + wc * 32;
                    const bool rope = ((cbase >> 6) % 3) == 2; const int seg = (cbase >> 5) & 1;
                    f32x4 v0 = acc[ai][bj][m][0], v1 = acc[ai][bj][m][1];
                    if (rope) {
                        const f32x4 cs = *(const f32x4*)(rc + (size_t)row * 32 + seg * 16 + 4 * fq), sn = *(const f32x4*)(rs + (size_t)row * 32 + seg * 16 + 4 * fq);
                        const f32x4 o0 = v0 * cs - v1 * sn, o1 = v1 * cs + v0 * sn; v0 = o0; v1 = o1;
                    }
                    u32x2 w0, w1; w0.x = pk_bf16(v0[0], v0[1]); w0.y = pk_bf16(v0[2], v0[3]); w1.x = pk_bf16(v1[0], v1[1]); w1.y = pk_bf16(v1[2], v1[3]);
                    bf16_t* p = Q + (size_t)row * 1536 + cbase + 4 * fq;
                    *(u32x2*)p = w0; *(u32x2*)(p + 16) = w1;
                }
            }
    }
};
template <bool BASEF, bool Q8 = false>
struct EpiResid {
    static constexpr bool PERM = true, AFTER_DRAIN = false, I8 = Q8;
    const void* base; bf16_t* out; const float* gate; const float* sa; const float* sw;
    __device__ __forceinline__ void operator()(const f32x4 (&acc)[2][2][4][2], const pg8::Unit& u, int wr, int wc, int fr, int fq) const {
        const int row0 = u.pm * 256 + wr * 64 + fr, col0 = u.pn * 256 + wc * 32 + 8 * fq;
        f32x4 gv[2][2];
#pragma unroll
        for (int bj = 0; bj < 2; ++bj)
#pragma unroll
            for (int n = 0; n < 2; ++n) { gv[bj][n] = *(const f32x4*)(gate + col0 + bj * 128 + n * 4); if (Q8) gv[bj][n] *= *(const f32x4*)(sw + col0 + bj * 128 + n * 4); }
#pragma unroll
        for (int ai = 0; ai < 2; ++ai)
#pragma unroll
            for (int m = 0; m < 4; ++m) { const size_t off = (size_t)(row0 + ai * 128 + m * 16) * DM + col0; const float rs = Q8 ? sa[row0 + ai * 128 + m * 16] : 1.0f;
                f32x4 bs[2][2];
#pragma unroll
                for (int bj = 0; bj < 2; ++bj) {
                    if (BASEF) { bs[bj][0] = *(const f32x4*)((const float*)base + off + bj * 128); bs[bj][1] = *(const f32x4*)((const float*)base + off + bj * 128 + 4); }
                    else { const u32x4 w = *(const u32x4*)((const bf16_t*)base + off + bj * 128); bs[bj][0] = (f32x4){bf_lo(w.x), bf_hi(w.x), bf_lo(w.y), bf_hi(w.y)}; bs[bj][1] = (f32x4){bf_lo(w.z), bf_hi(w.z), bf_lo(w.w), bf_hi(w.w)}; } }
#pragma unroll
                for (int bj = 0; bj < 2; ++bj) { f32x4 a0 = acc[ai][bj][m][0], a1 = acc[ai][bj][m][1];
                    if (Q8) {
#pragma unroll
                        for (int e = 0; e < 4; ++e) { a0[e] = (float)__float_as_int(a0[e]) * rs; a1[e] = (float)__float_as_int(a1[e]) * rs; } }
                    const f32x4 v0 = bs[bj][0] + gv[bj][0] * a0, v1 = bs[bj][1] + gv[bj][1] * a1;
                    u32x4 w; w.x = pk_bf16(v0[0], v0[1]); w.y = pk_bf16(v0[2], v0[3]); w.z = pk_bf16(v1[0], v1[1]); w.w = pk_bf16(v1[2], v1[3]);
                    *(u32x4*)(out + off + bj * 128) = w; } }
    }
};
struct OrderIn0 : pg8::StaticOrder {
    int rounds;
    __device__ void init2(int G_, int c_) { init(SEQ, 4096, G_, c_); rounds = (nwg + G - 1) / G; }
    __device__ bool next(int i, pg8::Unit& u) const {
        if (pg8::StaticOrder::next(i, u)) return true;
        if (i == rounds && c < 2) { u.pm = 64; u.pn = 14 + c; return true; }
        return false;
    }
};

struct OrderKV : pg8::StaticOrder {
    __device__ bool next(int i, pg8::Unit& u) const {
        if (G != 256 || nwg != 520) return pg8::StaticOrder::next(i, u);
        int L;
        if (c >= 128) { if (i > 2) return false; L = i * 128 + (c - 128); }
        else { if (i == 0) L = 384 + c; else if (i == 1 && c < 8) L = 512 + c; else return false; }
        pg8::StaticOrder t = *this; t.c = L % G;
        return t.pg8::StaticOrder::next(L / G, u);
    }
};
namespace att {
constexpr int KVBLK = 64;
constexpr float SCALE = 0.07216878364870322f;
constexpr float THR = 8.f;
constexpr int LDQ = 1536, LDK = 2048, LDKR = 64, LDO = 2048;
#define KSWZ(row, colB) ((row) * 256 + ((colB) ^ (((row) & 15) << 4)))
#define KRSWZ(row, colB) ((row) * 128 + ((colB) ^ ((((row) >> 1) & 7) << 4)))
#define SBAR() __builtin_amdgcn_sched_barrier(0)
__device__ __forceinline__ int crow(int r, int hi) { return (r & 3) + 8 * (r >> 2) + 4 * hi; }

__device__ __forceinline__ void partialSM(f32x16& p0, f32x16& p1, float& m_reg, float& mn, float& alpha) {
    constexpr float C = SCALE * 1.4426950408889634f;
    float pmax = p0[0];
#pragma unroll
    for (int r = 1; r < 16; ++r) pmax = fmaxf(pmax, p0[r]);
#pragma unroll
    for (int r = 0; r < 16; ++r) pmax = fmaxf(pmax, p1[r]);
    { auto rr = __builtin_amdgcn_permlane32_swap(__float_as_uint(pmax), __float_as_uint(pmax), false, false);
      pmax = fmaxf(__uint_as_float(rr[0]), __uint_as_float(rr[1])); }
    const bool keep = __all(pmax - m_reg <= THR / SCALE);
    mn = keep ? m_reg : fmaxf(m_reg, pmax); alpha = __builtin_amdgcn_exp2f((m_reg - mn) * C); m_reg = mn;
    const float mnC = -mn * C;
#pragma unroll
    for (int r = 0; r < 16; ++r) p0[r] = fmaf(p0[r], C, mnC);
#pragma unroll
    for (int r = 0; r < 16; ++r) p1[r] = fmaf(p1[r], C, mnC);
#pragma unroll
    for (int r = 0; r < 8; ++r) p0[r] = __builtin_amdgcn_exp2f(p0[r]);
}
#define PK4(P, BASE, OUT) do { unsigned a0 = pk_bf16(P[BASE + 0], P[BASE + 1]), a1 = pk_bf16(P[BASE + 2], P[BASE + 3]);   \
    unsigned b0 = pk_bf16(P[BASE + 4], P[BASE + 5]), b1 = pk_bf16(P[BASE + 6], P[BASE + 7]);                              \
    auto r0 = __builtin_amdgcn_permlane32_swap(a0, b0, false, false); auto r1 = __builtin_amdgcn_permlane32_swap(a1, b1, false, false); \
    u32x4 w = {r0[0], r1[0], r0[1], r1[1]}; OUT = *reinterpret_cast<bf16x8*>(&w); } while (0)
__device__ __forceinline__ void finishSM(f32x16& p0, f32x16& p1, float alpha, float& l_reg, bf16x8& pa0, bf16x8& pa1, bf16x8& pa2, bf16x8& pa3) {
#pragma unroll
    for (int r = 8; r < 16; ++r) p0[r] = __builtin_amdgcn_exp2f(p0[r]);
#pragma unroll
    for (int r = 0; r < 16; ++r) p1[r] = __builtin_amdgcn_exp2f(p1[r]);
    float ps = 0;
#pragma unroll
    for (int r = 0; r < 16; ++r) ps += p0[r];
#pragma unroll
    for (int r = 0; r < 16; ++r) ps += p1[r];
    { auto rr = __builtin_amdgcn_permlane32_swap(__float_as_uint(ps), __float_as_uint(ps), false, false);
      ps = __uint_as_float(rr[0]) + __uint_as_float(rr[1]); }
    l_reg = l_reg * alpha + ps;
    PK4(p0, 0, pa0); PK4(p0, 8, pa1); PK4(p1, 0, pa2); PK4(p1, 8, pa3);
}
template <int S> __device__ __forceinline__ void fin_piece(f32x16& p0, f32x16& p1, float& ps, bf16x8& pa0, bf16x8& pa1, bf16x8& pa2) {
    if constexpr (S < 8) p0[8 + S] = __builtin_amdgcn_exp2f(p0[8 + S]); else p1[S - 8] = __builtin_amdgcn_exp2f(p1[S - 8]);
    if constexpr (S == 0) ps = p0[0] + p0[1]; else if constexpr (S < 7) ps += p0[S + 1];
    if constexpr (S >= 1 && S <= 8) ps += p0[7 + S]; else if constexpr (S >= 9) ps += p1[S - 9];
    if constexpr (S == 8) PK4(p0, 0, pa0);
    if constexpr (S == 10) PK4(p0, 8, pa1);
    if constexpr (S == 18) PK4(p1, 0, pa2);
}
template <int S> __device__ __forceinline__ void part_piece(f32x16& o0, f32x16& o1, float& ps, float al_old, float& l_reg, bf16x8& pa3,
                                                           f32x16& q0, f32x16& q1, float (&t)[4], float& m_reg, float& mn, float& alpha, float& mnC) {
    constexpr float C = SCALE * 1.4426950408889634f;
    if constexpr (S == 0) { ps += o1[15]; auto rr = __builtin_amdgcn_permlane32_swap(__float_as_uint(ps), __float_as_uint(ps), false, false);
                            ps = __uint_as_float(rr[0]) + __uint_as_float(rr[1]); l_reg = l_reg * al_old + ps; }
    if constexpr (S == 1) PK4(o1, 8, pa3);
    if constexpr (S == 2) { float m = q0[0];
#pragma unroll
        for (int r = 1; r < 8; ++r) m = fmaxf(m, q0[r]); t[0] = m; }
    if constexpr (S == 3) { float m = q0[8];
#pragma unroll
        for (int r = 9; r < 16; ++r) m = fmaxf(m, q0[r]); t[1] = m; }
    if constexpr (S == 4) { float m = q1[0];
#pragma unroll
        for (int r = 1; r < 8; ++r) m = fmaxf(m, q1[r]); t[2] = m; }
    if constexpr (S == 5) { float m = q1[8];
#pragma unroll
        for (int r = 9; r < 16; ++r) m = fmaxf(m, q1[r]); t[3] = m; }
    if constexpr (S == 6) { float pmax = fmaxf(fmaxf(t[0], t[1]), fmaxf(t[2], t[3]));
        auto rr = __builtin_amdgcn_permlane32_swap(__float_as_uint(pmax), __float_as_uint(pmax), false, false);
        t[0] = fmaxf(__uint_as_float(rr[0]), __uint_as_float(rr[1])); }
    if constexpr (S == 7) { const bool keep = __all(t[0] - m_reg <= THR / SCALE);
        mn = keep ? m_reg : fmaxf(m_reg, t[0]); alpha = __builtin_amdgcn_exp2f((m_reg - mn) * C); m_reg = mn; mnC = -mn * C; }
    if constexpr (S >= 8 && S < 12) {
#pragma unroll
        for (int r = 0; r < 4; ++r) q0[(S - 8) * 4 + r] = fmaf(q0[(S - 8) * 4 + r], C, mnC); }
    if constexpr (S >= 12) {
#pragma unroll
        for (int r = 0; r < 4; ++r) q1[(S - 12) * 4 + r] = fmaf(q1[(S - 12) * 4 + r], C, mnC); }
    if constexpr (S >= 9) q0[S - 9] = __builtin_amdgcn_exp2f(q0[S - 9]);
    if constexpr (S == 15) q0[7] = __builtin_amdgcn_exp2f(q0[7]);
}
__device__ __forceinline__ int v_st(int k, int c) { const int kk = (k & ~0xC) | ((k & 4) << 1) | ((k & 8) >> 1); return ((kk >> 3) * 4 + (c >> 5)) * 512 + ((kk & 7) * 32 + (c & 31)) * 2; }
__device__ __forceinline__ int v_rd_base(int lane) { return ((lane & 3) << 3) | (((lane >> 2) & 3) << 6) | (((lane >> 4) & 1) << 5) | (((lane >> 5) & 1) << 8); }
constexpr int v_rd_off(int d0, int ks, int half) { return d0 * 512 + ks * 4096 + half * 2048; }
template <int OFF> __device__ __forceinline__ s16x4 tr_read(int vb) {
    s16x4 r; asm volatile("ds_read_b64_tr_b16 %0, %1 offset:%2" : "=&v"(r) : "v"(vb), "i"(OFF) : "memory"); return r;
}
struct VFrag { s16x4 l0, h0, l1, h1, l2, h2, l3, h3; };
template <int D0> __device__ __forceinline__ void pv_read(VFrag& f, int vb) {
    f.l0 = tr_read<v_rd_off(D0, 0, 0)>(vb); f.h0 = tr_read<v_rd_off(D0, 0, 1)>(vb); f.l1 = tr_read<v_rd_off(D0, 1, 0)>(vb); f.h1 = tr_read<v_rd_off(D0, 1, 1)>(vb);
    f.l2 = tr_read<v_rd_off(D0, 2, 0)>(vb); f.h2 = tr_read<v_rd_off(D0, 2, 1)>(vb); f.l3 = tr_read<v_rd_off(D0, 3, 0)>(vb); f.h3 = tr_read<v_rd_off(D0, 3, 1)>(vb);
}
__device__ __forceinline__ void pv_mma(f32x16& od, const VFrag& f, bf16x8 pa0, bf16x8 pa1, bf16x8 pa2, bf16x8 pa3) {
#define PKV(L, H) (bf16x8){L[0], L[1], L[2], L[3], H[0], H[1], H[2], H[3]}
    od = __builtin_amdgcn_mfma_f32_32x32x16_bf16(pa0, PKV(f.l0, f.h0), od, 0, 0, 0);
    od = __builtin_amdgcn_mfma_f32_32x32x16_bf16(pa1, PKV(f.l1, f.h1), od, 0, 0, 0);
    od = __builtin_amdgcn_mfma_f32_32x32x16_bf16(pa2, PKV(f.l2, f.h2), od, 0, 0, 0);
    od = __builtin_amdgcn_mfma_f32_32x32x16_bf16(pa3, PKV(f.l3, f.h3), od, 0, 0, 0);
#undef PKV
}
__device__ __forceinline__ void pv_d0(f32x16* o, int vb, bf16x8 pa0, bf16x8 pa1, bf16x8 pa2, bf16x8 pa3) {
    VFrag fa, fb;
    pv_read<0>(fa, vb); pv_read<1>(fb, vb);
    asm volatile("s_waitcnt lgkmcnt(8)" ::: "memory"); SBAR(); pv_mma(o[0], fa, pa0, pa1, pa2, pa3); SBAR();
    pv_read<2>(fa, vb);
    asm volatile("s_waitcnt lgkmcnt(8)" ::: "memory"); SBAR(); pv_mma(o[1], fb, pa0, pa1, pa2, pa3); SBAR();
    pv_read<3>(fb, vb);
    asm volatile("s_waitcnt lgkmcnt(8)" ::: "memory"); SBAR(); pv_mma(o[2], fa, pa0, pa1, pa2, pa3); SBAR();
    asm volatile("s_waitcnt lgkmcnt(0)" ::: "memory"); SBAR(); pv_mma(o[3], fb, pa0, pa1, pa2, pa3);
}
constexpr int SLOTB = 40960, S_V = 0, S_KN = 16384, S_KR = 32768, OFF_QR = 3 * SLOTB, OFF_WS2 = OFF_QR + 32768, LDS_ATT2 = OFF_WS2 + 2048;
static_assert(LDS_ATT2 <= LDS_CTL, "attention LDS");
__device__ __forceinline__ void qkt2(f32x16& p0, f32x16& p1, const LAS unsigned char* slot, const LAS unsigned char* qrp, const bf16x8 (&qr)[8], int r32, int hi) {
    p0 = f32x16{}; p1 = f32x16{};
    const LAS unsigned char* Kn = slot + S_KN; const LAS unsigned char* Kr = slot + S_KR;
    bf16x8 a0 = *(const LAS bf16x8*)(Kn + KSWZ(r32, (hi * 8) * 2)), a1 = *(const LAS bf16x8*)(Kn + KSWZ(32 + r32, (hi * 8) * 2));
#pragma unroll
    for (int d0 = 0; d0 < 8; ++d0) {
        bf16x8 n0, n1;
        if (d0 < 7) { const int cb = ((d0 + 1) * 16 + hi * 8) * 2; n0 = *(const LAS bf16x8*)(Kn + KSWZ(r32, cb)); n1 = *(const LAS bf16x8*)(Kn + KSWZ(32 + r32, cb)); }
        else { const int cb = (hi * 8) * 2; n0 = *(const LAS bf16x8*)(Kr + KRSWZ(r32, cb)); n1 = *(const LAS bf16x8*)(Kr + KRSWZ(32 + r32, cb)); }
        p0 = __builtin_amdgcn_mfma_f32_32x32x16_bf16(a0, qr[d0], p0, 0, 0, 0);
        p1 = __builtin_amdgcn_mfma_f32_32x32x16_bf16(a1, qr[d0], p1, 0, 0, 0);
        a0 = n0; a1 = n1;
    }
    bf16x8 qq = *(const LAS bf16x8*)(qrp + (((hi * 8) * 2) ^ (((r32 >> 1) & 7) << 4)));
#pragma unroll
    for (int d0 = 0; d0 < 4; ++d0) {
        bf16x8 n0, n1, nq;
        if (d0 < 3) { const int cb = ((d0 + 1) * 16 + hi * 8) * 2; n0 = *(const LAS bf16x8*)(Kr + KRSWZ(r32, cb)); n1 = *(const LAS bf16x8*)(Kr + KRSWZ(32 + r32, cb)); nq = *(const LAS bf16x8*)(qrp + (cb ^ (((r32 >> 1) & 7) << 4))); }
        p0 = __builtin_amdgcn_mfma_f32_32x32x16_bf16(a0, qq, p0, 0, 0, 0);
        p1 = __builtin_amdgcn_mfma_f32_32x32x16_bf16(a1, qq, p1, 0, 0, 0);
        if (d0 < 3) { a0 = n0; a1 = n1; qq = nq; }
    }
}
__device__ __forceinline__ void s1_step(f32x16& q0, f32x16& q1, const LAS unsigned char* slot, const LAS unsigned char* qrp, const bf16x8 (&qr)[8], int r32, int hi,
                                        f32x16& p0, f32x16& p1, float& ps, bf16x8& pa0, bf16x8& pa1, bf16x8& pa2) {
    q0 = f32x16{}; q1 = f32x16{};
    const LAS unsigned char* Kn = slot + S_KN; const LAS unsigned char* Kr = slot + S_KR;
    bf16x8 a0 = *(const LAS bf16x8*)(Kn + KSWZ(r32, (hi * 8) * 2)), a1 = *(const LAS bf16x8*)(Kn + KSWZ(32 + r32, (hi * 8) * 2)), qq = a0;
#define S1_STEP(D) do { bf16x8 n0 = a0, n1 = a1, nq = qq; \
        if ((D) < 7) { const int cb = (((D) + 1) * 16 + hi * 8) * 2; n0 = *(const LAS bf16x8*)(Kn + KSWZ(r32, cb)); n1 = *(const LAS bf16x8*)(Kn + KSWZ(32 + r32, cb)); } \
        else if ((D) < 11) { const int cb = (((D) - 7) * 16 + hi * 8) * 2; n0 = *(const LAS bf16x8*)(Kr + KRSWZ(r32, cb)); n1 = *(const LAS bf16x8*)(Kr + KRSWZ(32 + r32, cb)); \
                             nq = *(const LAS bf16x8*)(qrp + (cb ^ (((r32 >> 1) & 7) << 4))); } \
        q0 = __builtin_amdgcn_mfma_f32_32x32x16_bf16(a0, (D) < 8 ? qr[(D) & 7] : qq, q0, 0, 0, 0); fin_piece<2 * (D)>(p0, p1, ps, pa0, pa1, pa2); SBAR(); \
        q1 = __builtin_amdgcn_mfma_f32_32x32x16_bf16(a1, (D) < 8 ? qr[(D) & 7] : qq, q1, 0, 0, 0); fin_piece<2 * (D) + 1>(p0, p1, ps, pa0, pa1, pa2); SBAR(); \
        a0 = n0; a1 = n1; qq = nq; } while (0)
    S1_STEP(0); S1_STEP(1); S1_STEP(2); S1_STEP(3); S1_STEP(4); S1_STEP(5); S1_STEP(6); S1_STEP(7); S1_STEP(8); S1_STEP(9); S1_STEP(10); S1_STEP(11);
#undef S1_STEP
}
__device__ __forceinline__ void s2_step(f32x16* o, int vb, bf16x8 pa0, bf16x8 pa1, bf16x8 pa2, bf16x8& pa3, f32x16& po0, f32x16& po1, float& ps, float al_old, float& l_reg,
                                        f32x16& q0, f32x16& q1, float& m_reg, float& mn, float& alpha) {
    VFrag fa, fb; float t[4] = {0.f, 0.f, 0.f, 0.f}, mnC = 0.f;
#define PKV(L, H) (bf16x8){L[0], L[1], L[2], L[3], H[0], H[1], H[2], H[3]}
#define S2_MMA(OD, L, H, PA, S) do { OD = __builtin_amdgcn_mfma_f32_32x32x16_bf16(PA, PKV(L, H), OD, 0, 0, 0); part_piece<S>(po0, po1, ps, al_old, l_reg, pa3, q0, q1, t, m_reg, mn, alpha, mnC); SBAR(); } while (0)
    pv_read<0>(fa, vb); pv_read<1>(fb, vb);
    asm volatile("s_waitcnt lgkmcnt(8)" ::: "memory"); SBAR();
    S2_MMA(o[0], fa.l0, fa.h0, pa0, 0); S2_MMA(o[0], fa.l1, fa.h1, pa1, 1); S2_MMA(o[0], fa.l2, fa.h2, pa2, 2); S2_MMA(o[0], fa.l3, fa.h3, pa3, 3);
    pv_read<2>(fa, vb);
    asm volatile("s_waitcnt lgkmcnt(8)" ::: "memory"); SBAR();
    S2_MMA(o[1], fb.l0, fb.h0, pa0, 4); S2_MMA(o[1], fb.l1, fb.h1, pa1, 5); S2_MMA(o[1], fb.l2, fb.h2, pa2, 6); S2_MMA(o[1], fb.l3, fb.h3, pa3, 7);
    pv_read<3>(fb, vb);
    asm volatile("s_waitcnt lgkmcnt(8)" ::: "memory"); SBAR();
    S2_MMA(o[2], fa.l0, fa.h0, pa0, 8); S2_MMA(o[2], fa.l1, fa.h1, pa1, 9); S2_MMA(o[2], fa.l2, fa.h2, pa2, 10); S2_MMA(o[2], fa.l3, fa.h3, pa3, 11);
    asm volatile("s_waitcnt lgkmcnt(0)" ::: "memory"); SBAR();
    S2_MMA(o[3], fb.l0, fb.h0, pa0, 12); S2_MMA(o[3], fb.l1, fb.h1, pa1, 13); S2_MMA(o[3], fb.l2, fb.h2, pa2, 14); S2_MMA(o[3], fb.l3, fb.h3, pa3, 15);
    asm volatile("" : "+v"(q0), "+v"(q1));
#undef S2_MMA
#undef PKV
}
__device__ __forceinline__ void attn_body(const bf16_t* __restrict__ Qb, const bf16_t* __restrict__ Kh, const bf16_t* __restrict__ Krp, const bf16_t* __restrict__ Vh,
                                          bf16_t* __restrict__ Ob, int seq, LAS unsigned char* lds) {
    int tid = threadIdx.x; asm volatile("" : "+v"(tid));
    const int wid = __builtin_amdgcn_readfirstlane(tid >> 6), lane = tid & 63, r32 = lane & 31, hi = lane >> 5;
    LAS float* ws = (LAS float*)(lds + OFF_WS2) + wid * 64; LAS float* li_l = ws; LAS float* al_l = ws + 32;
    LAS unsigned char* qrp = lds + OFF_QR + (wid * 32 + r32) * 128;
    float m_reg = -1e30f, l_reg = 0; f32x16 o[4] = {}; bf16x8 qr[8];
    const bf16_t* Qw = Qb + (long)(wid * 32 + r32) * LDQ + hi * 8;
#pragma unroll
    for (int d0 = 0; d0 < 8; ++d0) qr[d0] = *(const bf16x8*)(Qw + d0 * 16);
#pragma unroll
    for (int d0 = 0; d0 < 4; ++d0) { const bf16x8 q = *(const bf16x8*)(Qw + 128 + d0 * 16); const int cb = (d0 * 16 + hi * 8) * 2;
        *(LAS bf16x8*)(qrp + (cb ^ (((r32 >> 1) & 7) << 4))) = q; }
#define OFF_V() ({ const int u_ = wid * 64 + lane, sub_ = u_ >> 5, within_ = u_ & 31, kk_ = ((sub_ >> 2) << 3) | (within_ >> 2), c_ = ((sub_ & 3) << 5) | ((within_ & 3) << 3); \
                  const int k_ = (kk_ & ~0xC) | ((kk_ & 4) << 1) | ((kk_ & 8) >> 1); (unsigned)(k_ * LDK + c_); })
#define OFF_K() ({ const int u_ = wid * 64 + lane, row_ = u_ >> 4, sl_ = u_ & 15; (unsigned)(row_ * LDK + ((sl_ ^ (row_ & 15)) << 3)); })
#define OFF_R() ({ const int u_ = wid * 64 + lane, row_ = u_ >> 3, sl_ = u_ & 7; (unsigned)(row_ * LDKR + ((sl_ ^ ((row_ >> 1) & 7)) << 3)); })
    const int vbase = (int)(unsigned)(uintptr_t)lds + v_rd_base(lane);
#define DMA(t, slot) do { const bf16_t* vh_ = Vh + (size_t)(t) * KVBLK * LDK; const bf16_t* kh_ = Kh + (size_t)(t) * KVBLK * LDK; const bf16_t* kr_ = Krp + (size_t)(t) * KVBLK * LDKR; \
    LAS unsigned char* sb_ = lds + (slot) * SLOTB; \
    __builtin_amdgcn_global_load_lds((const unsigned*)(vh_ + OFF_V()), (LAS unsigned*)(sb_ + S_V + wid * 1024), 16, 0, 0); \
    __builtin_amdgcn_global_load_lds((const unsigned*)(vh_ + OFF_V() + 32 * LDK), (LAS unsigned*)(sb_ + S_V + (wid + 8) * 1024), 16, 0, 0); \
    __builtin_amdgcn_global_load_lds((const unsigned*)(kh_ + OFF_K()), (LAS unsigned*)(sb_ + S_KN + wid * 1024), 16, 0, 0); \
    __builtin_amdgcn_global_load_lds((const unsigned*)(kh_ + OFF_K() + 32 * LDK), (LAS unsigned*)(sb_ + S_KN + (wid + 8) * 1024), 16, 0, 0); \
    __builtin_amdgcn_global_load_lds((const unsigned*)(kr_ + OFF_R()), (LAS unsigned*)(sb_ + S_KR + wid * 1024), 16, 0, 0); } while (0)
#define RESC(a) do { if (__any((a) < 1.f)) { if (hi == 0) al_l[r32] = (a); asm volatile("s_waitcnt lgkmcnt(0)" ::: "memory"); \
    _Pragma("unroll") for (int d = 0; d < 4; ++d) _Pragma("unroll") for (int r = 0; r < 16; ++r) o[d][r] *= al_l[crow(r, hi)]; } } while (0)
#define TILE_SYNC() do { asm volatile("s_waitcnt vmcnt(0)" ::: "memory"); __syncthreads(); } while (0)
    f32x16 pA0, pA1, pB0, pB1; float mnA, mnB, alA, alB, psum = 0.f; bf16x8 pa0, pa1, pa2, pa3; const int NT = seq / KVBLK;
    DMA(0, 0); DMA(1, 1);
    TILE_SYNC();
    qkt2(pA0, pA1, lds, qrp, qr, r32, hi); partialSM(pA0, pA1, m_reg, mnA, alA);
    int s_prev = 0, s_cur = 1, s_next = 2;
    for (int j = 1; j + 1 < NT; j += 2) {
        DMA(j + 1, s_next);
        SBAR(); s1_step(pB0, pB1, lds + s_cur * SLOTB, qrp, qr, r32, hi, pA0, pA1, psum, pa0, pa1, pa2);
        s2_step(o, vbase + s_prev * SLOTB, pa0, pa1, pa2, pa3, pA0, pA1, psum, alA, l_reg, pB0, pB1, m_reg, mnB, alB);
        TILE_SYNC(); RESC(alB);
        { const int t_ = s_prev; s_prev = s_cur; s_cur = s_next; s_next = t_; }
        if (j + 2 < NT) DMA(j + 2, s_next);
        SBAR(); s1_step(pA0, pA1, lds + s_cur * SLOTB, qrp, qr, r32, hi, pB0, pB1, psum, pa0, pa1, pa2);
        s2_step(o, vbase + s_prev * SLOTB, pa0, pa1, pa2, pa3, pB0, pB1, psum, alB, l_reg, pA0, pA1, m_reg, mnA, alA);
        TILE_SYNC(); RESC(alA);
        { const int t_ = s_prev; s_prev = s_cur; s_cur = s_next; s_next = t_; }
    }
    SBAR(); qkt2(pB0, pB1, lds + s_cur * SLOTB, qrp, qr, r32, hi);
    finishSM(pA0, pA1, alA, l_reg, pa0, pa1, pa2, pa3); SBAR();
    pv_d0(o, vbase + s_prev * SLOTB, pa0, pa1, pa2, pa3); partialSM(pB0, pB1, m_reg, mnB, alB);
    RESC(alB);
    finishSM(pB0, pB1, alB, l_reg, pa0, pa1, pa2, pa3); SBAR();
    pv_d0(o, vbase + s_cur * SLOTB, pa0, pa1, pa2, pa3);
    if (hi == 0) li_l[r32] = l_reg; asm volatile("s_waitcnt lgkmcnt(0)" ::: "memory");
    float rli[16];
#pragma unroll
    for (int r = 0; r < 16; ++r) rli[r] = __builtin_amdgcn_rcpf(li_l[crow(r, hi)]);
    bf16_t* Ow = Ob + (long)(wid * 32) * LDO;
#pragma unroll
    for (int r = 0; r < 16; ++r) { const int orow = crow(r, hi);
#pragma unroll
        for (int d0 = 0; d0 < 4; ++d0) Ow[(long)orow * LDO + d0 * 32 + r32] = f2bf(o[d0][r] * rli[r]); }
    __syncthreads();
#undef DMA
#undef OFF_V
#undef OFF_K
#undef OFF_R
#undef RESC
#undef TILE_SYNC
}

constexpr int SLOTB8 = 28672, S8_V = 0, S8_KN = 16384, S8_KR = 24576, OFF8_WS = 3 * SLOTB8, OFF8_SK = OFF8_WS + 2048, LDS_ATT8 = OFF8_SK + 2048;
static_assert(LDS_ATT8 <= LDS_CTL, "attention LDS (int8)");
typedef int i32x4v __attribute__((ext_vector_type(4)));
typedef int i32x16v __attribute__((ext_vector_type(16)));
#define K8N_SWZ(row, ch) ((row) * 128 + ((((ch)) ^ (((row) >> 1) & 7)) << 4))
#define K8R_SWZ(row, ch) ((row) * 64 + ((((ch)) ^ (((row) >> 2) & 3)) << 4))
__device__ __forceinline__ unsigned q8pack(float a, float b, float c, float d) {
    const int q0 = (int)rintf(a), q1 = (int)rintf(b), q2 = (int)rintf(c), q3 = (int)rintf(d);
    return (unsigned)((q0 & 255) | ((q1 & 255) << 8) | ((q2 & 255) << 16) | ((q3 & 255) << 24));
}
__device__ __forceinline__ void kq_phase(const Fr& F, const bf16_t* KV, const bf16_t* KR, unsigned char* K8N, unsigned char* K8R, float* SK, int nkey) {
    const int ntile = nkey / 64, kq = F.lane >> 3, ch = F.lane & 7;
    for (int it = F.bid * 8 + F.wave; it < ntile * 8; it += F.G * 8) {
        const int h = it & 7, t = it >> 3;
        u32x4 n[8][2]; u32x4 r[8];
#pragma unroll
        for (int g = 0; g < 8; ++g) { const size_t key = (size_t)t * 64 + g * 8 + kq;
            n[g][0] = *(const u32x4*)(KV + key * LDK + h * 256 + ch * 16); n[g][1] = *(const u32x4*)(KV + key * LDK + h * 256 + ch * 16 + 8);
            r[g] = *(const u32x4*)(KR + key * LDKR + ch * 8); }
        float am = 0.f;
#pragma unroll
        for (int g = 0; g < 8; ++g) {
#pragma unroll
            for (int q = 0; q < 4; ++q) { am = fmaxf(am, fmaxf(fabsf(bf_lo(n[g][0][q])), fabsf(bf_hi(n[g][0][q])))); am = fmaxf(am, fmaxf(fabsf(bf_lo(n[g][1][q])), fabsf(bf_hi(n[g][1][q]))));
                am = fmaxf(am, fmaxf(fabsf(bf_lo(r[g][q])), fabsf(bf_hi(r[g][q])))); } }
#pragma unroll
        for (int o = 32; o >= 1; o >>= 1) am = fmaxf(am, __shfl_xor(am, o));
        const float inv = am > 0.f ? 127.0f / am : 0.f;
#pragma unroll
        for (int g = 0; g < 8; ++g) { const size_t key = (size_t)t * 64 + g * 8 + kq;
            u32x4 w;
            w.x = q8pack(bf_lo(n[g][0].x) * inv, bf_hi(n[g][0].x) * inv, bf_lo(n[g][0].y) * inv, bf_hi(n[g][0].y) * inv);
            w.y = q8pack(bf_lo(n[g][0].z) * inv, bf_hi(n[g][0].z) * inv, bf_lo(n[g][0].w) * inv, bf_hi(n[g][0].w) * inv);
            w.z = q8pack(bf_lo(n[g][1].x) * inv, bf_hi(n[g][1].x) * inv, bf_lo(n[g][1].y) * inv, bf_hi(n[g][1].y) * inv);
            w.w = q8pack(bf_lo(n[g][1].z) * inv, bf_hi(n[g][1].z) * inv, bf_lo(n[g][1].w) * inv, bf_hi(n[g][1].w) * inv);
            *(u32x4*)(K8N + ((size_t)h * nkey + key) * 128 + ch * 16) = w;
            u32x2 v;
            v.x = q8pack(bf_lo(r[g].x) * inv, bf_hi(r[g].x) * inv, bf_lo(r[g].y) * inv, bf_hi(r[g].y) * inv);
            v.y = q8pack(bf_lo(r[g].z) * inv, bf_hi(r[g].z) * inv, bf_lo(r[g].w) * inv, bf_hi(r[g].w) * inv);
            *(u32x2*)(K8R + ((size_t)h * nkey + key) * 64 + ch * 8) = v; }
        if (F.lane == 0) SK[h * ntile + t] = am > 0.f ? am * (1.0f / 127.0f) : 1.0f;
    }
}
#define QK8_FRAG(S, ROW) ((S) < 4 ? *(const LAS i32x4v*)(Kn + K8N_SWZ((ROW), (S) * 2 + hi)) : *(const LAS i32x4v*)(Kr + K8R_SWZ((ROW), ((S) - 4) * 2 + hi)))
__device__ __forceinline__ void qkt8(f32x16& p0, f32x16& p1, const LAS unsigned char* slot, const i32x4v (&qi)[6], int r32, int hi) {
    const LAS unsigned char* Kn = slot + S8_KN; const LAS unsigned char* Kr = slot + S8_KR;
    i32x16v c0 = {}, c1 = {};
    i32x4v a0 = QK8_FRAG(0, r32), a1 = QK8_FRAG(0, 32 + r32);
#pragma unroll
    for (int s = 0; s < 6; ++s) {
        i32x4v n0 = a0, n1 = a1;
        if (s < 5) { n0 = QK8_FRAG(s + 1, r32); n1 = QK8_FRAG(s + 1, 32 + r32); }
        c0 = __builtin_amdgcn_mfma_i32_32x32x32_i8(a0, qi[s], c0, 0, 0, 0);
        c1 = __builtin_amdgcn_mfma_i32_32x32x32_i8(a1, qi[s], c1, 0, 0, 0);
        a0 = n0; a1 = n1;
    }
    p0 = __builtin_bit_cast(f32x16, c0); p1 = __builtin_bit_cast(f32x16, c1);
}
__device__ __forceinline__ void i2f_scores(f32x16& p0, f32x16& p1, float mraw) {
#pragma unroll
    for (int r = 0; r < 16; ++r) { p0[r] = (float)__float_as_int(p0[r]) * mraw; p1[r] = (float)__float_as_int(p1[r]) * mraw; }
}
__device__ __forceinline__ void s1_step8(f32x16& q0, f32x16& q1, const LAS unsigned char* slot, const i32x4v (&qi)[6], int r32, int hi,
                                         f32x16& p0, f32x16& p1, float& ps, bf16x8& pa0, bf16x8& pa1, bf16x8& pa2) {
    const LAS unsigned char* Kn = slot + S8_KN; const LAS unsigned char* Kr = slot + S8_KR;
    i32x16v c0 = {}, c1 = {};
    i32x4v a0 = QK8_FRAG(0, r32), a1 = QK8_FRAG(0, 32 + r32);
#define S1_STEP8(S) do { i32x4v n0 = a0, n1 = a1; \
        if ((S) < 5) { n0 = QK8_FRAG((S) + 1, r32); n1 = QK8_FRAG((S) + 1, 32 + r32); } \
        c0 = __builtin_amdgcn_mfma_i32_32x32x32_i8(a0, qi[S], c0, 0, 0, 0); fin_piece<4 * (S)>(p0, p1, ps, pa0, pa1, pa2); SBAR(); fin_piece<4 * (S) + 1>(p0, p1, ps, pa0, pa1, pa2); SBAR(); \
        c1 = __builtin_amdgcn_mfma_i32_32x32x32_i8(a1, qi[S], c1, 0, 0, 0); fin_piece<4 * (S) + 2>(p0, p1, ps, pa0, pa1, pa2); SBAR(); fin_piece<4 * (S) + 3>(p0, p1, ps, pa0, pa1, pa2); SBAR(); \
        a0 = n0; a1 = n1; } while (0)
    S1_STEP8(0); S1_STEP8(1); S1_STEP8(2); S1_STEP8(3); S1_STEP8(4); S1_STEP8(5);
#undef S1_STEP8
    q0 = __builtin_bit_cast(f32x16, c0); q1 = __builtin_bit_cast(f32x16, c1);
}
template <int S> __device__ __forceinline__ void part_piece8(f32x16& o0, f32x16& o1, float& ps, float al_old, float& l_reg, bf16x8& pa3,
                                                            f32x16& q0, f32x16& q1, int (&ti)[4], float& tf, float mraw, float& m_reg, float& mn, float& alpha, float& mnC) {
    constexpr float C = SCALE * 1.4426950408889634f;
    if constexpr (S == 0) { ps += o1[15]; auto rr = __builtin_amdgcn_permlane32_swap(__float_as_uint(ps), __float_as_uint(ps), false, false);
                            ps = __uint_as_float(rr[0]) + __uint_as_float(rr[1]); l_reg = l_reg * al_old + ps; }
    if constexpr (S == 1) PK4(o1, 8, pa3);
    if constexpr (S == 2) { int m = __float_as_int(q0[0]);
#pragma unroll
        for (int r = 1; r < 8; ++r) m = max(m, __float_as_int(q0[r])); ti[0] = m; }
    if constexpr (S == 3) { int m = __float_as_int(q0[8]);
#pragma unroll
        for (int r = 9; r < 16; ++r) m = max(m, __float_as_int(q0[r])); ti[1] = m; }
    if constexpr (S == 4) { int m = __float_as_int(q1[0]);
#pragma unroll
        for (int r = 1; r < 8; ++r) m = max(m, __float_as_int(q1[r])); ti[2] = m; }
    if constexpr (S == 5) { int m = __float_as_int(q1[8]);
#pragma unroll
        for (int r = 9; r < 16; ++r) m = max(m, __float_as_int(q1[r])); ti[3] = m; }
    if constexpr (S == 6) { const float pmax = (float)max(max(ti[0], ti[1]), max(ti[2], ti[3])) * mraw;
        auto rr = __builtin_amdgcn_permlane32_swap(__float_as_uint(pmax), __float_as_uint(pmax), false, false);
        tf = fmaxf(__uint_as_float(rr[0]), __uint_as_float(rr[1])); }
    if constexpr (S == 7) { const bool keep = __all(tf - m_reg <= THR / SCALE);
        mn = keep ? m_reg : fmaxf(m_reg, tf); alpha = __builtin_amdgcn_exp2f((m_reg - mn) * C); m_reg = mn; mnC = -mn * C; }
    if constexpr (S >= 8 && S < 12) {
#pragma unroll
        for (int r = 0; r < 4; ++r) q0[(S - 8) * 4 + r] = fmaf((float)__float_as_int(q0[(S - 8) * 4 + r]), mraw * C, mnC); }
    if constexpr (S >= 12) {
#pragma unroll
        for (int r = 0; r < 4; ++r) q1[(S - 12) * 4 + r] = fmaf((float)__float_as_int(q1[(S - 12) * 4 + r]), mraw * C, mnC); }
    if constexpr (S >= 9) q0[S - 9] = __builtin_amdgcn_exp2f(q0[S - 9]);
    if constexpr (S == 15) q0[7] = __builtin_amdgcn_exp2f(q0[7]);
}
__device__ __forceinline__ void s2_step8(f32x16* o, int vb, bf16x8 pa0, bf16x8 pa1, bf16x8 pa2, bf16x8& pa3, f32x16& po0, f32x16& po1, float& ps, float al_old, float& l_reg,
                                         f32x16& q0, f32x16& q1, float mraw, float& m_reg, float& mn, float& alpha) {
    VFrag fa, fb; int ti[4] = {0, 0, 0, 0}; float tf = 0.f, mnC = 0.f;
#define PKV(L, H) (bf16x8){L[0], L[1], L[2], L[3], H[0], H[1], H[2], H[3]}
#define S2_MMA(OD, L, H, PA, S) do { OD = __builtin_amdgcn_mfma_f32_32x32x16_bf16(PA, PKV(L, H), OD, 0, 0, 0); part_piece8<S>(po0, po1, ps, al_old, l_reg, pa3, q0, q1, ti, tf, mraw, m_reg, mn, alpha, mnC); SBAR(); } while (0)
    pv_read<0>(fa, vb); pv_read<1>(fb, vb);
    asm volatile("s_waitcnt lgkmcnt(8)" ::: "memory"); SBAR();
    S2_MMA(o[0], fa.l0, fa.h0, pa0, 0); S2_MMA(o[0], fa.l1, fa.h1, pa1, 1); S2_MMA(o[0], fa.l2, fa.h2, pa2, 2); S2_MMA(o[0], fa.l3, fa.h3, pa3, 3);
    pv_read<2>(fa, vb);
    asm volatile("s_waitcnt lgkmcnt(8)" ::: "memory"); SBAR();
    S2_MMA(o[1], fb.l0, fb.h0, pa0, 4); S2_MMA(o[1], fb.l1, fb.h1, pa1, 5); S2_MMA(o[1], fb.l2, fb.h2, pa2, 6); S2_MMA(o[1], fb.l3, fb.h3, pa3, 7);
    pv_read<3>(fb, vb);
    asm volatile("s_waitcnt lgkmcnt(8)" ::: "memory"); SBAR();
    S2_MMA(o[2], fa.l0, fa.h0, pa0, 8); S2_MMA(o[2], fa.l1, fa.h1, pa1, 9); S2_MMA(o[2], fa.l2, fa.h2, pa2, 10); S2_MMA(o[2], fa.l3, fa.h3, pa3, 11);
    asm volatile("s_waitcnt lgkmcnt(0)" ::: "memory"); SBAR();
    S2_MMA(o[3], fb.l0, fb.h0, pa0, 12); S2_MMA(o[3], fb.l1, fb.h1, pa1, 13); S2_MMA(o[3], fb.l2, fb.h2, pa2, 14); S2_MMA(o[3], fb.l3, fb.h3, pa3, 15);
    asm volatile("" : "+v"(q0), "+v"(q1));
#undef S2_MMA
#undef PKV
}
__device__ __forceinline__ void attn_body8(const bf16_t* __restrict__ Qb, const unsigned char* __restrict__ K8n, const unsigned char* __restrict__ K8r, const float* __restrict__ SKh,
                                           const bf16_t* __restrict__ Vh, bf16_t* __restrict__ Ob, int seq, LAS unsigned char* lds) {
    int tid = threadIdx.x; asm volatile("" : "+v"(tid));
    const int wid = __builtin_amdgcn_readfirstlane(tid >> 6), lane = tid & 63, r32 = lane & 31, hi = lane >> 5;
    LAS float* ws = (LAS float*)(lds + OFF8_WS) + wid * 64; LAS float* li_l = ws; LAS float* al_l = ws + 32;
    float m_reg = -1e30f, l_reg = 0; f32x16 o[4] = {}; i32x4v qi[6]; float sq;
#define OFF_V() ({ const int u_ = wid * 64 + lane, sub_ = u_ >> 5, within_ = u_ & 31, kk_ = ((sub_ >> 2) << 3) | (within_ >> 2), c_ = ((sub_ & 3) << 5) | ((within_ & 3) << 3); \
                  const int k_ = (kk_ & ~0xC) | ((kk_ & 4) << 1) | ((kk_ & 8) >> 1); (unsigned)(k_ * LDK + c_); })
#define OFF_KN8() ({ const int u_ = wid * 64 + lane, row_ = u_ >> 3, c_ = u_ & 7; (unsigned)(row_ * 128 + ((c_ ^ ((row_ >> 1) & 7)) << 4)); })
#define OFF_KR8() ({ const int u_ = wid * 64 + lane, row_ = u_ >> 2, c_ = u_ & 3; (unsigned)(row_ * 64 + ((c_ ^ ((row_ >> 2) & 3)) << 4)); })
    const int vbase = (int)(unsigned)(uintptr_t)lds + v_rd_base(lane);
#define DMA(t, slot) do { const bf16_t* vh_ = Vh + (size_t)(t) * KVBLK * LDK; LAS unsigned char* sb_ = lds + (slot) * SLOTB8; \
    __builtin_amdgcn_global_load_lds((const unsigned*)(vh_ + OFF_V()), (LAS unsigned*)(sb_ + S8_V + wid * 1024), 16, 0, 0); \
    __builtin_amdgcn_global_load_lds((const unsigned*)(vh_ + OFF_V() + 32 * LDK), (LAS unsigned*)(sb_ + S8_V + (wid + 8) * 1024), 16, 0, 0); \
    __builtin_amdgcn_global_load_lds((const unsigned*)(K8n + (size_t)(t) * 8192 + OFF_KN8()), (LAS unsigned*)(sb_ + S8_KN + wid * 1024), 16, 0, 0); \
    if (wid < 4) __builtin_amdgcn_global_load_lds((const unsigned*)(K8r + (size_t)(t) * 4096 + OFF_KR8()), (LAS unsigned*)(sb_ + S8_KR + wid * 1024), 16, 0, 0); } while (0)
#define RESC(a) do { if (__any((a) < 1.f)) { if (hi == 0) al_l[r32] = (a); asm volatile("s_waitcnt lgkmcnt(0)" ::: "memory"); \
    _Pragma("unroll") for (int d = 0; d < 4; ++d) _Pragma("unroll") for (int r = 0; r < 16; ++r) o[d][r] *= al_l[crow(r, hi)]; } } while (0)
#define TILE_SYNC() do { asm volatile("s_waitcnt vmcnt(0)" ::: "memory"); __syncthreads(); } while (0)
    f32x16 pA0, pA1, pB0, pB1; float mnA, mnB, alA, alB, psum = 0.f; bf16x8 pa0, pa1, pa2, pa3; const int NT = seq / KVBLK;
    LAS float* skl = (LAS float*)(lds + OFF8_SK);
    for (int i = tid; i < NT; i += NTHR) skl[i] = SKh[i];
    DMA(0, 0); DMA(1, 1);
    {
        const bf16_t* Qw = Qb + (long)(wid * 32 + r32) * LDQ + hi * 16;
        u32x4 w[6][2];
#pragma unroll
        for (int s = 0; s < 6; ++s) { w[s][0] = *(const u32x4*)(Qw + s * 32); w[s][1] = *(const u32x4*)(Qw + s * 32 + 8); }
        float am = 0.f;
#pragma unroll
        for (int s = 0; s < 6; ++s)
#pragma unroll
            for (int q = 0; q < 4; ++q) { am = fmaxf(am, fmaxf(fabsf(bf_lo(w[s][0][q])), fabsf(bf_hi(w[s][0][q])))); am = fmaxf(am, fmaxf(fabsf(bf_lo(w[s][1][q])), fabsf(bf_hi(w[s][1][q])))); }
        { auto rr = __builtin_amdgcn_permlane32_swap(__float_as_uint(am), __float_as_uint(am), false, false); am = fmaxf(__uint_as_float(rr[0]), __uint_as_float(rr[1])); }
        const float inv = am > 0.f ? 127.0f / am : 0.f; sq = am * (1.0f / 127.0f);
#pragma unroll
        for (int s = 0; s < 6; ++s) {
            qi[s].x = (int)q8pack(bf_lo(w[s][0].x) * inv, bf_hi(w[s][0].x) * inv, bf_lo(w[s][0].y) * inv, bf_hi(w[s][0].y) * inv);
            qi[s].y = (int)q8pack(bf_lo(w[s][0].z) * inv, bf_hi(w[s][0].z) * inv, bf_lo(w[s][0].w) * inv, bf_hi(w[s][0].w) * inv);
            qi[s].z = (int)q8pack(bf_lo(w[s][1].x) * inv, bf_hi(w[s][1].x) * inv, bf_lo(w[s][1].y) * inv, bf_hi(w[s][1].y) * inv);
            qi[s].w = (int)q8pack(bf_lo(w[s][1].z) * inv, bf_hi(w[s][1].z) * inv, bf_lo(w[s][1].w) * inv, bf_hi(w[s][1].w) * inv); }
    }
    TILE_SYNC();
    qkt8(pA0, pA1, lds, qi, r32, hi); i2f_scores(pA0, pA1, sq * skl[0]); partialSM(pA0, pA1, m_reg, mnA, alA);
    if (wid >= 4) __builtin_amdgcn_s_setprio(1);
    int s_prev = 0, s_cur = 1, s_next = 2;
    for (int j = 1; j + 1 < NT; j += 2) {
        DMA(j + 1, s_next);
        const float mB = sq * skl[j];
        SBAR(); s1_step8(pB0, pB1, lds + s_cur * SLOTB8, qi, r32, hi, pA0, pA1, psum, pa0, pa1, pa2);
        s2_step8(o, vbase + s_prev * SLOTB8, pa0, pa1, pa2, pa3, pA0, pA1, psum, alA, l_reg, pB0, pB1, mB, m_reg, mnB, alB);
        TILE_SYNC(); RESC(alB);
        { const int t_ = s_prev; s_prev = s_cur; s_cur = s_next; s_next = t_; }
        if (j + 2 < NT) DMA(j + 2, s_next);
        const float mA = sq * skl[j + 1];
        SBAR(); s1_step8(pA0, pA1, lds + s_cur * SLOTB8, qi, r32, hi, pB0, pB1, psum, pa0, pa1, pa2);
        s2_step8(o, vbase + s_prev * SLOTB8, pa0, pa1, pa2, pa3, pB0, pB1, psum, alB, l_reg, pA0, pA1, mA, m_reg, mnA, alA);
        TILE_SYNC(); RESC(alA);
        { const int t_ = s_prev; s_prev = s_cur; s_cur = s_next; s_next = t_; }
    }
    __builtin_amdgcn_s_setprio(0);
    SBAR(); qkt8(pB0, pB1, lds + s_cur * SLOTB8, qi, r32, hi); i2f_scores(pB0, pB1, sq * skl[NT - 1]);
    finishSM(pA0, pA1, alA, l_reg, pa0, pa1, pa2, pa3); SBAR();
    pv_d0(o, vbase + s_prev * SLOTB8, pa0, pa1, pa2, pa3); partialSM(pB0, pB1, m_reg, mnB, alB);
    RESC(alB);
    finishSM(pB0, pB1, alB, l_reg, pa0, pa1, pa2, pa3); SBAR();
    pv_d0(o, vbase + s_cur * SLOTB8, pa0, pa1, pa2, pa3);
    if (hi == 0) li_l[r32] = l_reg; asm volatile("s_waitcnt lgkmcnt(0)" ::: "memory");
    float rli[16];
#pragma unroll
    for (int r = 0; r < 16; ++r) rli[r] = __builtin_amdgcn_rcpf(li_l[crow(r, hi)]);
    bf16_t* Ow = Ob + (long)(wid * 32) * LDO;
#pragma unroll
    for (int r = 0; r < 16; ++r) { const int orow = crow(r, hi);
#pragma unroll
        for (int d0 = 0; d0 < 4; ++d0) Ow[(long)orow * LDO + d0 * 32 + r32] = f2bf(o[d0][r] * rli[r]); }
    __syncthreads();
#undef DMA
#undef OFF_V
#undef OFF_KN8
#undef OFF_KR8
#undef RESC
#undef TILE_SYNC
}
}

__device__ __forceinline__ int crow32(int r, int hi) { return (r & 3) + 8 * (r >> 2) + 4 * hi; }

__device__ __forceinline__ void ce_desc(unsigned& x, unsigned& y) { const unsigned hi = x > y ? x : y, lo = x > y ? y : x; x = hi; y = lo; }
__device__ __forceinline__ unsigned f2key(float s) { const unsigned b = __float_as_uint(s); return b ^ (((unsigned)((int)b >> 31)) | 0x80000000u); }
__device__ __forceinline__ float key2f(unsigned k) { const unsigned b = (k & 0x80000000u) ? (k ^ 0x80000000u) : ~k; return __uint_as_float(b); }
__device__ __forceinline__ void sort16_desc(unsigned (&a)[16]) {
#pragma unroll
    for (int k = 2; k <= 16; k <<= 1)
#pragma unroll
        for (int j = k >> 1; j > 0; j >>= 1)
#pragma unroll
            for (int i = 0; i < 16; ++i) { const int l = i ^ j; if (l > i) { if ((i & k) == 0) ce_desc(a[i], a[l]); else ce_desc(a[l], a[i]); } }
}
__device__ __forceinline__ void merge_top16(unsigned (&a)[16], const unsigned (&b)[16]) {
#pragma unroll
    for (int i = 0; i < 16; ++i) a[i] = a[i] > b[15 - i] ? a[i] : b[15 - i];
#pragma unroll
    for (int j = 8; j > 0; j >>= 1)
#pragma unroll
        for (int i = 0; i < 16; ++i) { const int l = i ^ j; if (l > i) ce_desc(a[i], a[l]); }
}
__device__ __forceinline__ void peer_select(const Fr& F, const bf16_t* PQ, const bf16_t* KEYS, unsigned short* PIDX, float* PGATE) {
    LAS bf16_t* KL = (LAS bf16_t*)F.lds;
    LAS unsigned* LST = (LAS unsigned*)(F.lds + 69632);
    LAS int* IDX = (LAS int*)(F.lds + 69632 + 32768);
    LAS float* GT = (LAS float*)(F.lds + 69632 + 32768 + 16384);
    LAS int* CODE = (LAS int*)(F.lds + 69632 + 32768 + 32768);
    __syncthreads();
    if (F.tid < 64) { int cnt = 0, code = 0; for (int ab = 0; ab < 256; ++ab) { if (((ab >> 4) + 1) * ((ab & 15) + 1) <= 16) { if (cnt == F.tid) code = ab; ++cnt; } } CODE[F.tid] = code; }
    for (int ch = F.tid; ch < 2 * 128 * 16; ch += NTHR) { const int row = ch >> 4, c8 = (ch & 15) * 8; *(LAS u32x4*)(KL + row * 136 + c8) = *(const u32x4*)(KEYS + (size_t)row * 128 + c8); }
    __syncthreads();
    const int r32 = F.lane & 31, hi = F.lane >> 5;
    bf16x8 qn[8];
    { const int p = F.wave >> 2, rb = F.wave & 3, r = rb * 32 + r32, tl = r >> 3, h = r & 7;
      if (F.bid < SEQ / 16) { const bf16_t* qp = PQ + (size_t)(F.bid * 16 + tl) * 2048 + h * 256 + p * 128 + hi * 8;
#pragma unroll
          for (int k = 0; k < 8; ++k) qn[k] = *(const bf16x8*)(qp + k * 16); } }
    for (int tile = F.bid; tile < SEQ / 16; tile += 2 * F.G) {
        const bool two = tile + F.G < SEQ / 16;
        { const int t0 = tile * 16; (void)t0;
        {
            const int p = F.wave >> 2, rb = F.wave & 3, r = rb * 32 + r32, tl = r >> 3, h = r & 7;
            bf16x8 qa[8];
#pragma unroll
            for (int k = 0; k < 8; ++k) qa[k] = qn[k];
            if ((tile + F.G) < SEQ / 16) { const bf16_t* qp = PQ + (size_t)((tile + F.G) * 16 + tl) * 2048 + h * 256 + p * 128 + hi * 8;
#pragma unroll
                for (int k = 0; k < 8; ++k) qn[k] = *(const bf16x8*)(qp + k * 16); }
            unsigned g[4][16];
#pragma unroll
            for (int nb = 0; nb < 4; ++nb) {
                const LAS bf16_t* kp = KL + (p * 128 + nb * 32 + r32) * 136 + hi * 8;
                f32x16 acc = {};
#pragma unroll
                for (int k = 0; k < 8; ++k) { const bf16x8 kb = *(const LAS bf16x8*)(kp + k * 16); acc = __builtin_amdgcn_mfma_f32_32x32x16_bf16(kb, qa[k], acc, 0, 0, 0); }
#pragma unroll
                for (int rr = 0; rr < 16; ++rr) { const int nbase = nb * 32 + (rr & 3) + 8 * (rr >> 2);
                    g[nb][rr] = (f2key(acc[rr]) & ~127u) | (unsigned)((127 - nbase) - 4 * hi); }
            }
            sort16_desc(g[0]); sort16_desc(g[1]); sort16_desc(g[2]); sort16_desc(g[3]);
            merge_top16(g[0], g[1]); merge_top16(g[2], g[3]); merge_top16(g[0], g[2]);
            unsigned other[16];
#pragma unroll
            for (int k = 0; k < 16; ++k) { auto sw = __builtin_amdgcn_permlane32_swap(g[0][k], g[0][k], false, false); other[k] = hi ? sw[0] : sw[1]; }
            merge_top16(g[0], other);
            if (hi == 0) {
#pragma unroll
                for (int k = 0; k < 16; k += 4) *(LAS u32x4*)(LST + 0 + (p * 128 + r) * 16 + k) = (u32x4){g[0][k], g[0][k + 1], g[0][k + 2], g[0][k + 3]};
            }
        }
        }
        if (two) { const int t0 = (tile + F.G) * 16; (void)t0;
        {
            const int p = F.wave >> 2, rb = F.wave & 3, r = rb * 32 + r32, tl = r >> 3, h = r & 7;
            bf16x8 qa[8];
#pragma unroll
            for (int k = 0; k < 8; ++k) qa[k] = qn[k];
            if ((tile + 2 * F.G) < SEQ / 16) { const bf16_t* qp = PQ + (size_t)((tile + 2 * F.G) * 16 + tl) * 2048 + h * 256 + p * 128 + hi * 8;
#pragma unroll
                for (int k = 0; k < 8; ++k) qn[k] = *(const bf16x8*)(qp + k * 16); }
            unsigned g[4][16];
#pragma unroll
            for (int nb = 0; nb < 4; ++nb) {
                const LAS bf16_t* kp = KL + (p * 128 + nb * 32 + r32) * 136 + hi * 8;
                f32x16 acc = {};
#pragma unroll
                for (int k = 0; k < 8; ++k) { const bf16x8 kb = *(const LAS bf16x8*)(kp + k * 16); acc = __builtin_amdgcn_mfma_f32_32x32x16_bf16(kb, qa[k], acc, 0, 0, 0); }
#pragma unroll
                for (int rr = 0; rr < 16; ++rr) { const int nbase = nb * 32 + (rr & 3) + 8 * (rr >> 2);
                    g[nb][rr] = (f2key(acc[rr]) & ~127u) | (unsigned)((127 - nbase) - 4 * hi); }
            }
            sort16_desc(g[0]); sort16_desc(g[1]); sort16_desc(g[2]); sort16_desc(g[3]);
            merge_top16(g[0], g[1]); merge_top16(g[2], g[3]); merge_top16(g[0], g[2]);
            unsigned other[16];
#pragma unroll
            for (int k = 0; k < 16; ++k) { auto sw = __builtin_amdgcn_permlane32_swap(g[0][k], g[0][k], false, false); other[k] = hi ? sw[0] : sw[1]; }
            merge_top16(g[0], other);
            if (hi == 0) {
#pragma unroll
                for (int k = 0; k < 16; k += 4) *(LAS u32x4*)(LST + 4096 + (p * 128 + r) * 16 + k) = (u32x4){g[0][k], g[0][k + 1], g[0][k + 2], g[0][k + 3]};
            }
        }
        }
        __syncthreads();
        if (F.tid < 256 && (F.tid < 128 || two)) {
            const int sub = F.tid >> 7, j = F.tid & 127, tl = j >> 3, h = j & 7;
            unsigned k1[16], k2[16];
#pragma unroll
            for (int k = 0; k < 16; k += 4) { const u32x4 a = *(const LAS u32x4*)(LST + sub * 4096 + j * 16 + k), b = *(const LAS u32x4*)(LST + sub * 4096 + (128 + j) * 16 + k);
                k1[k] = a.x; k1[k + 1] = a.y; k1[k + 2] = a.z; k1[k + 3] = a.w; k2[k] = b.x; k2[k + 1] = b.y; k2[k + 2] = b.z; k2[k + 3] = b.w; }
            float v1[16], v2[16];
#pragma unroll
            for (int k = 0; k < 16; ++k) { v1[k] = key2f(k1[k] & ~127u); v2[k] = key2f(k2[k] & ~127u); }
            unsigned cg[4][16];
            {
                int n = 0;
#pragma unroll
                for (int a = 0; a < 16; ++a)
#pragma unroll
                    for (int b = 0; b < 16; ++b) if ((a + 1) * (b + 1) <= 16) { cg[n >> 4][n & 15] = (f2key(v1[a] + v2[b]) & ~63u) | (unsigned)(63 - n); ++n; }
#pragma unroll
                for (int m = 50; m < 64; ++m) cg[m >> 4][m & 15] = 0u;
            }
            sort16_desc(cg[0]); sort16_desc(cg[1]); sort16_desc(cg[2]); sort16_desc(cg[3]);
            merge_top16(cg[0], cg[1]); merge_top16(cg[2], cg[3]); merge_top16(cg[0], cg[2]);
            float bs[16];
#pragma unroll
            for (int k = 0; k < 16; ++k) bs[k] = key2f(cg[0][k] & ~63u);
            float den = 0.f, ex[16];
#pragma unroll
            for (int k = 0; k < 16; ++k) { ex[k] = __expf(bs[k] - bs[0]); den += ex[k]; }
            const float rden = 1.0f / den;
            unsigned ib = (unsigned)(uintptr_t)(IDX + sub * 2048 + tl * 128 + h * 2), gb2 = (unsigned)(uintptr_t)(GT + sub * 2048 + tl * 128 + h * 2), lb = (unsigned)(uintptr_t)(LST + sub * 4096 + j * 16);
            asm volatile("" : "+v"(ib), "+v"(gb2), "+v"(lb));
            LAS int* ip = (LAS int*)(uintptr_t)ib; LAS float* gp = (LAS float*)(uintptr_t)gb2; LAS unsigned* l1 = (LAS unsigned*)(uintptr_t)lb;
#pragma unroll
            for (int k = 0; k < 16; ++k) {
                const int code = CODE[63 - (int)(cg[0][k] & 63u)]; const int a = code >> 4, b = code & 15;
                const int i1 = 127 - (int)(l1[a] & 127u), i2 = 127 - (int)(l1[128 * 16 + b] & 127u);
                ip[(k & 7) * 16 + (k >> 3)] = i1 * 128 + i2;
                gp[(k & 7) * 16 + (k >> 3)] = ex[k] * rden;
            }
        }
        __syncthreads();
        for (int i = F.tid; i < 16 * 128; i += NTHR) { PIDX[(size_t)tile * 16 * 128 + i] = (unsigned short)IDX[i]; PGATE[(size_t)tile * 16 * 128 + i] = GT[i]; }
        if (two) for (int i = F.tid; i < 16 * 128; i += NTHR) { PIDX[(size_t)(tile + F.G) * 16 * 128 + i] = (unsigned short)IDX[2048 + i]; PGATE[(size_t)(tile + F.G) * 16 * 128 + i] = GT[2048 + i]; }
        __syncthreads();
    }
}

struct PeerBuf { u32x4 g[8]; };
struct PeerMeta { u32x4 id[2]; u32x4 p[2]; unsigned xr; };
template <int CTRL> __device__ __forceinline__ float dpp_f(float v) { return __int_as_float(__builtin_amdgcn_update_dpp(0, __float_as_int(v), CTRL, 0xf, 0xf, true)); }
__device__ __forceinline__ float xor16_f(float v, bool hi16) { auto r = __builtin_amdgcn_permlane16_swap(__float_as_uint(v), __float_as_uint(v), false, false); return __uint_as_float(hi16 ? r[0] : r[1]); }
__device__ __forceinline__ float xor32_f(float v, bool hi32) { auto r = __builtin_amdgcn_permlane32_swap(__float_as_uint(v), __float_as_uint(v), false, false); return __uint_as_float(hi32 ? r[0] : r[1]); }
template <int HALF>
__device__ __forceinline__ void peer_issue(PeerBuf& b, const unsigned char* tab, unsigned lane_off, const PeerMeta& m) {
#pragma unroll
    for (int i = 0; i < 8; ++i) { const int k = HALF * 8 + i; const unsigned w = m.id[k >> 3][(k >> 1) & 3]; unsigned off;
        if (k & 1) asm("v_mad_u32_u16 %0, %1, %2, %3 op_sel:[1,0,0,0]" : "=v"(off) : "v"(w), "v"(128u), "v"(lane_off));
        else asm("v_mad_u32_u16 %0, %1, %2, %3" : "=v"(off) : "v"(w), "v"(128u), "v"(lane_off));
        b.g[i] = *(const u32x4*)(tab + off); }
}
__device__ __forceinline__ void peer_u_quant(const PeerMeta& m, int (&xq)[4], float& sx) {
#pragma unroll
    for (int q = 0; q < 4; ++q) xq[q] = (int)m.p[0][q];
    sx = __uint_as_float(m.p[1].x);
}
template <int HALF>
__device__ __forceinline__ void peer_u_compute(const PeerBuf& b, const int (&xq)[4], float sx, _Float16* pdrow, int q8, int eg) {
    int d[8];
#pragma unroll
    for (int i = 0; i < 8; ++i) { int a = 0;
#pragma unroll
        for (int q = 0; q < 4; ++q) a = __builtin_amdgcn_sdot4((int)b.g[i][q], xq[q], a, false);
        d[i] = a; }
    const bool b2 = (q8 & 4) != 0, b1 = (q8 & 2) != 0, b0 = (q8 & 1) != 0;
    int k4[4], k2[2];
#pragma unroll
    for (int k = 0; k < 4; ++k) { const int keep = b2 ? d[4 + k] : d[k], send = b2 ? d[k] : d[4 + k]; k4[k] = keep + __builtin_amdgcn_update_dpp(0, send, 0x141, 0xf, 0xf, true); }
#pragma unroll
    for (int k = 0; k < 2; ++k) { const int keep = b1 ? k4[2 + k] : k4[k], send = b1 ? k4[k] : k4[2 + k]; k2[k] = keep + __builtin_amdgcn_update_dpp(0, send, 0x4E, 0xf, 0xf, true); }
    const int keep = b0 ? k2[1] : k2[0], send = b0 ? k2[0] : k2[1];
    pdrow[eg * 16 + 8 * HALF + q8] = (_Float16)((float)(keep + __builtin_amdgcn_update_dpp(0, send, 0xB1, 0xf, 0xf, true)) * (sx * 0.0625f));
}
template <int HALF>
__device__ __forceinline__ void peer_v_accum(h2_t (&acc)[8], const PeerBuf& b, const PeerMeta& m) {
#pragma unroll
    for (int i = 0; i < 8; ++i) { const int k = HALF * 8 + i; const unsigned ww = m.p[k >> 3][(k >> 1) & 3];
        const h2_t wp = __builtin_bit_cast(h2_t, ww);
        const h2_t w2 = (k & 1) ? (h2_t){wp.y, wp.y} : (h2_t){wp.x, wp.x};
#pragma unroll
        for (int q = 0; q < 4; ++q) { const unsigned w = b.g[i][q];
            const h2_t lo = __builtin_amdgcn_cvt_scalef32_pk_f16_fp8(w, 1.0f, false), hi2 = __builtin_amdgcn_cvt_scalef32_pk_f16_fp8(w, 1.0f, true);
            if (HALF == 0 && i == 0) { acc[2 * q] = w2 * lo; acc[2 * q + 1] = w2 * hi2; }
            else { acc[2 * q] = __builtin_elementwise_fma(w2, lo, acc[2 * q]); acc[2 * q + 1] = __builtin_elementwise_fma(w2, hi2, acc[2 * q + 1]); } } }
}
__device__ __forceinline__ void peer_v_finish(h2_t (&acch)[8], bf16_t* xrow, const unsigned xr, const f32x2 gf, int q8, int eg) {
    const bool c0 = (eg & 1) != 0, c1 = (eg & 2) != 0, c2 = (eg & 4) != 0;
    h2_t s1[4], s2[2];
#pragma unroll
    for (int k = 0; k < 4; ++k) { const h2_t keep = c0 ? acch[4 + k] : acch[k], send = c0 ? acch[k] : acch[4 + k];
        const int rv = __builtin_amdgcn_update_dpp(0, __builtin_bit_cast(int, send), 0x128, 0xf, 0xf, true);
        s1[k] = keep + __builtin_bit_cast(h2_t, rv); }
#pragma unroll
    for (int k = 0; k < 2; ++k) { const h2_t keep = c1 ? s1[2 + k] : s1[k], send = c1 ? s1[k] : s1[2 + k];
        const unsigned sv = __builtin_bit_cast(unsigned, send); auto r = __builtin_amdgcn_permlane16_swap(sv, sv, false, false);
        const unsigned rv = c1 ? r[0] : r[1];
        s2[k] = keep + __builtin_bit_cast(h2_t, rv); }
    const float f0 = (float)s2[0].x, f1 = (float)s2[0].y, f2 = (float)s2[1].x, f3 = (float)s2[1].y;
    float k2[2];
    { const float keep0 = c2 ? f2 : f0, send0 = c2 ? f0 : f2, keep1 = c2 ? f3 : f1, send1 = c2 ? f1 : f3;
      k2[0] = keep0 + xor32_f(send0, c2); k2[1] = keep1 + xor32_f(send1, c2); }
    const int dim = q8 * 16 + (c0 ? 8 : 0) + (c1 ? 4 : 0) + (c2 ? 2 : 0);
    *(unsigned*)(xrow + dim) = pk_bf16(bf_lo(xr) + gf.x * (k2[0] * (1.0f / 1024.0f)), bf_hi(xr) + gf.y * (k2[1] * (1.0f / 1024.0f)));
}
template <int MODE>
__device__ __forceinline__ void peer_sliced(const Fr& F, const unsigned char* TAB, const unsigned short* PIDX, const unsigned char* H8, const float* SA, const _Float16* PW, _Float16* PD, bf16_t* XR, const float* gate_f) {
    const bool hw = F.xcc_ok != 0, al = (F.G & 7) == 0;
    const int nr = hw ? F.xcc_n : (al ? (F.G >> 3) : F.G), r = hw ? F.xcc_rank : (al ? (F.bid >> 3) : F.bid);
    const int xs_lo = hw ? F.xcc : (al ? (F.bid & 7) : 0), xs_hi = (hw || al) ? xs_lo + 1 : 8;
    const int q8 = F.lane & 7, eg = F.lane >> 3;
    const int stride = nr * 8, tfirst = r + nr * F.wave;
    const int ntok = tfirst < SEQ ? (SEQ - tfirst + stride - 1) / stride : 0;
    for (int xs = xs_lo; xs < xs_hi; ++xs)
        for (int ps = 0; ps < 2; ++ps) {
            const int s = xs * 2 + ps;
            const unsigned lane_off = (unsigned)(s * 2097152 + q8 * 16);
            PeerBuf b0, b1, b2; PeerMeta m0, m1, m2; h2_t acc[8];
            const int vdim = q8 * 16 + ((eg & 1) ? 8 : 0) + ((eg & 2) ? 4 : 0) + ((eg & 4) ? 2 : 0);
            const f32x2 gfv = (MODE == 1) ? *(const f32x2*)(gate_f + s * 128 + vdim) : (f32x2){0.f, 0.f};
#pragma unroll
            for (int q = 0; q < 8; ++q) acc[q] = (h2_t){(_Float16)0.f, (_Float16)0.f};
#define PEER_META(m, t) do { const u32x4* ip_ = (const u32x4*)(PIDX + (size_t)(t) * 128 + eg * 16); (m).id[0] = ip_[0]; (m).id[1] = ip_[1]; \
    if (MODE == 0) { (m).p[0] = *(const u32x4*)(H8 + (size_t)(t) * 2048 + s * 128 + q8 * 16); (m).p[1].x = __float_as_uint(SA[(t)]); } \
    else { const u32x4* wp_ = (const u32x4*)(PW + (size_t)(t) * 128 + eg * 16); (m).p[0] = wp_[0]; (m).p[1] = wp_[1]; \
           (m).xr = *(const unsigned*)(XR + (size_t)(t) * DM + s * 128 + vdim); } } while (0)
#define PEER_TRIP(mc, mn, ml, bx, by, bz, kk, C2, C1) do { const int t = tfirst + (kk) * stride; int xq_[4] = {0, 0, 0, 0}; float sx_ = 0.f; \
                if (C2) PEER_META(ml, t + 2 * stride); \
                if (C1) peer_issue<0>(bz, TAB, lane_off, mn); \
                if (MODE == 0) { peer_u_quant(mc, xq_, sx_); peer_u_compute<0>(bx, xq_, sx_, PD + ((size_t)s * SEQ + t) * 128, q8, eg); } else peer_v_accum<0>(acc, bx, mc); \
                if (C1) peer_issue<1>(bx, TAB, lane_off, mn); \
                if (MODE == 0) peer_u_compute<1>(by, xq_, sx_, PD + ((size_t)s * SEQ + t) * 128, q8, eg); \
                else { peer_v_accum<1>(acc, by, mc); peer_v_finish(acc, XR + (size_t)t * DM + s * 128, (mc).xr, gfv, q8, eg); } } while (0)
            int k = 0;
            if (ntok >= 5) {
                PEER_META(m0, tfirst); PEER_META(m1, tfirst + stride);
                peer_issue<0>(b0, TAB, lane_off, m0); peer_issue<1>(b1, TAB, lane_off, m0);
                for (; k + 4 < ntok; k += 3) {
                    PEER_TRIP(m0, m1, m2, b0, b1, b2, k, true, true);
                    PEER_TRIP(m1, m2, m0, b2, b0, b1, k + 1, true, true);
                    PEER_TRIP(m2, m0, m1, b1, b2, b0, k + 2, true, true);
                }
            } else if (ntok > 0) {
                PEER_META(m0, tfirst);
                if (ntok > 1) PEER_META(m1, tfirst + stride);
                peer_issue<0>(b0, TAB, lane_off, m0); peer_issue<1>(b1, TAB, lane_off, m0);
            }
            for (; k < ntok; k += 3) {
                PEER_TRIP(m0, m1, m2, b0, b1, b2, k, (k + 2 < ntok), (k + 1 < ntok));
                if (k + 1 < ntok) PEER_TRIP(m1, m2, m0, b2, b0, b1, k + 1, (k + 3 < ntok), (k + 2 < ntok));
                if (k + 2 < ntok) PEER_TRIP(m2, m0, m1, b1, b2, b0, k + 2, (k + 4 < ntok), (k + 3 < ntok));
            }
#undef PEER_TRIP
#undef PEER_META
        }
}
__device__ __forceinline__ void peer_weights(const Fr& F, const _Float16* PD, const unsigned short* PIDX, const float* PGATE, const float* SU, const float* SV, _Float16* PW) {
    typedef _Float16 h4_t __attribute__((ext_vector_type(4)));
    constexpr int NB = 4;
    const int step = F.G * NTHR, total = SEQ * 32;
    for (int it0 = F.bid * NTHR + F.tid; it0 < total; it0 += NB * step) {
        bool ok[NB]; size_t o[NB];
#pragma unroll
        for (int k = 0; k < NB; ++k) { ok[k] = it0 + k * step < total; o[k] = (size_t)(ok[k] ? it0 + k * step : it0) * 4; }
        h4_t h[NB][16]; u32x2 iw[NB]; f32x4 g[NB];
#pragma unroll
        for (int k = 0; k < NB; ++k) {
#pragma unroll
            for (int s = 0; s < 16; ++s) h[k][s] = *(const h4_t*)(PD + (size_t)s * SEQ * 128 + o[k]);
            iw[k] = *(const u32x2*)(PIDX + o[k]); g[k] = *(const f32x4*)(PGATE + o[k]); }
        float su[NB][4], sv[NB][4];
#pragma unroll
        for (int k = 0; k < NB; ++k) { const unsigned idx[4] = {iw[k].x & 0xffffu, iw[k].x >> 16, iw[k].y & 0xffffu, iw[k].y >> 16};
#pragma unroll
            for (int e = 0; e < 4; ++e) { su[k][e] = SU[idx[e]]; sv[k][e] = SV[idx[e]]; } }
#pragma unroll
        for (int k = 0; k < NB; ++k) {
            if (!ok[k]) continue;
            f32x4 a = {0.f, 0.f, 0.f, 0.f};
#pragma unroll
            for (int s = 0; s < 16; ++s) a += (f32x4){(float)h[k][s][0], (float)h[k][s][1], (float)h[k][s][2], (float)h[k][s][3]};
            h4_t w;
#pragma unroll
            for (int e = 0; e < 4; ++e) w[e] = (_Float16)(g[k][e] * gelu_tanh(a[e] * (16.0f * su[k][e])) * sv[k][e] * 1024.0f);
            *(h4_t*)(PW + o[k]) = w;
        }
    }
}
__device__ __forceinline__ void final_norm_rows(const Fr& F, const bf16_t* X, const float* g, float* out) {
    f32x4 cs[8];
#pragma unroll
    for (int i = 0; i < 4; ++i) { cs[2 * i] = *(const f32x4*)(g + i * 512 + F.lane * 8); cs[2 * i + 1] = *(const f32x4*)(g + i * 512 + F.lane * 8 + 4); }
    for (int row0 = (F.bid * 8 + F.wave) * 2; row0 < SEQ; row0 += F.G * 16) {
        u32x4 w[2][4];
#pragma unroll
        for (int rr = 0; rr < 2; ++rr)
#pragma unroll
            for (int i = 0; i < 4; ++i) w[rr][i] = *(const u32x4*)(X + (size_t)(row0 + rr) * DM + i * 512 + F.lane * 8);
#pragma unroll
        for (int rr = 0; rr < 2; ++rr) {
            f32x4 v[8]; float ss = 0.f;
#pragma unroll
            for (int i = 0; i < 4; ++i) { v[2 * i] = (f32x4){bf_lo(w[rr][i].x), bf_hi(w[rr][i].x), bf_lo(w[rr][i].y), bf_hi(w[rr][i].y)}; v[2 * i + 1] = (f32x4){bf_lo(w[rr][i].z), bf_hi(w[rr][i].z), bf_lo(w[rr][i].w), bf_hi(w[rr][i].w)}; }
#pragma unroll
            for (int i = 0; i < 8; ++i) ss += v[i][0] * v[i][0] + v[i][1] * v[i][1] + v[i][2] * v[i][2] + v[i][3] * v[i][3];
            ss = wave_sum(ss);
            const float rstd = rsqrtf(ss * (1.0f / DM) + 1e-6f);
#pragma unroll
            for (int i = 0; i < 4; ++i) { float* op = out + (size_t)(row0 + rr) * DM + i * 512 + F.lane * 8; *(f32x4*)op = v[2 * i] * rstd * cs[2 * i]; *(f32x4*)(op + 4) = v[2 * i + 1] * rstd * cs[2 * i + 1]; }
        }
    }
}

__device__ __forceinline__ void gmlp_phase(const Fr& F, const bf16_t* PB, const bf16_t* GMWS, bf16_t* YCAT) {
    const float* gng = F.in[I_GMNG1]; const float* gmb = F.in[I_GMB1];
    LAS float* rstd_s = (LAS float*)F.lds;
    LAS bf16_t* VT = (LAS bf16_t*)(F.lds + 1024);
    LAS bf16_t* AT = (LAS bf16_t*)(F.lds + 1024 + 128 * 136 * 2);
    LAS float* ST = (LAS float*)(F.lds + 1024 + 2 * 128 * 136 * 2);
    for (int unit = F.bid; unit < 256; unit += F.G) {
        const int n = unit >> 1, gh = unit & 1, pos0 = n * 128;
        __syncthreads();
#pragma unroll 1
        for (int r0 = F.wave * 16; r0 < F.wave * 16 + 16; r0 += 8) {
            u32x4 a[8], b[8];
#pragma unroll
            for (int q = 0; q < 8; ++q) { const bf16_t* pr = PB + (size_t)(pos0 + r0 + q) * 5120 + 1024 + F.lane * 16; a[q] = *(const u32x4*)pr; b[q] = *(const u32x4*)(pr + 8); }
#pragma unroll
            for (int q = 0; q < 8; ++q) {
                float ss = 0.f;
#pragma unroll
                for (int e = 0; e < 4; ++e) { ss += bf_lo(a[q][e]) * bf_lo(a[q][e]) + bf_hi(a[q][e]) * bf_hi(a[q][e]) + bf_lo(b[q][e]) * bf_lo(b[q][e]) + bf_hi(b[q][e]) * bf_hi(b[q][e]); }
                ss = wave_sum(ss);
                if (F.lane == 0) rstd_s[r0 + q] = rsqrtf(ss * (1.0f / 1024.0f) + 1e-6f);
            }
        }
        __syncthreads();
        for (int g = gh * 4; g < gh * 4 + 4; ++g) {
            { u32x4 a4[4];
#pragma unroll
              for (int k = 0; k < 4; ++k) { const int ch = F.tid + k * NTHR, p = ch >> 4, q8 = (ch & 15) * 8; a4[k] = *(const u32x4*)(GMWS + (size_t)g * 16384 + p * 128 + q8); }
#pragma unroll
              for (int k = 0; k < 4; ++k) { const int ch = F.tid + k * NTHR, p = ch >> 4, q8 = (ch & 15) * 8; *(LAS u32x4*)(AT + p * 136 + q8) = a4[k]; } }
            { const int q = F.tid >> 2, cp = (F.tid & 3) * 32; const float rs = rstd_s[q];
              const bf16_t* pr = PB + (size_t)(pos0 + q) * 5120 + 1024 + g * 128 + cp;
              u32x4 w4[4]; f32x4 gg[8];
#pragma unroll
              for (int i = 0; i < 4; ++i) { w4[i] = *(const u32x4*)(pr + i * 8); gg[2 * i] = *(const f32x4*)(gng + g * 128 + cp + i * 8); gg[2 * i + 1] = *(const f32x4*)(gng + g * 128 + cp + i * 8 + 4); }
#pragma unroll
              for (int i = 0; i < 4; ++i) { const u32x4 w = w4[i];
                  const float v[8] = {bf_lo(w.x), bf_hi(w.x), bf_lo(w.y), bf_hi(w.y), bf_lo(w.z), bf_hi(w.z), bf_lo(w.w), bf_hi(w.w)};
#pragma unroll
                  for (int e = 0; e < 8; ++e) { const int c = cp + i * 8 + e; VT[c * 136 + q] = f2bf(v[e] * rs * gg[2 * i + (e >> 2)][e & 3]); } } }
            __syncthreads();
            { const int pb = F.wave >> 1, cb0 = (F.wave & 1) * 2, r32 = F.lane & 31, hi = F.lane >> 5;
#pragma unroll
              for (int cbi = 0; cbi < 2; ++cbi) { const int cb = cb0 + cbi; f32x16 acc = {};
#pragma unroll
                  for (int k = 0; k < 8; ++k) { const bf16x8 a = *(const LAS bf16x8*)(AT + (pb * 32 + r32) * 136 + k * 16 + hi * 8), b = *(const LAS bf16x8*)(VT + (cb * 32 + r32) * 136 + k * 16 + hi * 8);
                      acc = __builtin_amdgcn_mfma_f32_32x32x16_bf16(a, b, acc, 0, 0, 0); }
#pragma unroll
                  for (int rr = 0; rr < 16; ++rr) { const int p = pb * 32 + crow32(rr, hi); ST[p * 132 + cb * 32 + r32] = acc[rr] + gmb[g * 128 + p]; } } }
            __syncthreads();
            u32x4 u4[4];
#pragma unroll
            for (int k = 0; k < 4; ++k) { const int ch = F.tid + k * NTHR, p = ch >> 4, c8 = (ch & 15) * 8; u4[k] = *(const u32x4*)(PB + (size_t)(pos0 + p) * 5120 + g * 128 + c8); }
#pragma unroll
            for (int k = 0; k < 4; ++k) { const int ch = F.tid + k * NTHR; const int p = ch >> 4, c8 = (ch & 15) * 8; const size_t pos = (size_t)(pos0 + p);
                const f32x4 s0 = *(const LAS f32x4*)(ST + p * 132 + c8), s1 = *(const LAS f32x4*)(ST + p * 132 + c8 + 4);
                const u32x4 uu = u4[k];
                u32x4 y; y.x = pk_bf16(bf_lo(uu.x) * s0[0], bf_hi(uu.x) * s0[1]); y.y = pk_bf16(bf_lo(uu.y) * s0[2], bf_hi(uu.y) * s0[3]);
                y.z = pk_bf16(bf_lo(uu.z) * s1[0], bf_hi(uu.z) * s1[1]); y.w = pk_bf16(bf_lo(uu.w) * s1[2], bf_hi(uu.w) * s1[3]);
                *(u32x4*)(YCAT + pos * 2048 + g * 128 + c8) = y; }
        }
    }
}
__device__ __forceinline__ void hyena_pre(const Fr& F, const bf16_t* PB, unsigned* Z, bf16_t* G1B, bf16_t* X0B) {
    const float* cw = F.in[I_HYCW1]; const float* cb = F.in[I_HYCB1];
    const int cg = F.tid & 127, c0 = cg * 8;
    float w0[3][8], w1[3][8], w2[3][8], bb[3][8];
#pragma unroll
    for (int pt = 0; pt < 3; ++pt)
#pragma unroll
        for (int e = 0; e < 8; ++e) { const int c = pt * 1024 + c0 + e; w0[pt][e] = cw[c]; w1[pt][e] = cw[3072 + c]; w2[pt][e] = cw[6144 + c]; bb[pt][e] = cb[c]; }
    for (int t = F.bid * 4 + (F.tid >> 7); t < SEQ; t += F.G * 4) {
        u32x4 r[3][3];
#pragma unroll
        for (int dt = 0; dt < 3; ++dt) { const int tt = t + dt - 1; const bool ok = (tt >= 0) && (tt < SEQ);
#pragma unroll
            for (int pt = 0; pt < 3; ++pt) r[dt][pt] = ok ? *(const u32x4*)(PB + (size_t)tt * 5120 + 2048 + pt * 1024 + c0) : (u32x4){0u, 0u, 0u, 0u}; }
        float xs[3][8];
#pragma unroll
        for (int pt = 0; pt < 3; ++pt)
#pragma unroll
            for (int q = 0; q < 4; ++q) {
                xs[pt][2 * q] = w0[pt][2 * q] * bf_lo(r[0][pt][q]) + w1[pt][2 * q] * bf_lo(r[1][pt][q]) + w2[pt][2 * q] * bf_lo(r[2][pt][q]) + bb[pt][2 * q];
                xs[pt][2 * q + 1] = w0[pt][2 * q + 1] * bf_hi(r[0][pt][q]) + w1[pt][2 * q + 1] * bf_hi(r[1][pt][q]) + w2[pt][2 * q + 1] * bf_hi(r[2][pt][q]) + bb[pt][2 * q + 1];
            }
        float g1[8];
#pragma unroll
        for (int e = 0; e < 8; ++e) g1[e] = xs[1][e] * xs[2][e];
        *(u32x4*)(Z + (size_t)t * ZP + (c0 >> 1)) = (u32x4){pk_h2((f32x2){g1[0] * 0.125f, g1[1] * 0.125f}), pk_h2((f32x2){g1[2] * 0.125f, g1[3] * 0.125f}),
                                                              pk_h2((f32x2){g1[4] * 0.125f, g1[5] * 0.125f}), pk_h2((f32x2){g1[6] * 0.125f, g1[7] * 0.125f})};
        *(u32x4*)(G1B + (size_t)t * 1024 + c0) = (u32x4){pk_bf16(g1[0], g1[1]), pk_bf16(g1[2], g1[3]), pk_bf16(g1[4], g1[5]), pk_bf16(g1[6], g1[7])};
        *(u32x4*)(X0B + (size_t)t * 1024 + c0) = (u32x4){pk_bf16(xs[0][0], xs[0][1]), pk_bf16(xs[0][2], xs[0][3]), pk_bf16(xs[0][4], xs[0][5]), pk_bf16(xs[0][6], xs[0][7])};
    }
}

__device__ __forceinline__ f32x2 cmul(f32x2 a, f32x2 b) { return (f32x2){a.x * b.x - a.y * b.y, a.x * b.y + a.y * b.x}; }
template <bool INV>
__device__ __forceinline__ void fft32(f32x2 (&v)[32]) {
    constexpr float CS[16] = {1.0f, 0.98078528040323043f, 0.92387953251128674f, 0.83146961230254524f, 0.70710678118654752f, 0.55557023301960218f, 0.38268343236508977f, 0.19509032201612825f,
                              0.0f, -0.19509032201612825f, -0.38268343236508977f, -0.55557023301960218f, -0.70710678118654752f, -0.83146961230254524f, -0.92387953251128674f, -0.98078528040323043f};
    constexpr float SN[16] = {0.0f, 0.19509032201612825f, 0.38268343236508977f, 0.55557023301960218f, 0.70710678118654752f, 0.83146961230254524f, 0.92387953251128674f, 0.98078528040323043f,
                              1.0f, 0.98078528040323043f, 0.92387953251128674f, 0.83146961230254524f, 0.70710678118654752f, 0.55557023301960218f, 0.38268343236508977f, 0.19509032201612825f};
#pragma unroll
    for (int s = 0; s < 5; ++s) {
        const int half = 16 >> s;
#pragma unroll
        for (int i = 0; i < 32; ++i) {
            if ((i & half) == 0) {
                const int j = i | half, tw = (i & (half - 1)) << s;
                const f32x2 a = v[i], b = v[j];
                v[i] = a + b;
                const f32x2 d = a - b;
                const float c = CS[tw], sn = INV ? SN[tw] : -SN[tw];
                v[j] = (f32x2){d.x * c - d.y * sn, d.x * sn + d.y * c};
            }
        }
    }
}
__host__ __device__ constexpr int brev5(int k) { return ((k & 1) << 4) | ((k & 2) << 2) | (k & 4) | ((k & 8) >> 2) | ((k & 16) >> 4); }

template <int MP, bool INV, int MODE>
__device__ __forceinline__ void fft_pass(const Fr& F, const unsigned* Zs, unsigned* Zb, const bf16_t* G1B, const bf16_t* X0B, const float* hbias, bf16_t* YCAT) {
    constexpr int S = 32 * MP, NIT = 1024 * 512;
    const int step = F.G * NTHR;
    int it = F.bid * NTHR + F.tid;
    unsigned raw[32];
#define FFT_LOAD(itx) do { const int cp_ = (itx) & 511, j_ = (itx) >> 9, nl_ = j_ % MP, sb_ = j_ / MP; const size_t b_ = ((size_t)sb_ * S + nl_) * ZP + cp_; \
        _Pragma("unroll") for (int m = 0; m < 32; ++m) raw[m] = (MODE == 1 && m >= 16) ? 0u : Zs[b_ + (size_t)m * MP * ZP]; } while (0)
    if (it < NIT) FFT_LOAD(it);
    for (; it < NIT; it += step) {
        const int cp = it & 511, j = it >> 9, n_lo = j % MP, sblk = j / MP;
        const size_t base = ((size_t)sblk * S + n_lo) * ZP + cp;
        f32x2 v[32];
#pragma unroll
        for (int m = 0; m < 32; ++m) v[m] = un_h2(raw[m]);
        if (it + step < NIT) FFT_LOAD(it + step);
        if (!INV) {
            fft32<false>(v);
#pragma unroll
            for (int k = 0; k < 32; ++k) {
                f32x2 o = v[brev5(k)];
                if (MP > 1 && k > 0) { const float fr = (float)(n_lo * k) * (1.0f / (float)S); const f32x2 w = {__builtin_amdgcn_cosf(fr), -__builtin_amdgcn_sinf(fr)}; o = cmul(o, w); }
                Zb[base + (size_t)k * MP * ZP] = pk_h2(o);
            }
        } else {
            if (MP > 1) {
#pragma unroll
                for (int k = 1; k < 32; ++k) { const float fr = (float)(n_lo * k) * (1.0f / (float)S); const f32x2 w = {__builtin_amdgcn_cosf(fr), __builtin_amdgcn_sinf(fr)}; v[k] = cmul(v[k], w); }
            }
            fft32<true>(v);
#pragma unroll
            for (int m = 0; m < 32; ++m) {
                const f32x2 o = v[brev5(m)];
                if (MODE != 2) Zb[base + (size_t)m * MP * ZP] = pk_h2(o);
                else if (m < 16) {
                    const int nrow = sblk * S + n_lo + m * MP;
                    const unsigned g1w = *(const unsigned*)(G1B + (size_t)nrow * 1024 + cp * 2), x0w = *(const unsigned*)(X0B + (size_t)nrow * 1024 + cp * 2);
                    const f32x2 hb = *(const f32x2*)(hbias + cp * 2);
                    const float ya = bf_lo(x0w) * (o.x * (1.0f / 128.0f) + hb.x * bf_lo(g1w)), yb = bf_hi(x0w) * (o.y * (1.0f / 128.0f) + hb.y * bf_hi(g1w));
                    *(unsigned*)(YCAT + (size_t)nrow * 2048 + 1024 + cp * 2) = pk_bf16(ya, yb);
                }
            }
        }
    }
#undef FFT_LOAD
}
__device__ __forceinline__ int fft_pos(int k) { return ((k & 31) << 10) | (((k >> 5) & 31) << 5) | (k >> 10); }
__device__ __forceinline__ void fft_pointwise(const Fr& F, unsigned* Zb, const unsigned* Kb, const float* FNORM) {
    constexpr int N = 32768, NIT = (N / 2 + 1) * 512;
    const int step = F.G * NTHR;
    for (int it0 = F.bid * NTHR + F.tid; it0 < NIT; it0 += 4 * step) {
        unsigned z1[4], z2[4], q1[4], q2[4]; size_t p1[4], p2[4]; bool ok[4], two[4];
#pragma unroll
        for (int u = 0; u < 4; ++u) { const int it = it0 + u * step; ok[u] = it < NIT; const int itc = ok[u] ? it : it0;
            const int cp = itc & 511, k = itc >> 9, k2 = (N - k) & (N - 1);
            p1[u] = (size_t)fft_pos(k) * ZP + cp; p2[u] = (size_t)fft_pos(k2) * ZP + cp; two[u] = (k2 != k);
            z1[u] = Zb[p1[u]]; z2[u] = Zb[p2[u]]; q1[u] = Kb[p1[u]]; q2[u] = Kb[p2[u]]; }
        const int cp = it0 & 511;
        const float na = FNORM[cp * 2] * (0.25f * 8.0f / 256.0f), nb = FNORM[cp * 2 + 1] * (0.25f * 8.0f / 256.0f);
#pragma unroll
        for (int u = 0; u < 4; ++u) {
            if (!ok[u]) continue;
            const f32x2 a1 = un_h2(z1[u]), a2 = un_h2(z2[u]), b1 = un_h2(q1[u]), b2 = un_h2(q2[u]);
            const f32x2 ga = {a1.x + a2.x, a1.y - a2.y}, gb = {a1.y + a2.y, -(a1.x - a2.x)};
            const f32x2 ka = {(b1.x + b2.x) * na, (b1.y - b2.y) * na}, kb = {(b1.y + b2.y) * nb, -(b1.x - b2.x) * nb};
            const f32x2 ya = cmul(ga, ka), yb = cmul(gb, kb);
            Zb[p1[u]] = pk_h2((f32x2){ya.x - yb.y, ya.y + yb.x});
            if (two[u]) Zb[p2[u]] = pk_h2((f32x2){ya.x + yb.y, -ya.y + yb.x});
        }
    }
}

#ifndef MK_PER_PHASE
#define MK_PER_PHASE 0
#endif
enum { PH_PRO = 0, PH_NORM0, PH_IN0, PH_POST0, PH_UP0, PH_KQ, PH_ATT, PH_QY0, PH_OUT0, PH_PNORM0, PH_PQ0, PH_SEL0, PH_U0, PH_W0, PH_V0, PH_N1,
       PH_IN1, PH_POST1, PH_F1, PH_F2, PH_F3, PH_PWISE, PH_I1, PH_I2, PH_I3, PH_QY1, PH_OUT1, PH_PNORM1, PH_PQ1, PH_SEL1, PH_U1, PH_W1, PH_V1, PH_FIN, NPH };
#ifndef PROBE_SEQ
#define PROBE_SEQ 0
#endif

__global__ void __launch_bounds__(NTHR, 2) mk_fwd(Params P) {
    extern __shared__ __attribute__((aligned(16))) unsigned char lds_raw[];
    Fr F;
    F.in = P.in; F.out = P.out; F.ws = P.ws; F.lds = (LAS unsigned char*)lds_raw;
    F.tid = threadIdx.x; F.lane = F.tid & 63; F.wave = __builtin_amdgcn_readfirstlane(F.tid >> 6); F.G = gridDim.x; F.bid = blockIdx.x;
    unsigned char* ws = P.ws;
    const int lo = P.ph_lo, hi = P.ph_hi;
    volatile LAS unsigned* xbw = (volatile LAS unsigned*)(F.lds + LDS_CTL);
    if (F.tid < 4) xbw[F.tid] = 0u;
    __syncthreads();
    XcdBarrier bar; bar.bar = (unsigned*)(ws + WS_CTL); bar.x = 0; bar.st = xbw;
    if (hi - lo > 1) bar = xcd_barrier_post((unsigned*)(ws + WS_CTL), xbw);
    if (F.tid == 0) { const unsigned x = xb_xcc_id(); xbw[2] = x; xbw[3] = (hi - lo > 1) ? xb_add((unsigned*)(ws + WS_CTL) + 8192 + 64 * x, 1u) : 0u; }
    __syncthreads();
    F.xcc = (int)xbw[2]; F.xcc_rank = (int)xbw[3]; F.xcc_n = 0; F.xcc_ok = 0;
#define XCC_REFRESH() do { const unsigned nl_ = xbw[0], nx_ = xbw[1]; F.xcc_n = (int)nl_; F.xcc_ok = (hi - lo > 1) && nx_ == 8u && nl_ > 0u && F.xcc < 8 && F.xcc_rank < (int)nl_; } while (0)
#ifdef ONLY_PHASE
#define IN(k) ((k) == ONLY_PHASE && lo <= (k) && (k) < hi)
#else
#define IN(k) (lo <= (k) && (k) < hi)
#endif
#define SEAM(k) do { if (IN(k) && IN((k) + 1)) xcd_barrier(bar); } while (0)

    float* MOD0 = (float*)(ws + WS_MOD0); float* MOD1 = (float*)(ws + WS_MOD1); float* MC0 = (float*)(ws + WS_MC0);
    float* ROPEC = (float*)(ws + WS_ROPEC); float* ROPES = (float*)(ws + WS_ROPES);
    float* FPART = (float*)(ws + WS_FPART); float* FNORM = (float*)(ws + WS_FNORM);
    bf16_t* KEYS0 = (bf16_t*)(ws + WS_KEYS0); bf16_t* KEYS1 = (bf16_t*)(ws + WS_KEYS1); bf16_t* GMWS = (bf16_t*)(ws + WS_GMWS);
    bf16_t* WIN0 = (bf16_t*)(ws + WS_WIN0); bf16_t* WUQ = (bf16_t*)(ws + WS_WUQ); bf16_t* WUKV = (bf16_t*)(ws + WS_WUKV);
    bf16_t* WOUT0 = (bf16_t*)(ws + WS_WOUT0); bf16_t* WPQ0 = (bf16_t*)(ws + WS_WPQ0);
    bf16_t* WIN1 = (bf16_t*)(ws + WS_WIN1); bf16_t* WOUT1 = (bf16_t*)(ws + WS_WOUT1); bf16_t* WPQ1 = (bf16_t*)(ws + WS_WPQ1);
    unsigned char* TABU = ws + WS_TABU; unsigned char* TABV = ws + WS_TABV; float* TSC = (float*)(ws + WS_TSC);
    float* SA = (float*)(ws + WS_SA); float* SW = (float*)(ws + WS_SW); unsigned char* H8 = ws + WS_H;
    bf16_t* XR = (bf16_t*)(ws + WS_XR); bf16_t* H = (bf16_t*)(ws + WS_H); bf16_t* PBUF = (bf16_t*)(ws + WS_PBUF);
    bf16_t* QN = (bf16_t*)(ws + WS_QN); bf16_t* KVN = (bf16_t*)(ws + WS_KVN); bf16_t* KROPE = (bf16_t*)(ws + WS_KROPE);
    bf16_t* Q = (bf16_t*)(ws + WS_Q); bf16_t* KV = (bf16_t*)(ws + WS_KV); bf16_t* YCAT = (bf16_t*)(ws + WS_YCAT);
    unsigned* Z = (unsigned*)(ws + WS_Z); unsigned* KZ = (unsigned*)(ws + WS_KZ); unsigned* KZ2 = (unsigned*)(ws + WS_KZ2);
    bf16_t* G1B = (bf16_t*)(ws + WS_G1B); bf16_t* X0B = (bf16_t*)(ws + WS_X0B);
    bf16_t* PQ = PBUF;
    unsigned short* PIDX = (unsigned short*)(ws + WS_YCAT); float* PGATE = (float*)(ws + WS_YCAT + 8388608); _Float16* PW = (_Float16*)(ws + WS_YCAT + 16777216);
    _Float16* PD = (_Float16*)(ws + WS_L0X);

    if (IN(PH_PRO)) {
        const int fl = P.flags;
        const bool late_ = ((F.bid >> 3) & 1) != 0;
        if (!(fl & 2) && !late_) {
        modgemv(F, P.in[I_C], P.in[I_CCTX], P.in[I_WMOD0], P.in[I_BMOD0], MOD0, MC0, 4096);
        }
        if (!(fl & 4)) {
        colmax_task(F, P.in[I_WIN0], 2048, 3904, 4096, SW);
        tconv_task(F, P.in[I_WUQ0], 512, 1536, 1536, WUQ);
        tconv_task(F, P.in[I_WUKV0], 256, 2048, 2048, WUKV);
        }
        if (!(fl & 16)) {
        cvt_task(F, P.in[I_PKEYS0], KEYS0, 32768 / 8);
        cvt_task(F, P.in[I_PKEYS1], KEYS1, 32768 / 8);
        cvt_task(F, P.in[I_GMWS1], GMWS, 131072 / 8);
        rope_tables(F, ROPEC, ROPES);
        hyena_filter_gen(F, KZ, FPART);
        }
        if (!(fl & 2) && late_) {
        modgemv(F, P.in[I_C], P.in[I_CCTX], P.in[I_WMOD0], P.in[I_BMOD0], MOD0, MC0, 4096);
        }
        if (!(fl & 8)) {
        }
    }
    SEAM(PH_PRO);
    if (IN(PH_NORM0)) {
        tconv_q_task(F, P.in[I_WIN0], 2048, 3904, 4096, SW, (unsigned char*)WIN0);
        norm_rows<true>(F, P.in[I_X], SEQ, P.in[I_LN1G0], MOD0 + 2048, MOD0, nullptr, H8, SA);
        norm_rows<true>(F, P.in[I_CTX], CTXL, P.in[I_LN1G0], MC0 + 2048, MC0, nullptr, H8 + (size_t)SEQ * 2048, SA + SEQ);
        hyena_filter_norm(F, FPART, FNORM);
        fft_pass<1024, false, 0>(F, KZ, KZ2, nullptr, nullptr, nullptr, nullptr);
    }
    SEAM(PH_NORM0);
    if (IN(PH_IN0)) {
        pg8::Gemm g{(const bf16_t*)H8, (const bf16_t*)WIN0, SEQ, 4096, 1024}; OrderIn0 S; S.init2(F.G, F.bid);
        EpiI8G E{PBUF, 4096, 0, SA, SW};
        pg8::gemm_phase<EpiI8G, OrderIn0, false>(F.lds, g, S, E, nullptr);
        const bool sh = F.G > 2;
        if (!sh || F.bid >= 2) {
            Fr F2 = F; if (sh) { F2.bid -= 2; F2.G -= 2; }
            __syncthreads();
            { Fr R = F2; const int g2 = F2.G;
              colmax_task(R, P.in[I_WIN1], 2048, 5120, 5120, SW + 6144);
              R.bid = (F2.bid + g2 - 160 % g2) % g2; colmax_task(R, P.in[I_PWQ1], 2048, 2048, 2048, SW + 11264);
              R.bid = (F2.bid + g2 - 224 % g2) % g2; colmax_task(R, P.in[I_PWQ0], 2048, 2048, 2048, SW + 4096);
              R.bid = (F2.bid + g2 - 288 % g2) % g2; colmax_task(R, P.in[I_WOUT1], 2048, 2048, 2048, SW + 15360);
              R.bid = (F2.bid + g2 - 352 % g2) % g2; colmax_task(R, P.in[I_WOUT0], 2048, 2048, 2048, SW + 13312); }
            cvt_table<false>(F2, P.in[I_PU1], TABU + (size_t)33554432, TSC + 32768);
        }
    }
    SEAM(PH_IN0);
    if (IN(PH_POST0)) {
        l0_post_proj(F, PBUF, QN, KVN, KROPE, YCAT, ROPEC, ROPES, NKEY);
        fft_pass<32, false, 0>(F, KZ2, KZ, nullptr, nullptr, nullptr, nullptr);
    }
    SEAM(PH_POST0);
    if (IN(PH_UP0)) {
        { pg8::Gemm g{QN, WUQ, SEQ, 1536, 512}; pg8::StaticOrder S; S.init(SEQ, 1536, F.G, F.bid);
          EpiQRope E{Q, ROPEC, ROPES};
          pg8::gemm_phase<EpiQRope, pg8::StaticOrder, false>(F.lds, g, S, E, nullptr); }
        { pg8::Gemm g{KVN, WUKV, NKEY, 2048, 256}; OrderKV S; S.init(NKEY, 2048, F.G, F.bid);
          EpiBf16G E{KV, 2048, 0};
          pg8::gemm_phase<EpiBf16G, OrderKV, false>(F.lds, g, S, E, nullptr); }
    }
    SEAM(PH_UP0);
    unsigned char* K8N = (unsigned char*)PBUF; unsigned char* K8R = K8N + (size_t)8 * NKEY * 128; float* SKT = (float*)(K8R + (size_t)8 * NKEY * 64);
    if (IN(PH_KQ)) att::kq_phase(F, KV, KROPE, K8N, K8R, SKT, NKEY);
    SEAM(PH_KQ);
    if (IN(PH_ATT)) {
        const int nu = F.bid < 512 ? (512 - F.bid + F.G - 1) / F.G : 0;
        const int grp = (F.bid >> 3) % 3, slot = grp < nu ? grp : nu;
        for (int i = 0; i <= nu; ++i) {
            if (i == slot) {
                Fr F3 = F;
                asm volatile("" : "+v"(F3.tid), "+v"(F3.lane));
                asm volatile("" : "+s"(F3.bid), "+s"(F3.wave), "+s"(F3.G));
                tconv_q_task(F3, P.in[I_WOUT0], 2048, 2048, 2048, SW + 13312, (unsigned char*)WOUT0);
                tconv_q_task(F3, P.in[I_WOUT1], 2048, 2048, 2048, SW + 15360, (unsigned char*)WOUT1);
                tconv_q_task(F3, P.in[I_PWQ0], 2048, 2048, 2048, SW + 4096, (unsigned char*)WPQ0);
                tconv_q_task(F3, P.in[I_PWQ1], 2048, 2048, 2048, SW + 11264, (unsigned char*)WPQ1);
                tconv_q_task(F3, P.in[I_WIN1], 2048, 5120, 5120, SW + 6144, (unsigned char*)WIN1);
                cvt_table<false>(F3, P.in[I_PU0], TABU, TSC);
                cvt_table<true>(F3, P.in[I_PV0], TABV, TSC + 16384);
                cvt_table<true>(F3, P.in[I_PV1], TABV + (size_t)33554432, TSC + 49152);
                modgemv(F3, P.in[I_C], nullptr, P.in[I_WMOD1], P.in[I_BMOD1], MOD1, nullptr, 0);
            }
            if (i < nu) {
                const int u = F.bid + i * F.G, h = u & 7, qb = u >> 3;
                att::attn_body8(Q + (size_t)qb * 256 * 1536 + h * 192, K8N + (size_t)h * NKEY * 128, K8R + (size_t)h * NKEY * 64, SKT + h * (NKEY / 64), KV + h * 256 + 128,
                                YCAT + (size_t)qb * 256 * 2048 + 1024 + h * 128, NKEY, F.lds);
            }
        }
    }
    SEAM(PH_ATT);
    if (IN(PH_QY0)) quant_rows(F, YCAT, H8, SA);
    SEAM(PH_QY0);
    if (IN(PH_OUT0)) {
        pg8::Gemm g{(const bf16_t*)H8, (const bf16_t*)WOUT0, SEQ, 2048, 1024}; pg8::StaticOrder S; S.init(SEQ, 2048, F.G, F.bid);
        EpiResid<true, true> E{P.in[I_X], XR, MOD0 + 4096, SA, SW + 13312};
        pg8::gemm_phase<EpiResid<true, true>, pg8::StaticOrder, false>(F.lds, g, S, E, nullptr);
    }
    SEAM(PH_OUT0);
    if (IN(PH_PNORM0)) {
        norm_rows_b<true>(F, XR, P.in[I_LN2G0], MOD0 + 8192, MOD0 + 6144, nullptr, H8, SA);
        fft_pass<1, false, 0>(F, KZ, KZ2, nullptr, nullptr, nullptr, nullptr);
    }
    SEAM(PH_PNORM0);
    if (IN(PH_PQ0)) {
        pg8::Gemm g{(const bf16_t*)H8, (const bf16_t*)WPQ0, SEQ, 2048, 1024}; pg8::StaticOrder S; S.init(SEQ, 2048, F.G, F.bid);
        EpiI8G E{PQ, 2048, 0, SA, SW + 4096};
        pg8::gemm_phase<EpiI8G, pg8::StaticOrder, false>(F.lds, g, S, E, nullptr);
    }
    SEAM(PH_PQ0);
    if (IN(PH_SEL0)) peer_select(F, PQ, KEYS0, PIDX, PGATE);
    SEAM(PH_SEL0);
    XCC_REFRESH();
    if (IN(PH_U0)) peer_sliced<0>(F, TABU, PIDX, H8, SA, nullptr, PD, nullptr, nullptr);
    SEAM(PH_U0);
    if (IN(PH_W0)) peer_weights(F, PD, PIDX, PGATE, TSC, TSC + 16384, PW);
    SEAM(PH_W0);
    XCC_REFRESH();
    if (IN(PH_V0)) peer_sliced<1>(F, TABV, PIDX, nullptr, nullptr, PW, nullptr, XR, (P.flags & 1) ? (const float*)(ws + WS_CTL + 40960) : MOD0 + 10240);
    SEAM(PH_V0);
    if (IN(PH_N1)) norm_rows_b<true>(F, XR, P.in[I_LN1G1], MOD1 + 2048, MOD1, nullptr, H8, SA);
    SEAM(PH_N1);
    if (IN(PH_IN1)) {
        pg8::Gemm g{(const bf16_t*)H8, (const bf16_t*)WIN1, SEQ, 5120, 1024}; pg8::StaticOrder S; S.init(SEQ, 5120, F.G, F.bid);
        EpiI8G E{PBUF, 5120, 2048, SA, SW + 6144};
        pg8::gemm_phase<EpiI8G, pg8::StaticOrder, false>(F.lds, g, S, E, nullptr);
    }
    SEAM(PH_IN1);
    if (IN(PH_POST1)) {
        gmlp_phase(F, PBUF, GMWS, YCAT);
        hyena_pre(F, PBUF, Z, G1B, X0B);
    }
    SEAM(PH_POST1);
    if (IN(PH_F1)) fft_pass<1024, false, 1>(F, Z, Z, nullptr, nullptr, nullptr, nullptr);
    SEAM(PH_F1);
    if (IN(PH_F2)) fft_pass<32, false, 0>(F, Z, Z, nullptr, nullptr, nullptr, nullptr);
    SEAM(PH_F2);
    if (IN(PH_F3)) fft_pass<1, false, 0>(F, Z, Z, nullptr, nullptr, nullptr, nullptr);
    SEAM(PH_F3);
    if (IN(PH_PWISE)) fft_pointwise(F, Z, KZ2, FNORM);
    SEAM(PH_PWISE);
    if (IN(PH_I1)) fft_pass<1, true, 0>(F, Z, Z, nullptr, nullptr, nullptr, nullptr);
    SEAM(PH_I1);
    if (IN(PH_I2)) fft_pass<32, true, 0>(F, Z, Z, nullptr, nullptr, nullptr, nullptr);
    SEAM(PH_I2);
    if (IN(PH_I3)) fft_pass<1024, true, 2>(F, Z, Z, G1B, X0B, P.in[I_HYBIAS1], YCAT);
    SEAM(PH_I3);
    if (IN(PH_QY1)) quant_rows(F, YCAT, H8, SA);
    SEAM(PH_QY1);
    if (IN(PH_OUT1)) {
        pg8::Gemm g{(const bf16_t*)H8, (const bf16_t*)WOUT1, SEQ, 2048, 1024}; pg8::StaticOrder S; S.init(SEQ, 2048, F.G, F.bid);
        EpiResid<false, true> E{XR, XR, MOD1 + 4096, SA, SW + 15360};
        pg8::gemm_phase<EpiResid<false, true>, pg8::StaticOrder, false>(F.lds, g, S, E, nullptr);
    }
    SEAM(PH_OUT1);
    if (IN(PH_PNORM1)) norm_rows_b<true>(F, XR, P.in[I_LN2G1], MOD1 + 8192, MOD1 + 6144, nullptr, H8, SA);
    SEAM(PH_PNORM1);
    if (IN(PH_PQ1)) {
        pg8::Gemm g{(const bf16_t*)H8, (const bf16_t*)WPQ1, SEQ, 2048, 1024}; pg8::StaticOrder S; S.init(SEQ, 2048, F.G, F.bid);
        EpiI8G E{PQ, 2048, 0, SA, SW + 11264};
        pg8::gemm_phase<EpiI8G, pg8::StaticOrder, false>(F.lds, g, S, E, nullptr);
    }
    SEAM(PH_PQ1);
    if (IN(PH_SEL1)) peer_select(F, PQ, KEYS1, PIDX, PGATE);
    SEAM(PH_SEL1);
    XCC_REFRESH();
    if (IN(PH_U1)) peer_sliced<0>(F, TABU + (size_t)33554432, PIDX, H8, SA, nullptr, PD, nullptr, nullptr);
    SEAM(PH_U1);
    if (IN(PH_W1)) peer_weights(F, PD, PIDX, PGATE, TSC + 32768, TSC + 49152, PW);
    SEAM(PH_W1);
    XCC_REFRESH();
    if (IN(PH_V1)) peer_sliced<1>(F, TABV + (size_t)33554432, PIDX, nullptr, nullptr, PW, nullptr, XR, MOD1 + 10240);
    SEAM(PH_V1);
    if (IN(PH_FIN)) final_norm_rows(F, XR, P.in[I_FINALG], P.out);
#undef IN
#undef SEAM
}

#include <cstdio>
extern "C" void kernel_launch(void* const* d_in, const int* in_sizes, int n_in, void* d_out, int out_size, void* d_ws, size_t ws_size, hipStream_t stream) {
    static int grid = 0;
    if (grid == 0) {
        if (n_in != 43 || in_sizes[0] != SEQ * DM || out_size != SEQ * DM || ws_size < WS_END) {
            fprintf(stderr, "kernel_launch: unexpected shapes: n_in %d in0 %d out %d ws %zu (need %zu)\n", n_in, n_in > 0 ? in_sizes[0] : -1, out_size, ws_size, (size_t)WS_END); grid = -1; return; }
        int dev = 0, cus = 0, per_cu = 0;
        if (hipGetDevice(&dev) != hipSuccess || hipDeviceGetAttribute(&cus, hipDeviceAttributeMultiprocessorCount, dev) != hipSuccess) { grid = -1; return; }
        if (hipFuncSetAttribute((const void*)mk_fwd, hipFuncAttributeMaxDynamicSharedMemorySize, LDS_BYTES) != hipSuccess) { fprintf(stderr, "kernel_launch: hipFuncSetAttribute failed\n"); grid = -1; return; }
        if (hipOccupancyMaxActiveBlocksPerMultiprocessor(&per_cu, (const void*)mk_fwd, NTHR, LDS_BYTES) != hipSuccess || per_cu < 1) { fprintf(stderr, "kernel_launch: occupancy query says %d blocks per CU\n", per_cu); (void)hipGetLastError(); grid = -1; return; }
        grid = cus;
    }
    if (grid < 0) return;
    (void)hipMemsetAsync((char*)d_ws + WS_CTL, 0, 65536, stream);
    Params p{};
    for (int i = 0; i < 43; ++i) p.in[i] = (const float*)d_in[i];
    p.out = (float*)d_out; p.ws = (unsigned char*)d_ws;
#if MK_PER_PHASE
    for (int ph = 0; ph < NPH; ++ph) { p.ph_lo = ph; p.ph_hi = ph + 1; hipLaunchKernelGGL(mk_fwd, dim3(grid), dim3(NTHR), LDS_BYTES, stream, p); }
#else
#if PROBE_SEQ == 0
    p.ph_lo = 0; p.ph_hi = NPH;
    hipLaunchKernelGGL(mk_fwd, dim3(grid), dim3(NTHR), LDS_BYTES, stream, p);
#elif PROBE_SEQ == 40
    p.ph_lo = 0; p.ph_hi = NPH;
    hipLaunchKernelGGL(mk_fwd, dim3(grid), dim3(NTHR), LDS_BYTES, stream, p);
    for (int r = 0; r < 6; ++r) for (int ph = PROBE_LO; ph < PROBE_HI; ++ph) { p.ph_lo = ph; p.ph_hi = ph + 1; p.flags = 32; hipLaunchKernelGGL(mk_fwd, dim3(grid), dim3(NTHR), LDS_BYTES, stream, p); }
#elif PROBE_SEQ >= 20
    p.ph_lo = 0; p.ph_hi = NPH;
    hipLaunchKernelGGL(mk_fwd, dim3(grid), dim3(NTHR), LDS_BYTES, stream, p);
    for (int r = 0; r < 8; ++r) { p.ph_lo = 0; p.ph_hi = 1; p.flags = PROBE_FLAGS; hipLaunchKernelGGL(mk_fwd, dim3(grid), dim3(NTHR), LDS_BYTES, stream, p); }
#else
    static const int seq[][2] = {
#if PROBE_SEQ == 1
        {0, PH_U0 + 1}, {PH_U0, PH_U0 + 1}, {PH_U0 + 1, NPH}
#elif PROBE_SEQ == 2
        {0, PH_SEL0 + 1}, {PH_SEL0, PH_SEL0 + 1}, {PH_SEL0 + 1, NPH}
#elif PROBE_SEQ == 10
        {0, PH_W0 + 1}, {PH_W0, PH_W0 + 1}, {PH_W0 + 1, NPH}
#elif PROBE_SEQ == 11
        {0, 1}, {0, 1}, {1, NPH}
#elif PROBE_SEQ == 12
        {0, PH_POST1 + 1}, {PH_POST1, PH_POST1 + 1}, {PH_POST1 + 1, NPH}
#elif PROBE_SEQ == 13
        {0, PH_OUT1}, {PH_POST1, PH_OUT1}, {PH_OUT1, NPH}
#elif PROBE_SEQ == 15
        {0, PH_PQ0 + 1}, {PH_PQ0, PH_PQ0 + 1}, {PH_PQ0 + 1, NPH}
#elif PROBE_SEQ == 16
        {0, PH_IN0 + 1}, {PH_IN0, PH_IN0 + 1}, {PH_IN0 + 1, NPH}
#elif PROBE_SEQ == 14
        {0, PH_N1 + 1}, {PH_N1, PH_N1 + 1}, {PH_N1 + 1, NPH}
#elif PROBE_SEQ == 99
        {0, 0}
#elif PROBE_SEQ == 3
        {0, PH_UP0 + 1}, {PH_UP0, PH_UP0 + 1}, {PH_UP0 + 1, NPH}
#elif PROBE_SEQ == 5
        {0, PH_IN1 + 1}, {PH_IN1, PH_IN1 + 1}, {PH_IN1 + 1, NPH}
#elif PROBE_SEQ == 6
        {0, PH_OUT0 + 1}, {PH_OUT0, PH_OUT0 + 1}, {PH_OUT0 + 1, NPH}
#elif PROBE_SEQ == 7
        {0, PH_NORM0 + 1}, {PH_NORM0, PH_NORM0 + 1}, {PH_NORM0 + 1, NPH}
#elif PROBE_SEQ == 8
        {0, PH_POST0 + 1}, {PH_POST0, PH_POST0 + 1}, {PH_POST0 + 1, NPH}
#elif PROBE_SEQ == 9
        {0, PH_PNORM0 + 1}, {PH_PNORM0, PH_PNORM0 + 1}, {PH_PNORM0 + 1, NPH}
#elif PROBE_SEQ == 4
        {0, PH_V0 + 1}, {-PH_V0, PH_V0 + 1}, {PH_V0 + 1, NPH}
#endif
    };
#if PROBE_SEQ == 99
    for (int ph = 0; ph < NPH; ++ph) { p.ph_lo = ph; p.ph_hi = ph + 1; hipLaunchKernelGGL(mk_fwd, dim3(grid), dim3(NTHR), LDS_BYTES, stream, p); }
#endif
    for (unsigned i = 0; i < sizeof(seq) / sizeof(seq[0]); ++i) {
        if (PROBE_SEQ == 99) break;
        (void)hipMemsetAsync((char*)d_ws + WS_CTL, 0, 65536, stream);
        p.ph_lo = seq[i][0] < 0 ? -seq[i][0] : seq[i][0]; p.ph_hi = seq[i][1]; p.flags = seq[i][0] < 0 ? 1 : 0;
        hipLaunchKernelGGL(mk_fwd, dim3(grid), dim3(NTHR), LDS_BYTES, stream, p);
    }
#endif
#endif
    const hipError_t le = hipPeekAtLastError();
    if (le != hipSuccess) fprintf(stderr, "kernel_launch: launch failed: %s\n", hipGetErrorName(le));
}
```
